# Optimizing an MI355X kernel written in HIP

```python
import math
import jax, jax.numpy as jnp
from jax import lax
import numpy as np

D_MODEL = 1024
BATCH = 16
SEQ = 4096
DEPTH = 2

HEAD_DIM = 64
Q_BLOCK = 128
A_HEADS = 4
IDX_HEADS = 4
IDX_DIM = 32
DSA_TOPK = 256
B_HEADS = 4
N_NSA_KV = 6
CMP_BLOCK = 32
CMP_STRIDE = 16
CMP_HIDDEN = 256
SLC_BLOCK = 64
SLC_TOPN = 16
WINDOW = 512
FORCE_SCORE = 1e9
C_HEADS = 4
C_VDIM = 2 * HEAD_DIM
N_BUCKETS = 32
MAX_DISTANCE = 128
N_BIAS_HEADS = A_HEADS + B_HEADS + C_HEADS
N_EXPERTS = 32
TOP_K = 4
D_FF = D_MODEL
SWIGLU_LIMIT = 7.0
SWIGLU_ALPHA = 1.702
DN_ALPHA = (2 * DEPTH) ** 0.25
DN_BETA = (8 * DEPTH) ** -0.25
LN_EPS = 1e-5
A_W = A_HEADS * HEAD_DIM
B_W = B_HEADS * HEAD_DIM
C_W = C_HEADS * C_VDIM
IN_SIZES = (A_HEADS * HEAD_DIM, HEAD_DIM, HEAD_DIM,
            IDX_HEADS * IDX_DIM, IDX_DIM, IDX_HEADS,
            B_HEADS * HEAD_DIM, N_NSA_KV * HEAD_DIM, 3 * B_HEADS,
            C_HEADS * 2 * HEAD_DIM, C_HEADS * 2 * HEAD_DIM, C_W,
            3 * D_MODEL)
D_IN = sum(IN_SIZES)

kernel_name = "hybrid_dsa_nsa_diff_moe_deepnorm_adaln"


def _split_points():
    return [int(v) for v in np.cumsum(IN_SIZES)[:-1]]


def _normal(key, shape, scale):
    return jax.random.normal(key, shape, jnp.float32) * scale


def layer_norm(x, g, b):
    xf = x.astype(jnp.float32)
    mu = jnp.mean(xf, axis=-1, keepdims=True)
    var = jnp.mean(jnp.square(xf - mu), axis=-1, keepdims=True)
    return ((xf - mu) * lax.rsqrt(var + LN_EPS) * g + b).astype(x.dtype)


def rms_norm(x, g):
    xf = x.astype(jnp.float32)
    return xf * lax.rsqrt(jnp.mean(jnp.square(xf), axis=-1, keepdims=True) + LN_EPS) * g


def masked_softmax(logits, mask):
    lg = jnp.where(mask, logits.astype(jnp.float32), -jnp.inf)
    m = jnp.max(lg, axis=-1, keepdims=True)
    m = jnp.where(jnp.isfinite(m), m, 0.0)
    p = jnp.exp(lg - m)
    return p / jnp.maximum(jnp.sum(p, axis=-1, keepdims=True), 1e-30)


def rel_bucket(dist):
    exact = N_BUCKETS // 2
    n = jnp.maximum(dist, 0)
    nf = jnp.maximum(n, 1).astype(jnp.float32)
    large = exact + (jnp.log(nf / exact) / math.log(MAX_DISTANCE / exact)
                     * (N_BUCKETS - exact)).astype(jnp.int32)
    large = jnp.minimum(large, N_BUCKETS - 1)
    return jnp.where(n < exact, n, large)


def _gather_rows(table, idx):
    return jax.vmap(lambda tb, ib: tb[ib])(table, idx)


def _slc_overlap(n_cmp, n_slc):
    start = np.arange(n_cmp) * CMP_STRIDE
    end = start + CMP_BLOCK
    bs = np.arange(n_slc) * SLC_BLOCK
    ov = (start[:, None] < bs[None, :] + SLC_BLOCK) & (end[:, None] > bs[None, :])
    return ov.astype(np.float32)


def adaln(c, w, b):
    mod = jax.nn.silu(c) @ w + b
    shift, scale, gate = jnp.split(mod, 3, axis=-1)
    return shift[:, None, :], scale[:, None, :], gate[:, None, :]


def hybrid_mixer(h, w_in, cmp_pos, cmp_w1, cmp_w2, diff_lambda, diff_norm_g,
                 w_branch_a, w_branch_b, w_branch_c, w_out, rel_bias, lam_init):
    Bn, S, _ = h.shape
    f32 = jnp.float32
    scale = HEAD_DIM ** -0.5
    proj = h @ w_in
    (aq, ak, av, iq, ik, iw, bq, bkv, bg, cq, ck, cv, mg) = jnp.split(proj, _split_points(), axis=-1)
    aq = aq.reshape(Bn, S, A_HEADS, HEAD_DIM)
    iq = iq.reshape(Bn, S, IDX_HEADS, IDX_DIM)
    bq = bq.reshape(Bn, S, B_HEADS, HEAD_DIM)
    bkv = bkv.reshape(Bn, S, N_NSA_KV, HEAD_DIM)
    k_cmp_raw, v_cmp_raw, k_slc, v_slc, k_win, v_win = [bkv[:, :, i] for i in range(N_NSA_KV)]
    bg = jax.nn.sigmoid(bg.reshape(Bn, S, B_HEADS, 3).astype(f32))
    cq = cq.reshape(Bn, S, C_HEADS, 2, HEAD_DIM)
    ck = ck.reshape(Bn, S, C_HEADS, 2, HEAD_DIM)
    cv = cv.reshape(Bn, S, C_HEADS, C_VDIM)

    n_cmp = (S - CMP_BLOCK) // CMP_STRIDE + 1
    cmp_idx = np.arange(n_cmp)[:, None] * CMP_STRIDE + np.arange(CMP_BLOCK)[None, :]
    cmp_last = jnp.asarray(cmp_idx[:, -1], jnp.int32)

    def compress(raw, j):
        blocks = raw[:, cmp_idx] + cmp_pos[j]
        hid = jax.nn.gelu(blocks.reshape(Bn, n_cmp, CMP_BLOCK * HEAD_DIM) @ cmp_w1[j])
        return hid @ cmp_w2[j]

    k_cmp = compress(k_cmp_raw, 0)
    v_cmp = compress(v_cmp_raw, 1)
    n_slc = S // SLC_BLOCK
    overlap = jnp.asarray(_slc_overlap(n_cmp, n_slc))
    k_slc_blk = k_slc.reshape(Bn, n_slc, SLC_BLOCK, HEAD_DIM)
    v_slc_blk = v_slc.reshape(Bn, n_slc, SLC_BLOCK, HEAD_DIM)
    k_win_pad = jnp.pad(k_win, ((0, 0), (WINDOW, 0), (0, 0)))
    v_win_pad = jnp.pad(v_win, ((0, 0), (WINDOW, 0), (0, 0)))

    k_dsa = min(DSA_TOPK, S // 4)
    n_sel = min(SLC_TOPN, n_slc)
    tab_a = rel_bias[:, :A_HEADS]
    tab_b = rel_bias[:, A_HEADS:A_HEADS + B_HEADS]
    tab_c = rel_bias[:, A_HEADS + B_HEADS:]
    dl = diff_lambda.astype(f32)
    lam = jnp.exp(jnp.sum(dl[0] * dl[1])) - jnp.exp(jnp.sum(dl[2] * dl[3])) + lam_init
    keys = jnp.arange(S, dtype=jnp.int32)

    def block_fn(qi):
        q0 = qi * Q_BLOCK
        t = q0 + jnp.arange(Q_BLOCK, dtype=jnp.int32)
        sl = lambda a: lax.dynamic_slice_in_dim(a, q0, Q_BLOCK, axis=1)
        causal = keys[None, :] <= t[:, None]

        isc = jnp.einsum('bthd,bsd->bths', sl(iq), ik) * (IDX_DIM ** -0.5)
        iscore = jnp.einsum('bth,bths->bts', sl(iw) * (IDX_HEADS ** -0.5), jax.nn.relu(isc))
        iscore = jnp.where(causal[None], iscore.astype(f32), -jnp.inf)
        top_val, top_idx = lax.top_k(iscore, k_dsa)
        valid_a = jnp.isfinite(top_val)
        ka = _gather_rows(ak, top_idx)
        va = _gather_rows(av, top_idx)
        la = jnp.einsum('bthd,btkd->bhtk', sl(aq), ka) * scale
        la = la + jnp.transpose(tab_a[rel_bucket(t[None, :, None] - top_idx)], (0, 3, 1, 2))
        pa = masked_softmax(la, valid_a[:, None])
        oa = jnp.einsum('bhtk,btkd->bthd', pa, va).reshape(Bn, Q_BLOCK, A_W)

        qb = sl(bq)
        lc = jnp.einsum('bthd,bnd->bhtn', qb, k_cmp) * scale
        cmask = cmp_last[None, :] <= t[:, None]
        p_cmp = masked_softmax(lc, cmask[None, None])
        o_cmp = jnp.einsum('bhtn,bnd->bthd', p_cmp, v_cmp)
        imp = jnp.einsum('bhtn,nj->btj', p_cmp, overlap)
        blk = jnp.arange(n_slc, dtype=jnp.int32)
        cur = t // SLC_BLOCK
        forced = (blk[None] == 0) | (blk[None] == cur[:, None]) | (blk[None] == cur[:, None] - 1)
        allowed = blk[None] <= cur[:, None]
        imp = jnp.where(allowed[None], jnp.where(forced[None], FORCE_SCORE, imp), -jnp.inf)
        sv, sidx = lax.top_k(imp, n_sel)
        ks = _gather_rows(k_slc_blk, sidx).reshape(Bn, Q_BLOCK, n_sel * SLC_BLOCK, HEAD_DIM)
        vs = _gather_rows(v_slc_blk, sidx).reshape(Bn, Q_BLOCK, n_sel * SLC_BLOCK, HEAD_DIM)
        tok = (sidx[..., None] * SLC_BLOCK + jnp.arange(SLC_BLOCK, dtype=jnp.int32)).reshape(Bn, Q_BLOCK, -1)
        smask = jnp.repeat(jnp.isfinite(sv), SLC_BLOCK, axis=-1) & (tok <= t[None, :, None])
        ls = jnp.einsum('bthd,btmd->bhtm', qb, ks) * scale
        ls = ls + jnp.transpose(tab_b[rel_bucket(t[None, :, None] - tok)], (0, 3, 1, 2))
        o_slc = jnp.einsum('bhtm,btmd->bthd', masked_softmax(ls, smask[:, None]), vs)
        kw = lax.dynamic_slice_in_dim(k_win_pad, q0, Q_BLOCK + WINDOW, axis=1)
        vw = lax.dynamic_slice_in_dim(v_win_pad, q0, Q_BLOCK + WINDOW, axis=1)
        pos = q0 - WINDOW + jnp.arange(Q_BLOCK + WINDOW, dtype=jnp.int32)
        dw = t[:, None] - pos[None, :]
        wmask = (dw >= 0) & (dw < WINDOW) & (pos[None, :] >= 0)
        lw = jnp.einsum('bthd,bsd->bhts', qb, kw) * scale
        lw = lw + jnp.transpose(tab_b[rel_bucket(dw)], (2, 0, 1))[None]
        o_win = jnp.einsum('bhts,bsd->bthd', masked_softmax(lw, wmask[None, None]), vw)
        g = sl(bg)
        ob = (g[..., 0:1] * o_cmp + g[..., 1:2] * o_slc + g[..., 2:3] * o_win).reshape(Bn, Q_BLOCK, B_W)

        lcd = jnp.einsum('bthjd,bshjd->bjhts', sl(cq), ck) * scale
        lcd = lcd + jnp.transpose(tab_c[rel_bucket(t[:, None] - keys[None, :])], (2, 0, 1))[None, None]
        pc = masked_softmax(lcd, causal[None, None, None])
        attn = pc[:, 0] - lam * pc[:, 1]
        oc = jnp.einsum('bhts,bshd->bthd', attn, cv)
        oc = (rms_norm(oc, diff_norm_g) * (1.0 - lam_init)).reshape(Bn, Q_BLOCK, C_W)
        return oa, ob, oc

    oa, ob, oc = lax.map(block_fn, jnp.arange(S // Q_BLOCK))
    unblock = lambda o: jnp.swapaxes(o, 0, 1).reshape(Bn, S, -1).astype(h.dtype)
    ya = unblock(oa) @ w_branch_a
    yb = unblock(ob) @ w_branch_b
    yc = unblock(oc) @ w_branch_c
    gates = jax.nn.sigmoid(mg.reshape(Bn, S, 3, D_MODEL))
    merged = gates[:, :, 0] * ya + gates[:, :, 1] * yb + gates[:, :, 2] * yc
    return merged @ w_out


def moe_ffn(h, router_w, router_b, w_gu, b_gu, w_down, b_down):
    Bn, S, D = h.shape
    tok = h.reshape(Bn * S, D)
    logits = (tok @ router_w + router_b).astype(jnp.float32)
    top_v, top_i = lax.top_k(logits, TOP_K)
    top_w = jax.nn.softmax(top_v, axis=-1)
    combine = jnp.sum(jax.nn.one_hot(top_i, N_EXPERTS, dtype=jnp.float32) * top_w[..., None], axis=1)
    out = jnp.zeros((Bn * S, D), jnp.float32)
    for e in range(N_EXPERTS):
        gu = tok @ w_gu[e] + b_gu[e]
        gate = jnp.minimum(gu[:, 0::2], SWIGLU_LIMIT)
        up = jnp.clip(gu[:, 1::2], -SWIGLU_LIMIT, SWIGLU_LIMIT)
        act = (up + 1.0) * (gate * jax.nn.sigmoid(SWIGLU_ALPHA * gate))
        out = out + combine[:, e:e + 1] * (act @ w_down[e] + b_down[e])
    return out.reshape(Bn, S, D).astype(h.dtype)


def setup_inputs(seed: int = 0) -> dict:
    key = jax.random.key(seed)
    ks = jax.random.split(key, 32)
    L, D = DEPTH, D_MODEL
    cmp_in = CMP_BLOCK * HEAD_DIM
    return {
        "x": _normal(ks[0], (BATCH, SEQ, D), 1.0),
        "c": _normal(ks[1], (BATCH, D), 1.0),
        "rel_bias": _normal(ks[2], (N_BUCKETS, N_BIAS_HEADS), 0.5),
        "mod_attn_w": _normal(ks[3], (L, D, 3 * D), 0.1 * D ** -0.5),
        "mod_attn_b": _normal(ks[4], (L, 3 * D), 0.02),
        "w_in": _normal(ks[5], (L, D, D_IN), D ** -0.5),
        "cmp_pos": _normal(ks[6], (L, 2, CMP_BLOCK, HEAD_DIM), 0.1),
        "cmp_w1": _normal(ks[7], (L, 2, cmp_in, CMP_HIDDEN), cmp_in ** -0.5),
        "cmp_w2": _normal(ks[8], (L, 2, CMP_HIDDEN, HEAD_DIM), CMP_HIDDEN ** -0.5),
        "diff_lambda": _normal(ks[9], (L, 4, HEAD_DIM), 0.1),
        "diff_norm_g": 1.0 + _normal(ks[10], (L, C_VDIM), 0.02),
        "w_branch_a": _normal(ks[11], (L, A_W, D), A_W ** -0.5),
        "w_branch_b": _normal(ks[12], (L, B_W, D), B_W ** -0.5),
        "w_branch_c": _normal(ks[13], (L, C_W, D), C_W ** -0.5),
        "w_out": _normal(ks[14], (L, D, D), DN_BETA * D ** -0.5),
        "ln1_g": 1.0 + _normal(ks[15], (L, D), 0.02),
        "ln1_b": _normal(ks[16], (L, D), 0.02),
        "mod_ffn_w": _normal(ks[17], (L, D, 3 * D), 0.1 * D ** -0.5),
        "mod_ffn_b": _normal(ks[18], (L, 3 * D), 0.02),
        "router_w": _normal(ks[19], (L, D, N_EXPERTS), D ** -0.5),
        "router_b": _normal(ks[20], (L, N_EXPERTS), 0.01),
        "exp_w_gu": _normal(ks[21], (L, N_EXPERTS, D, 2 * D_FF), D ** -0.5),
        "exp_b_gu": _normal(ks[22], (L, N_EXPERTS, 2 * D_FF), 0.02),
        "exp_w_down": _normal(ks[23], (L, N_EXPERTS, D_FF, D), DN_BETA * D_FF ** -0.5),
        "exp_b_down": _normal(ks[24], (L, N_EXPERTS, D), 0.02),
        "ln2_g": 1.0 + _normal(ks[25], (L, D), 0.02),
        "ln2_b": _normal(ks[26], (L, D), 0.02),
    }


def reference(x, c, rel_bias, mod_attn_w, mod_attn_b, w_in, cmp_pos, cmp_w1, cmp_w2,
              diff_lambda, diff_norm_g, w_branch_a, w_branch_b, w_branch_c, w_out,
              ln1_g, ln1_b, mod_ffn_w, mod_ffn_b, router_w, router_b,
              exp_w_gu, exp_b_gu, exp_w_down, exp_b_down, ln2_g, ln2_b):
    for l in range(DEPTH):
        lam_init = 0.8 - 0.6 * math.exp(-0.3 * l)
        shift, scale, gate = adaln(c, mod_attn_w[l], mod_attn_b[l])
        h = x * (1.0 + scale) + shift
        y = hybrid_mixer(h, w_in[l], cmp_pos[l], cmp_w1[l], cmp_w2[l], diff_lambda[l], diff_norm_g[l],
                         w_branch_a[l], w_branch_b[l], w_branch_c[l], w_out[l], rel_bias, lam_init)
        x = layer_norm(DN_ALPHA * x + (1.0 + gate) * y, ln1_g[l], ln1_b[l])
        shift, scale, gate = adaln(c, mod_ffn_w[l], mod_ffn_b[l])
        h = x * (1.0 + scale) + shift
        y = moe_ffn(h, router_w[l], router_b[l], exp_w_gu[l], exp_b_gu[l], exp_w_down[l], exp_b_down[l])
        x = layer_norm(DN_ALPHA * x + (1.0 + gate) * y, ln2_g[l], ln2_b[l])
    return x
```

```cpp
#include <hip/hip_runtime.h>
#include <cstdio>
#include <cstdint>

#define GAS __attribute__((address_space(1)))
#define LAS __attribute__((address_space(3)))
typedef unsigned short bf16_t;
typedef short bf16x8 __attribute__((ext_vector_type(8)));
typedef short s16x4 __attribute__((ext_vector_type(4)));
typedef float f32x2 __attribute__((ext_vector_type(2)));
typedef float f32x4 __attribute__((ext_vector_type(4)));
typedef float f32x16 __attribute__((ext_vector_type(16)));
typedef unsigned u32x4 __attribute__((ext_vector_type(4)));
typedef unsigned u32x2 __attribute__((ext_vector_type(2)));
typedef unsigned long long u64;

constexpr bool USE_A = true, USE_B = true, USE_C = true;
constexpr bool A_DENSE = false; constexpr bool DSA_FAKE = false;
constexpr int PROBE_ATT = 0;
constexpr int DUP = -1;
constexpr int NB = 16, SEQ = 4096, NTOK = NB * SEQ, D = 1024, DEPTH = 2, NEXP = 32;
constexpr int DP = 5888;
constexpr int D_IN = 5808;
constexpr int C_AQ = 0, C_AK = 256, C_AV = 320, C_IQ = 384, C_IK = 512, C_IW = 544, C_BG = 548, C_BQ = 576, C_BKV = 832, C_CQ = 1216, C_CK = 1728, C_CV = 2240, C_MG = 2752;
constexpr float LOG2E = 1.4426950408889634f;
constexpr float QS = 0.125f * LOG2E;
constexpr float IQS = 0.17677669529663687f;
constexpr float DN_ALPHA = 1.4142135623730951f;
constexpr float LN_EPS = 1e-5f;
constexpr int MOE_ROWS = NTOK * 4 + NEXP * 256;
constexpr float F8_WGU = 256.f, F8_WDN = 512.f, F8_H = 4.f, F8_ACT = 4.f, F8_WIN = 256.f;
constexpr int N_BF = 2816, N_F8 = 3072;

constexpr size_t MiB = 1u << 20;
constexpr size_t WS_CTL = 0, CTL_BYTES = 1 * MiB;
constexpr size_t WS_MOD = 1 * MiB;
constexpr size_t WS_BIAS1 = WS_MOD + 4 * 16 * 3072 * 4;
constexpr size_t WS_LUT = WS_BIAS1 + 4096;
constexpr size_t WS_LAM = WS_LUT + 8192;
constexpr size_t WS_TOKE = 2 * MiB;
constexpr size_t WS_TOKW = 3 * MiB;
constexpr size_t WS_TOKP = 4 * MiB;
constexpr size_t WS_TOKR = 5 * MiB;
constexpr size_t WS_KCMP = 6 * MiB;
constexpr size_t WS_WIN_T = 8 * MiB;
constexpr size_t WS_WBR_T = 31 * MiB;
constexpr size_t WS_WOUT_T = 35 * MiB;
constexpr size_t WS_W1_T = 39 * MiB;
constexpr size_t WS_W2_T = 43 * MiB;
constexpr size_t WS_WGU_T = 44 * MiB;
constexpr size_t WS_WDN_T = 300 * MiB;
constexpr size_t WS_WMG8 = 172 * MiB;
constexpr size_t WS_HB8 = 364 * MiB;
constexpr size_t WS_X1 = 428 * MiB;
constexpr size_t WS_X2B = 556 * MiB;
constexpr size_t WS_HB = 684 * MiB;
constexpr size_t WS_HID = 812 * MiB;
constexpr size_t WS_BIG = 820 * MiB;
constexpr size_t WS_PROJ = WS_BIG;
constexpr size_t WS_OCAT = WS_BIG + 737 * MiB;
constexpr size_t WS_MERG = WS_OCAT + 128 * MiB;
constexpr size_t WS_BM64 = WS_MERG + 128 * MiB;
constexpr size_t WS_HS = WS_BIG;
constexpr size_t WS_HS8 = WS_BIG + 792 * MiB;
constexpr size_t WS_ACT = WS_BIG + 528 * MiB;
constexpr size_t WS_END = WS_BIG + 1056 * MiB;
static_assert((size_t)(NTOK + 32) * DP * 2 <= 737 * MiB, "proj");
static_assert((size_t)MOE_ROWS * 1024 * 2 <= 528 * MiB, "moe rows");
static_assert(WS_BM64 + 32 * MiB <= WS_END, "ws");
constexpr int CW_CNT = 1024;
constexpr int CW_BAR = 4096;

constexpr int LDS_MISC = 147456;
constexpr int LDS_BYTES = 151552;

#define LDS_WAIT() asm volatile("s_waitcnt lgkmcnt(0)" ::: "memory")
#define VM_WAIT() asm volatile("s_waitcnt vmcnt(0)" ::: "memory")

__device__ __forceinline__ unsigned f2bf(float f) { unsigned u = __builtin_bit_cast(unsigned, f); return (u + 0x7fffu + ((u >> 16) & 1u)) >> 16; }
__device__ __forceinline__ unsigned pk2(float lo, float hi) { return f2bf(lo) | (f2bf(hi) << 16); }
__device__ __forceinline__ float bf2f(unsigned short b) { return __builtin_bit_cast(float, (unsigned)b << 16); }
__device__ __forceinline__ float bflo(unsigned w) { return __builtin_bit_cast(float, w << 16); }
__device__ __forceinline__ float bfhi(unsigned w) { return __builtin_bit_cast(float, w & 0xffff0000u); }
typedef __bf16 bf16x2_t __attribute__((ext_vector_type(2)));
__device__ __forceinline__ unsigned cvt_pk_bf16(float lo, float hi) { return __builtin_bit_cast(unsigned, __builtin_convertvector((f32x2){lo, hi}, bf16x2_t)); }
__device__ __forceinline__ unsigned pk4_fp8(float a, float b, float c, float d) { int r = 0; r = __builtin_amdgcn_cvt_pk_fp8_f32(a, b, r, false); r = __builtin_amdgcn_cvt_pk_fp8_f32(c, d, r, true); return (unsigned)r; }
__device__ __forceinline__ float fexp2(float x) { return __builtin_amdgcn_exp2f(x); }
__device__ __forceinline__ float frcp(float x) { return __builtin_amdgcn_rcpf(x); }
__device__ __forceinline__ float fsigmoid(float x) { return frcp(1.f + fexp2(-LOG2E * x)); }
__device__ __forceinline__ float gelu_tanh(float x) { const float u = 0.7978845608028654f * (x + 0.044715f * x * x * x); return x * fsigmoid(2.f * u); }
__device__ __forceinline__ int bperm_i(int idx, int v) { return __builtin_amdgcn_ds_bpermute(idx << 2, v); }
__device__ __forceinline__ float bperm_f(int idx, float v) { return __builtin_bit_cast(float, __builtin_amdgcn_ds_bpermute(idx << 2, __builtin_bit_cast(int, v))); }
__device__ __forceinline__ float other32(float v, int lane) { return bperm_f(lane ^ 32, v); }
__device__ __forceinline__ float sum32(float v, int lane) { return v + bperm_f(lane ^ 32, v); }
__device__ __forceinline__ float max32(float v, int lane) { return fmaxf(v, bperm_f(lane ^ 32, v)); }
__device__ __forceinline__ float shx_f(float v, int mask, int lane) { return bperm_f(lane ^ mask, v); }
__device__ __forceinline__ int shx_i(int v, int mask, int lane) { return bperm_i(lane ^ mask, v); }
__device__ __forceinline__ float wave_sum(float v, int lane) {
#pragma unroll
    for (int o = 1; o < 32; o <<= 1) v += shx_f(v, o, lane);
    return sum32(v, lane);
}

#define XB_TMO      128
#define XB_XCNT(j)  (256  + 64 * (j))
#define XB_XSUB(j)  (1280 + 64 * (j))
#define XB_XGEN(j)  (2304 + 64 * (j))
#define XB_TOP      3328
#define XB_TOPGEN   3392
#define XCD_BAR_WORDS 3456
#define XB_SPIN_CAP (1u << 18)

__device__ __forceinline__ unsigned xb_ld(unsigned* p)              { return __hip_atomic_load(p, __ATOMIC_RELAXED, __HIP_MEMORY_SCOPE_AGENT); }
__device__ __forceinline__ unsigned xb_add(unsigned* p, unsigned v) { return __hip_atomic_fetch_add(p, v, __ATOMIC_RELAXED, __HIP_MEMORY_SCOPE_AGENT); }
__device__ __forceinline__ unsigned xb_xcc_id() { return (unsigned)__builtin_amdgcn_s_getreg((3 << 11) | 20) & 0xFu; }
#define XB_SPIN(cond, bar) do { unsigned _sp = 0; while (cond) { __builtin_amdgcn_s_sleep(1); \
    if ((++_sp & 255u) == 0u) { if (xb_ld(&(bar)[XB_TMO])) break; if (_sp > XB_SPIN_CAP) { atomicAdd(&(bar)[XB_TMO], 1u); break; } } } } while (0)

struct XcdBarrier { unsigned* bar; unsigned x; volatile LAS unsigned* st; };

__device__ __forceinline__ XcdBarrier xcd_barrier_post(unsigned* bar, volatile LAS unsigned* st) {
    XcdBarrier b; b.bar = bar; b.x = xb_xcc_id(); b.st = st;
    if (threadIdx.x == 0) (void)xb_add(&bar[XB_XCNT(b.x)], 1u);
    return b;
}
__device__ __forceinline__ void xcd_barrier_complete(unsigned* bar, unsigned x, unsigned& nloc, unsigned& nx) {
    const unsigned G = gridDim.x * gridDim.y * gridDim.z;
    unsigned sum, cnt, mine, sp = 0u;
    for (;;) {
        sum = 0u; cnt = 0u; mine = 0u;
#pragma unroll
        for (unsigned j = 0; j < 16; ++j) { const unsigned c = xb_ld(&bar[XB_XCNT(j)]); sum += c; cnt += (c > 0u) ? 1u : 0u; mine = (j == x) ? c : mine; }
        if (sum == G) break;
        __builtin_amdgcn_s_sleep(1);
        if ((++sp & 255u) == 0u) { if (xb_ld(&bar[XB_TMO])) break; if (sp > XB_SPIN_CAP) { atomicAdd(&bar[XB_TMO], 1u); break; } }
    }
    nloc = mine > 0u ? mine : 1u; nx = cnt > 0u ? cnt : 1u;
}
__device__ __forceinline__ void xcd_barrier(const XcdBarrier& b) {
    asm volatile("s_waitcnt vmcnt(0)" ::: "memory");
    __syncthreads();
    if (threadIdx.x == 0) {
        unsigned* bar = b.bar;
        __builtin_amdgcn_s_waitcnt(0);
        unsigned nloc = b.st[0], nx = b.st[1];
        if (nloc == 0u) { xcd_barrier_complete(bar, b.x, nloc, nx); b.st[0] = nloc; b.st[1] = nx; }
        const unsigned old = xb_add(&bar[XB_XSUB(b.x)], 1u);
        const unsigned gen = old / nloc;
        if (old + 1u == (gen + 1u) * nloc) {
            __builtin_amdgcn_fence(__ATOMIC_RELEASE, "agent");
            asm volatile("s_waitcnt vmcnt(0)" ::: "memory");
            const unsigned og = xb_add(&bar[XB_TOP], 1u);
            const unsigned tg = og / nx;
            if (og + 1u == (tg + 1u) * nx) xb_add(&bar[XB_TOPGEN], 1u);
            else XB_SPIN(xb_ld(&bar[XB_TOPGEN]) == tg, bar);
            __builtin_amdgcn_fence(__ATOMIC_ACQUIRE, "agent");
            xb_add(&bar[XB_XGEN(b.x)], 1u);
            asm volatile("s_waitcnt vmcnt(0)" ::: "memory");
        } else {
            XB_SPIN(xb_ld(&bar[XB_XGEN(b.x)]) == gen, bar);
            __builtin_amdgcn_fence(__ATOMIC_ACQUIRE, "agent");
            asm volatile("s_waitcnt vmcnt(0)" ::: "memory");
        }
    }
    __syncthreads();
}

__device__ __forceinline__ int fresh_tid(int wave_s) {
    unsigned ones = ~0u; asm volatile("" : "+s"(ones));
    int ln = (int)__builtin_amdgcn_mbcnt_hi(ones, __builtin_amdgcn_mbcnt_lo(ones, 0u)); asm volatile("" : "+v"(ln));
    return wave_s * 64 + ln;
}

namespace pg8 {
typedef int v4i_t __attribute__((ext_vector_type(4)));
typedef int v8i_t __attribute__((ext_vector_type(8)));
constexpr int BM = 256, BK = 64, HALF = 128, HTB = HALF * BK * 2, STAGE_BYTES = 8 * HTB, NXCD = 8, WGM = 8;
__device__ __forceinline__ int lds_byte(int r, int c) { const int st = (r >> 4) * 2 + (c >> 5), rr = r & 15, cc = c & 31, ob = rr * 64 + cc * 2; return st * 1024 + (ob ^ (((ob >> 9) & 1) << 5)); }
__device__ __forceinline__ void stage_rc(int b, int& R, int& C) { const int st = b / 1024, sb = b % 1024, swz = sb ^ (((sb >> 9) & 1) << 5); R = (st >> 1) * 16 + swz / 64; C = (st & 1) * 32 + (swz % 64) / 2; }
__device__ __forceinline__ int perm32(int rho) { const int n = rho >> 4, i = rho & 15; return 8 * (i >> 2) + 4 * n + (i & 3); }

struct Unit { int pm, pn; };
struct Gemm { const bf16_t* A; const bf16_t* Bt; int lda, ldb, K, kstepA; };

struct StaticOrder {
    int nM, nN, nwg, G, c;
    __device__ void init(int M, int N, int G_, int c_) { nM = M / BM; nN = N / BM; nwg = nM * nN; G = G_; c = c_; }
    __device__ bool next(int i, Unit& u) const {
        const long L = (long)i * G + c; if (L >= nwg) return false;
        int wgid = (int)L; { const int q = nwg / NXCD, r = nwg % NXCD, xcd = wgid % NXCD, off = wgid / NXCD; wgid = (xcd < r ? xcd * (q + 1) : r * (q + 1) + (xcd - r) * q) + off; }
        const int nig = WGM * nN, gid = wgid / nig, fm = gid * WGM, gsz = (nM - fm) < WGM ? (nM - fm) : WGM;
        u.pm = fm + ((wgid % nig) % gsz); u.pn = (wgid % nig) / gsz; return true;
    }
    __device__ __forceinline__ const char* a_ptr(const Gemm& g, const Unit& u) const { return (const char*)g.A + (size_t)u.pm * (size_t)(BM * 2) * g.lda; }
    __device__ __forceinline__ const char* b_ptr(const Gemm& g, const Unit& u) const { return (const char*)g.Bt + (size_t)u.pn * (size_t)(BM * 2) * g.ldb; }
};
struct CmpOrder {
    int G, c;
    __device__ bool next(int i, Unit& u) const { const int L = i * G + c; if (L >= 32) return false; u.pn = L >> 4; u.pm = L & 15; return true; }
    __device__ __forceinline__ const char* a_ptr(const Gemm& g, const Unit& u) const { return (const char*)g.A + (size_t)u.pm * (size_t)(BM * 2) * g.lda + u.pn * 128; }
    __device__ __forceinline__ const char* b_ptr(const Gemm& g, const Unit& u) const { return (const char*)g.Bt + (size_t)u.pn * (size_t)(BM * 2) * g.ldb; }
};
struct MoeOrder {
    int G, c, NT, npan; const volatile LAS int* pstart;
    __device__ bool next(int i, Unit& u) const {
        const int ppx = (256 / NT) / 8, x = c & 7, r = c >> 3;
        const int p = i * (256 / NT) + x * ppx + (r % ppx), n = r / ppx; if (p >= npan) return false;
        int e = 0;
#pragma unroll 1
        for (int k = 1; k < 32; ++k) e += (pstart[k] <= p) ? 1 : 0;
        u.pm = p; u.pn = e * NT + n; return true;
    }
    __device__ __forceinline__ const char* a_ptr(const Gemm& g, const Unit& u) const { return (const char*)g.A + (size_t)u.pm * (size_t)(BM * 2) * g.lda; }
    __device__ __forceinline__ const char* b_ptr(const Gemm& g, const Unit& u) const { return (const char*)g.Bt + (size_t)u.pn * (size_t)(BM * 2) * g.ldb; }
};

#define EPI_LOOP_AI_M  _Pragma("unroll") for (int ai = 0; ai < 2; ++ai) _Pragma("unroll") for (int m = 0; m < 4; ++m)

struct EpiProj {
    static constexpr bool PERM = true;
    bf16_t* O; int colbase; float scl;
    __device__ __forceinline__ void operator()(const f32x4 (&acc)[2][2][4][2], const Unit& u, int wr, int wc, int fr, int fq) const {
        const int row0 = u.pm * BM + wr * 64 + fr, col0 = colbase + u.pn * BM + wc * 32 + 8 * fq;
        EPI_LOOP_AI_M { bf16_t* rowp = O + (size_t)(row0 + ai * HALF + m * 16) * DP + col0;
#pragma unroll
            for (int bj = 0; bj < 2; ++bj) { const f32x4 v0 = acc[ai][bj][m][0] * scl, v1 = acc[ai][bj][m][1] * scl;
                u32x4 w; w.x = cvt_pk_bf16(v0[0], v0[1]); w.y = cvt_pk_bf16(v0[2], v0[3]); w.z = cvt_pk_bf16(v1[0], v1[1]); w.w = cvt_pk_bf16(v1[2], v1[3]);
                *(u32x4*)(rowp + bj * HALF) = w; } }
    }
};
struct EpiCmp1 {
    static constexpr bool PERM = true;
    bf16_t* O; const float* bias;
    __device__ __forceinline__ void operator()(const f32x4 (&acc)[2][2][4][2], const Unit& u, int wr, int wc, int fr, int fq) const {
        const int row0 = u.pm * BM + wr * 64 + fr, col0 = wc * 32 + 8 * fq; const int j = u.pn;
        f32x4 bv[2][2];
#pragma unroll
        for (int bj = 0; bj < 2; ++bj)
#pragma unroll
            for (int n = 0; n < 2; ++n) bv[bj][n] = *(const f32x4*)(bias + j * 256 + col0 + bj * HALF + 4 * n);
        EPI_LOOP_AI_M { bf16_t* rowp = O + ((size_t)j * 4096 + row0 + ai * HALF + m * 16) * 256 + col0;
#pragma unroll
            for (int bj = 0; bj < 2; ++bj) { f32x4 v0 = acc[ai][bj][m][0] + bv[bj][0], v1 = acc[ai][bj][m][1] + bv[bj][1];
#pragma unroll
                for (int q = 0; q < 4; ++q) { v0[q] = gelu_tanh(v0[q]); v1[q] = gelu_tanh(v1[q]); }
                u32x4 w; w.x = cvt_pk_bf16(v0[0], v0[1]); w.y = cvt_pk_bf16(v0[2], v0[3]); w.z = cvt_pk_bf16(v1[0], v1[1]); w.w = cvt_pk_bf16(v1[2], v1[3]);
                *(u32x4*)(rowp + bj * HALF) = w; } }
    }
};
template <int GI> struct EpiBranch {
    static constexpr bool PERM = true;
    bf16_t* MG; const bf16_t* P;
    __device__ __forceinline__ void operator()(const f32x4 (&acc)[2][2][4][2], const Unit& u, int wr, int wc, int fr, int fq) const {
        const int row0 = u.pm * BM + wr * 64 + fr, col0 = u.pn * BM + wc * 32 + 8 * fq;
#pragma unroll
        for (int ai = 0; ai < 2; ++ai) {
            u32x4 gq[4][2], oq[4][2];
#pragma unroll
            for (int m = 0; m < 4; ++m) { const size_t row = (size_t)(row0 + ai * HALF + m * 16);
#pragma unroll
                for (int bj = 0; bj < 2; ++bj) { const int col = col0 + bj * HALF;
                    gq[m][bj] = *(const u32x4*)(P + row * DP + C_MG + GI * 1024 + col);
                    if (GI > 0) oq[m][bj] = *(const u32x4*)(MG + row * 1024 + col); } }
            asm volatile("" ::: "memory");
#pragma unroll
            for (int m = 0; m < 4; ++m) { const size_t row = (size_t)(row0 + ai * HALF + m * 16);
#pragma unroll
                for (int bj = 0; bj < 2; ++bj) { const int col = col0 + bj * HALF; const u32x4 g = gq[m][bj];
                    f32x4 v0 = acc[ai][bj][m][0], v1 = acc[ai][bj][m][1];
                    v0[0] *= fsigmoid(bflo(g.x)); v0[1] *= fsigmoid(bfhi(g.x)); v0[2] *= fsigmoid(bflo(g.y)); v0[3] *= fsigmoid(bfhi(g.y));
                    v1[0] *= fsigmoid(bflo(g.z)); v1[1] *= fsigmoid(bfhi(g.z)); v1[2] *= fsigmoid(bflo(g.w)); v1[3] *= fsigmoid(bfhi(g.w));
                    if (GI > 0) { const u32x4 o = oq[m][bj];
                        v0[0] += bflo(o.x); v0[1] += bfhi(o.x); v0[2] += bflo(o.y); v0[3] += bfhi(o.y); v1[0] += bflo(o.z); v1[1] += bfhi(o.z); v1[2] += bflo(o.w); v1[3] += bfhi(o.w); }
                    u32x4 w; w.x = cvt_pk_bf16(v0[0], v0[1]); w.y = cvt_pk_bf16(v0[2], v0[3]); w.z = cvt_pk_bf16(v1[0], v1[1]); w.w = cvt_pk_bf16(v1[2], v1[3]);
                    *(u32x4*)(MG + row * 1024 + col) = w; } }
            asm volatile("" ::: "memory");
        }
    }
};
template <bool XBF> struct EpiWout {
    static constexpr bool PERM = true;
    bf16_t* Z; const void* XR; const float* gate;
    __device__ __forceinline__ void operator()(const f32x4 (&acc)[2][2][4][2], const Unit& u, int wr, int wc, int fr, int fq) const {
        const int row0 = u.pm * BM + wr * 64 + fr, col0 = u.pn * BM + wc * 32 + 8 * fq;
        const int b = (u.pm * BM) >> 12;
        f32x4 gv[2][2];
#pragma unroll
        for (int bj = 0; bj < 2; ++bj)
#pragma unroll
            for (int n = 0; n < 2; ++n) gv[bj][n] = *(const f32x4*)(gate + (size_t)b * 3072 + col0 + bj * HALF + 4 * n) + 1.0f;
#pragma unroll
        for (int ai = 0; ai < 2; ++ai) {
            f32x4 xr[4][2][2];
#pragma unroll
            for (int m = 0; m < 4; ++m) { const size_t ro = (size_t)(row0 + ai * HALF + m * 16) * 1024 + col0;
#pragma unroll
                for (int bj = 0; bj < 2; ++bj) {
                    if (XBF) { const u32x4 q = *(const u32x4*)((const bf16_t*)XR + ro + bj * HALF);
                        xr[m][bj][0] = (f32x4){bflo(q.x), bfhi(q.x), bflo(q.y), bfhi(q.y)}; xr[m][bj][1] = (f32x4){bflo(q.z), bfhi(q.z), bflo(q.w), bfhi(q.w)}; }
                    else { xr[m][bj][0] = *(const f32x4*)((const float*)XR + ro + bj * HALF); xr[m][bj][1] = *(const f32x4*)((const float*)XR + ro + bj * HALF + 4); } } }
            asm volatile("" ::: "memory");
#pragma unroll
            for (int m = 0; m < 4; ++m) { const size_t ro = (size_t)(row0 + ai * HALF + m * 16) * 1024 + col0;
#pragma unroll
                for (int bj = 0; bj < 2; ++bj) { const f32x4 v0 = xr[m][bj][0] * DN_ALPHA + gv[bj][0] * acc[ai][bj][m][0], v1 = xr[m][bj][1] * DN_ALPHA + gv[bj][1] * acc[ai][bj][m][1];
                    u32x4 w; w.x = cvt_pk_bf16(v0[0], v0[1]); w.y = cvt_pk_bf16(v0[2], v0[3]); w.z = cvt_pk_bf16(v1[0], v1[1]); w.w = cvt_pk_bf16(v1[2], v1[3]);
                    *(u32x4*)(Z + ro + bj * HALF) = w; } }
            asm volatile("" ::: "memory");
        }
    }
};
__device__ __forceinline__ float swiglu(float g, float u) { const float gg = fminf(g, 7.f), uu = fminf(fmaxf(u, -7.f), 7.f); return (uu + 1.f) * gg * fsigmoid(1.702f * gg); }
struct EpiMoe1 {
    static constexpr bool PERM = true;
    unsigned char* O; const float* bias;
    __device__ __forceinline__ void operator()(const f32x4 (&acc)[2][2][4][2], const Unit& u, int wr, int wc, int fr, int fq) const {
        const int row0 = u.pm * BM + wr * 64 + fr; const int e = u.pn >> 3, n8 = u.pn & 7; const int cg0 = n8 * BM + wc * 32 + 8 * fq;
        constexpr float isc = 1.f / (F8_H * F8_WGU);
        f32x4 bv[2][2];
#pragma unroll
        for (int bj = 0; bj < 2; ++bj)
#pragma unroll
            for (int n = 0; n < 2; ++n) bv[bj][n] = *(const f32x4*)(bias + (size_t)e * 2048 + cg0 + bj * HALF + 4 * n);
        EPI_LOOP_AI_M { unsigned char* rowp = O + (size_t)(row0 + ai * HALF + m * 16) * 1024 + (cg0 >> 1);
#pragma unroll
            for (int bj = 0; bj < 2; ++bj) { const f32x4 v0 = acc[ai][bj][m][0] * isc + bv[bj][0], v1 = acc[ai][bj][m][1] * isc + bv[bj][1];
                *(unsigned*)(rowp + bj * (HALF / 2)) = pk4_fp8(F8_ACT * swiglu(v0[0], v0[1]), F8_ACT * swiglu(v0[2], v0[3]), F8_ACT * swiglu(v1[0], v1[1]), F8_ACT * swiglu(v1[2], v1[3])); } }
    }
};
struct EpiMoe2 {
    static constexpr bool PERM = true;
    bf16_t* O; const float* bias;
    __device__ __forceinline__ void operator()(const f32x4 (&acc)[2][2][4][2], const Unit& u, int wr, int wc, int fr, int fq) const {
        const int row0 = u.pm * BM + wr * 64 + fr; const int e = u.pn >> 2, n4 = u.pn & 3; const int c0 = n4 * BM + wc * 32 + 8 * fq;
        constexpr float isc = 1.f / (F8_ACT * F8_WDN);
        f32x4 bv[2][2];
#pragma unroll
        for (int bj = 0; bj < 2; ++bj)
#pragma unroll
            for (int n = 0; n < 2; ++n) bv[bj][n] = *(const f32x4*)(bias + (size_t)e * 1024 + c0 + bj * HALF + 4 * n);
        EPI_LOOP_AI_M { bf16_t* rowp = O + (size_t)(row0 + ai * HALF + m * 16) * 1024 + c0;
#pragma unroll
            for (int bj = 0; bj < 2; ++bj) { const f32x4 v0 = acc[ai][bj][m][0] * isc + bv[bj][0], v1 = acc[ai][bj][m][1] * isc + bv[bj][1];
                u32x4 w; w.x = cvt_pk_bf16(v0[0], v0[1]); w.y = cvt_pk_bf16(v0[2], v0[3]); w.z = cvt_pk_bf16(v1[0], v1[1]); w.w = cvt_pk_bf16(v1[2], v1[3]);
                *(u32x4*)(rowp + bj * HALF) = w; } }
    }
};

__device__ __forceinline__ unsigned stage_voff(int tid, int i, int ld, bool perm) {
    int t = tid; asm volatile("" : "+v"(t));
    int R, C; stage_rc(t * 16 + i * 8192, R, C); const int Rb = perm ? ((R & ~31) + perm32(R & 31)) : R;
    return (unsigned)(Rb * ld + C) * 2u;
}
template <class Epi, class Sched, bool FP8 = false>
__device__ __forceinline__ void gemm_phase(LAS unsigned char* lds, const Gemm g, const Sched& S, const Epi& E, int wave_s) {
    const int tid = fresh_tid(wave_s), wid = wave_s, lane = tid & 63, wr = wid >> 2, wc = wid & 3, fr = lane & 15, fq = lane >> 4;
    const int K = g.K, nt = K / BK;
    unsigned voffA[2], voffB[2];
#pragma unroll
    for (int i = 0; i < 2; ++i) { int R, C; stage_rc(tid * 16 + i * 8192, R, C); const int Rb = Epi::PERM ? ((R & ~31) + perm32(R & 31)) : R;
        voffA[i] = (unsigned)(R * g.lda + C) * 2u; voffB[i] = (unsigned)(Rb * g.ldb + C) * 2u; }
    const size_t kstepA = (size_t)g.kstepA, kstepB = (size_t)(BK * 2);
    const size_t hstepA = (size_t)HALF * g.lda * 2, hstepB = (size_t)HALF * g.ldb * 2;
    const unsigned ldsw = (unsigned)wid * 1024u;
    const int aoff = lds_byte(wr * 64 + fr, fq * 8), boff = lds_byte(wc * 32 + fr, fq * 8);
#define PG8_SA(b, h) (((b) * 2 + (h)) * HTB)
#define PG8_SB(b, h) ((4 + (b) * 2 + (h)) * HTB)
#define PG8_VOFF(voff, _i) (FP8 ? stage_voff(tid, _i, (voff) == voffA ? g.lda : g.ldb, (voff) == voffB && Epi::PERM) : (voff)[_i])
#define PG8_STAGE(bufoff, gbase, voff) do { _Pragma("unroll") for (int _i = 0; _i < 2; ++_i) \
        __builtin_amdgcn_global_load_lds((const unsigned*)((const char*)(gbase) + PG8_VOFF(voff, _i)), (LAS unsigned*)(lds + (bufoff) + ldsw + _i * 8192), 16, 0, 0); } while (0)
    const LAS unsigned char* aB = lds + aoff; asm volatile("" : "+v"(aB));
    const LAS unsigned char* bB = lds + 4 * HTB + boff; asm volatile("" : "+v"(bB));
#define PG8_RDA(off) (*(const LAS v4i_t*)(aB + (off)))
#define PG8_RDB(off) (*(const LAS v4i_t*)(bB + (off)))
#define PG8_LDA(dst, b, h) do { _Pragma("unroll") for (int m = 0; m < 4; ++m) dst[m] = __builtin_shufflevector(PG8_RDA(((b) * 2 + (h)) * HTB + m * 2048), PG8_RDA(((b) * 2 + (h)) * HTB + m * 2048 + 1024), 0, 1, 2, 3, 4, 5, 6, 7); } while (0)
#define PG8_LDB(dst, b, h) do { _Pragma("unroll") for (int n = 0; n < 2; ++n) dst[n] = __builtin_shufflevector(PG8_RDB(((b) * 2 + (h)) * HTB + n * 2048), PG8_RDB(((b) * 2 + (h)) * HTB + n * 2048 + 1024), 0, 1, 2, 3, 4, 5, 6, 7); } while (0)
#define PG8_LO(x) __builtin_bit_cast(bf16x8, __builtin_shufflevector(x, x, 0, 1, 2, 3))
#define PG8_HI(x) __builtin_bit_cast(bf16x8, __builtin_shufflevector(x, x, 4, 5, 6, 7))
#define PG8_MMA(ai, bj, At, Bt) do { __builtin_amdgcn_s_setprio(1); _Pragma("unroll") for (int m = 0; m < 4; ++m) _Pragma("unroll") for (int n = 0; n < 2; ++n) { \
        if (FP8) acc[ai][bj][m][n] = __builtin_amdgcn_mfma_scale_f32_16x16x128_f8f6f4(Bt[n], At[m], acc[ai][bj][m][n], 0, 0, 0, 0, 0, 0); \
        else { acc[ai][bj][m][n] = __builtin_amdgcn_mfma_f32_16x16x32_bf16(PG8_LO(Bt[n]), PG8_LO(At[m]), acc[ai][bj][m][n], 0, 0, 0); \
               acc[ai][bj][m][n] = __builtin_amdgcn_mfma_f32_16x16x32_bf16(PG8_HI(Bt[n]), PG8_HI(At[m]), acc[ai][bj][m][n], 0, 0, 0); } } \
        __builtin_amdgcn_s_setprio(0); } while (0)
#define PG8_WAIT_V(n) asm volatile("s_waitcnt vmcnt(" #n ")" ::: "memory")
#define PG8_WAIT_L(n) asm volatile("s_waitcnt lgkmcnt(" #n ")" ::: "memory")
#define PG8_BAR __builtin_amdgcn_s_barrier()
#define PG8_SCHED __builtin_amdgcn_sched_barrier(0)
    Unit cur, nxt; int ui = 0;
    if (!S.next(0, cur)) return;
    f32x4 acc[2][2][4][2];
#pragma unroll
    for (int a = 0; a < 2; ++a)
#pragma unroll
        for (int b = 0; b < 2; ++b)
#pragma unroll
            for (int m = 0; m < 4; ++m)
#pragma unroll
                for (int n = 0; n < 2; ++n) acc[a][b][m][n] = (f32x4){0.f, 0.f, 0.f, 0.f};
    v8i_t At[4], B0[2], B1[2];
    const char* cA = S.a_ptr(g, cur); const char* cB = S.b_ptr(g, cur);
    PG8_STAGE(PG8_SB(0, 0), cB, voffB); PG8_STAGE(PG8_SA(0, 0), cA, voffA); PG8_STAGE(PG8_SB(0, 1), cB + hstepB, voffB); PG8_STAGE(PG8_SA(0, 1), cA + hstepA, voffA);
    if (wr == 1) PG8_BAR;
    PG8_WAIT_V(4); PG8_BAR;
    PG8_STAGE(PG8_SB(1, 0), cB + kstepB, voffB); PG8_STAGE(PG8_SA(1, 0), cA + kstepA, voffA); PG8_STAGE(PG8_SB(1, 1), cB + hstepB + kstepB, voffB);
    PG8_WAIT_V(6); PG8_BAR;
    for (;;) {
        const bool has_next = S.next(ui + 1, nxt);
        const char* nA = has_next ? S.a_ptr(g, nxt) : cA; const char* nB = has_next ? S.b_ptr(g, nxt) : cB;
        for (int t = 0; t < nt; t += 2) {
            const bool last = (t == nt - 2);
            const char* a1 = cA + (size_t)(t + 1) * kstepA;
            const char* a2 = last ? nA : cA + (size_t)(t + 2) * kstepA; const char* b2 = last ? nB : cB + (size_t)(t + 2) * kstepB;
            const char* a3 = a2 + kstepA; const char* b3 = b2 + kstepB;
            PG8_LDB(B0, 0, 0); PG8_SCHED; PG8_LDA(At, 0, 0); PG8_STAGE(PG8_SA(1, 1), a1 + hstepA, voffA);
            PG8_WAIT_L(8); PG8_BAR; PG8_WAIT_L(0); PG8_MMA(0, 0, At, B0); PG8_BAR; PG8_SCHED;
            PG8_LDB(B1, 0, 1); PG8_STAGE(PG8_SB(0, 0), b2, voffB);
            PG8_BAR; PG8_WAIT_L(0); PG8_MMA(0, 1, At, B1); PG8_BAR;
            PG8_LDA(At, 0, 1); PG8_STAGE(PG8_SA(0, 0), a2, voffA);
            PG8_BAR; PG8_WAIT_L(0); PG8_MMA(1, 0, At, B0); PG8_BAR; PG8_SCHED;
            PG8_STAGE(PG8_SB(0, 1), b2 + hstepB, voffB);
            PG8_WAIT_V(6); PG8_BAR; PG8_MMA(1, 1, At, B1); PG8_BAR;
            PG8_LDB(B0, 1, 0); PG8_SCHED; PG8_LDA(At, 1, 0); PG8_STAGE(PG8_SA(0, 1), a2 + hstepA, voffA);
            PG8_WAIT_L(8); PG8_BAR; PG8_WAIT_L(0); PG8_MMA(0, 0, At, B0); PG8_BAR; PG8_SCHED;
            PG8_LDB(B1, 1, 1); PG8_STAGE(PG8_SB(1, 0), b3, voffB);
            PG8_BAR; PG8_WAIT_L(0); PG8_MMA(0, 1, At, B1); PG8_BAR;
            PG8_LDA(At, 1, 1); PG8_STAGE(PG8_SA(1, 0), a3, voffA);
            PG8_BAR; PG8_WAIT_L(0); PG8_MMA(1, 0, At, B0); PG8_BAR; PG8_SCHED;
            PG8_STAGE(PG8_SB(1, 1), b3 + hstepB, voffB);
            PG8_WAIT_V(6); PG8_BAR; PG8_MMA(1, 1, At, B1); PG8_BAR;
        }
        { const int tz = fresh_tid(wave_s), ln = tz & 63; E(acc, cur, wave_s >> 2, wave_s & 3, ln & 15, ln >> 4); }
        if (!has_next) break;
#pragma unroll
        for (int a = 0; a < 2; ++a)
#pragma unroll
            for (int b = 0; b < 2; ++b)
#pragma unroll
                for (int m = 0; m < 4; ++m)
#pragma unroll
                    for (int n = 0; n < 2; ++n) acc[a][b][m][n] = (f32x4){0.f, 0.f, 0.f, 0.f};
        cur = nxt; cA = nA; cB = nB; ++ui;
    }
    PG8_WAIT_V(0);
    if (wr == 0) PG8_BAR;
    PG8_BAR;
#undef PG8_SA
#undef PG8_SB
#undef PG8_STAGE
#undef PG8_VOFF
#undef PG8_LDA
#undef PG8_LDB
#undef PG8_MMA
#undef PG8_LO
#undef PG8_HI
#undef PG8_RDA
#undef PG8_RDB
#undef PG8_WAIT_V
#undef PG8_WAIT_L
#undef PG8_BAR
#undef PG8_SCHED
}
}

struct Frame {
    LAS unsigned char* lds;
    volatile LAS unsigned* MISC;
    unsigned* ctl;
    unsigned char* ws; unsigned char* ws0;
    const float* const* in;
    float* out;
    int tid, lane, wave, G, gw, NGW, wave0;
};
__device__ __forceinline__ void refresh(Frame& F) {
    unsigned ones = ~0u; asm volatile("" : "+s"(ones));
    int ln = (int)__builtin_amdgcn_mbcnt_hi(ones, __builtin_amdgcn_mbcnt_lo(ones, 0u)); asm volatile("" : "+v"(ln));
    int wv = F.wave0; asm volatile("" : "+s"(wv));
    F.lane = ln; F.wave = wv; F.tid = wv * 64 + ln; F.gw = blockIdx.x * 8 + wv;
    GAS unsigned char* w = (GAS unsigned char*)F.ws0; asm volatile("" : "+s"(w)); F.ws = (unsigned char*)w;
}

__constant__ unsigned char kBucket[128] = {0, 1, 2, 3, 4, 5, 6, 7, 8, 9, 10, 11, 12, 13, 14, 15, 16, 16, 16, 17, 17, 18, 18, 18, 19, 19, 19, 20, 20, 20, 20, 21, 21, 21, 21, 22, 22, 22, 22, 22, 23, 23, 23, 23, 23, 23, 24, 24, 24, 24, 24, 24, 25, 25, 25, 25, 25, 25, 25, 26, 26, 26, 26, 26, 26, 26, 26, 27, 27, 27, 27, 27, 27, 27, 27, 27, 27, 28, 28, 28, 28, 28, 28, 28, 28, 28, 28, 29, 29, 29, 29, 29, 29, 29, 29, 29, 29, 29, 29, 30, 30, 30, 30, 30, 30, 30, 30, 30, 30, 30, 30, 30, 30, 31, 31, 31, 31, 31, 31, 31, 31, 31, 31, 31, 31, 31, 31, 31};

__device__ __forceinline__ int win_src(int n, float& sc) {
    sc = 1.f;
    if (n < 544) { if (n < 256) sc = QS; else if (n >= 384 && n < 512) sc = IQS; return n; }
    if (n < 548) { sc = 0.5f; return n; }
    if (n < 560) return 1188 + (n - 548);
    if (n < 576) return -1;
    if (n < 832) { sc = QS; return 548 + (n - 576); }
    if (n < 1216) return 804 + (n - 832);
    if (n < 1728) { sc = QS; return 1200 + (n - 1216); }
    if (n < 2240) return 1712 + (n - 1728);
    if (n < 2752) return 2224 + (n - 2240);
    if (n < 5824) return 2736 + (n - 2752);
    return -1;
}
template <bool WIN>
__device__ __forceinline__ void p0_transpose_item(const float* W, int K, int Nsrc, int Ndst, bf16_t* WT, LAS float* scr, int item, int lane) {
    const int nblk = Ndst / 32, kb = item / nblk, nb = item % nblk, k0 = 64 * kb, n0 = 32 * nb;
    if (WIN) { float sc = 1.f; const int src = win_src(n0 + (lane & 31), sc);
#pragma unroll 8
        for (int i = 0; i < 32; ++i) { const int kk = 2 * i + (lane >> 5); scr[kk * 33 + (lane & 31)] = (src >= 0) ? W[(size_t)(k0 + kk) * Nsrc + src] * sc : 0.f; }
    } else {
        f32x4 v[8];
#pragma unroll
        for (int i = 0; i < 8; ++i) v[i] = *(const f32x4*)(W + (size_t)(k0 + 8 * i + (lane >> 3)) * Nsrc + n0 + (lane & 7) * 4);
#pragma unroll
        for (int i = 0; i < 8; ++i) { LAS float* q = scr + (8 * i + (lane >> 3)) * 33 + (lane & 7) * 4; q[0] = v[i].x; q[1] = v[i].y; q[2] = v[i].z; q[3] = v[i].w; }
    }
    LDS_WAIT(); asm volatile("" ::: "memory");
    const int c = lane & 7;
#pragma unroll
    for (int j = 0; j < 4; ++j) { const int n = (lane >> 3) + 8 * j; const LAS float* s = scr + (8 * c) * 33 + n;
        u32x4 o; o.x = pk2(s[0 * 33], s[1 * 33]); o.y = pk2(s[2 * 33], s[3 * 33]); o.z = pk2(s[4 * 33], s[5 * 33]); o.w = pk2(s[6 * 33], s[7 * 33]);
        *(u32x4*)(WT + (size_t)(n0 + n) * K + k0 + 8 * c) = o; }
    LDS_WAIT(); asm volatile("" ::: "memory");
}

template <bool WIN>
__device__ __forceinline__ void p0_transpose_item_f8(const float* W, int K, int N, unsigned char* WT, float sc, LAS float* scr, int item, int lane, int Nsrc = 0, int ncol0 = 0) {
    const int nblk = N / 32, kb = item / nblk, nb = item % nblk, k0 = 64 * kb, n0 = 32 * nb;
    if (WIN) { float s1 = 1.f; const int src = win_src(ncol0 + n0 + (lane & 31), s1);
#pragma unroll 8
        for (int i = 0; i < 32; ++i) { const int kk = 2 * i + (lane >> 5); scr[kk * 33 + (lane & 31)] = (src >= 0) ? W[(size_t)(k0 + kk) * Nsrc + src] * (s1 * sc) : 0.f; }
    } else
    { f32x4 v[8];
#pragma unroll
      for (int i = 0; i < 8; ++i) v[i] = *(const f32x4*)(W + (size_t)(k0 + 8 * i + (lane >> 3)) * N + n0 + (lane & 7) * 4);
#pragma unroll
      for (int i = 0; i < 8; ++i) { LAS float* q = scr + (8 * i + (lane >> 3)) * 33 + (lane & 7) * 4; q[0] = v[i].x * sc; q[1] = v[i].y * sc; q[2] = v[i].z * sc; q[3] = v[i].w * sc; } }
    LDS_WAIT(); asm volatile("" ::: "memory");
    const int c = lane & 3;
#pragma unroll
    for (int j = 0; j < 2; ++j) { const int n = (lane >> 2) + 16 * j; const LAS float* q = scr + (16 * c) * 33 + n;
        u32x4 o; o.x = pk4_fp8(q[0 * 33], q[1 * 33], q[2 * 33], q[3 * 33]); o.y = pk4_fp8(q[4 * 33], q[5 * 33], q[6 * 33], q[7 * 33]);
        o.z = pk4_fp8(q[8 * 33], q[9 * 33], q[10 * 33], q[11 * 33]); o.w = pk4_fp8(q[12 * 33], q[13 * 33], q[14 * 33], q[15 * 33]);
        *(u32x4*)(WT + (size_t)(n0 + n) * K + k0 + 16 * c) = o; }
    LDS_WAIT(); asm volatile("" ::: "memory");
}
__device__ __forceinline__ void phase_prologue(Frame& F) {
    const float* const* in = F.in;
    LAS float* scr = (LAS float*)(F.lds + F.wave * 16384);
    constexpr int I_WIN = 16 * (N_BF / 32), I_WMG = 16 * (N_F8 / 32);
    constexpr int I_BA = 4 * 32, I_BC = 8 * 32, I_WO = 16 * 32, I_W1 = 32 * 8, I_W2 = 4 * 2;
    constexpr int I_GU = 16 * 64, I_DN = 16 * 32;
    constexpr int N_GU = 64 * I_GU, N_DN = 64 * I_DN, N_WIN = 2 * I_WIN, N_BA = 2 * I_BA, N_BC = 2 * I_BC, N_WO = 2 * I_WO, N_W1 = 4 * I_W1, N_W2 = 4 * I_W2, N_WMG = 2 * I_WMG;
    constexpr int NITEMS = N_GU + N_DN + N_WIN + N_WMG + 2 * N_BA + N_BC + N_WO + N_W1 + N_W2;
    for (int it = F.gw; it < NITEMS; it += F.NGW) {
        int r = it;
        if (r < N_GU) { const int m = r / I_GU; p0_transpose_item_f8<false>(in[21] + (size_t)m * 1024 * 2048, 1024, 2048, (unsigned char*)(F.ws + WS_WGU_T) + (size_t)m * 2048 * 1024, F8_WGU, scr, r % I_GU, F.lane); continue; } r -= N_GU;
        if (r < N_DN) { const int m = r / I_DN; p0_transpose_item_f8<false>(in[23] + (size_t)m * 1024 * 1024, 1024, 1024, (unsigned char*)(F.ws + WS_WDN_T) + (size_t)m * 1024 * 1024, F8_WDN, scr, r % I_DN, F.lane); continue; } r -= N_DN;
        if (r < N_WIN) { const int m = r / I_WIN; p0_transpose_item<true>(in[5] + (size_t)m * 1024 * D_IN, 1024, D_IN, N_BF, (bf16_t*)(F.ws + WS_WIN_T) + (size_t)m * DP * 1024, scr, r % I_WIN, F.lane); continue; } r -= N_WIN;
        if (r < N_WMG) { const int m = r / I_WMG; p0_transpose_item_f8<true>(in[5] + (size_t)m * 1024 * D_IN, 1024, N_F8, (unsigned char*)(F.ws + WS_WMG8) + (size_t)m * N_F8 * 1024, F8_WIN, scr, r % I_WMG, F.lane, D_IN, N_BF); continue; } r -= N_WMG;
        if (r < N_BA) { const int m = r / I_BA; p0_transpose_item<false>(in[11] + (size_t)m * 256 * 1024, 256, 1024, 1024, (bf16_t*)(F.ws + WS_WBR_T + m * 2 * MiB), scr, r % I_BA, F.lane); continue; } r -= N_BA;
        if (r < N_BA) { const int m = r / I_BA; p0_transpose_item<false>(in[12] + (size_t)m * 256 * 1024, 256, 1024, 1024, (bf16_t*)(F.ws + WS_WBR_T + m * 2 * MiB + 512 * 1024), scr, r % I_BA, F.lane); continue; } r -= N_BA;
        if (r < N_BC) { const int m = r / I_BC; p0_transpose_item<false>(in[13] + (size_t)m * 512 * 1024, 512, 1024, 1024, (bf16_t*)(F.ws + WS_WBR_T + m * 2 * MiB + 1024 * 1024), scr, r % I_BC, F.lane); continue; } r -= N_BC;
        if (r < N_WO) { const int m = r / I_WO; p0_transpose_item<false>(in[14] + (size_t)m * 1024 * 1024, 1024, 1024, 1024, (bf16_t*)(F.ws + WS_WOUT_T) + (size_t)m * 1024 * 1024, scr, r % I_WO, F.lane); continue; } r -= N_WO;
        if (r < N_W1) { const int m = r / I_W1; p0_transpose_item<false>(in[7] + (size_t)m * 2048 * 256, 2048, 256, 256, (bf16_t*)(F.ws + WS_W1_T) + (size_t)m * 256 * 2048, scr, r % I_W1, F.lane); continue; } r -= N_W1;
        { const int m = r / I_W2; p0_transpose_item<false>(in[8] + (size_t)m * 256 * 64, 256, 64, 64, (bf16_t*)(F.ws + WS_W2_T) + (size_t)m * 64 * 256, scr, r % I_W2, F.lane); }
    }
    __syncthreads();
    if (blockIdx.x < 27) {
        LAS float* sc = (LAS float*)F.lds;
        for (int i = F.tid; i < 16 * 1024; i += 512) { const int b = i >> 10, k = i & 1023; const float v = in[1][i]; sc[k * 16 + b] = v * fsigmoid(v); }
        __syncthreads();
        if (F.gw < 192) {
            const int which = F.gw / 48, cb = F.gw % 48, layer = which >> 1, col = cb * 64 + F.lane;
            const float* W = (which & 1 ? in[17] : in[3]) + (size_t)layer * 1024 * 3072;
            const float* Bv = (which & 1 ? in[18] : in[4]) + (size_t)layer * 3072;
            float acc[16];
#pragma unroll
            for (int b = 0; b < 16; ++b) acc[b] = 0.f;
#pragma unroll 4
            for (int k = 0; k < 1024; ++k) { const float w = W[(size_t)k * 3072 + col];
                const f32x4 s0 = *(const LAS f32x4*)(sc + k * 16), s1 = *(const LAS f32x4*)(sc + k * 16 + 4), s2 = *(const LAS f32x4*)(sc + k * 16 + 8), s3 = *(const LAS f32x4*)(sc + k * 16 + 12);
#pragma unroll
                for (int q = 0; q < 4; ++q) { acc[q] += s0[q] * w; acc[4 + q] += s1[q] * w; acc[8 + q] += s2[q] * w; acc[12 + q] += s3[q] * w; } }
            float* mod = (float*)(F.ws + WS_MOD) + (size_t)which * 16 * 3072;
            const float bb = Bv[col];
#pragma unroll
            for (int b = 0; b < 16; ++b) mod[(size_t)b * 3072 + col] = acc[b] + bb;
        } else if (F.gw < 208) {
            const int u = F.gw - 192, m = u >> 2, n = (u & 3) * 64 + F.lane;
            const float* P = in[6] + (size_t)m * 2048; const float* W = in[7] + (size_t)m * 2048 * 256;
            float a = 0.f;
#pragma unroll 8
            for (int r = 0; r < 2048; ++r) a += P[r] * W[(size_t)r * 256 + n];
            ((float*)(F.ws + WS_BIAS1))[m * 256 + n] = a;
        } else if (F.gw == 208) {
            float* lut = (float*)(F.ws + WS_LUT);
            for (int i = F.lane; i < 12 * 128; i += 64) { const int h = i >> 7, d = i & 127; lut[i] = (in[2][kBucket[d] * 12 + h] - in[2][31 * 12 + h]) * LOG2E; }
            for (int l = 0; l < 2; ++l) { const float* dl = in[9] + l * 256;
                const float s1 = wave_sum(dl[F.lane] * dl[64 + F.lane], F.lane), s2 = wave_sum(dl[128 + F.lane] * dl[192 + F.lane], F.lane);
                const float lam_init = 0.8f - 0.6f * __expf(-0.3f * (float)l);
                if (F.lane == 0) ((float*)(F.ws + WS_LAM))[l] = __expf(s1) - __expf(s2) + lam_init; }
        }
    }
}

__device__ __forceinline__ void phase_h0(Frame& F, const float* X, const float* mod, bf16_t* HB, unsigned char* HB8) {
    for (int row = F.gw; row < NTOK; row += F.NGW) { const int b = row >> 12;
        const f32x4* xr = (const f32x4*)(X + (size_t)row * 1024) + F.lane; const f32x4* sh = (const f32x4*)(mod + (size_t)b * 3072) + F.lane; const f32x4* sc = (const f32x4*)(mod + (size_t)b * 3072 + 1024) + F.lane;
        u64* o8 = (u64*)(HB + (size_t)row * 1024) + F.lane; unsigned* q8 = (unsigned*)(HB8 + (size_t)row * 1024) + F.lane;
#pragma unroll
        for (int j = 0; j < 4; ++j) { const f32x4 v = xr[64 * j] * (sc[64 * j] + 1.0f) + sh[64 * j]; o8[64 * j] = (u64)pk2(v.x, v.y) | ((u64)pk2(v.z, v.w) << 32);
            q8[64 * j] = pk4_fp8(F8_H * v.x, F8_H * v.y, F8_H * v.z, F8_H * v.w); } }
}
__device__ __forceinline__ void ln_stats(const f32x4 (&v)[4], float& mean, float& rstd, int lane) {
    float s = 0.f;
#pragma unroll
    for (int j = 0; j < 4; ++j) s += (v[j].x + v[j].y) + (v[j].z + v[j].w);
    mean = wave_sum(s, lane) * (1.f / 1024.f); float s2 = 0.f;
#pragma unroll
    for (int j = 0; j < 4; ++j) { const f32x4 d = v[j] - mean; s2 += (d.x * d.x + d.y * d.y) + (d.z * d.z + d.w * d.w); }
    rstd = 1.f / sqrtf(wave_sum(s2, lane) * (1.f / 1024.f) + LN_EPS);
}

__device__ __forceinline__ void phase_ln1_router(Frame& F, bf16_t* Z, const float* g1, const float* b1, const float* mod, const float* rw, const float* rb, bf16_t* HB, unsigned* cnt) {
    LAS float* rwT = (LAS float*)F.lds;
    for (int i = F.tid; i < 32 * 1024; i += 512) { const int k = i >> 5, e = i & 31; rwT[e * 1024 + k] = rw[i]; }
    __syncthreads();
    const int lane = F.lane, e_l = lane >> 1;
    const float rbias = rb[e_l];
    unsigned slot0 = 0, slot1 = 0; unsigned cnt_local = 0;
    f32x4 gg[4], bb[4];
#pragma unroll
    for (int j = 0; j < 4; ++j) { gg[j] = ((const f32x4*)g1)[lane + 64 * j]; bb[j] = ((const f32x4*)b1)[lane + 64 * j]; }
    int it = 0;
    for (int row = F.gw; row < NTOK; row += F.NGW, ++it) { const int b = row >> 12;
        u32x2* zr = (u32x2*)(Z + (size_t)row * 1024) + lane; const f32x4* sh = (const f32x4*)(mod + (size_t)b * 3072) + lane; const f32x4* sc = (const f32x4*)(mod + (size_t)b * 3072 + 1024) + lane;
        f32x4 v[4];
#pragma unroll
        for (int j = 0; j < 4; ++j) { const u32x2 q = zr[64 * j]; v[j] = (f32x4){bflo(q.x), bfhi(q.x), bflo(q.y), bfhi(q.y)}; }
        float mean, rstd; ln_stats(v, mean, rstd, lane);
        u64* o8 = (u64*)(HB + (size_t)row * 1024) + lane;
        f32x4 h[4];
#pragma unroll
        for (int j = 0; j < 4; ++j) { const f32x4 xn = (v[j] - mean) * rstd * gg[j] + bb[j]; zr[64 * j] = (u32x2){cvt_pk_bf16(xn.x, xn.y), cvt_pk_bf16(xn.z, xn.w)}; h[j] = xn * (sc[64 * j] + 1.0f) + sh[64 * j];
            o8[64 * j] = (u64)pk2(h[j].x, h[j].y) | ((u64)pk2(h[j].z, h[j].w) << 32); }
        float a[32];
#pragma unroll
        for (int e = 0; e < 32; ++e) { float s = 0.f;
#pragma unroll
            for (int j = 0; j < 4; ++j) { const f32x4 w = *(const LAS f32x4*)(rwT + e * 1024 + 4 * lane + 256 * j); s += (h[j].x * w.x + h[j].y * w.y) + (h[j].z * w.z + h[j].w * w.w); }
            a[e] = s; if ((e & 3) == 3) __builtin_amdgcn_sched_barrier(0); }
#pragma unroll
        for (int st = 0; st < 5; ++st) { const int half = 16 >> st, x = 32 >> st; const bool up = (lane & x) != 0;
#pragma unroll
            for (int i = 0; i < half; ++i) { const float send = up ? a[i] : a[i + half], keep = up ? a[i + half] : a[i]; a[i] = keep + (st == 0 ? other32(send, lane) : shx_f(send, x, lane)); } }
        float lg = a[0] + shx_f(a[0], 1, lane) + rbias;
        float tv[4]; int te[4];
#pragma unroll
        for (int k = 0; k < 4; ++k) { float bv = lg; int be = e_l;
#pragma unroll
            for (int x = 2; x < 64; x <<= 1) { const float ov = shx_f(bv, x, lane); const int oe = shx_i(be, x, lane); if (ov > bv || (ov == bv && oe < be)) { bv = ov; be = oe; } }
            tv[k] = bv; te[k] = be; if (e_l == be) lg = -INFINITY; }
        const float e1 = __expf(tv[1] - tv[0]), e2 = __expf(tv[2] - tv[0]), e3 = __expf(tv[3] - tv[0]); const float inv = 1.f / (1.f + e1 + e2 + e3);
        if (lane == 0) { *(int4*)((int*)(F.ws + WS_TOKE) + (size_t)row * 4) = make_int4(te[0], te[1], te[2], te[3]);
            *(f32x4*)((float*)(F.ws + WS_TOKW) + (size_t)row * 4) = (f32x4){inv, e1 * inv, e2 * inv, e3 * inv}; }
#pragma unroll
        for (int k = 0; k < 4; ++k) { const int ek = __builtin_amdgcn_readfirstlane(te[k]); const unsigned rk = (unsigned)__builtin_amdgcn_readlane((int)cnt_local, ek);
            if (lane == ek) ++cnt_local;
            const int idx = it * 4 + k; const unsigned val = ((unsigned)ek << 16) | rk;
            if (lane == (idx & 63)) { if (idx < 64) slot0 = val; else slot1 = val; } }
    }
    unsigned base = 0;
    if (lane < 32) base = __hip_atomic_fetch_add(cnt + lane, cnt_local, __ATOMIC_RELAXED, __HIP_MEMORY_SCOPE_AGENT);
#pragma unroll
    for (int s = 0; s < 2; ++s) { const unsigned val = s ? slot1 : slot0; const int e = (int)(val >> 16); const unsigned pos = (unsigned)bperm_i(e, (int)base) + (val & 0xffffu);
        const int i = (64 * s + lane) >> 2, k = lane & 3; const int row = F.gw + i * F.NGW;
        if (i < it) ((int*)(F.ws + WS_TOKP))[(size_t)row * 4 + k] = (int)pos; }
    __syncthreads();
}

__device__ __forceinline__ void build_pstart(Frame& F, const unsigned* cnt) {
    if (F.tid == 0) { int p = 0; for (int e = 0; e < 32; ++e) { F.MISC[16 + e] = (unsigned)p; p += (int)((__hip_atomic_load(cnt + e, __ATOMIC_RELAXED, __HIP_MEMORY_SCOPE_AGENT) + 255u) >> 8); } F.MISC[48] = (unsigned)p; }
    __syncthreads();
}
__device__ __forceinline__ void phase_gather(Frame& F, const unsigned* cnt, const bf16_t* HB, unsigned char* HS) {
    build_pstart(F, cnt);
    for (int row = F.gw; row < NTOK; row += F.NGW) {
        const int4 te = *(const int4*)((const int*)(F.ws + WS_TOKE) + (size_t)row * 4), tp = *(const int4*)((const int*)(F.ws + WS_TOKP) + (size_t)row * 4);
        const int r0 = (int)F.MISC[16 + te.x] * 256 + tp.x, r1 = (int)F.MISC[16 + te.y] * 256 + tp.y, r2 = (int)F.MISC[16 + te.z] * 256 + tp.z, r3 = (int)F.MISC[16 + te.w] * 256 + tp.w;
        if (F.lane == 0) *(int4*)((int*)(F.ws + WS_TOKR) + (size_t)row * 4) = make_int4(r0, r1, r2, r3);
        const u32x4* src = (const u32x4*)(HB + (size_t)row * 1024) + 2 * F.lane; const u32x4 a = src[0], b = src[1];
        u32x4 v;
        v.x = pk4_fp8(F8_H * bflo(a.x), F8_H * bfhi(a.x), F8_H * bflo(a.y), F8_H * bfhi(a.y)); v.y = pk4_fp8(F8_H * bflo(a.z), F8_H * bfhi(a.z), F8_H * bflo(a.w), F8_H * bfhi(a.w));
        v.z = pk4_fp8(F8_H * bflo(b.x), F8_H * bfhi(b.x), F8_H * bflo(b.y), F8_H * bfhi(b.y)); v.w = pk4_fp8(F8_H * bflo(b.z), F8_H * bfhi(b.z), F8_H * bflo(b.w), F8_H * bfhi(b.w));
        ((u32x4*)(HS + (size_t)r0 * 1024))[F.lane] = v; ((u32x4*)(HS + (size_t)r1 * 1024))[F.lane] = v; ((u32x4*)(HS + (size_t)r2 * 1024))[F.lane] = v; ((u32x4*)(HS + (size_t)r3 * 1024))[F.lane] = v;
    }
    if (blockIdx.x < 32) { const int e = blockIdx.x; const int c = (int)__hip_atomic_load(cnt + e, __ATOMIC_RELAXED, __HIP_MEMORY_SCOPE_AGENT);
        const int rbeg = (int)F.MISC[16 + e] * 256 + c, rend = (int)F.MISC[17 + e] * 256;
        for (int r = rbeg + F.wave; r < rend; r += 8) ((u32x4*)(HS + (size_t)r * 1024))[F.lane] = (u32x4){0u, 0u, 0u, 0u}; }
}
__device__ __forceinline__ void phase_combine(Frame& F, const bf16_t* YS, const bf16_t* X1, const float* modf, const float* g2, const float* b2, float* XO, const float* modn, bf16_t* HB, unsigned char* HB8, bf16_t* X2B) {
    const int lane = F.lane;
    f32x4 gg[4], bb[4];
#pragma unroll
    for (int q = 0; q < 4; ++q) { gg[q] = ((const f32x4*)g2)[128 * (q >> 1) + 2 * lane + (q & 1)]; bb[q] = ((const f32x4*)b2)[128 * (q >> 1) + 2 * lane + (q & 1)]; }
    for (int row = F.gw; row < NTOK; row += F.NGW) { const int b = row >> 12;
        const int4 tr = *(const int4*)((const int*)(F.ws + WS_TOKR) + (size_t)row * 4); const f32x4 tw = *(const f32x4*)((const float*)(F.ws + WS_TOKW) + (size_t)row * 4);
        const int rr[4] = {tr.x, tr.y, tr.z, tr.w}; const float ww[4] = {tw.x, tw.y, tw.z, tw.w};
        u32x4 yq[4][2];
#pragma unroll
        for (int k = 0; k < 4; ++k)
#pragma unroll
            for (int c = 0; c < 2; ++c) yq[k][c] = ((const u32x4*)(YS + (size_t)rr[k] * 1024))[64 * c + lane];
        u32x4 xq[2];
#pragma unroll
        for (int c = 0; c < 2; ++c) xq[c] = ((const u32x4*)(X1 + (size_t)row * 1024))[64 * c + lane];
        const f32x4* gt = (const f32x4*)(modf + (size_t)b * 3072 + 2048);
        f32x4 v[4];
#pragma unroll
        for (int c = 0; c < 2; ++c) { f32x4 y0 = (f32x4){0.f, 0.f, 0.f, 0.f}, y1 = y0;
#pragma unroll
            for (int k = 0; k < 4; ++k) { const u32x4 w = yq[k][c]; y0 += (f32x4){bflo(w.x), bfhi(w.x), bflo(w.y), bfhi(w.y)} * ww[k]; y1 += (f32x4){bflo(w.z), bfhi(w.z), bflo(w.w), bfhi(w.w)} * ww[k]; }
            const u32x4 q = xq[c];
            v[2 * c] = (f32x4){bflo(q.x), bfhi(q.x), bflo(q.y), bfhi(q.y)} * DN_ALPHA + (gt[128 * c + 2 * lane] + 1.0f) * y0;
            v[2 * c + 1] = (f32x4){bflo(q.z), bfhi(q.z), bflo(q.w), bfhi(q.w)} * DN_ALPHA + (gt[128 * c + 2 * lane + 1] + 1.0f) * y1; }
        float mean, rstd; ln_stats(v, mean, rstd, lane);
        if (modn) { const f32x4* sh = (const f32x4*)(modn + (size_t)b * 3072); const f32x4* sc = (const f32x4*)(modn + (size_t)b * 3072 + 1024);
#pragma unroll
            for (int c = 0; c < 2; ++c) { const f32x4 x0 = (v[2 * c] - mean) * rstd * gg[2 * c] + bb[2 * c], x1 = (v[2 * c + 1] - mean) * rstd * gg[2 * c + 1] + bb[2 * c + 1];
                ((u32x4*)(X2B + (size_t)row * 1024))[64 * c + lane] = (u32x4){cvt_pk_bf16(x0.x, x0.y), cvt_pk_bf16(x0.z, x0.w), cvt_pk_bf16(x1.x, x1.y), cvt_pk_bf16(x1.z, x1.w)};
                const f32x4 h0 = x0 * (sc[128 * c + 2 * lane] + 1.0f) + sh[128 * c + 2 * lane], h1 = x1 * (sc[128 * c + 2 * lane + 1] + 1.0f) + sh[128 * c + 2 * lane + 1];
                ((u32x4*)(HB + (size_t)row * 1024))[64 * c + lane] = (u32x4){cvt_pk_bf16(h0.x, h0.y), cvt_pk_bf16(h0.z, h0.w), cvt_pk_bf16(h1.x, h1.y), cvt_pk_bf16(h1.z, h1.w)};
                ((u32x2*)(HB8 + (size_t)row * 1024))[64 * c + lane] = (u32x2){pk4_fp8(F8_H * h0.x, F8_H * h0.y, F8_H * h0.z, F8_H * h0.w), pk4_fp8(F8_H * h1.x, F8_H * h1.y, F8_H * h1.z, F8_H * h1.w)}; }
        } else {
#pragma unroll
            for (int q = 0; q < 4; ++q) ((f32x4*)(XO + (size_t)row * 1024))[128 * (q >> 1) + 2 * lane + (q & 1)] = (v[q] - mean) * rstd * gg[q] + bb[q];
        }
    }
}

__device__ __forceinline__ unsigned okey24(float v) { if (v == 0.f) v = 0.f; unsigned u = __builtin_bit_cast(unsigned, v); u = (u & 0x80000000u) ? ~u : (u | 0x80000000u); return u >> 8; }
__device__ __forceinline__ f32x4 idx_score(const bf16x8 ka, const bf16x8 (&qb)[4], const float (&w4)[4]) {
    f32x4 s = (f32x4){0.f, 0.f, 0.f, 0.f};
#pragma unroll
    for (int h = 0; h < 4; ++h) { const f32x4 c = __builtin_amdgcn_mfma_f32_16x16x32_bf16(ka, qb[h], (f32x4){0.f, 0.f, 0.f, 0.f}, 0, 0, 0);
#pragma unroll
        for (int j = 0; j < 4; ++j) s[j] += w4[h] * fmaxf(c[j], 0.f); }
    return s;
}
__device__ __forceinline__ void scan_row(const volatile LAS unsigned* hw, unsigned need, int lane, int& bin, unsigned& above, unsigned& cntb) {
    unsigned s = 0;
#pragma unroll 8
    for (int i = 0; i < 32; ++i) { const unsigned wv = hw[32 * lane + ((i + lane) & 31)]; s += (wv & 0xffffu) + (wv >> 16); }
    unsigned S = s;
#pragma unroll
    for (int o = 1; o < 64; o <<= 1) { const unsigned t = (unsigned)bperm_i((lane + o) & 63, (int)S); if (lane + o < 64) S += t; }
    const u64 bal = __ballot(S >= need);
    const int L = bal ? 63 - __clzll((long long)bal) : 0;
    const unsigned Snext = (unsigned)bperm_i((L + 1) & 63, (int)S);
    const unsigned aboveL = (L < 63) ? Snext : 0u;
    const int bi = 63 - lane; const unsigned wv = hw[32 * L + (bi >> 1)]; const unsigned c = (bi & 1) ? (wv >> 16) : (wv & 0xffffu);
    unsigned Pj = c;
#pragma unroll
    for (int o = 1; o < 64; o <<= 1) { const unsigned t = (unsigned)bperm_i((lane - o) & 63, (int)Pj); if (lane >= o) Pj += t; }
    Pj += aboveL;
    const u64 hit = __ballot(Pj >= need);
    const int js = hit ? __ffsll((long long)hit) - 1 : 63;
    bin = 64 * L + 63 - js; cntb = (unsigned)bperm_i(js, (int)c); above = (unsigned)bperm_i(js, (int)Pj) - cntb;
}
template <int PASS>
__device__ __forceinline__ void dsa_pass(Frame& F, const bf16_t* kbase, unsigned* KS, const bf16x8 (&qb)[4], const float (&w4)[4], int nkt, int tq, unsigned r_a, unsigned r_b) {
    const int lane = F.lane, fr = lane & 15, fq = lane >> 4;
    LAS unsigned* hist = (LAS unsigned*)F.lds;
    const int kt0 = F.wave; if (kt0 >= nkt) return;
    u32x4* ksl = (u32x4*)KS + lane;
    u32x4 kc[4], kn[4];
#pragma unroll
    for (int u = 0; u < 4; ++u) { kc[u] = (u32x4){0u, 0u, 0u, 0u}; if (kt0 + 8 * u < nkt) kc[u] = (PASS == 1) ? __builtin_bit_cast(u32x4, *(const bf16x8*)(kbase + (size_t)(kt0 + 8 * u) * 16 * DP)) : ksl[(size_t)(kt0 + 8 * u) * 64]; }
    for (int kg = kt0; kg < nkt; kg += 32) {
#pragma unroll
        for (int u = 0; u < 4; ++u) { kn[u] = kc[u]; if (kg + 32 + 8 * u < nkt) kn[u] = (PASS == 1) ? __builtin_bit_cast(u32x4, *(const bf16x8*)(kbase + (size_t)(kg + 32 + 8 * u) * 16 * DP)) : ksl[(size_t)(kg + 32 + 8 * u) * 64]; }
#pragma unroll
        for (int u = 0; u < 4; ++u) { const int kt = kg + 8 * u;
            if (kt < nkt) {
                unsigned kk[4];
                if (PASS == 1) { const f32x4 sc = idx_score(__builtin_bit_cast(bf16x8, kc[u]), qb, w4);
#pragma unroll
                    for (int j = 0; j < 4; ++j) { const int s = kt * 16 + 4 * fq + j; kk[j] = okey24(sc[j]) | ((s <= tq) ? 0x80000000u : 0u); }
                    ksl[(size_t)kt * 64] = (u32x4){kk[0], kk[1], kk[2], kk[3]};
                } else { kk[0] = kc[u].x; kk[1] = kc[u].y; kk[2] = kc[u].z; kk[3] = kc[u].w; }
                unsigned nd = 0, nt_ = 0;
#pragma unroll
                for (int j = 0; j < 4; ++j) { const bool valid = (kk[j] >> 31) != 0u; const unsigned key = kk[j] & 0xffffffu;
                    if (PASS == 1) { if (valid) { const unsigned bin = key >> 12; __hip_atomic_fetch_add(hist + fr * 2048 + (bin >> 1), 1u << (16 * (bin & 1)), __ATOMIC_RELAXED, __HIP_MEMORY_SCOPE_WORKGROUP); } }
                    if (PASS == 2) { if (valid && (key >> 12) == r_a) { const unsigned bin = key & 4095u; __hip_atomic_fetch_add(hist + fr * 2048 + (bin >> 1), 1u << (16 * (bin & 1)), __ATOMIC_RELAXED, __HIP_MEMORY_SCOPE_WORKGROUP); } }
                    if (PASS == 3) { if (valid) { if (DSA_FAKE) nd |= 1u << j; else { nd |= (key > r_a ? 1u : 0u) << j; nt_ |= (key == r_a ? 1u : 0u) << j; } } } }
                if (PASS == 3) { const int sh = 16 * (kt & 1) + 4 * fq; const int wd = fr * 128 + (kt >> 1);
                    if (nd) __hip_atomic_fetch_or(hist + wd, nd << sh, __ATOMIC_RELAXED, __HIP_MEMORY_SCOPE_WORKGROUP);
                    if (nt_) __hip_atomic_fetch_or(hist + 2048 + wd, nt_ << sh, __ATOMIC_RELAXED, __HIP_MEMORY_SCOPE_WORKGROUP); }
            } }
#pragma unroll
        for (int u = 0; u < 4; ++u) kc[u] = kn[u];
    }
}
__device__ __forceinline__ void lds_zero(Frame& F, int bytes) {
    LAS u32x4* p = (LAS u32x4*)F.lds; unsigned z = 0u; asm volatile("" : "+v"(z));
    for (int i = F.tid; i < bytes / 16; i += 512) p[i] = (u32x4){z, z, z, z};
}
__device__ __forceinline__ void dsa_select_tile(Frame& F, const bf16_t* P, u64* BM, unsigned* KS, int b, int qt) {
    volatile LAS unsigned* rinfo = F.MISC + 64;
    volatile LAS unsigned* hist = (volatile LAS unsigned*)F.lds;
    const int lane = F.lane, fr = lane & 15, fq = lane >> 4, w = F.wave;
    const int t0 = qt * 16, nkt = qt + 1; const size_t rowbase = (size_t)b * 4096;
    const bf16_t* qrow = P + (rowbase + t0 + fr) * DP;
    bf16x8 qb[4];
#pragma unroll
    for (int h = 0; h < 4; ++h) qb[h] = *(const bf16x8*)(qrow + C_IQ + h * 32 + 8 * fq);
    const u32x2 iwp = *(const u32x2*)(qrow + C_IW); const float w4[4] = {bflo(iwp.x), bfhi(iwp.x), bflo(iwp.y), bfhi(iwp.y)};
    const bf16_t* kbase = P + (rowbase + fr) * DP + C_IK + 8 * fq;
    const int tq = t0 + fr;
    if (qt >= 16 && !DSA_FAKE) {
        lds_zero(F, 131072); __syncthreads();
        dsa_pass<1>(F, kbase, KS, qb, w4, nkt, tq, 0u, 0u);
        __syncthreads();
#pragma unroll 1
        for (int rr = 0; rr < 2; ++rr) { const int r = 2 * w + rr; int bin; unsigned above, cb; scan_row(hist + r * 2048, 256u, lane, bin, above, cb);
            if (lane == 0) { rinfo[r * 4 + 0] = (unsigned)bin; rinfo[r * 4 + 1] = 256u - above; } }
        __syncthreads();
        lds_zero(F, 131072); __syncthreads();
        dsa_pass<2>(F, kbase, KS, qb, w4, nkt, tq, rinfo[fr * 4 + 0], 0u);
        __syncthreads();
#pragma unroll 1
        for (int rr = 0; rr < 2; ++rr) { const int r = 2 * w + rr; const unsigned b1 = rinfo[r * 4 + 0], rem1 = rinfo[r * 4 + 1]; int bin; unsigned above, cb; scan_row(hist + r * 2048, rem1, lane, bin, above, cb);
            if (lane == 0) { const unsigned take = rem1 - above; rinfo[r * 4 + 0] = (b1 << 12) | (unsigned)bin; rinfo[r * 4 + 1] = take; rinfo[r * 4 + 2] = (cb > take) ? 1u : 0u; } }
        __syncthreads();
    } else {
        if (F.tid < 16) { rinfo[F.tid * 4 + 0] = 0u; rinfo[F.tid * 4 + 1] = 0xffffffffu; rinfo[F.tid * 4 + 2] = 0u; }
        dsa_pass<1>(F, kbase, KS, qb, w4, nkt, tq, 0u, 0u);
        __syncthreads();
    }
    lds_zero(F, 16384); __syncthreads();
    dsa_pass<3>(F, kbase, KS, qb, w4, nkt, tq, rinfo[fr * 4 + 0], 0u);
    __syncthreads();
    volatile LAS u64* FIN = (volatile LAS u64*)(F.lds + 16384);
#pragma unroll 1
    for (int rr = 0; rr < 2; ++rr) { const int r = 2 * w + rr;
        const u64 def = (u64)hist[r * 128 + 2 * lane] | ((u64)hist[r * 128 + 2 * lane + 1] << 32);
        u64 tie = (u64)hist[2048 + r * 128 + 2 * lane] | ((u64)hist[2048 + r * 128 + 2 * lane + 1] << 32);
        if (rinfo[r * 4 + 2]) { const int take = (int)rinfo[r * 4 + 1]; const int c = __popcll(tie); int inc = c;
#pragma unroll
            for (int o = 1; o < 64; o <<= 1) { const int t = bperm_i((lane - o) & 63, inc); if (lane >= o) inc += t; }
            int tk = take - (inc - c); tk = tk < 0 ? 0 : (tk > c ? c : tk);
            while (__popcll(tie) > tk) tie &= ~(1ull << (63 - __clzll((long long)tie))); }
        FIN[lane * 16 + r] = def | tie; }
    __syncthreads();
#pragma unroll
    for (int k = 0; k < 2; ++k) { const int idx = F.tid + 512 * k, l = idx >> 4, r = idx & 15;
        if (l <= (t0 >> 6)) BM[((size_t)(b * 64 + l) * 4096) + t0 + r] = FIN[l * 16 + r]; }
    __builtin_amdgcn_fence(__ATOMIC_ACQUIRE, "agent");
    __syncthreads();
}

#define MFMA32(a, b, c) __builtin_amdgcn_mfma_f32_32x32x16_bf16(a, b, c, 0, 0, 0)
typedef short v4i16_t __attribute__((ext_vector_type(4)));
__device__ __forceinline__ s16x4 vtr(const LAS unsigned char* p) { return __builtin_bit_cast(s16x4, __builtin_amdgcn_ds_read_tr16_b64_v4i16((LAS v4i16_t*)p)); }
constexpr int AT_KBUF = 0, AT_VBUF = 16384, AT_WSF = 49152, AT_LUT = 51200, AT_IMP = 57344, AT_RMASK = 124928, AT_WOR = 125440;
enum { MK_C = 0, MK_A = 1, MK_WIN = 2, MK_SLC = 3, MK_CMP = 4 };
constexpr float ATT_THR = 8.f;

template <int VD> struct AState { f32x16 o[VD / 32]; float m, l; };
template <int VD> __device__ __forceinline__ void astate_init(AState<VD>& s) {
#pragma unroll
    for (int d = 0; d < VD / 32; ++d)
#pragma unroll
        for (int r = 0; r < 16; ++r) s.o[d][r] = 0.f;
    s.m = -1e30f; s.l = 0.f;
}
template <int VD>
__device__ __forceinline__ void stage_kv(LAS unsigned char* kbuf, LAS unsigned char* vbuf, const bf16_t* Kt, int ldk, const bf16_t* Vt, int ldv, int wave, int lane, bool with_v) {
    __builtin_amdgcn_global_load_lds((const unsigned*)(Kt + (size_t)lane * ldk + wave * 8), (LAS unsigned*)(kbuf + wave * 1024), 16, 0, 0);
    if (with_v) {
#pragma unroll
        for (int pc0 = 0; pc0 < VD / 8; pc0 += 8) { const int pc = pc0 + wave;
            __builtin_amdgcn_global_load_lds((const unsigned*)(Vt + (size_t)(16 * (pc & 3) + (lane >> 2)) * ldv + (pc >> 2) * 32 + (lane & 3) * 8), (LAS unsigned*)(vbuf + pc * 1024), 16, 0, 0); }
    }
}
__device__ __forceinline__ void qk_tile(f32x16& S0, f32x16& S1, const bf16x8 (&qr)[4], const LAS unsigned char* kbuf, int r32, int hi) {
    const LAS unsigned char* kp = kbuf + hi * 1024 + r32 * 16;
#pragma unroll
    for (int r = 0; r < 16; ++r) { S0[r] = 0.f; S1[r] = 0.f; }
#pragma unroll
    for (int g = 0; g < 2; ++g) {
        bf16x8 kf[4];
#pragma unroll
        for (int d = 0; d < 2; ++d) { kf[2 * d] = *(const LAS bf16x8*)(kp + (2 * g + d) * 2048); kf[2 * d + 1] = *(const LAS bf16x8*)(kp + (2 * g + d) * 2048 + 512); }
#pragma unroll
        for (int d = 0; d < 2; ++d) { S0 = MFMA32(kf[2 * d], qr[2 * g + d], S0); S1 = MFMA32(kf[2 * d + 1], qr[2 * g + d], S1); }
        if (PROBE_ATT == 2) { f32x16 D0, D1;
#pragma unroll
            for (int r = 0; r < 16; ++r) { D0[r] = 0.f; D1[r] = 0.f; }
#pragma unroll
            for (int d = 0; d < 2; ++d) { D0 = MFMA32(kf[2 * d], qr[2 * g + d], D0); D1 = MFMA32(kf[2 * d + 1], qr[2 * g + d], D1); }
            asm volatile("" :: "v"(D0[0] + D1[0])); }
    }
}
template <int MODE>
__device__ __forceinline__ void apply_mask(f32x16& S0, f32x16& S1, int tq, int key0, int hi, bool near, const LAS float* lut, u64 bits, int aux) {
    const unsigned blo = (unsigned)bits >> (4 * hi), bhi = (unsigned)(bits >> 32) >> (4 * hi);
#pragma unroll
    for (int n = 0; n < 2; ++n)
#pragma unroll
        for (int r = 0; r < 16; ++r) { const int kk0 = (r & 3) + 8 * (r >> 2); const int kk = kk0 + 4 * hi + 32 * n; const int dist = tq - (key0 + kk);
            bool valid;
            if (MODE == MK_C) valid = dist >= 0;
            else if (MODE == MK_A) valid = true;
            else if (MODE == MK_WIN) valid = dist >= 0 && dist < 512;
            else if (MODE == MK_SLC) valid = (aux != 0) && dist >= 0;
            else valid = (key0 + kk) < aux;
            float s = n ? S1[r] : S0[r];
            if (MODE != MK_CMP && near) { const int dc = dist < 0 ? 0 : (dist > 127 ? 127 : dist); s += lut[dc]; }
            if (MODE == MK_A) { const int mk = __builtin_amdgcn_sbfe((int)(n ? bhi : blo), kk0, 1);
                unsigned sb; asm("v_bfi_b32 %0, %1, %2, %3" : "=v"(sb) : "v"(mk), "v"(__builtin_bit_cast(unsigned, s)), "v"(0xff800000u)); s = __builtin_bit_cast(float, sb); }
            else s = valid ? s : -INFINITY;
            if (n) S1[r] = s; else S0[r] = s; }
}
__device__ __forceinline__ float vmax3(float a, float b, float c) { float r; asm("v_max3_f32 %0, %1, %2, %3" : "=v"(r) : "v"(a), "v"(b), "v"(c)); return r; }
__device__ __forceinline__ float vmax2(float a, float b) { float r; asm("v_max_f32 %0, %1, %2" : "=v"(r) : "v"(a), "v"(b)); return r; }
__device__ __forceinline__ float row_max32(const f32x16& S0, const f32x16& S1, int lane) {
    float a = vmax3(S0[0], S0[1], S1[0]), b = vmax3(S0[2], S0[3], S1[1]); a = vmax3(a, S1[2], S1[3]);
#pragma unroll
    for (int r = 4; r < 16; r += 4) { a = vmax3(a, S0[r], S0[r + 1]); b = vmax3(b, S0[r + 2], S0[r + 3]); a = vmax3(a, S1[r], S1[r + 1]); b = vmax3(b, S1[r + 2], S1[r + 3]); }
    return vmax2(a, b);
}
__device__ __forceinline__ void v_load2(bf16x8 (&vf)[2][4], const LAS unsigned char* vbuf, int db0, int lane) {
    const int hi = lane >> 5;
    const LAS unsigned char* vp = vbuf + ((lane >> 4) & 1) * 32 + (lane & 3) * 8 + (4 * hi + ((lane & 15) >> 2)) * 64 + db0 * 4096;
#pragma unroll
    for (int d = 0; d < 2; ++d)
#pragma unroll
        for (int ks = 0; ks < 4; ++ks) { const s16x4 lo = vtr(vp + d * 4096 + ks * 1024), hh = vtr(vp + d * 4096 + ks * 1024 + 512);
            vf[d][ks] = (bf16x8){lo[0], lo[1], lo[2], lo[3], hh[0], hh[1], hh[2], hh[3]}; }
}
__device__ __forceinline__ void p_pack(bf16x8 (&pa)[4], const f32x16& S0, const f32x16& S1) {
#pragma unroll
    for (int ks = 0; ks < 4; ++ks) { u32x4 w;
        if (ks == 0) { w.x = cvt_pk_bf16(S0[0], S0[1]); w.y = cvt_pk_bf16(S0[2], S0[3]); w.z = cvt_pk_bf16(S0[4], S0[5]); w.w = cvt_pk_bf16(S0[6], S0[7]); }
        else if (ks == 1) { w.x = cvt_pk_bf16(S0[8], S0[9]); w.y = cvt_pk_bf16(S0[10], S0[11]); w.z = cvt_pk_bf16(S0[12], S0[13]); w.w = cvt_pk_bf16(S0[14], S0[15]); }
        else if (ks == 2) { w.x = cvt_pk_bf16(S1[0], S1[1]); w.y = cvt_pk_bf16(S1[2], S1[3]); w.z = cvt_pk_bf16(S1[4], S1[5]); w.w = cvt_pk_bf16(S1[6], S1[7]); }
        else { w.x = cvt_pk_bf16(S1[8], S1[9]); w.y = cvt_pk_bf16(S1[10], S1[11]); w.z = cvt_pk_bf16(S1[12], S1[13]); w.w = cvt_pk_bf16(S1[14], S1[15]); }
        pa[ks] = __builtin_bit_cast(bf16x8, w); }
}
template <int VD>
__device__ __forceinline__ void pv_tile(f32x16 (&o)[VD / 32], const f32x16& S0, const f32x16& S1, const bf16x8 (&vf01)[2][4], const LAS unsigned char* vbuf, int lane) {
    bf16x8 pa[4]; p_pack(pa, S0, S1);
    if (VD == 128) {
        bf16x8 va[4], vb[4];
        const int hi = lane >> 5;
        const LAS unsigned char* vp = vbuf + ((lane >> 4) & 1) * 32 + (lane & 3) * 8 + (4 * hi + ((lane & 15) >> 2)) * 64;
#pragma unroll
        for (int ks = 0; ks < 4; ++ks) { const s16x4 lo = vtr(vp + 2 * 4096 + ks * 1024), hh = vtr(vp + 2 * 4096 + ks * 1024 + 512); va[ks] = (bf16x8){lo[0], lo[1], lo[2], lo[3], hh[0], hh[1], hh[2], hh[3]}; }
#pragma unroll
        for (int ks = 0; ks < 4; ++ks) { const s16x4 lo = vtr(vp + 3 * 4096 + ks * 1024), hh = vtr(vp + 3 * 4096 + ks * 1024 + 512); vb[ks] = (bf16x8){lo[0], lo[1], lo[2], lo[3], hh[0], hh[1], hh[2], hh[3]}; }
#pragma unroll
        for (int ks = 0; ks < 4; ++ks) { o[0] = MFMA32(pa[ks], vf01[0][ks], o[0]); o[1] = MFMA32(pa[ks], vf01[1][ks], o[1]); }
        __builtin_amdgcn_sched_barrier(0);
#pragma unroll
        for (int ks = 0; ks < 4; ++ks) { o[(VD == 128) ? 2 : 0] = MFMA32(pa[ks], va[ks], o[(VD == 128) ? 2 : 0]); o[(VD == 128) ? 3 : 0] = MFMA32(pa[ks], vb[ks], o[(VD == 128) ? 3 : 0]); }
    } else {
#pragma unroll
        for (int ks = 0; ks < 4; ++ks)
#pragma unroll
            for (int d = 0; d < 2; ++d) o[d] = MFMA32(pa[ks], vf01[d][ks], o[d]);
    }
}
template <int ND>
__device__ __forceinline__ void scale_rows(f32x16 (&o)[ND], float f, LAS float* wsf, int lane) {
    const int hi = lane >> 5;
    wsf[lane & 31] = f;
#pragma unroll
    for (int g = 0; g < 4; ++g) { const f32x4 a = *(const LAS f32x4*)(wsf + 8 * g + 4 * hi);
#pragma unroll
        for (int d = 0; d < ND; ++d)
#pragma unroll
            for (int i = 0; i < 4; ++i) o[d][4 * g + i] *= a[i]; }
}
template <int VD, bool PV>
__device__ __forceinline__ void softmax_step(AState<VD>& st, f32x16& S0, f32x16& S1, const LAS unsigned char* vbuf, LAS float* wsf, int lane) {
    bf16x8 vf01[2][4];
    if (PV) { v_load2(vf01, vbuf, 0, lane); __builtin_amdgcn_sched_barrier(0); }
    const float mx = row_max32(S0, S1, lane);
    if (__any(mx - st.m > ATT_THR)) { const float mnew = vmax2(st.m, vmax2(mx, bperm_f(lane ^ 32, mx))); const float alpha = fexp2(st.m - mnew); st.l *= alpha; st.m = mnew;
        if (PV) scale_rows<VD / 32>(st.o, alpha, wsf, lane); }
    float sum = 0.f;
#pragma unroll
    for (int r = 0; r < 16; ++r) { S0[r] = fexp2(S0[r] - st.m); S1[r] = fexp2(S1[r] - st.m); }
#pragma unroll
    for (int r = 0; r < 16; ++r) sum += S0[r];
#pragma unroll
    for (int r = 0; r < 16; ++r) sum += S1[r];
    st.l += sum;
    if (PROBE_ATT == 1) { float dm = 0.f;
#pragma unroll
        for (int r = 0; r < 16; ++r) { float t0 = S0[r], t1 = S1[r]; asm volatile("" : "+v"(t0), "+v"(t1)); dm += fexp2(t0 - st.m) + fexp2(t1 - st.m); }
        asm volatile("" :: "v"(dm)); }
    if (PV) pv_tile<VD>(st.o, S0, S1, vf01, vbuf, lane);
}
template <int ND>
__device__ __forceinline__ void finish_add(f32x16 (&acc)[ND], const f32x16 (&o)[ND], float l, float gate, LAS float* wsf, int lane) {
    const int hi = lane >> 5;
    const float lt = sum32(l, lane); const float f = lt > 0.f ? gate / lt : 0.f;
    wsf[lane & 31] = f;
#pragma unroll
    for (int g = 0; g < 4; ++g) { const f32x4 a = *(const LAS f32x4*)(wsf + 8 * g + 4 * hi);
#pragma unroll
        for (int d = 0; d < ND; ++d)
#pragma unroll
            for (int i = 0; i < 4; ++i) acc[d][4 * g + i] += o[d][4 * g + i] * a[i]; }
}

__device__ __forceinline__ int crow(int r, int hi) { return (r & 3) + 8 * (r >> 2) + 4 * hi; }

__device__ __forceinline__ void unit_C(Frame& F, const bf16_t* P, bf16_t* OC, const float* gnorm, float lam, float lam_init, int b, int h, int qb) {
    const int lane = F.lane, r32 = lane & 31, hi = lane >> 5, w = F.wave;
    LAS unsigned char* lds = F.lds; LAS float* wsf = (LAS float*)(lds + AT_WSF) + w * 64; const LAS float* lut = (const LAS float*)(lds + AT_LUT) + (8 + h) * 128;
    const int q0 = qb * 256, tw0 = q0 + 32 * w, tq = tw0 + r32; const size_t rowbase = (size_t)b * 4096;
    const int NT = 4 * qb + 4, my_last = (tw0 + 31) >> 6;
    LAS unsigned* kpl = (LAS unsigned*)(lds + AT_IMP) + w * 2048 + lane;
    AState<128> st;
#pragma unroll 1
    for (int j = 0; j < 2; ++j) {
        const bf16_t* Qp = P + (rowbase + tq) * DP + C_CQ + h * 128 + j * 64;
        bf16x8 qr[4];
#pragma unroll
        for (int d0 = 0; d0 < 4; ++d0) qr[d0] = *(const bf16x8*)(Qp + d0 * 16 + hi * 8);
        const bf16_t* Kb = P + rowbase * DP + C_CK + h * 128 + j * 64; const bf16_t* Vb = P + rowbase * DP + C_CV + h * 128;
        astate_init(st);
        stage_kv<128>(lds + AT_KBUF, lds + AT_VBUF, Kb, DP, Vb, DP, w, lane, true);
#pragma unroll 1
        for (int kt = 0; kt < NT; ++kt) {
            VM_WAIT(); __syncthreads();
            const int cb = kt & 1;
            if (kt + 1 < NT) stage_kv<128>(lds + AT_KBUF + (cb ^ 1) * 8192, lds + AT_VBUF + (cb ^ 1) * 16384, Kb + (size_t)(kt + 1) * 64 * DP, DP, Vb + (size_t)(kt + 1) * 64 * DP, DP, w, lane, true);
            if (kt <= my_last) {
                f32x16 S0, S1; qk_tile(S0, S1, qr, lds + AT_KBUF + cb * 8192, r32, hi);
                const int key0 = kt * 64; const bool near = (tw0 - (key0 + 63)) < 113;
                if (near) apply_mask<MK_C>(S0, S1, tq, key0, hi, true, lut, 0ull, 0);
                softmax_step<128, true>(st, S0, S1, lds + AT_VBUF + cb * 16384, wsf, lane);
            }
        }
        __syncthreads();
        const float lt = sum32(st.l, lane);
        if (j == 0) { scale_rows<4>(st.o, 1.f / lt, wsf, lane);
#pragma unroll
            for (int d = 0; d < 4; ++d)
#pragma unroll
                for (int r = 0; r < 8; ++r) kpl[(d * 8 + r) * 64] = cvt_pk_bf16(st.o[d][2 * r], st.o[d][2 * r + 1]);
        } else { scale_rows<4>(st.o, -lam / lt, wsf, lane);
#pragma unroll
            for (int d = 0; d < 4; ++d)
#pragma unroll
                for (int r = 0; r < 8; ++r) { const unsigned kw = kpl[(d * 8 + r) * 64]; st.o[d][2 * r] += bflo(kw); st.o[d][2 * r + 1] += bfhi(kw); } }
    }
    f32x16 (&keep)[4] = st.o;
    float gch[4];
#pragma unroll
    for (int d = 0; d < 4; ++d) gch[d] = gnorm[32 * d + r32] * (1.f - lam_init);
    GAS bf16_t* orow = (GAS bf16_t*)OC + (rowbase + tw0) * 1024 + 512 + h * 128 + r32; asm volatile("" : "+v"(orow)); int hs = hi; asm volatile("" : "+v"(hs));
#pragma unroll
    for (int r = 0; r < 16; ++r) { float ss = keep[0][r] * keep[0][r] + keep[1][r] * keep[1][r] + keep[2][r] * keep[2][r] + keep[3][r] * keep[3][r];
        ss += shx_f(ss, 1, lane); ss += shx_f(ss, 2, lane); ss += shx_f(ss, 4, lane); ss += shx_f(ss, 8, lane); ss += shx_f(ss, 16, lane);
        const float sc = 1.f / sqrtf(ss * (1.f / 128.f) + LN_EPS);
#pragma unroll
        for (int d = 0; d < 4; ++d) orow[crow(r, hs) * 1024 + 32 * d] = (bf16_t)f2bf(keep[d][r] * sc * gch[d]); }
}

__device__ __forceinline__ void unit_A(Frame& F, const bf16_t* P, const u64* BM, bf16_t* OC, int b, int qi) {
    const int lane = F.lane, r32 = lane & 31, hi = lane >> 5, w = F.wave, h = w & 3, rg = w >> 2;
    LAS unsigned char* lds = F.lds; LAS float* wsf = (LAS float*)(lds + AT_WSF) + w * 64; const LAS float* lut = (const LAS float*)(lds + AT_LUT) + h * 128;
    const int q0 = qi * 64, tw0 = q0 + 32 * rg, tq = tw0 + r32; const size_t rowbase = (size_t)b * 4096;
    const int NT = qi + 1;
    const bf16_t* Qp = P + (rowbase + tq) * DP + C_AQ + h * 64;
    bf16x8 qr[4];
#pragma unroll
    for (int d0 = 0; d0 < 4; ++d0) qr[d0] = *(const bf16x8*)(Qp + d0 * 16 + hi * 8);
    const bf16_t* Kb = P + rowbase * DP + C_AK; const bf16_t* Vb = P + rowbase * DP + C_AV;
    const u64* bmp = BM + (size_t)b * 64 * 4096 + tq;
    u64 bits = bmp[0];
    AState<64> st; astate_init(st);
    stage_kv<64>(lds + AT_KBUF, lds + AT_VBUF, Kb, DP, Vb, DP, w, lane, true);
#pragma unroll 1
    for (int kt = 0; kt < NT; ++kt) {
        VM_WAIT(); __syncthreads();
        const int cb = kt & 1;
        u64 nbits = 0ull;
        if (kt + 1 < NT) { stage_kv<64>(lds + AT_KBUF + (cb ^ 1) * 8192, lds + AT_VBUF + (cb ^ 1) * 16384, Kb + (size_t)(kt + 1) * 64 * DP, DP, Vb + (size_t)(kt + 1) * 64 * DP, DP, w, lane, true);
            nbits = bmp[(size_t)(kt + 1) * 4096]; }
        f32x16 S0, S1; qk_tile(S0, S1, qr, lds + AT_KBUF + cb * 8192, r32, hi);
        const int key0 = kt * 64; const bool near = (tw0 - (key0 + 63)) < 113;
        if (A_DENSE) { if (near) apply_mask<MK_C>(S0, S1, tq, key0, hi, true, lut, 0ull, 0); } else apply_mask<MK_A>(S0, S1, tq, key0, hi, near, lut, bits, 0);
        softmax_step<64, true>(st, S0, S1, lds + AT_VBUF + cb * 16384, wsf, lane);
        bits = nbits;
    }
    __syncthreads();
    f32x16 acc[2];
#pragma unroll
    for (int d = 0; d < 2; ++d)
#pragma unroll
        for (int r = 0; r < 16; ++r) acc[d][r] = 0.f;
    const float lt = sum32(st.l, lane);
    finish_add<2>(acc, st.o, 0.5f, lt > 0.f ? 1.f / lt : 0.f, wsf, lane);
    GAS bf16_t* orow = (GAS bf16_t*)OC + (rowbase + tw0) * 1024 + h * 64 + r32; asm volatile("" : "+v"(orow)); int hs = hi; asm volatile("" : "+v"(hs));
#pragma unroll
    for (int r = 0; r < 16; ++r)
#pragma unroll
        for (int d = 0; d < 2; ++d) orow[crow(r, hs) * 1024 + 32 * d] = (bf16_t)f2bf(acc[d][r]);
}

constexpr int IMP_LD = 65;
__device__ __forceinline__ void unit_B(Frame& F, const bf16_t* P, const bf16_t* KC, const bf16_t* VC, bf16_t* OC, int b, int qi) {
    const int lane = F.lane, r32 = lane & 31, hi = lane >> 5, w = F.wave, h = w & 3, rg = w >> 2;
    LAS unsigned char* lds = F.lds; LAS float* wsf = (LAS float*)(lds + AT_WSF) + w * 64; const LAS float* lut = (const LAS float*)(lds + AT_LUT) + (4 + h) * 128;
    LAS float* imp = (LAS float*)(lds + AT_IMP); volatile LAS u64* rmask = (volatile LAS u64*)(lds + AT_RMASK); volatile LAS u64* wor = (volatile LAS u64*)(lds + AT_WOR);
    const int q0 = qi * 64, cur = qi, tw0 = q0 + 32 * rg, tq = tw0 + r32, urow = 32 * rg + r32; const size_t rowbase = (size_t)b * 4096;
    const bf16_t* prow = P + (rowbase + tq) * DP;
    bf16x8 qr[4];
#pragma unroll
    for (int d0 = 0; d0 < 4; ++d0) qr[d0] = *(const bf16x8*)(prow + C_BQ + h * 64 + d0 * 16 + hi * 8);
    const float g0 = fsigmoid(bf2f(prow[C_BG + h * 3 + 0])), g1 = fsigmoid(bf2f(prow[C_BG + h * 3 + 1])), g2 = fsigmoid(bf2f(prow[C_BG + h * 3 + 2]));
    f32x16 ob[2];
#pragma unroll
    for (int d = 0; d < 2; ++d)
#pragma unroll
        for (int r = 0; r < 16; ++r) ob[d][r] = 0.f;
    {
        const int ncv = tq >= 31 ? ((tq - 31) >> 4) + 1 : 0;
        const int ncv_max = ((q0 + 63 - 31) >> 4) + 1, NTc = (ncv_max + 63) >> 6;
        const bf16_t* Kc = KC + (size_t)b * 256 * 64; const bf16_t* Vc = VC + (size_t)b * 256 * 64;
        AState<64> st; astate_init(st);
        stage_kv<64>(lds + AT_KBUF, lds + AT_VBUF, Kc, 64, Vc, 64, w, lane, false);
#pragma unroll 1
        for (int kt = 0; kt < NTc; ++kt) {
            VM_WAIT(); __syncthreads();
            const int cb = kt & 1;
            if (kt + 1 < NTc) stage_kv<64>(lds + AT_KBUF + (cb ^ 1) * 8192, lds + AT_VBUF + (cb ^ 1) * 16384, Kc + (size_t)(kt + 1) * 64 * 64, 64, Vc, 64, w, lane, false);
            f32x16 S0, S1; qk_tile(S0, S1, qr, lds + AT_KBUF + cb * 8192, r32, hi);
            apply_mask<MK_CMP>(S0, S1, tq, kt * 64, hi, false, lut, 0ull, ncv);
            softmax_step<64, false>(st, S0, S1, lds + AT_VBUF, wsf, lane);
        }
        __syncthreads();
        const float lt = sum32(st.l, lane); const float inv = lt > 0.f ? 1.f / lt : 0.f; const float mfin = st.m;
        f32x16 oc[2];
#pragma unroll
        for (int d = 0; d < 2; ++d)
#pragma unroll
            for (int r = 0; r < 16; ++r) oc[d][r] = 0.f;
        float carry = 0.f;
        stage_kv<64>(lds + AT_KBUF, lds + AT_VBUF, Kc, 64, Vc, 64, w, lane, true);
#pragma unroll 1
        for (int kt = 0; kt < NTc; ++kt) {
            VM_WAIT(); __syncthreads();
            const int cb = kt & 1;
            if (kt + 1 < NTc) stage_kv<64>(lds + AT_KBUF + (cb ^ 1) * 8192, lds + AT_VBUF + (cb ^ 1) * 16384, Kc + (size_t)(kt + 1) * 64 * 64, 64, Vc + (size_t)(kt + 1) * 64 * 64, 64, w, lane, true);
            f32x16 S0, S1; qk_tile(S0, S1, qr, lds + AT_KBUF + cb * 8192, r32, hi);
            apply_mask<MK_CMP>(S0, S1, tq, kt * 64, hi, false, lut, 0ull, ncv);
#pragma unroll
            for (int r = 0; r < 16; ++r) { S0[r] = fexp2(S0[r] - mfin) * inv; S1[r] = fexp2(S1[r] - mfin) * inv; }
            float own[2][4], pl[2][4];
#pragma unroll
            for (int g = 0; g < 4; ++g) { own[0][g] = (S0[4 * g] + S0[4 * g + 1]) + (S0[4 * g + 2] + S0[4 * g + 3]); own[1][g] = (S1[4 * g] + S1[4 * g + 1]) + (S1[4 * g + 2] + S1[4 * g + 3]);
                pl[0][g] = other32(S0[4 * g + 3], lane); pl[1][g] = other32(S1[4 * g + 3], lane); }
#pragma unroll
            for (int n = 0; n < 2; ++n)
#pragma unroll
                for (int g = 0; g < 4; ++g) { const int J = 16 * kt + 8 * n + 2 * g + hi;
                    const float prev0 = (g > 0) ? pl[n][g > 0 ? g - 1 : 0] : (n == 1 ? pl[0][3] : carry);
                    const float prev = hi ? pl[n][g] : prev0;
                    imp[(h * 64 + urow) * IMP_LD + J] = own[n][g] + prev; }
            carry = pl[1][3];
            { bf16x8 vf01[2][4]; v_load2(vf01, lds + AT_VBUF + cb * 16384, 0, lane); pv_tile<64>(oc, S0, S1, vf01, lds + AT_VBUF + cb * 16384, lane); }
        }
        finish_add<2>(ob, oc, 0.5f, g0, wsf, lane);
        __syncthreads();
    }
    {
        const int nf = cur >= 2 ? 3 : cur + 1, nfree = 16 - nf; u64 worl = 0ull;
#pragma unroll 1
        for (int rr = 0; rr < 8; ++rr) { const int row = 8 * w + rr; const int j = lane;
            const float v = (imp[(0 * 64 + row) * IMP_LD + j] + imp[(1 * 64 + row) * IMP_LD + j]) + (imp[(2 * 64 + row) * IMP_LD + j] + imp[(3 * 64 + row) * IMP_LD + j]);
            const bool cand = (j >= 1) && (j <= cur - 2);
            int rank = 0;
#pragma unroll 1
            for (int k = 1; k <= cur - 2; ++k) { const float vk = bperm_f(k, v); rank += (vk > v || (vk == v && k < j)) ? 1 : 0; }
            const bool forced = (j <= cur) && (j == 0 || j == cur || j == cur - 1);
            const bool sel = forced || (cand && rank < nfree);
            const u64 mk = __ballot(sel);
            if (lane == 0) rmask[row] = mk;
            worl |= mk; }
        if (lane == 0) wor[w] = worl;
        __syncthreads();
    }
    const u64 myrm = rmask[urow];
    u64 un = 0ull;
#pragma unroll
    for (int k = 0; k < 8; ++k) un |= wor[k];
    {
        const bf16_t* Kb = P + rowbase * DP + C_BKV + 2 * 64; const bf16_t* Vb = P + rowbase * DP + C_BKV + 3 * 64;
        AState<64> st; astate_init(st);
        const int nsel = __popcll(un);
        int j = __ffsll((long long)un) - 1; un &= un - 1;
        stage_kv<64>(lds + AT_KBUF, lds + AT_VBUF, Kb + (size_t)j * 64 * DP, DP, Vb + (size_t)j * 64 * DP, DP, w, lane, true);
#pragma unroll 1
        for (int i = 0; i < nsel; ++i) {
            VM_WAIT(); __syncthreads();
            const int cb = i & 1;
            int jn = -1;
            if (un) { jn = __ffsll((long long)un) - 1; un &= un - 1;
                stage_kv<64>(lds + AT_KBUF + (cb ^ 1) * 8192, lds + AT_VBUF + (cb ^ 1) * 16384, Kb + (size_t)jn * 64 * DP, DP, Vb + (size_t)jn * 64 * DP, DP, w, lane, true); }
            const int rowsel = (int)((myrm >> j) & 1ull);
            if (__any(rowsel)) {
                f32x16 S0, S1; qk_tile(S0, S1, qr, lds + AT_KBUF + cb * 8192, r32, hi);
                const int key0 = j * 64; const bool near = (tw0 - (key0 + 63)) < 113;
                if (near || j == cur || !__all(rowsel)) apply_mask<MK_SLC>(S0, S1, tq, key0, hi, near, lut, 0ull, rowsel);
                softmax_step<64, true>(st, S0, S1, lds + AT_VBUF + cb * 16384, wsf, lane);
            }
            j = jn;
        }
        __syncthreads();
        const float lt = sum32(st.l, lane);
        finish_add<2>(ob, st.o, 0.5f, lt > 0.f ? g1 / lt : 0.f, wsf, lane);
    }
    {
        const bf16_t* Kb = P + rowbase * DP + C_BKV + 4 * 64; const bf16_t* Vb = P + rowbase * DP + C_BKV + 5 * 64;
        AState<64> st; astate_init(st);
        const int kt0 = cur >= 8 ? cur - 8 : 0;
        stage_kv<64>(lds + AT_KBUF, lds + AT_VBUF, Kb + (size_t)kt0 * 64 * DP, DP, Vb + (size_t)kt0 * 64 * DP, DP, w, lane, true);
#pragma unroll 1
        for (int kt = kt0; kt <= cur; ++kt) {
            VM_WAIT(); __syncthreads();
            const int cb = (kt - kt0) & 1;
            if (kt + 1 <= cur) stage_kv<64>(lds + AT_KBUF + (cb ^ 1) * 8192, lds + AT_VBUF + (cb ^ 1) * 16384, Kb + (size_t)(kt + 1) * 64 * DP, DP, Vb + (size_t)(kt + 1) * 64 * DP, DP, w, lane, true);
            f32x16 S0, S1; qk_tile(S0, S1, qr, lds + AT_KBUF + cb * 8192, r32, hi);
            const int key0 = kt * 64; const bool near = (tw0 - (key0 + 63)) < 113;
            const bool allv = (key0 + 63 <= tw0) && (tw0 + 31 - key0 < 512);
            if (near || !allv) apply_mask<MK_WIN>(S0, S1, tq, key0, hi, near, lut, 0ull, 0);
            softmax_step<64, true>(st, S0, S1, lds + AT_VBUF + cb * 16384, wsf, lane);
        }
        __syncthreads();
        const float lt = sum32(st.l, lane);
        finish_add<2>(ob, st.o, 0.5f, lt > 0.f ? g2 / lt : 0.f, wsf, lane);
    }
    GAS bf16_t* orow = (GAS bf16_t*)OC + (rowbase + tw0) * 1024 + 256 + h * 64 + r32; asm volatile("" : "+v"(orow)); int hs = hi; asm volatile("" : "+v"(hs));
#pragma unroll
    for (int r = 0; r < 16; ++r)
#pragma unroll
        for (int d = 0; d < 2; ++d) orow[crow(r, hs) * 1024 + 32 * d] = (bf16_t)f2bf(ob[d][r]);
}

__device__ __forceinline__ void phase_cmp2(Frame& F, const bf16_t* HID, const bf16_t* W2T, bf16_t* KC) {
    const int lane = F.lane, fr = lane & 15, fq = lane >> 4;
    for (int task = F.gw; task < 512; task += F.NGW) { const int j = task >> 8, row0 = (task & 255) * 16;
        f32x4 acc[4];
#pragma unroll
        for (int n = 0; n < 4; ++n) acc[n] = (f32x4){0.f, 0.f, 0.f, 0.f};
#pragma unroll
        for (int ks = 0; ks < 8; ++ks) { const bf16x8 a = *(const bf16x8*)(HID + ((size_t)j * 4096 + row0 + fr) * 256 + ks * 32 + 8 * fq);
#pragma unroll
            for (int n = 0; n < 4; ++n) { const bf16x8 bb = *(const bf16x8*)(W2T + ((size_t)j * 64 + n * 16 + fr) * 256 + ks * 32 + 8 * fq);
                acc[n] = __builtin_amdgcn_mfma_f32_16x16x32_bf16(a, bb, acc[n], 0, 0, 0); } }
#pragma unroll
        for (int n = 0; n < 4; ++n)
#pragma unroll
            for (int jj = 0; jj < 4; ++jj) KC[((size_t)j * 4096 + row0 + 4 * fq + jj) * 64 + n * 16 + fr] = (bf16_t)f2bf(acc[n][jj]);
    }
}

constexpr int PH_PER_LAYER = 11, N_PHASES = 2 + DEPTH * PH_PER_LAYER;
struct Args { const float* in[27]; float* out; unsigned char* ws; int ph_lo, ph_hi, li, pad; };

#define IN(k) (lo <= (k) && (k) < hi)
#define SEAM(k) do { if (IN((k) + 1)) xcd_barrier(bar); } while (0)
#define WSB (F.ws)
#define PROJ ((bf16_t*)(WSB + WS_PROJ))
#define HB ((bf16_t*)(WSB + WS_HB))
#define OCAT ((bf16_t*)(WSB + WS_OCAT))
#define MERG ((bf16_t*)(WSB + WS_MERG))
#define X1 ((bf16_t*)(WSB + WS_X1))
#define MOD ((const float*)(WSB + WS_MOD))

template <int l>
__device__ __forceinline__ void run_layer(Frame& F, const Args& args, const XcdBarrier& bar, int lo, int hi) {
        const int pb = 2 + l * PH_PER_LAYER;
#define xres ((l == 0) ? args.in[0] : (const float*)args.out)
#define mod_a (MOD + (size_t)(2 * l) * 16 * 3072)
#define mod_f (MOD + (size_t)(2 * l + 1) * 16 * 3072)
        if (IN(pb + 0)) for (int rep = 0; rep < ((l == 0 && DUP == 0) ? 2 : 1); ++rep) { if (rep) xcd_barrier(bar); refresh(F);
            { pg8::Gemm g{HB, (const bf16_t*)(WSB + WS_WIN_T) + (size_t)l * DP * 1024, 1024, 1024, 1024, 128}; pg8::StaticOrder S; S.init(NTOK, N_BF, F.G, (int)blockIdx.x);
              pg8::EpiProj E{PROJ, 0, 1.f};
              pg8::gemm_phase<pg8::EpiProj, pg8::StaticOrder>(F.lds, g, S, E, F.wave); }
            { pg8::Gemm g{(const bf16_t*)(WSB + WS_HB8), (const bf16_t*)(WSB + WS_WMG8 + (size_t)l * N_F8 * 1024), 512, 512, 512, 128}; pg8::StaticOrder S; S.init(NTOK, N_F8, F.G, (int)blockIdx.x);
              pg8::EpiProj E{PROJ, N_BF, 1.f / (F8_H * F8_WIN)};
              pg8::gemm_phase<pg8::EpiProj, pg8::StaticOrder, true>(F.lds, g, S, E, F.wave); }
            if (blockIdx.x == 255) { u32x4* z = (u32x4*)(PROJ + (size_t)NTOK * DP); for (int i = F.tid; i < 32 * DP * 2 / 16; i += 512) z[i] = (u32x4){0u, 0u, 0u, 0u}; }
            SEAM(pb + 0);
        }
        if (IN(pb + 1)) for (int rep = 0; rep < ((l == 0 && DUP == 1) ? 2 : 1); ++rep) { if (rep) xcd_barrier(bar); refresh(F);
            { pg8::Gemm g{PROJ + C_BKV, (const bf16_t*)(WSB + WS_W1_T) + (size_t)l * 2 * 256 * 2048, 16 * DP, 2048, 2048, DP * 2}; pg8::CmpOrder S{F.G, (int)blockIdx.x};
              pg8::EpiCmp1 E{(bf16_t*)(WSB + WS_HID), (const float*)(WSB + WS_BIAS1) + l * 512};
              pg8::gemm_phase<pg8::EpiCmp1, pg8::CmpOrder>(F.lds, g, S, E, F.wave); }
            __syncthreads();
            if (USE_A) {
#pragma unroll 1
                for (int i = 0; i < 16; ++i) { const int c = (int)blockIdx.x; const int qt = (i & 1) ? 255 - c : c;
                    dsa_select_tile(F, PROJ, (u64*)(WSB + WS_BM64), (unsigned*)(WSB + WS_OCAT) + (size_t)blockIdx.x * 65536, i, qt); }
            }
            SEAM(pb + 1);
        }
        if (IN(pb + 2)) for (int rep = 0; rep < ((l == 0 && DUP == 2) ? 2 : 1); ++rep) { if (rep) xcd_barrier(bar); refresh(F); phase_cmp2(F, (const bf16_t*)(WSB + WS_HID), (const bf16_t*)(WSB + WS_W2_T) + (size_t)l * 2 * 64 * 256, (bf16_t*)(WSB + WS_KCMP)); SEAM(pb + 2); }
        if (IN(pb + 3)) for (int rep = 0; rep < ((l == 0 && DUP == 3) ? 2 : 1); ++rep) { if (rep) xcd_barrier(bar); refresh(F);
            for (int i = F.tid; i < 12 * 128; i += 512) ((LAS float*)(F.lds + AT_LUT))[i] = ((const float*)(WSB + WS_LUT))[i];
            __syncthreads();
            const int c = (int)blockIdx.x;
            if (USE_C) {
                const float lam = ((const float*)(WSB + WS_LAM))[l]; const float lam_init = 0.8f - 0.6f * __expf(-0.3f * (float)l);
#pragma unroll 1
                for (int u = 0; u < 4; ++u) { const int bh = (c & 7) * 8 + (c >> 5), pp = ((c >> 3) & 3) * 2 + (u >> 1); const int qb = (u & 1) ? pp : 15 - pp;
                    refresh(F); unit_C(F, PROJ, OCAT, args.in[10] + l * 128, lam, lam_init, bh >> 2, bh & 3, qb); }
            }
            if (USE_A) {
#pragma unroll 1
                for (int u = 0; u < 4; ++u) { const int b = (c & 7) * 2 + (c >> 7), pp = ((c >> 3) & 15) * 2 + (u >> 1); const int qi = (u & 1) ? pp : 63 - pp;
                    refresh(F); unit_A(F, PROJ, (const u64*)(WSB + WS_BM64), OCAT, b, qi); }
            }
            if (USE_B) {
#pragma unroll 1
                for (int u = 0; u < 4; ++u) { const int b = (c & 7) * 2 + (c >> 7), pp = ((c >> 3) & 15) * 2 + (u >> 1); const int qi = (u & 1) ? pp : 63 - pp;
                    refresh(F); unit_B(F, PROJ, (const bf16_t*)(WSB + WS_KCMP), (const bf16_t*)(WSB + WS_KCMP) + 4096 * 64, OCAT, b, qi); }
            }
            if (!USE_A || !USE_B || !USE_C) {
                for (int row = F.gw; row < NTOK; row += F.NGW) { u32x4* o = (u32x4*)(OCAT + (size_t)row * 1024);
                    for (int q = F.lane; q < 128; q += 64) { const int col = q * 8; const bool z = (col < 256) ? !USE_A : (col < 512 ? !USE_B : !USE_C); if (z) o[q] = (u32x4){0u, 0u, 0u, 0u}; } }
            }
            SEAM(pb + 3);
        }
        if (IN(pb + 4)) for (int rep = 0; rep < ((l == 0 && DUP == 4) ? 2 : 1); ++rep) { if (rep) xcd_barrier(bar); refresh(F);
            const bf16_t* WB = (const bf16_t*)(WSB + WS_WBR_T + (size_t)l * 2 * MiB);
            pg8::StaticOrder S; S.init(NTOK, 1024, F.G, (int)blockIdx.x);
            { pg8::Gemm g{OCAT, WB, 1024, 256, 256, 128}; pg8::EpiBranch<0> E{MERG, PROJ}; pg8::gemm_phase<pg8::EpiBranch<0>, pg8::StaticOrder>(F.lds, g, S, E, F.wave); }
            VM_WAIT(); __syncthreads(); __builtin_amdgcn_fence(__ATOMIC_ACQUIRE, "agent"); VM_WAIT(); __syncthreads();
            { pg8::Gemm g{OCAT + 256, WB + 256 * 1024, 1024, 256, 256, 128}; pg8::EpiBranch<1> E{MERG, PROJ}; pg8::gemm_phase<pg8::EpiBranch<1>, pg8::StaticOrder>(F.lds, g, S, E, F.wave); }
            VM_WAIT(); __syncthreads(); __builtin_amdgcn_fence(__ATOMIC_ACQUIRE, "agent"); VM_WAIT(); __syncthreads();
            { pg8::Gemm g{OCAT + 512, WB + 512 * 1024, 1024, 512, 512, 128}; pg8::EpiBranch<2> E{MERG, PROJ}; pg8::gemm_phase<pg8::EpiBranch<2>, pg8::StaticOrder>(F.lds, g, S, E, F.wave); }
            SEAM(pb + 4);
        }
        if (IN(pb + 5)) for (int rep = 0; rep < ((l == 0 && DUP == 5) ? 2 : 1); ++rep) { if (rep) xcd_barrier(bar); refresh(F);
            pg8::Gemm g{MERG, (const bf16_t*)(WSB + WS_WOUT_T) + (size_t)l * 1024 * 1024, 1024, 1024, 1024, 128}; pg8::StaticOrder S; S.init(NTOK, 1024, F.G, (int)blockIdx.x);
            pg8::EpiWout<(l > 0)> E{X1, (l == 0) ? (const void*)args.in[0] : (const void*)(WSB + WS_X2B), mod_a + 2048};
            pg8::gemm_phase<pg8::EpiWout<(l > 0)>, pg8::StaticOrder>(F.lds, g, S, E, F.wave);
            SEAM(pb + 5);
        }
#define cnt ((unsigned*)(WSB + WS_CTL) + CW_CNT + l * 64)
        if (IN(pb + 6)) for (int rep = 0; rep < ((l == 0 && DUP == 6) ? 2 : 1); ++rep) { if (rep) xcd_barrier(bar); refresh(F); phase_ln1_router(F, X1, args.in[15] + l * 1024, args.in[16] + l * 1024, mod_f, args.in[19] + (size_t)l * 1024 * 32, args.in[20] + l * 32, HB, cnt); SEAM(pb + 6); }
        if (IN(pb + 7)) for (int rep = 0; rep < ((l == 0 && DUP == 7) ? 2 : 1); ++rep) { if (rep) xcd_barrier(bar); refresh(F); phase_gather(F, cnt, HB, (unsigned char*)(WSB + WS_HS8)); SEAM(pb + 7); }
        if (IN(pb + 8)) for (int rep = 0; rep < ((l == 0 && DUP == 8) ? 2 : 1); ++rep) { if (rep) xcd_barrier(bar); refresh(F);
            build_pstart(F, cnt);
            pg8::Gemm g{(const bf16_t*)(WSB + WS_HS8), (const bf16_t*)(WSB + WS_WGU_T + (size_t)l * 32 * 2048 * 1024), 512, 512, 512, 128};
            pg8::MoeOrder S{F.G, (int)blockIdx.x, 8, (int)F.MISC[48], (const volatile LAS int*)(F.MISC + 16)};
            pg8::EpiMoe1 E{(unsigned char*)(WSB + WS_ACT), args.in[22] + (size_t)l * 32 * 2048};
            pg8::gemm_phase<pg8::EpiMoe1, pg8::MoeOrder, true>(F.lds, g, S, E, F.wave);
            SEAM(pb + 8);
        }
        if (IN(pb + 9)) for (int rep = 0; rep < ((l == 0 && DUP == 9) ? 2 : 1); ++rep) { if (rep) xcd_barrier(bar); refresh(F);
            build_pstart(F, cnt);
            pg8::Gemm g{(const bf16_t*)(WSB + WS_ACT), (const bf16_t*)(WSB + WS_WDN_T + (size_t)l * 32 * 1024 * 1024), 512, 512, 512, 128};
            pg8::MoeOrder S{F.G, (int)blockIdx.x, 4, (int)F.MISC[48], (const volatile LAS int*)(F.MISC + 16)};
            pg8::EpiMoe2 E{(bf16_t*)(WSB + WS_HS), args.in[24] + (size_t)l * 32 * 1024};
            pg8::gemm_phase<pg8::EpiMoe2, pg8::MoeOrder, true>(F.lds, g, S, E, F.wave);
            SEAM(pb + 9);
        }
        if (IN(pb + 10)) for (int rep = 0; rep < ((l == 0 && DUP == 10) ? 2 : 1); ++rep) { if (rep) xcd_barrier(bar); refresh(F);
            phase_combine(F, (const bf16_t*)(WSB + WS_HS), X1, mod_f, args.in[25] + l * 1024, args.in[26] + l * 1024, args.out, (l + 1 < DEPTH) ? MOD + (size_t)(2 * l + 2) * 16 * 3072 : nullptr, HB, (unsigned char*)(WSB + WS_HB8), (bf16_t*)(WSB + WS_X2B));
            SEAM(pb + 10);
        }
}

__global__ void __launch_bounds__(512, 2) mega_fwd(Args args) {
    extern __shared__ __attribute__((aligned(16))) unsigned char lds_raw[];
    Frame F;
    F.lds = (LAS unsigned char*)lds_raw; F.MISC = (volatile LAS unsigned*)(F.lds + LDS_MISC);
    F.tid = threadIdx.x; F.lane = F.tid & 63; F.wave = __builtin_amdgcn_readfirstlane(F.tid >> 6); F.wave0 = F.wave;
    F.G = gridDim.x; F.gw = blockIdx.x * 8 + F.wave; F.NGW = F.G * 8;
    F.ws = args.ws; F.ws0 = args.ws; F.ctl = (unsigned*)(args.ws + WS_CTL); F.in = args.in; F.out = args.out;
    for (int u = F.tid; u < (LDS_BYTES - LDS_MISC) / 4; u += 512) F.MISC[u] = 0u;
    __syncthreads();
    XcdBarrier bar = xcd_barrier_post(F.ctl + CW_BAR + args.li * XCD_BAR_WORDS, F.MISC);
    const int lo = args.ph_lo, hi = args.ph_hi;
    if (IN(0)) for (int rep = 0; rep < (DUP == 100 ? 2 : 1); ++rep) { refresh(F); phase_prologue(F); SEAM(0); }
    if (IN(1)) { refresh(F); phase_h0(F, args.in[0], MOD, HB, (unsigned char*)(WSB + WS_HB8)); SEAM(1); }

    run_layer<0>(F, args, bar, lo, hi);
    run_layer<1>(F, args, bar, lo, hi);
#undef IN
#undef SEAM
#undef WSB
#undef PROJ
#undef HB
#undef OCAT
#undef MERG
#undef X1
#undef MOD
#undef xres
#undef mod_a
#undef mod_f
#undef cnt
}

constexpr int N_LAUNCHES = 1;
extern "C" void kernel_launch(void* const* d_in, const int* in_sizes, int n_in, void* d_out, int out_size, void* d_ws, size_t ws_size, hipStream_t stream) {
    static int grid = 0;
    if (grid == 0) {
        if (n_in != 27 || out_size != NTOK * D || ws_size < WS_END) { fprintf(stderr, "kernel_launch: unexpected sizes n_in %d out %d ws %zu (need %zu)\n", n_in, out_size, ws_size, (size_t)WS_END); grid = -1; return; }
        int dev = 0, cus = 0, per_cu = 0;
        if (hipGetDevice(&dev) != hipSuccess || hipDeviceGetAttribute(&cus, hipDeviceAttributeMultiprocessorCount, dev) != hipSuccess) { grid = -1; return; }
        if (hipFuncSetAttribute((const void*)mega_fwd, hipFuncAttributeMaxDynamicSharedMemorySize, LDS_BYTES) != hipSuccess) { fprintf(stderr, "kernel_launch: hipFuncSetAttribute failed\n"); grid = -1; return; }
        if (hipOccupancyMaxActiveBlocksPerMultiprocessor(&per_cu, (const void*)mega_fwd, 512, LDS_BYTES) != hipSuccess || per_cu < 1) fprintf(stderr, "kernel_launch: occupancy query says %d\n", per_cu);
        (void)hipGetLastError();
        grid = cus;
        if (grid != 256) { fprintf(stderr, "kernel_launch: built for 256 CUs, got %d\n", cus); grid = -1; return; }
    }
    if (grid < 0) return;
    (void)hipMemsetAsync((char*)d_ws + WS_CTL, 0, CTL_BYTES, stream);
    Args a{};
    for (int i = 0; i < 27; ++i) a.in[i] = (const float*)d_in[i];
    a.out = (float*)d_out; a.ws = (unsigned char*)d_ws; a.pad = 0;
    for (int li = 0; li < N_LAUNCHES; ++li) {
        a.ph_lo = (N_LAUNCHES == 1) ? 0 : li; a.ph_hi = (N_LAUNCHES == 1) ? N_PHASES : li + 1; a.li = li;
        hipLaunchKernelGGL(mega_fwd, dim3(grid), dim3(512), LDS_BYTES, stream, a);
    }
}
```

```cpp
#include <hip/hip_runtime.h>
#include <cstdio>
#include <cstdint>

#define GAS __attribute__((address_space(1)))
#define LAS __attribute__((address_space(3)))
typedef unsigned short bf16_t;
typedef short bf16x8 __attribute__((ext_vector_type(8)));
typedef short s16x4 __attribute__((ext_vector_type(4)));
typedef float f32x2 __attribute__((ext_vector_type(2)));
typedef float f32x4 __attribute__((ext_vector_type(4)));
typedef float f32x16 __attribute__((ext_vector_type(16)));
typedef unsigned u32x4 __attribute__((ext_vector_type(4)));
typedef unsigned u32x2 __attribute__((ext_vector_type(2)));
typedef unsigned long long u64;

constexpr bool USE_A = true, USE_B = true, USE_C = true;
constexpr bool A_DENSE = false; constexpr bool DSA_FAKE = false;
constexpr int PROBE_ATT = 0;
constexpr int DUP = -1;
constexpr int NB = 16, SEQ = 4096, NTOK = NB * SEQ, D = 1024, DEPTH = 2, NEXP = 32;
constexpr int DP = 5888;
constexpr int D_IN = 5808;
constexpr int C_AQ = 0, C_AK = 256, C_AV = 320, C_IQ = 384, C_IK = 512, C_IW = 544, C_BG = 548, C_BQ = 576, C_BKV = 832, C_CQ = 1216, C_CK = 1728, C_CV = 2240, C_MG = 2752;
constexpr float LOG2E = 1.4426950408889634f;
constexpr float QS = 0.125f * LOG2E;
constexpr float IQS = 0.17677669529663687f;
constexpr float DN_ALPHA = 1.4142135623730951f;
constexpr float LN_EPS = 1e-5f;
constexpr int MOE_ROWS = NTOK * 4 + NEXP * 256;
constexpr float F8_WGU = 256.f, F8_WDN = 512.f, F8_H = 4.f, F8_ACT = 4.f, F8_WIN = 256.f;
constexpr int N_BF = 2816, N_F8 = 3072;

constexpr size_t MiB = 1u << 20;
constexpr size_t WS_CTL = 0, CTL_BYTES = 1 * MiB;
constexpr size_t WS_MOD = 1 * MiB;
constexpr size_t WS_BIAS1 = WS_MOD + 4 * 16 * 3072 * 4;
constexpr size_t WS_LUT = WS_BIAS1 + 4096;
constexpr size_t WS_LAM = WS_LUT + 8192;
constexpr size_t WS_TOKE = 2 * MiB;
constexpr size_t WS_TOKW = 3 * MiB;
constexpr size_t WS_TOKP = 4 * MiB;
constexpr size_t WS_TOKR = 5 * MiB;
constexpr size_t WS_KCMP = 6 * MiB;
constexpr size_t WS_WIN_T = 8 * MiB;
constexpr size_t WS_WBR_T = 31 * MiB;
constexpr size_t WS_WOUT_T = 35 * MiB;
constexpr size_t WS_W1_T = 39 * MiB;
constexpr size_t WS_W2_T = 43 * MiB;
constexpr size_t WS_WGU_T = 44 * MiB;
constexpr size_t WS_WDN_T = 300 * MiB;
constexpr size_t WS_WMG8 = 172 * MiB;
constexpr size_t WS_HB8 = 364 * MiB;
constexpr size_t WS_X1 = 428 * MiB;
constexpr size_t WS_X2B = 556 * MiB;
constexpr size_t WS_HB = 684 * MiB;
constexpr size_t WS_HID = 812 * MiB;
constexpr size_t WS_BIG = 820 * MiB;
constexpr size_t WS_PROJ = WS_BIG;
constexpr size_t WS_OCAT = WS_BIG + 737 * MiB;
constexpr size_t WS_MERG = WS_OCAT + 128 * MiB;
constexpr size_t WS_BM64 = WS_MERG + 128 * MiB;
constexpr size_t WS_HS = WS_BIG;
constexpr size_t WS_HS8 = WS_BIG + 792 * MiB;
constexpr size_t WS_ACT = WS_BIG + 528 * MiB;
constexpr size_t WS_END = WS_BIG + 1056 * MiB;
static_assert((size_t)(NTOK + 32) * DP * 2 <= 737 * MiB, "proj");
static_assert((size_t)MOE_ROWS * 1024 * 2 <= 528 * MiB, "moe rows");
static_assert(WS_BM64 + 32 * MiB <= WS_END, "ws");
constexpr int CW_CNT = 1024;
constexpr int CW_BAR = 4096;

constexpr int LDS_MISC = 147456;
constexpr int LDS_BYTES = 151552;

#define LDS_WAIT() asm volatile("s_waitcnt lgkmcnt(0)" ::: "memory")
#define VM_WAIT() asm volatile("s_waitcnt vmcnt(0)" ::: "memory")

__device__ __forceinline__ unsigned f2bf(float f) { unsigned u = __builtin_bit_cast(unsigned, f); return (u + 0x7fffu + ((u >> 16) & 1u)) >> 16; }
__device__ __forceinline__ unsigned pk2(float lo, float hi) { return f2bf(lo) | (f2bf(hi) << 16); }
__device__ __forceinline__ float bf2f(unsigned short b) { return __builtin_bit_cast(float, (unsigned)b << 16); }
__device__ __forceinline__ float bflo(unsigned w) { return __builtin_bit_cast(float, w << 16); }
__device__ __forceinline__ float bfhi(unsigned w) { return __builtin_bit_cast(float, w & 0xffff0000u); }
typedef __bf16 bf16x2_t __attribute__((ext_vector_type(2)));
__device__ __forceinline__ unsigned cvt_pk_bf16(float lo, float hi) { return __builtin_bit_cast(unsigned, __builtin_convertvector((f32x2){lo, hi}, bf16x2_t)); }
__device__ __forceinline__ unsigned pk4_fp8(float a, float b, float c, float d) { int r = 0; r = __builtin_amdgcn_cvt_pk_fp8_f32(a, b, r, false); r = __builtin_amdgcn_cvt_pk_fp8_f32(c, d, r, true); return (unsigned)r; }
__device__ __forceinline__ float fexp2(float x) { return __builtin_amdgcn_exp2f(x); }
__device__ __forceinline__ float frcp(float x) { return __builtin_amdgcn_rcpf(x); }
__device__ __forceinline__ float fsigmoid(float x) { return frcp(1.f + fexp2(-LOG2E * x)); }
__device__ __forceinline__ float gelu_tanh(float x) { const float u = 0.7978845608028654f * (x + 0.044715f * x * x * x); return x * fsigmoid(2.f * u); }
__device__ __forceinline__ int bperm_i(int idx, int v) { return __builtin_amdgcn_ds_bpermute(idx << 2, v); }
__device__ __forceinline__ float bperm_f(int idx, float v) { return __builtin_bit_cast(float, __builtin_amdgcn_ds_bpermute(idx << 2, __builtin_bit_cast(int, v))); }
__device__ __forceinline__ float other32(float v, int lane) { return bperm_f(lane ^ 32, v); }
__device__ __forceinline__ float sum32(float v, int lane) { return v + bperm_f(lane ^ 32, v); }
__device__ __forceinline__ float max32(float v, int lane) { return fmaxf(v, bperm_f(lane ^ 32, v)); }
__device__ __forceinline__ float shx_f(float v, int mask, int lane) { return bperm_f(lane ^ mask, v); }
__device__ __forceinline__ int shx_i(int v, int mask, int lane) { return bperm_i(lane ^ mask, v); }
__device__ __forceinline__ float wave_sum(float v, int lane) {
#pragma unroll
    for (int o = 1; o < 32; o <<= 1) v += shx_f(v, o, lane);
    return sum32(v, lane);
}

#define XB_TMO      128
#define XB_XCNT(j)  (256  + 64 * (j))
#define XB_XSUB(j)  (1280 + 64 * (j))
#define XB_XGEN(j)  (2304 + 64 * (j))
#define XB_TOP      3328
#define XB_TOPGEN   3392
#define XCD_BAR_WORDS 3456
#define XB_SPIN_CAP (1u << 18)

__device__ __forceinline__ unsigned xb_ld(unsigned* p)              { return __hip_atomic_load(p, __ATOMIC_RELAXED, __HIP_MEMORY_SCOPE_AGENT); }
__device__ __forceinline__ unsigned xb_add(unsigned* p, unsigned v) { return __hip_atomic_fetch_add(p, v, __ATOMIC_RELAXED, __HIP_MEMORY_SCOPE_AGENT); }
__device__ __forceinline__ unsigned xb_xcc_id() { return (unsigned)__builtin_amdgcn_s_getreg((3 << 11) | 20) & 0xFu; }
#define XB_SPIN(cond, bar) do { unsigned _sp = 0; while (cond) { __builtin_amdgcn_s_sleep(1); \
    if ((++_sp & 255u) == 0u) { if (xb_ld(&(bar)[XB_TMO])) break; if (_sp > XB_SPIN_CAP) { atomicAdd(&(bar)[XB_TMO], 1u); break; } } } } while (0)

struct XcdBarrier { unsigned* bar; unsigned x; volatile LAS unsigned* st; };

__device__ __forceinline__ XcdBarrier xcd_barrier_post(unsigned* bar, volatile LAS unsigned* st) {
    XcdBarrier b; b.bar = bar; b.x = xb_xcc_id(); b.st = st;
    if (threadIdx.x == 0) (void)xb_add(&bar[XB_XCNT(b.x)], 1u);
    return b;
}
__device__ __forceinline__ void xcd_barrier_complete(unsigned* bar, unsigned x, unsigned& nloc, unsigned& nx) {
    const unsigned G = gridDim.x * gridDim.y * gridDim.z;
    unsigned sum, cnt, mine, sp = 0u;
    for (;;) {
        sum = 0u; cnt = 0u; mine = 0u;
#pragma unroll
        for (unsigned j = 0; j < 16; ++j) { const unsigned c = xb_ld(&bar[XB_XCNT(j)]); sum += c; cnt += (c > 0u) ? 1u : 0u; mine = (j == x) ? c : mine; }
        if (sum == G) break;
        __builtin_amdgcn_s_sleep(1);
        if ((++sp & 255u) == 0u) { if (xb_ld(&bar[XB_TMO])) break; if (sp > XB_SPIN_CAP) { atomicAdd(&bar[XB_TMO], 1u); break; } }
    }
    nloc = mine > 0u ? mine : 1u; nx = cnt > 0u ? cnt : 1u;
}
__device__ __forceinline__ void xcd_barrier(const XcdBarrier& b) {
    asm volatile("s_waitcnt vmcnt(0)" ::: "memory");
    __syncthreads();
    if (threadIdx.x == 0) {
        unsigned* bar = b.bar;
        __builtin_amdgcn_s_waitcnt(0);
        unsigned nloc = b.st[0], nx = b.st[1];
        if (nloc == 0u) { xcd_barrier_complete(bar, b.x, nloc, nx); b.st[0] = nloc; b.st[1] = nx; }
        const unsigned old = xb_add(&bar[XB_XSUB(b.x)], 1u);
        const unsigned gen = old / nloc;
        if (old + 1u == (gen + 1u) * nloc) {
            __builtin_amdgcn_fence(__ATOMIC_RELEASE, "agent");
            asm volatile("s_waitcnt vmcnt(0)" ::: "memory");
            const unsigned og = xb_add(&bar[XB_TOP], 1u);
            const unsigned tg = og / nx;
            if (og + 1u == (tg + 1u) * nx) xb_add(&bar[XB_TOPGEN], 1u);
            else XB_SPIN(xb_ld(&bar[XB_TOPGEN]) == tg, bar);
            __builtin_amdgcn_fence(__ATOMIC_ACQUIRE, "agent");
            xb_add(&bar[XB_XGEN(b.x)], 1u);
            asm volatile("s_waitcnt vmcnt(0)" ::: "memory");
        } else {
            XB_SPIN(xb_ld(&bar[XB_XGEN(b.x)]) == gen, bar);
            __builtin_amdgcn_fence(__ATOMIC_ACQUIRE, "agent");
            asm volatile("s_waitcnt vmcnt(0)" ::: "memory");
        }
    }
    __syncthreads();
}

__device__ __forceinline__ int fresh_tid(int wave_s) {
    unsigned ones = ~0u; asm volatile("" : "+s"(ones));
    int ln = (int)__builtin_amdgcn_mbcnt_hi(ones, __builtin_amdgcn_mbcnt_lo(ones, 0u)); asm volatile("" : "+v"(ln));
    return wave_s * 64 + ln;
}

namespace pg8 {
typedef int v4i_t __attribute__((ext_vector_type(4)));
typedef int v8i_t __attribute__((ext_vector_type(8)));
constexpr int BM = 256, BK = 64, HALF = 128, HTB = HALF * BK * 2, STAGE_BYTES = 8 * HTB, NXCD = 8, WGM = 8;
__device__ __forceinline__ int lds_byte(int r, int c) { const int st = (r >> 4) * 2 + (c >> 5), rr = r & 15, cc = c & 31, ob = rr * 64 + cc * 2; return st * 1024 + (ob ^ (((ob >> 9) & 1) << 5)); }
__device__ __forceinline__ void stage_rc(int b, int& R, int& C) { const int st = b / 1024, sb = b % 1024, swz = sb ^ (((sb >> 9) & 1) << 5); R = (st >> 1) * 16 + swz / 64; C = (st & 1) * 32 + (swz % 64) / 2; }
__device__ __forceinline__ int perm32(int rho) { const int n = rho >> 4, i = rho & 15; return 8 * (i >> 2) + 4 * n + (i & 3); }

struct Unit { int pm, pn; };
struct Gemm { const bf16_t* A; const bf16_t* Bt; int lda, ldb, K, kstepA; };

struct StaticOrder {
    int nM, nN, nwg, G, c;
    __device__ void init(int M, int N, int G_, int c_) { nM = M / BM; nN = N / BM; nwg = nM * nN; G = G_; c = c_; }
    __device__ bool next(int i, Unit& u) const {
        const long L = (long)i * G + c; if (L >= nwg) return false;
        int wgid = (int)L; { const int q = nwg / NXCD, r = nwg % NXCD, xcd = wgid % NXCD, off = wgid / NXCD; wgid = (xcd < r ? xcd * (q + 1) : r * (q + 1) + (xcd - r) * q) + off; }
        const int nig = WGM * nN, gid = wgid / nig, fm = gid * WGM, gsz = (nM - fm) < WGM ? (nM - fm) : WGM;
        u.pm = fm + ((wgid % nig) % gsz); u.pn = (wgid % nig) / gsz; return true;
    }
    __device__ __forceinline__ const char* a_ptr(const Gemm& g, const Unit& u) const { return (const char*)g.A + (size_t)u.pm * (size_t)(BM * 2) * g.lda; }
    __device__ __forceinline__ const char* b_ptr(const Gemm& g, const Unit& u) const { return (const char*)g.Bt + (size_t)u.pn * (size_t)(BM * 2) * g.ldb; }
};
struct CmpOrder {
    int G, c;
    __device__ bool next(int i, Unit& u) const { const int L = i * G + c; if (L >= 32) return false; u.pn = L >> 4; u.pm = L & 15; return true; }
    __device__ __forceinline__ const char* a_ptr(const Gemm& g, const Unit& u) const { return (const char*)g.A + (size_t)u.pm * (size_t)(BM * 2) * g.lda + u.pn * 128; }
    __device__ __forceinline__ const char* b_ptr(const Gemm& g, const Unit& u) const { return (const char*)g.Bt + (size_t)u.pn * (size_t)(BM * 2) * g.ldb; }
};
struct MoeOrder {
    int G, c, NT, npan; const volatile LAS int* pstart;
    __device__ bool next(int i, Unit& u) const {
        const int ppx = (256 / NT) / 8, x = c & 7, r = c >> 3;
        const int p = i * (256 / NT) + x * ppx + (r % ppx), n = r / ppx; if (p >= npan) return false;
        int e = 0;
#pragma unroll 1
        for (int k = 1; k < 32; ++k) e += (pstart[k] <= p) ? 1 : 0;
        u.pm = p; u.pn = e * NT + n; return true;
    }
    __device__ __forceinline__ const char* a_ptr(const Gemm& g, const Unit& u) const { return (const char*)g.A + (size_t)u.pm * (size_t)(BM * 2) * g.lda; }
    __device__ __forceinline__ const char* b_ptr(const Gemm& g, const Unit& u) const { return (const char*)g.Bt + (size_t)u.pn * (size_t)(BM * 2) * g.ldb; }
};

#define EPI_LOOP_AI_M  _Pragma("unroll") for (int ai = 0; ai < 2; ++ai) _Pragma("unroll") for (int m = 0; m < 4; ++m)

struct EpiProj {
    static constexpr bool PERM = true;
    bf16_t* O; int colbase; float scl;
    __device__ __forceinline__ void operator()(const f32x4 (&acc)[2][2][4][2], const Unit& u, int wr, int wc, int fr, int fq) const {
        const int row0 = u.pm * BM + wr * 64 + fr, col0 = colbase + u.pn * BM + wc * 32 + 8 * fq;
        EPI_LOOP_AI_M { bf16_t* rowp = O + (size_t)(row0 + ai * HALF + m * 16) * DP + col0;
#pragma unroll
            for (int bj = 0; bj < 2; ++bj) { const f32x4 v0 = acc[ai][bj][m][0] * scl, v1 = acc[ai][bj][m][1] * scl;
                u32x4 w; w.x = cvt_pk_bf16(v0[0], v0[1]); w.y = cvt_pk_bf16(v0[2], v0[3]); w.z = cvt_pk_bf16(v1[0], v1[1]); w.w = cvt_pk_bf16(v1[2], v1[3]);
                *(u32x4*)(rowp + bj * HALF) = w; } }
    }
};
struct EpiCmp1 {
    static constexpr bool PERM = true;
    bf16_t* O; const float* bias;
    __device__ __forceinline__ void operator()(const f32x4 (&acc)[2][2][4][2], const Unit& u, int wr, int wc, int fr, int fq) const {
        const int row0 = u.pm * BM + wr * 64 + fr, col0 = wc * 32 + 8 * fq; const int j = u.pn;
        f32x4 bv[2][2];
#pragma unroll
        for (int bj = 0; bj < 2; ++bj)
#pragma unroll
            for (int n = 0; n < 2; ++n) bv[bj][n] = *(const f32x4*)(bias + j * 256 + col0 + bj * HALF + 4 * n);
        EPI_LOOP_AI_M { bf16_t* rowp = O + ((size_t)j * 4096 + row0 + ai * HALF + m * 16) * 256 + col0;
#pragma unroll
            for (int bj = 0; bj < 2; ++bj) { f32x4 v0 = acc[ai][bj][m][0] + bv[bj][0], v1 = acc[ai][bj][m][1] + bv[bj][1];
#pragma unroll
                for (int q = 0; q < 4; ++q) { v0[q] = gelu_tanh(v0[q]); v1[q] = gelu_tanh(v1[q]); }
                u32x4 w; w.x = cvt_pk_bf16(v0[0], v0[1]); w.y = cvt_pk_bf16(v0[2], v0[3]); w.z = cvt_pk_bf16(v1[0], v1[1]); w.w = cvt_pk_bf16(v1[2], v1[3]);
                *(u32x4*)(rowp + bj * HALF) = w; } }
    }
};
__device__ __forceinline__ float sig_ratio(float a, float b) { return (1.f + fexp2(-LOG2E * b)) * frcp(1.f + fexp2(-LOG2E * a)); }
struct EpiBranchCat {
    static constexpr bool PERM = true, MID = true;
    bf16_t* MG; const bf16_t* P;
    __device__ __forceinline__ void mid(f32x4 (&acc)[2][2][4][2], const Unit& u, int wr, int wc, int fr, int fq, int seg) const {
        const int row0 = u.pm * BM + wr * 64 + fr, col0 = u.pn * BM + wc * 32 + 8 * fq;
#pragma unroll
        for (int ai = 0; ai < 2; ++ai) {
            u32x4 ga[4][2], gb[4][2];
#pragma unroll
            for (int m = 0; m < 4; ++m) { const size_t row = (size_t)(row0 + ai * HALF + m * 16);
#pragma unroll
                for (int bj = 0; bj < 2; ++bj) { const bf16_t* gp = P + row * DP + C_MG + seg * 1024 + col0 + bj * HALF; ga[m][bj] = *(const u32x4*)gp; gb[m][bj] = *(const u32x4*)(gp + 1024); } }
#pragma unroll
            for (int m = 0; m < 4; ++m)
#pragma unroll
                for (int bj = 0; bj < 2; ++bj) { const u32x4 a = ga[m][bj], b = gb[m][bj]; f32x4& v0 = acc[ai][bj][m][0]; f32x4& v1 = acc[ai][bj][m][1];
                    v0[0] *= sig_ratio(bflo(a.x), bflo(b.x)); v0[1] *= sig_ratio(bfhi(a.x), bfhi(b.x)); v0[2] *= sig_ratio(bflo(a.y), bflo(b.y)); v0[3] *= sig_ratio(bfhi(a.y), bfhi(b.y));
                    v1[0] *= sig_ratio(bflo(a.z), bflo(b.z)); v1[1] *= sig_ratio(bfhi(a.z), bfhi(b.z)); v1[2] *= sig_ratio(bflo(a.w), bflo(b.w)); v1[3] *= sig_ratio(bfhi(a.w), bfhi(b.w)); }
        }
    }
    __device__ __forceinline__ void operator()(const f32x4 (&acc)[2][2][4][2], const Unit& u, int wr, int wc, int fr, int fq) const {
        const int row0 = u.pm * BM + wr * 64 + fr, col0 = u.pn * BM + wc * 32 + 8 * fq;
#pragma unroll
        for (int ai = 0; ai < 2; ++ai) {
            u32x4 gq[4][2];
#pragma unroll
            for (int m = 0; m < 4; ++m) { const size_t row = (size_t)(row0 + ai * HALF + m * 16);
#pragma unroll
                for (int bj = 0; bj < 2; ++bj) gq[m][bj] = *(const u32x4*)(P + row * DP + C_MG + 2 * 1024 + col0 + bj * HALF); }
#pragma unroll
            for (int m = 0; m < 4; ++m) { const size_t row = (size_t)(row0 + ai * HALF + m * 16);
#pragma unroll
                for (int bj = 0; bj < 2; ++bj) { const u32x4 g = gq[m][bj]; f32x4 v0 = acc[ai][bj][m][0], v1 = acc[ai][bj][m][1];
                    v0[0] *= fsigmoid(bflo(g.x)); v0[1] *= fsigmoid(bfhi(g.x)); v0[2] *= fsigmoid(bflo(g.y)); v0[3] *= fsigmoid(bfhi(g.y));
                    v1[0] *= fsigmoid(bflo(g.z)); v1[1] *= fsigmoid(bfhi(g.z)); v1[2] *= fsigmoid(bflo(g.w)); v1[3] *= fsigmoid(bfhi(g.w));
                    u32x4 w; w.x = cvt_pk_bf16(v0[0], v0[1]); w.y = cvt_pk_bf16(v0[2], v0[3]); w.z = cvt_pk_bf16(v1[0], v1[1]); w.w = cvt_pk_bf16(v1[2], v1[3]);
                    *(u32x4*)(MG + row * 1024 + col0 + bj * HALF) = w; } }
        }
    }
};
template <bool XBF> struct EpiWout {
    static constexpr bool PERM = true;
    bf16_t* Z; const void* XR; const float* gate;
    __device__ __forceinline__ void operator()(const f32x4 (&acc)[2][2][4][2], const Unit& u, int wr, int wc, int fr, int fq) const {
        const int row0 = u.pm * BM + wr * 64 + fr, col0 = u.pn * BM + wc * 32 + 8 * fq;
        const int b = (u.pm * BM) >> 12;
        f32x4 gv[2][2];
#pragma unroll
        for (int bj = 0; bj < 2; ++bj)
#pragma unroll
            for (int n = 0; n < 2; ++n) gv[bj][n] = *(const f32x4*)(gate + (size_t)b * 3072 + col0 + bj * HALF + 4 * n) + 1.0f;
#pragma unroll
        for (int ai = 0; ai < 2; ++ai) {
            f32x4 xr[4][2][2];
#pragma unroll
            for (int m = 0; m < 4; ++m) { const size_t ro = (size_t)(row0 + ai * HALF + m * 16) * 1024 + col0;
#pragma unroll
                for (int bj = 0; bj < 2; ++bj) {
                    if (XBF) { const u32x4 q = *(const u32x4*)((const bf16_t*)XR + ro + bj * HALF);
                        xr[m][bj][0] = (f32x4){bflo(q.x), bfhi(q.x), bflo(q.y), bfhi(q.y)}; xr[m][bj][1] = (f32x4){bflo(q.z), bfhi(q.z), bflo(q.w), bfhi(q.w)}; }
                    else { xr[m][bj][0] = *(const f32x4*)((const float*)XR + ro + bj * HALF); xr[m][bj][1] = *(const f32x4*)((const float*)XR + ro + bj * HALF + 4); } } }
            asm volatile("" ::: "memory");
#pragma unroll
            for (int m = 0; m < 4; ++m) { const size_t ro = (size_t)(row0 + ai * HALF + m * 16) * 1024 + col0;
#pragma unroll
                for (int bj = 0; bj < 2; ++bj) { const f32x4 v0 = xr[m][bj][0] * DN_ALPHA + gv[bj][0] * acc[ai][bj][m][0], v1 = xr[m][bj][1] * DN_ALPHA + gv[bj][1] * acc[ai][bj][m][1];
                    u32x4 w; w.x = cvt_pk_bf16(v0[0], v0[1]); w.y = cvt_pk_bf16(v0[2], v0[3]); w.z = cvt_pk_bf16(v1[0], v1[1]); w.w = cvt_pk_bf16(v1[2], v1[3]);
                    *(u32x4*)(Z + ro + bj * HALF) = w; } }
            asm volatile("" ::: "memory");
        }
    }
};
__device__ __forceinline__ float swiglu(float g, float u) { const float gg = fminf(g, 7.f), uu = fminf(fmaxf(u, -7.f), 7.f); return (uu + 1.f) * gg * fsigmoid(1.702f * gg); }
struct EpiMoe1 {
    static constexpr bool PERM = true;
    unsigned char* O; const float* bias;
    __device__ __forceinline__ void operator()(const f32x4 (&acc)[2][2][4][2], const Unit& u, int wr, int wc, int fr, int fq) const {
        const int row0 = u.pm * BM + wr * 64 + fr; const int e = u.pn >> 3, n8 = u.pn & 7; const int cg0 = n8 * BM + wc * 32 + 8 * fq;
        constexpr float isc = 1.f / (F8_H * F8_WGU);
        f32x4 bv[2][2];
#pragma unroll
        for (int bj = 0; bj < 2; ++bj)
#pragma unroll
            for (int n = 0; n < 2; ++n) bv[bj][n] = *(const f32x4*)(bias + (size_t)e * 2048 + cg0 + bj * HALF + 4 * n);
        EPI_LOOP_AI_M { unsigned char* rowp = O + (size_t)(row0 + ai * HALF + m * 16) * 1024 + (cg0 >> 1);
#pragma unroll
            for (int bj = 0; bj < 2; ++bj) { const f32x4 v0 = acc[ai][bj][m][0] * isc + bv[bj][0], v1 = acc[ai][bj][m][1] * isc + bv[bj][1];
                *(unsigned*)(rowp + bj * (HALF / 2)) = pk4_fp8(F8_ACT * swiglu(v0[0], v0[1]), F8_ACT * swiglu(v0[2], v0[3]), F8_ACT * swiglu(v1[0], v1[1]), F8_ACT * swiglu(v1[2], v1[3])); } }
    }
};
struct EpiMoe2 {
    static constexpr bool PERM = true;
    bf16_t* O; const float* bias;
    __device__ __forceinline__ void operator()(const f32x4 (&acc)[2][2][4][2], const Unit& u, int wr, int wc, int fr, int fq) const {
        const int row0 = u.pm * BM + wr * 64 + fr; const int e = u.pn >> 2, n4 = u.pn & 3; const int c0 = n4 * BM + wc * 32 + 8 * fq;
        constexpr float isc = 1.f / (F8_ACT * F8_WDN);
        f32x4 bv[2][2];
#pragma unroll
        for (int bj = 0; bj < 2; ++bj)
#pragma unroll
            for (int n = 0; n < 2; ++n) bv[bj][n] = *(const f32x4*)(bias + (size_t)e * 1024 + c0 + bj * HALF + 4 * n);
        EPI_LOOP_AI_M { bf16_t* rowp = O + (size_t)(row0 + ai * HALF + m * 16) * 1024 + c0;
#pragma unroll
            for (int bj = 0; bj < 2; ++bj) { const f32x4 v0 = acc[ai][bj][m][0] * isc + bv[bj][0], v1 = acc[ai][bj][m][1] * isc + bv[bj][1];
                u32x4 w; w.x = cvt_pk_bf16(v0[0], v0[1]); w.y = cvt_pk_bf16(v0[2], v0[3]); w.z = cvt_pk_bf16(v1[0], v1[1]); w.w = cvt_pk_bf16(v1[2], v1[3]);
                *(u32x4*)(rowp + bj * HALF) = w; } }
    }
};

__device__ __forceinline__ unsigned stage_voff(int tid, int i, int ld, bool perm) {
    int t = tid; asm volatile("" : "+v"(t));
    int R, C; stage_rc(t * 16 + i * 8192, R, C); const int Rb = perm ? ((R & ~31) + perm32(R & 31)) : R;
    return (unsigned)(Rb * ld + C) * 2u;
}
template <class T, class = void> struct has_mid { static constexpr bool value = false; };
template <class T> struct has_mid<T, decltype((void)T::MID)> { static constexpr bool value = T::MID; };
template <class Epi, class Sched, bool FP8 = false>
__device__ __forceinline__ void gemm_phase(LAS unsigned char* lds, const Gemm g, const Sched& S, const Epi& E, int wave_s) {
    const int tid = fresh_tid(wave_s), wid = wave_s, lane = tid & 63, wr = wid >> 2, wc = wid & 3, fr = lane & 15, fq = lane >> 4;
    const int K = g.K, nt = K / BK;
    unsigned voffA[2], voffB[2];
#pragma unroll
    for (int i = 0; i < 2; ++i) { int R, C; stage_rc(tid * 16 + i * 8192, R, C); const int Rb = Epi::PERM ? ((R & ~31) + perm32(R & 31)) : R;
        voffA[i] = (unsigned)(R * g.lda + C) * 2u; voffB[i] = (unsigned)(Rb * g.ldb + C) * 2u; }
    const size_t kstepA = (size_t)g.kstepA, kstepB = (size_t)(BK * 2);
    const size_t hstepA = (size_t)HALF * g.lda * 2, hstepB = (size_t)HALF * g.ldb * 2;
    const unsigned ldsw = (unsigned)wid * 1024u;
    const int aoff = lds_byte(wr * 64 + fr, fq * 8), boff = lds_byte(wc * 32 + fr, fq * 8);
#define PG8_SA(b, h) (((b) * 2 + (h)) * HTB)
#define PG8_SB(b, h) ((4 + (b) * 2 + (h)) * HTB)
#define PG8_VOFF(voff, _i) (FP8 ? stage_voff(tid, _i, (voff) == voffA ? g.lda : g.ldb, (voff) == voffB && Epi::PERM) : (voff)[_i])
#define PG8_STAGE(bufoff, gbase, voff) do { _Pragma("unroll") for (int _i = 0; _i < 2; ++_i) \
        __builtin_amdgcn_global_load_lds((const unsigned*)((const char*)(gbase) + PG8_VOFF(voff, _i)), (LAS unsigned*)(lds + (bufoff) + ldsw + _i * 8192), 16, 0, 0); } while (0)
    const LAS unsigned char* aB = lds + aoff; asm volatile("" : "+v"(aB));
    const LAS unsigned char* bB = lds + 4 * HTB + boff; asm volatile("" : "+v"(bB));
#define PG8_RDA(off) (*(const LAS v4i_t*)(aB + (off)))
#define PG8_RDB(off) (*(const LAS v4i_t*)(bB + (off)))
#define PG8_LDA(dst, b, h) do { _Pragma("unroll") for (int m = 0; m < 4; ++m) dst[m] = __builtin_shufflevector(PG8_RDA(((b) * 2 + (h)) * HTB + m * 2048), PG8_RDA(((b) * 2 + (h)) * HTB + m * 2048 + 1024), 0, 1, 2, 3, 4, 5, 6, 7); } while (0)
#define PG8_LDB(dst, b, h) do { _Pragma("unroll") for (int n = 0; n < 2; ++n) dst[n] = __builtin_shufflevector(PG8_RDB(((b) * 2 + (h)) * HTB + n * 2048), PG8_RDB(((b) * 2 + (h)) * HTB + n * 2048 + 1024), 0, 1, 2, 3, 4, 5, 6, 7); } while (0)
#define PG8_LO(x) __builtin_bit_cast(bf16x8, __builtin_shufflevector(x, x, 0, 1, 2, 3))
#define PG8_HI(x) __builtin_bit_cast(bf16x8, __builtin_shufflevector(x, x, 4, 5, 6, 7))
#define PG8_MMA(ai, bj, At, Bt) do { __builtin_amdgcn_s_setprio(1); _Pragma("unroll") for (int m = 0; m < 4; ++m) _Pragma("unroll") for (int n = 0; n < 2; ++n) { \
        if (FP8) acc[ai][bj][m][n] = __builtin_amdgcn_mfma_scale_f32_16x16x128_f8f6f4(Bt[n], At[m], acc[ai][bj][m][n], 0, 0, 0, 0, 0, 0); \
        else { acc[ai][bj][m][n] = __builtin_amdgcn_mfma_f32_16x16x32_bf16(PG8_LO(Bt[n]), PG8_LO(At[m]), acc[ai][bj][m][n], 0, 0, 0); \
               acc[ai][bj][m][n] = __builtin_amdgcn_mfma_f32_16x16x32_bf16(PG8_HI(Bt[n]), PG8_HI(At[m]), acc[ai][bj][m][n], 0, 0, 0); } } \
        __builtin_amdgcn_s_setprio(0); } while (0)
#define PG8_WAIT_V(n) asm volatile("s_waitcnt vmcnt(" #n ")" ::: "memory")
#define PG8_WAIT_L(n) asm volatile("s_waitcnt lgkmcnt(" #n ")" ::: "memory")
#define PG8_BAR __builtin_amdgcn_s_barrier()
#define PG8_SCHED __builtin_amdgcn_sched_barrier(0)
    Unit cur, nxt; int ui = 0;
    if (!S.next(0, cur)) return;
    f32x4 acc[2][2][4][2];
#pragma unroll
    for (int a = 0; a < 2; ++a)
#pragma unroll
        for (int b = 0; b < 2; ++b)
#pragma unroll
            for (int m = 0; m < 4; ++m)
#pragma unroll
                for (int n = 0; n < 2; ++n) acc[a][b][m][n] = (f32x4){0.f, 0.f, 0.f, 0.f};
    v8i_t At[4], B0[2], B1[2];
    const char* cA = S.a_ptr(g, cur); const char* cB = S.b_ptr(g, cur);
    PG8_STAGE(PG8_SB(0, 0), cB, voffB); PG8_STAGE(PG8_SA(0, 0), cA, voffA); PG8_STAGE(PG8_SB(0, 1), cB + hstepB, voffB); PG8_STAGE(PG8_SA(0, 1), cA + hstepA, voffA);
    if (wr == 1) PG8_BAR;
    PG8_WAIT_V(4); PG8_BAR;
    PG8_STAGE(PG8_SB(1, 0), cB + kstepB, voffB); PG8_STAGE(PG8_SA(1, 0), cA + kstepA, voffA); PG8_STAGE(PG8_SB(1, 1), cB + hstepB + kstepB, voffB);
    PG8_WAIT_V(6); PG8_BAR;
    for (;;) {
        const bool has_next = S.next(ui + 1, nxt);
        const char* nA = has_next ? S.a_ptr(g, nxt) : cA; const char* nB = has_next ? S.b_ptr(g, nxt) : cB;
        for (int t = 0; t < nt; t += 2) {
            if constexpr (has_mid<Epi>::value) { if (t == 4 || t == 8) { const int tz = fresh_tid(wave_s), ln = tz & 63; E.mid(acc, cur, wave_s >> 2, wave_s & 3, ln & 15, ln >> 4, (t >> 2) - 1); } }
            const bool last = (t == nt - 2);
            const char* a1 = cA + (size_t)(t + 1) * kstepA;
            const char* a2 = last ? nA : cA + (size_t)(t + 2) * kstepA; const char* b2 = last ? nB : cB + (size_t)(t + 2) * kstepB;
            const char* a3 = a2 + kstepA; const char* b3 = b2 + kstepB;
            PG8_LDB(B0, 0, 0); PG8_SCHED; PG8_LDA(At, 0, 0); PG8_STAGE(PG8_SA(1, 1), a1 + hstepA, voffA);
            PG8_WAIT_L(8); PG8_BAR; PG8_WAIT_L(0); PG8_MMA(0, 0, At, B0); PG8_BAR; PG8_SCHED;
            PG8_LDB(B1, 0, 1); PG8_STAGE(PG8_SB(0, 0), b2, voffB);
            PG8_BAR; PG8_WAIT_L(0); PG8_MMA(0, 1, At, B1); PG8_BAR;
            PG8_LDA(At, 0, 1); PG8_STAGE(PG8_SA(0, 0), a2, voffA);
            PG8_BAR; PG8_WAIT_L(0); PG8_MMA(1, 0, At, B0); PG8_BAR; PG8_SCHED;
            PG8_STAGE(PG8_SB(0, 1), b2 + hstepB, voffB);
            PG8_WAIT_V(6); PG8_BAR; PG8_MMA(1, 1, At, B1); PG8_BAR;
            PG8_LDB(B0, 1, 0); PG8_SCHED; PG8_LDA(At, 1, 0); PG8_STAGE(PG8_SA(0, 1), a2 + hstepA, voffA);
            PG8_WAIT_L(8); PG8_BAR; PG8_WAIT_L(0); PG8_MMA(0, 0, At, B0); PG8_BAR; PG8_SCHED;
            PG8_LDB(B1, 1, 1); PG8_STAGE(PG8_SB(1, 0), b3, voffB);
            PG8_BAR; PG8_WAIT_L(0); PG8_MMA(0, 1, At, B1); PG8_BAR;
            PG8_LDA(At, 1, 1); PG8_STAGE(PG8_SA(1, 0), a3, voffA);
            PG8_BAR; PG8_WAIT_L(0); PG8_MMA(1, 0, At, B0); PG8_BAR; PG8_SCHED;
            PG8_STAGE(PG8_SB(1, 1), b3 + hstepB, voffB);
            PG8_WAIT_V(6); PG8_BAR; PG8_MMA(1, 1, At, B1); PG8_BAR;
        }
        { const int tz = fresh_tid(wave_s), ln = tz & 63; E(acc, cur, wave_s >> 2, wave_s & 3, ln & 15, ln >> 4); }
        if (!has_next) break;
#pragma unroll
        for (int a = 0; a < 2; ++a)
#pragma unroll
            for (int b = 0; b < 2; ++b)
#pragma unroll
                for (int m = 0; m < 4; ++m)
#pragma unroll
                    for (int n = 0; n < 2; ++n) acc[a][b][m][n] = (f32x4){0.f, 0.f, 0.f, 0.f};
        cur = nxt; cA = nA; cB = nB; ++ui;
    }
    PG8_WAIT_V(0);
    if (wr == 0) PG8_BAR;
    PG8_BAR;
#undef PG8_SA
#undef PG8_SB
#undef PG8_STAGE
#undef PG8_VOFF
#undef PG8_LDA
#undef PG8_LDB
#undef PG8_MMA
#undef PG8_LO
#undef PG8_HI
#undef PG8_RDA
#undef PG8_RDB
#undef PG8_WAIT_V
#undef PG8_WAIT_L
#undef PG8_BAR
#undef PG8_SCHED
}
}

struct Frame {
    LAS unsigned char* lds;
    volatile LAS unsigned* MISC;
    unsigned* ctl;
    unsigned char* ws; unsigned char* ws0;
    const float* const* in;
    float* out;
    int tid, lane, wave, G, gw, NGW, wave0;
};
__device__ __forceinline__ void refresh(Frame& F) {
    unsigned ones = ~0u; asm volatile("" : "+s"(ones));
    int ln = (int)__builtin_amdgcn_mbcnt_hi(ones, __builtin_amdgcn_mbcnt_lo(ones, 0u)); asm volatile("" : "+v"(ln));
    int wv = F.wave0; asm volatile("" : "+s"(wv));
    F.lane = ln; F.wave = wv; F.tid = wv * 64 + ln; F.gw = blockIdx.x * 8 + wv;
    GAS unsigned char* w = (GAS unsigned char*)F.ws0; asm volatile("" : "+s"(w)); F.ws = (unsigned char*)w;
}

__constant__ unsigned char kBucket[128] = {0, 1, 2, 3, 4, 5, 6, 7, 8, 9, 10, 11, 12, 13, 14, 15, 16, 16, 16, 17, 17, 18, 18, 18, 19, 19, 19, 20, 20, 20, 20, 21, 21, 21, 21, 22, 22, 22, 22, 22, 23, 23, 23, 23, 23, 23, 24, 24, 24, 24, 24, 24, 25, 25, 25, 25, 25, 25, 25, 26, 26, 26, 26, 26, 26, 26, 26, 27, 27, 27, 27, 27, 27, 27, 27, 27, 27, 28, 28, 28, 28, 28, 28, 28, 28, 28, 28, 29, 29, 29, 29, 29, 29, 29, 29, 29, 29, 29, 29, 30, 30, 30, 30, 30, 30, 30, 30, 30, 30, 30, 30, 30, 30, 31, 31, 31, 31, 31, 31, 31, 31, 31, 31, 31, 31, 31, 31, 31};

__device__ __forceinline__ int win_src(int n, float& sc) {
    sc = 1.f;
    if (n < 544) { if (n < 256) sc = QS; else if (n >= 384 && n < 512) sc = IQS; return n; }
    if (n < 548) { sc = 0.5f; return n; }
    if (n < 560) return 1188 + (n - 548);
    if (n < 576) return -1;
    if (n < 832) { sc = QS; return 548 + (n - 576); }
    if (n < 1216) return 804 + (n - 832);
    if (n < 1728) { sc = QS; return 1200 + (n - 1216); }
    if (n < 2240) return 1712 + (n - 1728);
    if (n < 2752) return 2224 + (n - 2240);
    if (n < 5824) return 2736 + (n - 2752);
    return -1;
}
template <bool WIN>
__device__ __forceinline__ void p0_transpose_item(const float* W, int K, int Nsrc, int Ndst, bf16_t* WT, LAS float* scr, int item, int lane, int ldt = 0) {
    if (ldt == 0) ldt = K;
    const int nblk = Ndst / 32, kb = item / nblk, nb = item % nblk, k0 = 64 * kb, n0 = 32 * nb;
    if (WIN) { float sc = 1.f; const int src = win_src(n0 + (lane & 31), sc);
#pragma unroll 8
        for (int i = 0; i < 32; ++i) { const int kk = 2 * i + (lane >> 5); scr[kk * 33 + (lane & 31)] = (src >= 0) ? W[(size_t)(k0 + kk) * Nsrc + src] * sc : 0.f; }
    } else {
        f32x4 v[8];
#pragma unroll
        for (int i = 0; i < 8; ++i) v[i] = *(const f32x4*)(W + (size_t)(k0 + 8 * i + (lane >> 3)) * Nsrc + n0 + (lane & 7) * 4);
#pragma unroll
        for (int i = 0; i < 8; ++i) { LAS float* q = scr + (8 * i + (lane >> 3)) * 33 + (lane & 7) * 4; q[0] = v[i].x; q[1] = v[i].y; q[2] = v[i].z; q[3] = v[i].w; }
    }
    LDS_WAIT(); asm volatile("" ::: "memory");
    const int c = lane & 7;
#pragma unroll
    for (int j = 0; j < 4; ++j) { const int n = (lane >> 3) + 8 * j; const LAS float* s = scr + (8 * c) * 33 + n;
        u32x4 o; o.x = pk2(s[0 * 33], s[1 * 33]); o.y = pk2(s[2 * 33], s[3 * 33]); o.z = pk2(s[4 * 33], s[5 * 33]); o.w = pk2(s[6 * 33], s[7 * 33]);
        *(u32x4*)(WT + (size_t)(n0 + n) * ldt + k0 + 8 * c) = o; }
    LDS_WAIT(); asm volatile("" ::: "memory");
}

template <bool WIN>
__device__ __forceinline__ void p0_transpose_item_f8(const float* W, int K, int N, unsigned char* WT, float sc, LAS float* scr, int item, int lane, int Nsrc = 0, int ncol0 = 0) {
    const int nblk = N / 32, kb = item / nblk, nb = item % nblk, k0 = 64 * kb, n0 = 32 * nb;
    if (WIN) { float s1 = 1.f; const int src = win_src(ncol0 + n0 + (lane & 31), s1);
#pragma unroll 8
        for (int i = 0; i < 32; ++i) { const int kk = 2 * i + (lane >> 5); scr[kk * 33 + (lane & 31)] = (src >= 0) ? W[(size_t)(k0 + kk) * Nsrc + src] * (s1 * sc) : 0.f; }
    } else
    { f32x4 v[8];
#pragma unroll
      for (int i = 0; i < 8; ++i) v[i] = *(const f32x4*)(W + (size_t)(k0 + 8 * i + (lane >> 3)) * N + n0 + (lane & 7) * 4);
#pragma unroll
      for (int i = 0; i < 8; ++i) { LAS float* q = scr + (8 * i + (lane >> 3)) * 33 + (lane & 7) * 4; q[0] = v[i].x * sc; q[1] = v[i].y * sc; q[2] = v[i].z * sc; q[3] = v[i].w * sc; } }
    LDS_WAIT(); asm volatile("" ::: "memory");
    const int c = lane & 3;
#pragma unroll
    for (int j = 0; j < 2; ++j) { const int n = (lane >> 2) + 16 * j; const LAS float* q = scr + (16 * c) * 33 + n;
        u32x4 o; o.x = pk4_fp8(q[0 * 33], q[1 * 33], q[2 * 33], q[3 * 33]); o.y = pk4_fp8(q[4 * 33], q[5 * 33], q[6 * 33], q[7 * 33]);
        o.z = pk4_fp8(q[8 * 33], q[9 * 33], q[10 * 33], q[11 * 33]); o.w = pk4_fp8(q[12 * 33], q[13 * 33], q[14 * 33], q[15 * 33]);
        *(u32x4*)(WT + (size_t)(n0 + n) * K + k0 + 16 * c) = o; }
    LDS_WAIT(); asm volatile("" ::: "memory");
}
__device__ __forceinline__ void phase_prologue(Frame& F) {
    const float* const* in = F.in;
    LAS float* scr = (LAS float*)(F.lds + F.wave * 16384);
    constexpr int I_WIN = 16 * (N_BF / 32), I_WMG = 16 * (N_F8 / 32);
    constexpr int I_BA = 4 * 32, I_BC = 8 * 32, I_WO = 16 * 32, I_W1 = 32 * 8, I_W2 = 4 * 2;
    constexpr int I_GU = 16 * 64, I_DN = 16 * 32;
    constexpr int N_GU = 64 * I_GU, N_DN = 64 * I_DN, N_WIN = 2 * I_WIN, N_BA = 2 * I_BA, N_BC = 2 * I_BC, N_WO = 2 * I_WO, N_W1 = 4 * I_W1, N_W2 = 4 * I_W2, N_WMG = 2 * I_WMG;
    constexpr int NITEMS = N_GU + N_DN + N_WIN + N_WMG + 2 * N_BA + N_BC + N_WO + N_W1 + N_W2;
    for (int it = F.gw; it < NITEMS; it += F.NGW) {
        int r = it;
        if (r < N_GU) { const int m = r / I_GU; p0_transpose_item_f8<false>(in[21] + (size_t)m * 1024 * 2048, 1024, 2048, (unsigned char*)(F.ws + WS_WGU_T) + (size_t)m * 2048 * 1024, F8_WGU, scr, r % I_GU, F.lane); continue; } r -= N_GU;
        if (r < N_DN) { const int m = r / I_DN; p0_transpose_item_f8<false>(in[23] + (size_t)m * 1024 * 1024, 1024, 1024, (unsigned char*)(F.ws + WS_WDN_T) + (size_t)m * 1024 * 1024, F8_WDN, scr, r % I_DN, F.lane); continue; } r -= N_DN;
        if (r < N_WIN) { const int m = r / I_WIN; p0_transpose_item<true>(in[5] + (size_t)m * 1024 * D_IN, 1024, D_IN, N_BF, (bf16_t*)(F.ws + WS_WIN_T) + (size_t)m * DP * 1024, scr, r % I_WIN, F.lane); continue; } r -= N_WIN;
        if (r < N_WMG) { const int m = r / I_WMG; p0_transpose_item_f8<true>(in[5] + (size_t)m * 1024 * D_IN, 1024, N_F8, (unsigned char*)(F.ws + WS_WMG8) + (size_t)m * N_F8 * 1024, F8_WIN, scr, r % I_WMG, F.lane, D_IN, N_BF); continue; } r -= N_WMG;
        if (r < N_BA) { const int m = r / I_BA; p0_transpose_item<false>(in[11] + (size_t)m * 256 * 1024, 256, 1024, 1024, (bf16_t*)(F.ws + WS_WBR_T + m * 2 * MiB), scr, r % I_BA, F.lane, 1024); continue; } r -= N_BA;
        if (r < N_BA) { const int m = r / I_BA; p0_transpose_item<false>(in[12] + (size_t)m * 256 * 1024, 256, 1024, 1024, (bf16_t*)(F.ws + WS_WBR_T + m * 2 * MiB) + 256, scr, r % I_BA, F.lane, 1024); continue; } r -= N_BA;
        if (r < N_BC) { const int m = r / I_BC; p0_transpose_item<false>(in[13] + (size_t)m * 512 * 1024, 512, 1024, 1024, (bf16_t*)(F.ws + WS_WBR_T + m * 2 * MiB) + 512, scr, r % I_BC, F.lane, 1024); continue; } r -= N_BC;
        if (r < N_WO) { const int m = r / I_WO; p0_transpose_item<false>(in[14] + (size_t)m * 1024 * 1024, 1024, 1024, 1024, (bf16_t*)(F.ws + WS_WOUT_T) + (size_t)m * 1024 * 1024, scr, r % I_WO, F.lane); continue; } r -= N_WO;
        if (r < N_W1) { const int m = r / I_W1; p0_transpose_item<false>(in[7] + (size_t)m * 2048 * 256, 2048, 256, 256, (bf16_t*)(F.ws + WS_W1_T) + (size_t)m * 256 * 2048, scr, r % I_W1, F.lane); continue; } r -= N_W1;
        { const int m = r / I_W2; p0_transpose_item<false>(in[8] + (size_t)m * 256 * 64, 256, 64, 64, (bf16_t*)(F.ws + WS_W2_T) + (size_t)m * 64 * 256, scr, r % I_W2, F.lane); }
    }
    __syncthreads();
    if (blockIdx.x < 27) {
        LAS float* sc = (LAS float*)F.lds;
        for (int i = F.tid; i < 16 * 1024; i += 512) { const int b = i >> 10, k = i & 1023; const float v = in[1][i]; sc[k * 16 + b] = v * fsigmoid(v); }
        __syncthreads();
        if (F.gw < 192) {
            const int which = F.gw / 48, cb = F.gw % 48, layer = which >> 1, col = cb * 64 + F.lane;
            const float* W = (which & 1 ? in[17] : in[3]) + (size_t)layer * 1024 * 3072;
            const float* Bv = (which & 1 ? in[18] : in[4]) + (size_t)layer * 3072;
            float acc[16];
#pragma unroll
            for (int b = 0; b < 16; ++b) acc[b] = 0.f;
#pragma unroll 4
            for (int k = 0; k < 1024; ++k) { const float w = W[(size_t)k * 3072 + col];
                const f32x4 s0 = *(const LAS f32x4*)(sc + k * 16), s1 = *(const LAS f32x4*)(sc + k * 16 + 4), s2 = *(const LAS f32x4*)(sc + k * 16 + 8), s3 = *(const LAS f32x4*)(sc + k * 16 + 12);
#pragma unroll
                for (int q = 0; q < 4; ++q) { acc[q] += s0[q] * w; acc[4 + q] += s1[q] * w; acc[8 + q] += s2[q] * w; acc[12 + q] += s3[q] * w; } }
            float* mod = (float*)(F.ws + WS_MOD) + (size_t)which * 16 * 3072;
            const float bb = Bv[col];
#pragma unroll
            for (int b = 0; b < 16; ++b) mod[(size_t)b * 3072 + col] = acc[b] + bb;
        } else if (F.gw < 208) {
            const int u = F.gw - 192, m = u >> 2, n = (u & 3) * 64 + F.lane;
            const float* P = in[6] + (size_t)m * 2048; const float* W = in[7] + (size_t)m * 2048 * 256;
            float a = 0.f;
#pragma unroll 8
            for (int r = 0; r < 2048; ++r) a += P[r] * W[(size_t)r * 256 + n];
            ((float*)(F.ws + WS_BIAS1))[m * 256 + n] = a;
        } else if (F.gw == 208) {
            float* lut = (float*)(F.ws + WS_LUT);
            for (int i = F.lane; i < 12 * 128; i += 64) { const int h = i >> 7, d = i & 127; lut[i] = (in[2][kBucket[d] * 12 + h] - in[2][31 * 12 + h]) * LOG2E; }
            for (int l = 0; l < 2; ++l) { const float* dl = in[9] + l * 256;
                const float s1 = wave_sum(dl[F.lane] * dl[64 + F.lane], F.lane), s2 = wave_sum(dl[128 + F.lane] * dl[192 + F.lane], F.lane);
                const float lam_init = 0.8f - 0.6f * __expf(-0.3f * (float)l);
                if (F.lane == 0) ((float*)(F.ws + WS_LAM))[l] = __expf(s1) - __expf(s2) + lam_init; }
        }
    }
}

__device__ __forceinline__ void phase_h0(Frame& F, const float* X, const float* mod, bf16_t* HB, unsigned char* HB8) {
    for (int row = F.gw; row < NTOK; row += F.NGW) { const int b = row >> 12;
        const f32x4* xr = (const f32x4*)(X + (size_t)row * 1024) + F.lane; const f32x4* sh = (const f32x4*)(mod + (size_t)b * 3072) + F.lane; const f32x4* sc = (const f32x4*)(mod + (size_t)b * 3072 + 1024) + F.lane;
        u64* o8 = (u64*)(HB + (size_t)row * 1024) + F.lane; unsigned* q8 = (unsigned*)(HB8 + (size_t)row * 1024) + F.lane;
#pragma unroll
        for (int j = 0; j < 4; ++j) { const f32x4 v = xr[64 * j] * (sc[64 * j] + 1.0f) + sh[64 * j]; o8[64 * j] = (u64)pk2(v.x, v.y) | ((u64)pk2(v.z, v.w) << 32);
            q8[64 * j] = pk4_fp8(F8_H * v.x, F8_H * v.y, F8_H * v.z, F8_H * v.w); } }
}
__device__ __forceinline__ void ln_stats(const f32x4 (&v)[4], float& mean, float& rstd, int lane) {
    float s = 0.f;
#pragma unroll
    for (int j = 0; j < 4; ++j) s += (v[j].x + v[j].y) + (v[j].z + v[j].w);
    mean = wave_sum(s, lane) * (1.f / 1024.f); float s2 = 0.f;
#pragma unroll
    for (int j = 0; j < 4; ++j) { const f32x4 d = v[j] - mean; s2 += (d.x * d.x + d.y * d.y) + (d.z * d.z + d.w * d.w); }
    rstd = 1.f / sqrtf(wave_sum(s2, lane) * (1.f / 1024.f) + LN_EPS);
}

__device__ __forceinline__ void phase_ln1_router(Frame& F, bf16_t* Z, const float* g1, const float* b1, const float* mod, const float* rw, const float* rb, bf16_t* HB, unsigned* cnt) {
    LAS float* rwT = (LAS float*)F.lds;
    for (int i = F.tid; i < 32 * 1024; i += 512) { const int k = i >> 5, e = i & 31; rwT[e * 1024 + k] = rw[i]; }
    __syncthreads();
    const int lane = F.lane, e_l = lane >> 1;
    const float rbias = rb[e_l];
    unsigned slot0 = 0, slot1 = 0; unsigned cnt_local = 0;
    f32x4 gg[4], bb[4];
#pragma unroll
    for (int j = 0; j < 4; ++j) { gg[j] = ((const f32x4*)g1)[lane + 64 * j]; bb[j] = ((const f32x4*)b1)[lane + 64 * j]; }
    int it = 0;
    for (int row = F.gw; row < NTOK; row += F.NGW, ++it) { const int b = row >> 12;
        u32x2* zr = (u32x2*)(Z + (size_t)row * 1024) + lane; const f32x4* sh = (const f32x4*)(mod + (size_t)b * 3072) + lane; const f32x4* sc = (const f32x4*)(mod + (size_t)b * 3072 + 1024) + lane;
        f32x4 v[4];
#pragma unroll
        for (int j = 0; j < 4; ++j) { const u32x2 q = zr[64 * j]; v[j] = (f32x4){bflo(q.x), bfhi(q.x), bflo(q.y), bfhi(q.y)}; }
        float mean, rstd; ln_stats(v, mean, rstd, lane);
        u64* o8 = (u64*)(HB + (size_t)row * 1024) + lane;
        f32x4 h[4];
#pragma unroll
        for (int j = 0; j < 4; ++j) { const f32x4 xn = (v[j] - mean) * rstd * gg[j] + bb[j]; zr[64 * j] = (u32x2){cvt_pk_bf16(xn.x, xn.y), cvt_pk_bf16(xn.z, xn.w)}; h[j] = xn * (sc[64 * j] + 1.0f) + sh[64 * j];
            o8[64 * j] = (u64)pk2(h[j].x, h[j].y) | ((u64)pk2(h[j].z, h[j].w) << 32); }
        float a[32];
#pragma unroll
        for (int e = 0; e < 32; ++e) { float s = 0.f;
#pragma unroll
            for (int j = 0; j < 4; ++j) { const f32x4 w = *(const LAS f32x4*)(rwT + e * 1024 + 4 * lane + 256 * j); s += (h[j].x * w.x + h[j].y * w.y) + (h[j].z * w.z + h[j].w * w.w); }
            a[e] = s; if ((e & 3) == 3) __builtin_amdgcn_sched_barrier(0); }
#pragma unroll
        for (int st = 0; st < 5; ++st) { const int half = 16 >> st, x = 32 >> st; const bool up = (lane & x) != 0;
#pragma unroll
            for (int i = 0; i < half; ++i) { const float send = up ? a[i] : a[i + half], keep = up ? a[i + half] : a[i]; a[i] = keep + (st == 0 ? other32(send, lane) : shx_f(send, x, lane)); } }
        float lg = a[0] + shx_f(a[0], 1, lane) + rbias;
        float tv[4]; int te[4];
#pragma unroll
        for (int k = 0; k < 4; ++k) { float bv = lg; int be = e_l;
#pragma unroll
            for (int x = 2; x < 64; x <<= 1) { const float ov = shx_f(bv, x, lane); const int oe = shx_i(be, x, lane); if (ov > bv || (ov == bv && oe < be)) { bv = ov; be = oe; } }
            tv[k] = bv; te[k] = be; if (e_l == be) lg = -INFINITY; }
        const float e1 = __expf(tv[1] - tv[0]), e2 = __expf(tv[2] - tv[0]), e3 = __expf(tv[3] - tv[0]); const float inv = 1.f / (1.f + e1 + e2 + e3);
        if (lane == 0) { *(int4*)((int*)(F.ws + WS_TOKE) + (size_t)row * 4) = make_int4(te[0], te[1], te[2], te[3]);
            *(f32x4*)((float*)(F.ws + WS_TOKW) + (size_t)row * 4) = (f32x4){inv, e1 * inv, e2 * inv, e3 * inv}; }
#pragma unroll
        for (int k = 0; k < 4; ++k) { const int ek = __builtin_amdgcn_readfirstlane(te[k]); const unsigned rk = (unsigned)__builtin_amdgcn_readlane((int)cnt_local, ek);
            if (lane == ek) ++cnt_local;
            const int idx = it * 4 + k; const unsigned val = ((unsigned)ek << 16) | rk;
            if (lane == (idx & 63)) { if (idx < 64) slot0 = val; else slot1 = val; } }
    }
    unsigned base = 0;
    if (lane < 32) base = __hip_atomic_fetch_add(cnt + lane, cnt_local, __ATOMIC_RELAXED, __HIP_MEMORY_SCOPE_AGENT);
#pragma unroll
    for (int s = 0; s < 2; ++s) { const unsigned val = s ? slot1 : slot0; const int e = (int)(val >> 16); const unsigned pos = (unsigned)bperm_i(e, (int)base) + (val & 0xffffu);
        const int i = (64 * s + lane) >> 2, k = lane & 3; const int row = F.gw + i * F.NGW;
        if (i < it) ((int*)(F.ws + WS_TOKP))[(size_t)row * 4 + k] = (int)pos; }
    __syncthreads();
}

__device__ __forceinline__ void build_pstart(Frame& F, const unsigned* cnt) {
    if (F.tid == 0) { int p = 0; for (int e = 0; e < 32; ++e) { F.MISC[16 + e] = (unsigned)p; p += (int)((__hip_atomic_load(cnt + e, __ATOMIC_RELAXED, __HIP_MEMORY_SCOPE_AGENT) + 255u) >> 8); } F.MISC[48] = (unsigned)p; }
    __syncthreads();
}
__device__ __forceinline__ void phase_gather(Frame& F, const unsigned* cnt, const bf16_t* HB, unsigned char* HS) {
    build_pstart(F, cnt);
    for (int row = F.gw; row < NTOK; row += F.NGW) {
        const int4 te = *(const int4*)((const int*)(F.ws + WS_TOKE) + (size_t)row * 4), tp = *(const int4*)((const int*)(F.ws + WS_TOKP) + (size_t)row * 4);
        const int r0 = (int)F.MISC[16 + te.x] * 256 + tp.x, r1 = (int)F.MISC[16 + te.y] * 256 + tp.y, r2 = (int)F.MISC[16 + te.z] * 256 + tp.z, r3 = (int)F.MISC[16 + te.w] * 256 + tp.w;
        if (F.lane == 0) *(int4*)((int*)(F.ws + WS_TOKR) + (size_t)row * 4) = make_int4(r0, r1, r2, r3);
        const u32x4* src = (const u32x4*)(HB + (size_t)row * 1024) + 2 * F.lane; const u32x4 a = src[0], b = src[1];
        u32x4 v;
        v.x = pk4_fp8(F8_H * bflo(a.x), F8_H * bfhi(a.x), F8_H * bflo(a.y), F8_H * bfhi(a.y)); v.y = pk4_fp8(F8_H * bflo(a.z), F8_H * bfhi(a.z), F8_H * bflo(a.w), F8_H * bfhi(a.w));
        v.z = pk4_fp8(F8_H * bflo(b.x), F8_H * bfhi(b.x), F8_H * bflo(b.y), F8_H * bfhi(b.y)); v.w = pk4_fp8(F8_H * bflo(b.z), F8_H * bfhi(b.z), F8_H * bflo(b.w), F8_H * bfhi(b.w));
        ((u32x4*)(HS + (size_t)r0 * 1024))[F.lane] = v; ((u32x4*)(HS + (size_t)r1 * 1024))[F.lane] = v; ((u32x4*)(HS + (size_t)r2 * 1024))[F.lane] = v; ((u32x4*)(HS + (size_t)r3 * 1024))[F.lane] = v;
    }
    if (blockIdx.x < 32) { const int e = blockIdx.x; const int c = (int)__hip_atomic_load(cnt + e, __ATOMIC_RELAXED, __HIP_MEMORY_SCOPE_AGENT);
        const int rbeg = (int)F.MISC[16 + e] * 256 + c, rend = (int)F.MISC[17 + e] * 256;
        for (int r = rbeg + F.wave; r < rend; r += 8) ((u32x4*)(HS + (size_t)r * 1024))[F.lane] = (u32x4){0u, 0u, 0u, 0u}; }
}
__device__ __forceinline__ void phase_combine(Frame& F, const bf16_t* YS, const bf16_t* X1, const float* modf, const float* g2, const float* b2, float* XO, const float* modn, bf16_t* HB, unsigned char* HB8, bf16_t* X2B) {
    const int lane = F.lane;
    f32x4 gg[4], bb[4];
#pragma unroll
    for (int q = 0; q < 4; ++q) { gg[q] = ((const f32x4*)g2)[128 * (q >> 1) + 2 * lane + (q & 1)]; bb[q] = ((const f32x4*)b2)[128 * (q >> 1) + 2 * lane + (q & 1)]; }
    for (int row = F.gw; row < NTOK; row += F.NGW) { const int b = row >> 12;
        const int4 tr = *(const int4*)((const int*)(F.ws + WS_TOKR) + (size_t)row * 4); const f32x4 tw = *(const f32x4*)((const float*)(F.ws + WS_TOKW) + (size_t)row * 4);
        const int rr[4] = {tr.x, tr.y, tr.z, tr.w}; const float ww[4] = {tw.x, tw.y, tw.z, tw.w};
        u32x4 yq[4][2];
#pragma unroll
        for (int k = 0; k < 4; ++k)
#pragma unroll
            for (int c = 0; c < 2; ++c) yq[k][c] = ((const u32x4*)(YS + (size_t)rr[k] * 1024))[64 * c + lane];
        u32x4 xq[2];
#pragma unroll
        for (int c = 0; c < 2; ++c) xq[c] = ((const u32x4*)(X1 + (size_t)row * 1024))[64 * c + lane];
        const f32x4* gt = (const f32x4*)(modf + (size_t)b * 3072 + 2048);
        f32x4 v[4];
#pragma unroll
        for (int c = 0; c < 2; ++c) { f32x4 y0 = (f32x4){0.f, 0.f, 0.f, 0.f}, y1 = y0;
#pragma unroll
            for (int k = 0; k < 4; ++k) { const u32x4 w = yq[k][c]; y0 += (f32x4){bflo(w.x), bfhi(w.x), bflo(w.y), bfhi(w.y)} * ww[k]; y1 += (f32x4){bflo(w.z), bfhi(w.z), bflo(w.w), bfhi(w.w)} * ww[k]; }
            const u32x4 q = xq[c];
            v[2 * c] = (f32x4){bflo(q.x), bfhi(q.x), bflo(q.y), bfhi(q.y)} * DN_ALPHA + (gt[128 * c + 2 * lane] + 1.0f) * y0;
            v[2 * c + 1] = (f32x4){bflo(q.z), bfhi(q.z), bflo(q.w), bfhi(q.w)} * DN_ALPHA + (gt[128 * c + 2 * lane + 1] + 1.0f) * y1; }
        float mean, rstd; ln_stats(v, mean, rstd, lane);
        if (modn) { const f32x4* sh = (const f32x4*)(modn + (size_t)b * 3072); const f32x4* sc = (const f32x4*)(modn + (size_t)b * 3072 + 1024);
#pragma unroll
            for (int c = 0; c < 2; ++c) { const f32x4 x0 = (v[2 * c] - mean) * rstd * gg[2 * c] + bb[2 * c], x1 = (v[2 * c + 1] - mean) * rstd * gg[2 * c + 1] + bb[2 * c + 1];
                ((u32x4*)(X2B + (size_t)row * 1024))[64 * c + lane] = (u32x4){cvt_pk_bf16(x0.x, x0.y), cvt_pk_bf16(x0.z, x0.w), cvt_pk_bf16(x1.x, x1.y), cvt_pk_bf16(x1.z, x1.w)};
                const f32x4 h0 = x0 * (sc[128 * c + 2 * lane] + 1.0f) + sh[128 * c + 2 * lane], h1 = x1 * (sc[128 * c + 2 * lane + 1] + 1.0f) + sh[128 * c + 2 * lane + 1];
                ((u32x4*)(HB + (size_t)row * 1024))[64 * c + lane] = (u32x4){cvt_pk_bf16(h0.x, h0.y), cvt_pk_bf16(h0.z, h0.w), cvt_pk_bf16(h1.x, h1.y), cvt_pk_bf16(h1.z, h1.w)};
                ((u32x2*)(HB8 + (size_t)row * 1024))[64 * c + lane] = (u32x2){pk4_fp8(F8_H * h0.x, F8_H * h0.y, F8_H * h0.z, F8_H * h0.w), pk4_fp8(F8_H * h1.x, F8_H * h1.y, F8_H * h1.z, F8_H * h1.w)}; }
        } else {
#pragma unroll
            for (int q = 0; q < 4; ++q) ((f32x4*)(XO + (size_t)row * 1024))[128 * (q >> 1) + 2 * lane + (q & 1)] = (v[q] - mean) * rstd * gg[q] + bb[q];
        }
    }
}

__device__ __forceinline__ unsigned okey24(float v) { if (v == 0.f) v = 0.f; unsigned u = __builtin_bit_cast(unsigned, v); u = (u & 0x80000000u) ? ~u : (u | 0x80000000u); return u >> 8; }
__device__ __forceinline__ f32x4 idx_score(const bf16x8 ka, const bf16x8 (&qb)[4], const float (&w4)[4]) {
    f32x4 s = (f32x4){0.f, 0.f, 0.f, 0.f};
#pragma unroll
    for (int h = 0; h < 4; ++h) { const f32x4 c = __builtin_amdgcn_mfma_f32_16x16x32_bf16(ka, qb[h], (f32x4){0.f, 0.f, 0.f, 0.f}, 0, 0, 0);
#pragma unroll
        for (int j = 0; j < 4; ++j) s[j] += w4[h] * fmaxf(c[j], 0.f); }
    return s;
}
__device__ __forceinline__ void scan_row(const volatile LAS unsigned* hw, unsigned need, int lane, int& bin, unsigned& above, unsigned& cntb) {
    unsigned s = 0;
#pragma unroll 8
    for (int i = 0; i < 32; ++i) { const unsigned wv = hw[32 * lane + ((i + lane) & 31)]; s += (wv & 0xffffu) + (wv >> 16); }
    unsigned S = s;
#pragma unroll
    for (int o = 1; o < 64; o <<= 1) { const unsigned t = (unsigned)bperm_i((lane + o) & 63, (int)S); if (lane + o < 64) S += t; }
    const u64 bal = __ballot(S >= need);
    const int L = bal ? 63 - __clzll((long long)bal) : 0;
    const unsigned Snext = (unsigned)bperm_i((L + 1) & 63, (int)S);
    const unsigned aboveL = (L < 63) ? Snext : 0u;
    const int bi = 63 - lane; const unsigned wv = hw[32 * L + (bi >> 1)]; const unsigned c = (bi & 1) ? (wv >> 16) : (wv & 0xffffu);
    unsigned Pj = c;
#pragma unroll
    for (int o = 1; o < 64; o <<= 1) { const unsigned t = (unsigned)bperm_i((lane - o) & 63, (int)Pj); if (lane >= o) Pj += t; }
    Pj += aboveL;
    const u64 hit = __ballot(Pj >= need);
    const int js = hit ? __ffsll((long long)hit) - 1 : 63;
    bin = 64 * L + 63 - js; cntb = (unsigned)bperm_i(js, (int)c); above = (unsigned)bperm_i(js, (int)Pj) - cntb;
}
template <int PASS>
__device__ __forceinline__ void dsa_pass(Frame& F, const bf16_t* kbase, unsigned* KS, const bf16x8 (&qb)[4], const float (&w4)[4], int nkt, int tq, unsigned r_a, unsigned r_b) {
    const int lane = F.lane, fr = lane & 15, fq = lane >> 4;
    LAS unsigned* hist = (LAS unsigned*)F.lds;
    const int kt0 = F.wave; if (kt0 >= nkt) return;
    u32x4* ksl = (u32x4*)KS + lane;
    u32x4 kc[4], kn[4];
#pragma unroll
    for (int u = 0; u < 4; ++u) { kc[u] = (u32x4){0u, 0u, 0u, 0u}; if (kt0 + 8 * u < nkt) kc[u] = (PASS == 1) ? __builtin_bit_cast(u32x4, *(const bf16x8*)(kbase + (size_t)(kt0 + 8 * u) * 16 * DP)) : ksl[(size_t)(kt0 + 8 * u) * 64]; }
    for (int kg = kt0; kg < nkt; kg += 32) {
#pragma unroll
        for (int u = 0; u < 4; ++u) { kn[u] = kc[u]; if (kg + 32 + 8 * u < nkt) kn[u] = (PASS == 1) ? __builtin_bit_cast(u32x4, *(const bf16x8*)(kbase + (size_t)(kg + 32 + 8 * u) * 16 * DP)) : ksl[(size_t)(kg + 32 + 8 * u) * 64]; }
#pragma unroll
        for (int u = 0; u < 4; ++u) { const int kt = kg + 8 * u;
            if (kt < nkt) {
                unsigned kk[4];
                if (PASS == 1) { const f32x4 sc = idx_score(__builtin_bit_cast(bf16x8, kc[u]), qb, w4);
#pragma unroll
                    for (int j = 0; j < 4; ++j) { const int s = kt * 16 + 4 * fq + j; kk[j] = okey24(sc[j]) | ((s <= tq) ? 0x80000000u : 0u); }
                    ksl[(size_t)kt * 64] = (u32x4){kk[0], kk[1], kk[2], kk[3]};
                } else { kk[0] = kc[u].x; kk[1] = kc[u].y; kk[2] = kc[u].z; kk[3] = kc[u].w; }
                unsigned nd = 0, nt_ = 0;
#pragma unroll
                for (int j = 0; j < 4; ++j) { const bool valid = (kk[j] >> 31) != 0u; const unsigned key = kk[j] & 0xffffffu;
                    if (PASS == 1) { if (valid) { const unsigned bin = key >> 12; __hip_atomic_fetch_add(hist + fr * 2048 + (bin >> 1), 1u << (16 * (bin & 1)), __ATOMIC_RELAXED, __HIP_MEMORY_SCOPE_WORKGROUP); } }
                    if (PASS == 2) { if (valid && (key >> 12) == r_a) { const unsigned bin = key & 4095u; __hip_atomic_fetch_add(hist + fr * 2048 + (bin >> 1), 1u << (16 * (bin & 1)), __ATOMIC_RELAXED, __HIP_MEMORY_SCOPE_WORKGROUP); } }
                    if (PASS == 3) { if (valid) { if (DSA_FAKE) nd |= 1u << j; else { nd |= (key > r_a ? 1u : 0u) << j; nt_ |= (key == r_a ? 1u : 0u) << j; } } } }
                if (PASS == 3) { const int sh = 16 * (kt & 1) + 4 * fq; const int wd = fr * 128 + (kt >> 1);
                    if (nd) __hip_atomic_fetch_or(hist + wd, nd << sh, __ATOMIC_RELAXED, __HIP_MEMORY_SCOPE_WORKGROUP);
                    if (nt_) __hip_atomic_fetch_or(hist + 2048 + wd, nt_ << sh, __ATOMIC_RELAXED, __HIP_MEMORY_SCOPE_WORKGROUP); }
            } }
#pragma unroll
        for (int u = 0; u < 4; ++u) kc[u] = kn[u];
    }
}
__device__ __forceinline__ void lds_zero(Frame& F, int bytes) {
    LAS u32x4* p = (LAS u32x4*)F.lds; unsigned z = 0u; asm volatile("" : "+v"(z));
    for (int i = F.tid; i < bytes / 16; i += 512) p[i] = (u32x4){z, z, z, z};
}
__device__ __forceinline__ void dsa_select_tile(Frame& F, const bf16_t* P, u64* BM, unsigned* KS, int b, int qt) {
    volatile LAS unsigned* rinfo = F.MISC + 64;
    volatile LAS unsigned* hist = (volatile LAS unsigned*)F.lds;
    const int lane = F.lane, fr = lane & 15, fq = lane >> 4, w = F.wave;
    const int t0 = qt * 16, nkt = qt + 1; const size_t rowbase = (size_t)b * 4096;
    const bf16_t* qrow = P + (rowbase + t0 + fr) * DP;
    bf16x8 qb[4];
#pragma unroll
    for (int h = 0; h < 4; ++h) qb[h] = *(const bf16x8*)(qrow + C_IQ + h * 32 + 8 * fq);
    const u32x2 iwp = *(const u32x2*)(qrow + C_IW); const float w4[4] = {bflo(iwp.x), bfhi(iwp.x), bflo(iwp.y), bfhi(iwp.y)};
    const bf16_t* kbase = P + (rowbase + fr) * DP + C_IK + 8 * fq;
    const int tq = t0 + fr;
    if (qt >= 16 && !DSA_FAKE) {
        lds_zero(F, 131072); __syncthreads();
        dsa_pass<1>(F, kbase, KS, qb, w4, nkt, tq, 0u, 0u);
        __syncthreads();
#pragma unroll 1
        for (int rr = 0; rr < 2; ++rr) { const int r = 2 * w + rr; int bin; unsigned above, cb; scan_row(hist + r * 2048, 256u, lane, bin, above, cb);
            if (lane == 0) { rinfo[r * 4 + 0] = (unsigned)bin; rinfo[r * 4 + 1] = 256u - above; } }
        __syncthreads();
        lds_zero(F, 131072); __syncthreads();
        dsa_pass<2>(F, kbase, KS, qb, w4, nkt, tq, rinfo[fr * 4 + 0], 0u);
        __syncthreads();
#pragma unroll 1
        for (int rr = 0; rr < 2; ++rr) { const int r = 2 * w + rr; const unsigned b1 = rinfo[r * 4 + 0], rem1 = rinfo[r * 4 + 1]; int bin; unsigned above, cb; scan_row(hist + r * 2048, rem1, lane, bin, above, cb);
            if (lane == 0) { const unsigned take = rem1 - above; rinfo[r * 4 + 0] = (b1 << 12) | (unsigned)bin; rinfo[r * 4 + 1] = take; rinfo[r * 4 + 2] = (cb > take) ? 1u : 0u; } }
        __syncthreads();
    } else {
        if (F.tid < 16) { rinfo[F.tid * 4 + 0] = 0u; rinfo[F.tid * 4 + 1] = 0xffffffffu; rinfo[F.tid * 4 + 2] = 0u; }
        dsa_pass<1>(F, kbase, KS, qb, w4, nkt, tq, 0u, 0u);
        __syncthreads();
    }
    lds_zero(F, 16384); __syncthreads();
    dsa_pass<3>(F, kbase, KS, qb, w4, nkt, tq, rinfo[fr * 4 + 0], 0u);
    __syncthreads();
    volatile LAS u64* FIN = (volatile LAS u64*)(F.lds + 16384);
#pragma unroll 1
    for (int rr = 0; rr < 2; ++rr) { const int r = 2 * w + rr;
        const u64 def = (u64)hist[r * 128 + 2 * lane] | ((u64)hist[r * 128 + 2 * lane + 1] << 32);
        u64 tie = (u64)hist[2048 + r * 128 + 2 * lane] | ((u64)hist[2048 + r * 128 + 2 * lane + 1] << 32);
        if (rinfo[r * 4 + 2]) { const int take = (int)rinfo[r * 4 + 1]; const int c = __popcll(tie); int inc = c;
#pragma unroll
            for (int o = 1; o < 64; o <<= 1) { const int t = bperm_i((lane - o) & 63, inc); if (lane >= o) inc += t; }
            int tk = take - (inc - c); tk = tk < 0 ? 0 : (tk > c ? c : tk);
            while (__popcll(tie) > tk) tie &= ~(1ull << (63 - __clzll((long long)tie))); }
        FIN[lane * 16 + r] = def | tie; }
    __syncthreads();
#pragma unroll
    for (int k = 0; k < 2; ++k) { const int idx = F.tid + 512 * k, l = idx >> 4, r = idx & 15;
        if (l <= (t0 >> 6)) BM[((size_t)(b * 64 + l) * 4096) + t0 + r] = FIN[l * 16 + r]; }
    __builtin_amdgcn_fence(__ATOMIC_ACQUIRE, "agent");
    __syncthreads();
}

#define MFMA32(a, b, c) __builtin_amdgcn_mfma_f32_32x32x16_bf16(a, b, c, 0, 0, 0)
typedef short v4i16_t __attribute__((ext_vector_type(4)));
__device__ __forceinline__ s16x4 vtr(const LAS unsigned char* p) { return __builtin_bit_cast(s16x4, __builtin_amdgcn_ds_read_tr16_b64_v4i16((LAS v4i16_t*)p)); }
constexpr int AT_KBUF = 0, AT_VBUF = 16384, AT_WSF = 49152, AT_LUT = 51200, AT_IMP = 57344, AT_RMASK = 124928, AT_WOR = 125440;
enum { MK_C = 0, MK_A = 1, MK_WIN = 2, MK_SLC = 3, MK_CMP = 4 };
constexpr float ATT_THR = 8.f;

template <int VD> struct AState { f32x16 o[VD / 32]; float m, l; };
template <int VD> __device__ __forceinline__ void astate_init(AState<VD>& s) {
#pragma unroll
    for (int d = 0; d < VD / 32; ++d)
#pragma unroll
        for (int r = 0; r < 16; ++r) s.o[d][r] = 0.f;
    s.m = -1e30f; s.l = 0.f;
}
template <int VD>
__device__ __forceinline__ void stage_kv(LAS unsigned char* kbuf, LAS unsigned char* vbuf, const bf16_t* Kt, int ldk, const bf16_t* Vt, int ldv, int wave, int lane, bool with_v) {
    __builtin_amdgcn_global_load_lds((const unsigned*)(Kt + (size_t)lane * ldk + wave * 8), (LAS unsigned*)(kbuf + wave * 1024), 16, 0, 0);
    if (with_v) {
#pragma unroll
        for (int pc0 = 0; pc0 < VD / 8; pc0 += 8) { const int pc = pc0 + wave;
            __builtin_amdgcn_global_load_lds((const unsigned*)(Vt + (size_t)(16 * (pc & 3) + (lane >> 2)) * ldv + (pc >> 2) * 32 + (lane & 3) * 8), (LAS unsigned*)(vbuf + pc * 1024), 16, 0, 0); }
    }
}
__device__ __forceinline__ void qk_tile(f32x16& S0, f32x16& S1, const bf16x8 (&qr)[4], const LAS unsigned char* kbuf, int r32, int hi) {
    const LAS unsigned char* kp = kbuf + hi * 1024 + r32 * 16;
#pragma unroll
    for (int r = 0; r < 16; ++r) { S0[r] = 0.f; S1[r] = 0.f; }
#pragma unroll
    for (int g = 0; g < 2; ++g) {
        bf16x8 kf[4];
#pragma unroll
        for (int d = 0; d < 2; ++d) { kf[2 * d] = *(const LAS bf16x8*)(kp + (2 * g + d) * 2048); kf[2 * d + 1] = *(const LAS bf16x8*)(kp + (2 * g + d) * 2048 + 512); }
#pragma unroll
        for (int d = 0; d < 2; ++d) { S0 = MFMA32(kf[2 * d], qr[2 * g + d], S0); S1 = MFMA32(kf[2 * d + 1], qr[2 * g + d], S1); }
        if (PROBE_ATT == 2) { f32x16 D0, D1;
#pragma unroll
            for (int r = 0; r < 16; ++r) { D0[r] = 0.f; D1[r] = 0.f; }
#pragma unroll
            for (int d = 0; d < 2; ++d) { D0 = MFMA32(kf[2 * d], qr[2 * g + d], D0); D1 = MFMA32(kf[2 * d + 1], qr[2 * g + d], D1); }
            asm volatile("" :: "v"(D0[0] + D1[0])); }
    }
}
template <int MODE>
__device__ __forceinline__ void apply_mask(f32x16& S0, f32x16& S1, int tq, int key0, int hi, bool near, const LAS float* lut, u64 bits, int aux) {
    const unsigned blo = (unsigned)bits >> (4 * hi), bhi = (unsigned)(bits >> 32) >> (4 * hi);
#pragma unroll
    for (int n = 0; n < 2; ++n)
#pragma unroll
        for (int r = 0; r < 16; ++r) { const int kk0 = (r & 3) + 8 * (r >> 2); const int kk = kk0 + 4 * hi + 32 * n; const int dist = tq - (key0 + kk);
            bool valid;
            if (MODE == MK_C) valid = dist >= 0;
            else if (MODE == MK_A) valid = true;
            else if (MODE == MK_WIN) valid = dist >= 0 && dist < 512;
            else if (MODE == MK_SLC) valid = (aux != 0) && dist >= 0;
            else valid = (key0 + kk) < aux;
            float s = n ? S1[r] : S0[r];
            if (MODE != MK_CMP && near) { const int dc = dist < 0 ? 0 : (dist > 127 ? 127 : dist); s += lut[dc]; }
            if (MODE == MK_A) { const int mk = __builtin_amdgcn_sbfe((int)(n ? bhi : blo), kk0, 1);
                unsigned sb; asm("v_bfi_b32 %0, %1, %2, %3" : "=v"(sb) : "v"(mk), "v"(__builtin_bit_cast(unsigned, s)), "v"(0xff800000u)); s = __builtin_bit_cast(float, sb); }
            else s = valid ? s : -INFINITY;
            if (n) S1[r] = s; else S0[r] = s; }
}
__device__ __forceinline__ float vmax3(float a, float b, float c) { float r; asm("v_max3_f32 %0, %1, %2, %3" : "=v"(r) : "v"(a), "v"(b), "v"(c)); return r; }
__device__ __forceinline__ float vmax2(float a, float b) { float r; asm("v_max_f32 %0, %1, %2" : "=v"(r) : "v"(a), "v"(b)); return r; }
__device__ __forceinline__ float row_max32(const f32x16& S0, const f32x16& S1, int lane) {
    float a = vmax3(S0[0], S0[1], S1[0]), b = vmax3(S0[2], S0[3], S1[1]); a = vmax3(a, S1[2], S1[3]);
#pragma unroll
    for (int r = 4; r < 16; r += 4) { a = vmax3(a, S0[r], S0[r + 1]); b = vmax3(b, S0[r + 2], S0[r + 3]); a = vmax3(a, S1[r], S1[r + 1]); b = vmax3(b, S1[r + 2], S1[r + 3]); }
    return vmax2(a, b);
}
__device__ __forceinline__ void v_load2(bf16x8 (&vf)[2][4], const LAS unsigned char* vbuf, int db0, int lane) {
    const int hi = lane >> 5;
    const LAS unsigned char* vp = vbuf + ((lane >> 4) & 1) * 32 + (lane & 3) * 8 + (4 * hi + ((lane & 15) >> 2)) * 64 + db0 * 4096;
#pragma unroll
    for (int d = 0; d < 2; ++d)
#pragma unroll
        for (int ks = 0; ks < 4; ++ks) { const s16x4 lo = vtr(vp + d * 4096 + ks * 1024), hh = vtr(vp + d * 4096 + ks * 1024 + 512);
            vf[d][ks] = (bf16x8){lo[0], lo[1], lo[2], lo[3], hh[0], hh[1], hh[2], hh[3]}; }
}
__device__ __forceinline__ void p_pack(bf16x8 (&pa)[4], const f32x16& S0, const f32x16& S1) {
#pragma unroll
    for (int ks = 0; ks < 4; ++ks) { u32x4 w;
        if (ks == 0) { w.x = cvt_pk_bf16(S0[0], S0[1]); w.y = cvt_pk_bf16(S0[2], S0[3]); w.z = cvt_pk_bf16(S0[4], S0[5]); w.w = cvt_pk_bf16(S0[6], S0[7]); }
        else if (ks == 1) { w.x = cvt_pk_bf16(S0[8], S0[9]); w.y = cvt_pk_bf16(S0[10], S0[11]); w.z = cvt_pk_bf16(S0[12], S0[13]); w.w = cvt_pk_bf16(S0[14], S0[15]); }
        else if (ks == 2) { w.x = cvt_pk_bf16(S1[0], S1[1]); w.y = cvt_pk_bf16(S1[2], S1[3]); w.z = cvt_pk_bf16(S1[4], S1[5]); w.w = cvt_pk_bf16(S1[6], S1[7]); }
        else { w.x = cvt_pk_bf16(S1[8], S1[9]); w.y = cvt_pk_bf16(S1[10], S1[11]); w.z = cvt_pk_bf16(S1[12], S1[13]); w.w = cvt_pk_bf16(S1[14], S1[15]); }
        pa[ks] = __builtin_bit_cast(bf16x8, w); }
}
template <int VD>
__device__ __forceinline__ void pv_tile(f32x16 (&o)[VD / 32], const f32x16& S0, const f32x16& S1, const bf16x8 (&vf01)[2][4], const LAS unsigned char* vbuf, int lane) {
    bf16x8 pa[4]; p_pack(pa, S0, S1);
    if (VD == 128) {
        bf16x8 va[4], vb[4];
        const int hi = lane >> 5;
        const LAS unsigned char* vp = vbuf + ((lane >> 4) & 1) * 32 + (lane & 3) * 8 + (4 * hi + ((lane & 15) >> 2)) * 64;
#pragma unroll
        for (int ks = 0; ks < 4; ++ks) { const s16x4 lo = vtr(vp + 2 * 4096 + ks * 1024), hh = vtr(vp + 2 * 4096 + ks * 1024 + 512); va[ks] = (bf16x8){lo[0], lo[1], lo[2], lo[3], hh[0], hh[1], hh[2], hh[3]}; }
#pragma unroll
        for (int ks = 0; ks < 4; ++ks) { const s16x4 lo = vtr(vp + 3 * 4096 + ks * 1024), hh = vtr(vp + 3 * 4096 + ks * 1024 + 512); vb[ks] = (bf16x8){lo[0], lo[1], lo[2], lo[3], hh[0], hh[1], hh[2], hh[3]}; }
#pragma unroll
        for (int ks = 0; ks < 4; ++ks) { o[0] = MFMA32(pa[ks], vf01[0][ks], o[0]); o[1] = MFMA32(pa[ks], vf01[1][ks], o[1]); }
        __builtin_amdgcn_sched_barrier(0);
#pragma unroll
        for (int ks = 0; ks < 4; ++ks) { o[(VD == 128) ? 2 : 0] = MFMA32(pa[ks], va[ks], o[(VD == 128) ? 2 : 0]); o[(VD == 128) ? 3 : 0] = MFMA32(pa[ks], vb[ks], o[(VD == 128) ? 3 : 0]); }
    } else {
#pragma unroll
        for (int ks = 0; ks < 4; ++ks)
#pragma unroll
            for (int d = 0; d < 2; ++d) o[d] = MFMA32(pa[ks], vf01[d][ks], o[d]);
    }
}
template <int ND>
__device__ __forceinline__ void scale_rows(f32x16 (&o)[ND], float f, LAS float* wsf, int lane) {
    const int hi = lane >> 5;
    wsf[lane & 31] = f;
#pragma unroll
    for (int g = 0; g < 4; ++g) { const f32x4 a = *(const LAS f32x4*)(wsf + 8 * g + 4 * hi);
#pragma unroll
        for (int d = 0; d < ND; ++d)
#pragma unroll
            for (int i = 0; i < 4; ++i) o[d][4 * g + i] *= a[i]; }
}
template <int VD, bool PV>
__device__ __forceinline__ void softmax_step(AState<VD>& st, f32x16& S0, f32x16& S1, const LAS unsigned char* vbuf, LAS float* wsf, int lane) {
    bf16x8 vf01[2][4];
    if (PV) { v_load2(vf01, vbuf, 0, lane); __builtin_amdgcn_sched_barrier(0); }
    const float mx = row_max32(S0, S1, lane);
    if (__any(mx - st.m > ATT_THR)) { const float mnew = vmax2(st.m, vmax2(mx, bperm_f(lane ^ 32, mx))); const float alpha = fexp2(st.m - mnew); st.l *= alpha; st.m = mnew;
        if (PV) scale_rows<VD / 32>(st.o, alpha, wsf, lane); }
    float sum = 0.f;
#pragma unroll
    for (int r = 0; r < 16; ++r) { S0[r] = fexp2(S0[r] - st.m); S1[r] = fexp2(S1[r] - st.m); }
#pragma unroll
    for (int r = 0; r < 16; ++r) sum += S0[r];
#pragma unroll
    for (int r = 0; r < 16; ++r) sum += S1[r];
    st.l += sum;
    if (PROBE_ATT == 1) { float dm = 0.f;
#pragma unroll
        for (int r = 0; r < 16; ++r) { float t0 = S0[r], t1 = S1[r]; asm volatile("" : "+v"(t0), "+v"(t1)); dm += fexp2(t0 - st.m) + fexp2(t1 - st.m); }
        asm volatile("" :: "v"(dm)); }
    if (PV) pv_tile<VD>(st.o, S0, S1, vf01, vbuf, lane);
}
template <int ND>
__device__ __forceinline__ void finish_add(f32x16 (&acc)[ND], const f32x16 (&o)[ND], float l, float gate, LAS float* wsf, int lane) {
    const int hi = lane >> 5;
    const float lt = sum32(l, lane); const float f = lt > 0.f ? gate / lt : 0.f;
    wsf[lane & 31] = f;
#pragma unroll
    for (int g = 0; g < 4; ++g) { const f32x4 a = *(const LAS f32x4*)(wsf + 8 * g + 4 * hi);
#pragma unroll
        for (int d = 0; d < ND; ++d)
#pragma unroll
            for (int i = 0; i < 4; ++i) acc[d][4 * g + i] += o[d][4 * g + i] * a[i]; }
}

__device__ __forceinline__ int crow(int r, int hi) { return (r & 3) + 8 * (r >> 2) + 4 * hi; }

__device__ __forceinline__ void unit_C(Frame& F, const bf16_t* P, bf16_t* OC, const float* gnorm, float lam, float lam_init, int b, int h, int qb) {
    const int lane = F.lane, r32 = lane & 31, hi = lane >> 5, w = F.wave;
    LAS unsigned char* lds = F.lds; LAS float* wsf = (LAS float*)(lds + AT_WSF) + w * 64; const LAS float* lut = (const LAS float*)(lds + AT_LUT) + (8 + h) * 128;
    const int q0 = qb * 256, tw0 = q0 + 32 * w, tq = tw0 + r32; const size_t rowbase = (size_t)b * 4096;
    const int NT = 4 * qb + 4, my_last = (tw0 + 31) >> 6;
    LAS unsigned* kpl = (LAS unsigned*)(lds + AT_IMP) + w * 2048 + lane;
    AState<128> st;
#pragma unroll 1
    for (int j = 0; j < 2; ++j) {
        const bf16_t* Qp = P + (rowbase + tq) * DP + C_CQ + h * 128 + j * 64;
        bf16x8 qr[4];
#pragma unroll
        for (int d0 = 0; d0 < 4; ++d0) qr[d0] = *(const bf16x8*)(Qp + d0 * 16 + hi * 8);
        const bf16_t* Kb = P + rowbase * DP + C_CK + h * 128 + j * 64; const bf16_t* Vb = P + rowbase * DP + C_CV + h * 128;
        astate_init(st);
        stage_kv<128>(lds + AT_KBUF, lds + AT_VBUF, Kb, DP, Vb, DP, w, lane, true);
#pragma unroll 1
        for (int kt = 0; kt < NT; ++kt) {
            VM_WAIT(); __syncthreads();
            const int cb = kt & 1;
            if (kt + 1 < NT) stage_kv<128>(lds + AT_KBUF + (cb ^ 1) * 8192, lds + AT_VBUF + (cb ^ 1) * 16384, Kb + (size_t)(kt + 1) * 64 * DP, DP, Vb + (size_t)(kt + 1) * 64 * DP, DP, w, lane, true);
            if (kt <= my_last) {
                f32x16 S0, S1; qk_tile(S0, S1, qr, lds + AT_KBUF + cb * 8192, r32, hi);
                const int key0 = kt * 64; const bool near = (tw0 - (key0 + 63)) < 113;
                if (near) apply_mask<MK_C>(S0, S1, tq, key0, hi, true, lut, 0ull, 0);
                softmax_step<128, true>(st, S0, S1, lds + AT_VBUF + cb * 16384, wsf, lane);
            }
        }
        __syncthreads();
        const float lt = sum32(st.l, lane);
        if (j == 0) { scale_rows<4>(st.o, 1.f / lt, wsf, lane);
#pragma unroll
            for (int d = 0; d < 4; ++d)
#pragma unroll
                for (int r = 0; r < 8; ++r) kpl[(d * 8 + r) * 64] = cvt_pk_bf16(st.o[d][2 * r], st.o[d][2 * r + 1]);
        } else { scale_rows<4>(st.o, -lam / lt, wsf, lane);
#pragma unroll
            for (int d = 0; d < 4; ++d)
#pragma unroll
                for (int r = 0; r < 8; ++r) { const unsigned kw = kpl[(d * 8 + r) * 64]; st.o[d][2 * r] += bflo(kw); st.o[d][2 * r + 1] += bfhi(kw); } }
    }
    f32x16 (&keep)[4] = st.o;
    float gch[4];
#pragma unroll
    for (int d = 0; d < 4; ++d) gch[d] = gnorm[32 * d + r32] * (1.f - lam_init);
    GAS bf16_t* orow = (GAS bf16_t*)OC + (rowbase + tw0) * 1024 + 512 + h * 128 + r32; asm volatile("" : "+v"(orow)); int hs = hi; asm volatile("" : "+v"(hs));
#pragma unroll
    for (int r = 0; r < 16; ++r) { float ss = keep[0][r] * keep[0][r] + keep[1][r] * keep[1][r] + keep[2][r] * keep[2][r] + keep[3][r] * keep[3][r];
        ss += shx_f(ss, 1, lane); ss += shx_f(ss, 2, lane); ss += shx_f(ss, 4, lane); ss += shx_f(ss, 8, lane); ss += shx_f(ss, 16, lane);
        const float sc = 1.f / sqrtf(ss * (1.f / 128.f) + LN_EPS);
#pragma unroll
        for (int d = 0; d < 4; ++d) orow[crow(r, hs) * 1024 + 32 * d] = (bf16_t)f2bf(keep[d][r] * sc * gch[d]); }
}

__device__ __forceinline__ void unit_A(Frame& F, const bf16_t* P, const u64* BM, bf16_t* OC, int b, int qi) {
    const int lane = F.lane, r32 = lane & 31, hi = lane >> 5, w = F.wave, h = w & 3, rg = w >> 2;
    LAS unsigned char* lds = F.lds; LAS float* wsf = (LAS float*)(lds + AT_WSF) + w * 64; const LAS float* lut = (const LAS float*)(lds + AT_LUT) + h * 128;
    const int q0 = qi * 64, tw0 = q0 + 32 * rg, tq = tw0 + r32; const size_t rowbase = (size_t)b * 4096;
    const int NT = qi + 1;
    const bf16_t* Qp = P + (rowbase + tq) * DP + C_AQ + h * 64;
    bf16x8 qr[4];
#pragma unroll
    for (int d0 = 0; d0 < 4; ++d0) qr[d0] = *(const bf16x8*)(Qp + d0 * 16 + hi * 8);
    const bf16_t* Kb = P + rowbase * DP + C_AK; const bf16_t* Vb = P + rowbase * DP + C_AV;
    const u64* bmp = BM + (size_t)b * 64 * 4096 + tq;
    u64 bits = bmp[0];
    AState<64> st; astate_init(st);
    stage_kv<64>(lds + AT_KBUF, lds + AT_VBUF, Kb, DP, Vb, DP, w, lane, true);
#pragma unroll 1
    for (int kt = 0; kt < NT; ++kt) {
        VM_WAIT(); __syncthreads();
        const int cb = kt & 1;
        u64 nbits = 0ull;
        if (kt + 1 < NT) { stage_kv<64>(lds + AT_KBUF + (cb ^ 1) * 8192, lds + AT_VBUF + (cb ^ 1) * 16384, Kb + (size_t)(kt + 1) * 64 * DP, DP, Vb + (size_t)(kt + 1) * 64 * DP, DP, w, lane, true);
            nbits = bmp[(size_t)(kt + 1) * 4096]; }
        f32x16 S0, S1; qk_tile(S0, S1, qr, lds + AT_KBUF + cb * 8192, r32, hi);
        const int key0 = kt * 64; const bool near = (tw0 - (key0 + 63)) < 113;
        if (A_DENSE) { if (near) apply_mask<MK_C>(S0, S1, tq, key0, hi, true, lut, 0ull, 0); } else apply_mask<MK_A>(S0, S1, tq, key0, hi, near, lut, bits, 0);
        softmax_step<64, true>(st, S0, S1, lds + AT_VBUF + cb * 16384, wsf, lane);
        bits = nbits;
    }
    __syncthreads();
    f32x16 acc[2];
#pragma unroll
    for (int d = 0; d < 2; ++d)
#pragma unroll
        for (int r = 0; r < 16; ++r) acc[d][r] = 0.f;
    const float lt = sum32(st.l, lane);
    finish_add<2>(acc, st.o, 0.5f, lt > 0.f ? 1.f / lt : 0.f, wsf, lane);
    GAS bf16_t* orow = (GAS bf16_t*)OC + (rowbase + tw0) * 1024 + h * 64 + r32; asm volatile("" : "+v"(orow)); int hs = hi; asm volatile("" : "+v"(hs));
#pragma unroll
    for (int r = 0; r < 16; ++r)
#pragma unroll
        for (int d = 0; d < 2; ++d) orow[crow(r, hs) * 1024 + 32 * d] = (bf16_t)f2bf(acc[d][r]);
}

constexpr int IMP_LD = 65;
__device__ __forceinline__ void unit_B(Frame& F, const bf16_t* P, const bf16_t* KC, const bf16_t* VC, bf16_t* OC, int b, int qi) {
    const int lane = F.lane, r32 = lane & 31, hi = lane >> 5, w = F.wave, h = w & 3, rg = w >> 2;
    LAS unsigned char* lds = F.lds; LAS float* wsf = (LAS float*)(lds + AT_WSF) + w * 64; const LAS float* lut = (const LAS float*)(lds + AT_LUT) + (4 + h) * 128;
    LAS float* imp = (LAS float*)(lds + AT_IMP); volatile LAS u64* rmask = (volatile LAS u64*)(lds + AT_RMASK); volatile LAS u64* wor = (volatile LAS u64*)(lds + AT_WOR);
    const int q0 = qi * 64, cur = qi, tw0 = q0 + 32 * rg, tq = tw0 + r32, urow = 32 * rg + r32; const size_t rowbase = (size_t)b * 4096;
    const bf16_t* prow = P + (rowbase + tq) * DP;
    bf16x8 qr[4];
#pragma unroll
    for (int d0 = 0; d0 < 4; ++d0) qr[d0] = *(const bf16x8*)(prow + C_BQ + h * 64 + d0 * 16 + hi * 8);
    const float g0 = fsigmoid(bf2f(prow[C_BG + h * 3 + 0])), g1 = fsigmoid(bf2f(prow[C_BG + h * 3 + 1])), g2 = fsigmoid(bf2f(prow[C_BG + h * 3 + 2]));
    f32x16 ob[2];
#pragma unroll
    for (int d = 0; d < 2; ++d)
#pragma unroll
        for (int r = 0; r < 16; ++r) ob[d][r] = 0.f;
    {
        const int ncv = tq >= 31 ? ((tq - 31) >> 4) + 1 : 0;
        const int ncv_max = ((q0 + 63 - 31) >> 4) + 1, NTc = (ncv_max + 63) >> 6;
        const bf16_t* Kc = KC + (size_t)b * 256 * 64; const bf16_t* Vc = VC + (size_t)b * 256 * 64;
        AState<64> st; astate_init(st);
        stage_kv<64>(lds + AT_KBUF, lds + AT_VBUF, Kc, 64, Vc, 64, w, lane, false);
#pragma unroll 1
        for (int kt = 0; kt < NTc; ++kt) {
            VM_WAIT(); __syncthreads();
            const int cb = kt & 1;
            if (kt + 1 < NTc) stage_kv<64>(lds + AT_KBUF + (cb ^ 1) * 8192, lds + AT_VBUF + (cb ^ 1) * 16384, Kc + (size_t)(kt + 1) * 64 * 64, 64, Vc, 64, w, lane, false);
            f32x16 S0, S1; qk_tile(S0, S1, qr, lds + AT_KBUF + cb * 8192, r32, hi);
            apply_mask<MK_CMP>(S0, S1, tq, kt * 64, hi, false, lut, 0ull, ncv);
            softmax_step<64, false>(st, S0, S1, lds + AT_VBUF, wsf, lane);
        }
        __syncthreads();
        const float lt = sum32(st.l, lane); const float inv = lt > 0.f ? 1.f / lt : 0.f; const float mfin = st.m;
        f32x16 oc[2];
#pragma unroll
        for (int d = 0; d < 2; ++d)
#pragma unroll
            for (int r = 0; r < 16; ++r) oc[d][r] = 0.f;
        float carry = 0.f;
        stage_kv<64>(lds + AT_KBUF, lds + AT_VBUF, Kc, 64, Vc, 64, w, lane, true);
#pragma unroll 1
        for (int kt = 0; kt < NTc; ++kt) {
            VM_WAIT(); __syncthreads();
            const int cb = kt & 1;
            if (kt + 1 < NTc) stage_kv<64>(lds + AT_KBUF + (cb ^ 1) * 8192, lds + AT_VBUF + (cb ^ 1) * 16384, Kc + (size_t)(kt + 1) * 64 * 64, 64, Vc + (size_t)(kt + 1) * 64 * 64, 64, w, lane, true);
            f32x16 S0, S1; qk_tile(S0, S1, qr, lds + AT_KBUF + cb * 8192, r32, hi);
            apply_mask<MK_CMP>(S0, S1, tq, kt * 64, hi, false, lut, 0ull, ncv);
#pragma unroll
            for (int r = 0; r < 16; ++r) { S0[r] = fexp2(S0[r] - mfin) * inv; S1[r] = fexp2(S1[r] - mfin) * inv; }
            float own[2][4], pl[2][4];
#pragma unroll
            for (int g = 0; g < 4; ++g) { own[0][g] = (S0[4 * g] + S0[4 * g + 1]) + (S0[4 * g + 2] + S0[4 * g + 3]); own[1][g] = (S1[4 * g] + S1[4 * g + 1]) + (S1[4 * g + 2] + S1[4 * g + 3]);
                pl[0][g] = other32(S0[4 * g + 3], lane); pl[1][g] = other32(S1[4 * g + 3], lane); }
#pragma unroll
            for (int n = 0; n < 2; ++n)
#pragma unroll
                for (int g = 0; g < 4; ++g) { const int J = 16 * kt + 8 * n + 2 * g + hi;
                    const float prev0 = (g > 0) ? pl[n][g > 0 ? g - 1 : 0] : (n == 1 ? pl[0][3] : carry);
                    const float prev = hi ? pl[n][g] : prev0;
                    imp[(h * 64 + urow) * IMP_LD + J] = own[n][g] + prev; }
            carry = pl[1][3];
            { bf16x8 vf01[2][4]; v_load2(vf01, lds + AT_VBUF + cb * 16384, 0, lane); pv_tile<64>(oc, S0, S1, vf01, lds + AT_VBUF + cb * 16384, lane); }
        }
        finish_add<2>(ob, oc, 0.5f, g0, wsf, lane);
        __syncthreads();
    }
    {
        const int nf = cur >= 2 ? 3 : cur + 1, nfree = 16 - nf; u64 worl = 0ull;
#pragma unroll 1
        for (int rr = 0; rr < 8; ++rr) { const int row = 8 * w + rr; const int j = lane;
            const float v = (imp[(0 * 64 + row) * IMP_LD + j] + imp[(1 * 64 + row) * IMP_LD + j]) + (imp[(2 * 64 + row) * IMP_LD + j] + imp[(3 * 64 + row) * IMP_LD + j]);
            const bool cand = (j >= 1) && (j <= cur - 2);
            int rank = 0;
#pragma unroll 1
            for (int k = 1; k <= cur - 2; ++k) { const float vk = bperm_f(k, v); rank += (vk > v || (vk == v && k < j)) ? 1 : 0; }
            const bool forced = (j <= cur) && (j == 0 || j == cur || j == cur - 1);
            const bool sel = forced || (cand && rank < nfree);
            const u64 mk = __ballot(sel);
            if (lane == 0) rmask[row] = mk;
            worl |= mk; }
        if (lane == 0) wor[w] = worl;
        __syncthreads();
    }
    const u64 myrm = rmask[urow];
    u64 un = 0ull;
#pragma unroll
    for (int k = 0; k < 8; ++k) un |= wor[k];
    {
        const bf16_t* Kb = P + rowbase * DP + C_BKV + 2 * 64; const bf16_t* Vb = P + rowbase * DP + C_BKV + 3 * 64;
        AState<64> st; astate_init(st);
        const int nsel = __popcll(un);
        int j = __ffsll((long long)un) - 1; un &= un - 1;
        stage_kv<64>(lds + AT_KBUF, lds + AT_VBUF, Kb + (size_t)j * 64 * DP, DP, Vb + (size_t)j * 64 * DP, DP, w, lane, true);
#pragma unroll 1
        for (int i = 0; i < nsel; ++i) {
            VM_WAIT(); __syncthreads();
            const int cb = i & 1;
            int jn = -1;
            if (un) { jn = __ffsll((long long)un) - 1; un &= un - 1;
                stage_kv<64>(lds + AT_KBUF + (cb ^ 1) * 8192, lds + AT_VBUF + (cb ^ 1) * 16384, Kb + (size_t)jn * 64 * DP, DP, Vb + (size_t)jn * 64 * DP, DP, w, lane, true); }
            const int rowsel = (int)((myrm >> j) & 1ull);
            if (__any(rowsel)) {
                f32x16 S0, S1; qk_tile(S0, S1, qr, lds + AT_KBUF + cb * 8192, r32, hi);
                const int key0 = j * 64; const bool near = (tw0 - (key0 + 63)) < 113;
                if (near || j == cur || !__all(rowsel)) apply_mask<MK_SLC>(S0, S1, tq, key0, hi, near, lut, 0ull, rowsel);
                softmax_step<64, true>(st, S0, S1, lds + AT_VBUF + cb * 16384, wsf, lane);
            }
            j = jn;
        }
        __syncthreads();
        const float lt = sum32(st.l, lane);
        finish_add<2>(ob, st.o, 0.5f, lt > 0.f ? g1 / lt : 0.f, wsf, lane);
    }
    {
        const bf16_t* Kb = P + rowbase * DP + C_BKV + 4 * 64; const bf16_t* Vb = P + rowbase * DP + C_BKV + 5 * 64;
        AState<64> st; astate_init(st);
        const int kt0 = cur >= 8 ? cur - 8 : 0;
        stage_kv<64>(lds + AT_KBUF, lds + AT_VBUF, Kb + (size_t)kt0 * 64 * DP, DP, Vb + (size_t)kt0 * 64 * DP, DP, w, lane, true);
#pragma unroll 1
        for (int kt = kt0; kt <= cur; ++kt) {
            VM_WAIT(); __syncthreads();
            const int cb = (kt - kt0) & 1;
            if (kt + 1 <= cur) stage_kv<64>(lds + AT_KBUF + (cb ^ 1) * 8192, lds + AT_VBUF + (cb ^ 1) * 16384, Kb + (size_t)(kt + 1) * 64 * DP, DP, Vb + (size_t)(kt + 1) * 64 * DP, DP, w, lane, true);
            f32x16 S0, S1; qk_tile(S0, S1, qr, lds + AT_KBUF + cb * 8192, r32, hi);
            const int key0 = kt * 64; const bool near = (tw0 - (key0 + 63)) < 113;
            const bool allv = (key0 + 63 <= tw0) && (tw0 + 31 - key0 < 512);
            if (near || !allv) apply_mask<MK_WIN>(S0, S1, tq, key0, hi, near, lut, 0ull, 0);
            softmax_step<64, true>(st, S0, S1, lds + AT_VBUF + cb * 16384, wsf, lane);
        }
        __syncthreads();
        const float lt = sum32(st.l, lane);
        finish_add<2>(ob, st.o, 0.5f, lt > 0.f ? g2 / lt : 0.f, wsf, lane);
    }
    GAS bf16_t* orow = (GAS bf16_t*)OC + (rowbase + tw0) * 1024 + 256 + h * 64 + r32; asm volatile("" : "+v"(orow)); int hs = hi; asm volatile("" : "+v"(hs));
#pragma unroll
    for (int r = 0; r < 16; ++r)
#pragma unroll
        for (int d = 0; d < 2; ++d) orow[crow(r, hs) * 1024 + 32 * d] = (bf16_t)f2bf(ob[d][r]);
}

__device__ __forceinline__ void phase_cmp2(Frame& F, const bf16_t* HID, const bf16_t* W2T, bf16_t* KC) {
    const int lane = F.lane, fr = lane & 15, fq = lane >> 4;
    for (int task = F.gw; task < 512; task += F.NGW) { const int j = task >> 8, row0 = (task & 255) * 16;
        f32x4 acc[4];
#pragma unroll
        for (int n = 0; n < 4; ++n) acc[n] = (f32x4){0.f, 0.f, 0.f, 0.f};
#pragma unroll
        for (int ks = 0; ks < 8; ++ks) { const bf16x8 a = *(const bf16x8*)(HID + ((size_t)j * 4096 + row0 + fr) * 256 + ks * 32 + 8 * fq);
#pragma unroll
            for (int n = 0; n < 4; ++n) { const bf16x8 bb = *(const bf16x8*)(W2T + ((size_t)j * 64 + n * 16 + fr) * 256 + ks * 32 + 8 * fq);
                acc[n] = __builtin_amdgcn_mfma_f32_16x16x32_bf16(a, bb, acc[n], 0, 0, 0); } }
#pragma unroll
        for (int n = 0; n < 4; ++n)
#pragma unroll
            for (int jj = 0; jj < 4; ++jj) KC[((size_t)j * 4096 + row0 + 4 * fq + jj) * 64 + n * 16 + fr] = (bf16_t)f2bf(acc[n][jj]);
    }
}

constexpr int PH_PER_LAYER = 11, N_PHASES = 2 + DEPTH * PH_PER_LAYER;
struct Args { const float* in[27]; float* out; unsigned char* ws; int ph_lo, ph_hi, li, pad; };

#define IN(k) (lo <= (k) && (k) < hi)
#define SEAM(k) do { if (IN((k) + 1)) xcd_barrier(bar); } while (0)
#define WSB (F.ws)
#define PROJ ((bf16_t*)(WSB + WS_PROJ))
#define HB ((bf16_t*)(WSB + WS_HB))
#define OCAT ((bf16_t*)(WSB + WS_OCAT))
#define MERG ((bf16_t*)(WSB + WS_MERG))
#define X1 ((bf16_t*)(WSB + WS_X1))
#define MOD ((const float*)(WSB + WS_MOD))

template <int l>
__device__ __forceinline__ void run_layer(Frame& F, const Args& args, const XcdBarrier& bar, int lo, int hi) {
        const int pb = 2 + l * PH_PER_LAYER;
#define xres ((l == 0) ? args.in[0] : (const float*)args.out)
#define mod_a (MOD + (size_t)(2 * l) * 16 * 3072)
#define mod_f (MOD + (size_t)(2 * l + 1) * 16 * 3072)
        if (IN(pb + 0)) for (int rep = 0; rep < ((l == 0 && DUP == 0) ? 2 : 1); ++rep) { if (rep) xcd_barrier(bar); refresh(F);
            { pg8::Gemm g{HB, (const bf16_t*)(WSB + WS_WIN_T) + (size_t)l * DP * 1024, 1024, 1024, 1024, 128}; pg8::StaticOrder S; S.init(NTOK, N_BF, F.G, (int)blockIdx.x);
              pg8::EpiProj E{PROJ, 0, 1.f};
              pg8::gemm_phase<pg8::EpiProj, pg8::StaticOrder>(F.lds, g, S, E, F.wave); }
            { pg8::Gemm g{(const bf16_t*)(WSB + WS_HB8), (const bf16_t*)(WSB + WS_WMG8 + (size_t)l * N_F8 * 1024), 512, 512, 512, 128}; pg8::StaticOrder S; S.init(NTOK, N_F8, F.G, (int)blockIdx.x);
              pg8::EpiProj E{PROJ, N_BF, 1.f / (F8_H * F8_WIN)};
              pg8::gemm_phase<pg8::EpiProj, pg8::StaticOrder, true>(F.lds, g, S, E, F.wave); }
            if (blockIdx.x == 255) { u32x4* z = (u32x4*)(PROJ + (size_t)NTOK * DP); for (int i = F.tid; i < 32 * DP * 2 / 16; i += 512) z[i] = (u32x4){0u, 0u, 0u, 0u}; }
            SEAM(pb + 0);
        }
        if (IN(pb + 1)) for (int rep = 0; rep < ((l == 0 && DUP == 1) ? 2 : 1); ++rep) { if (rep) xcd_barrier(bar); refresh(F);
            { pg8::Gemm g{PROJ + C_BKV, (const bf16_t*)(WSB + WS_W1_T) + (size_t)l * 2 * 256 * 2048, 16 * DP, 2048, 2048, DP * 2}; pg8::CmpOrder S{F.G, (int)blockIdx.x};
              pg8::EpiCmp1 E{(bf16_t*)(WSB + WS_HID), (const float*)(WSB + WS_BIAS1) + l * 512};
              pg8::gemm_phase<pg8::EpiCmp1, pg8::CmpOrder>(F.lds, g, S, E, F.wave); }
            __syncthreads();
            if (USE_A) {
#pragma unroll 1
                for (int i = 0; i < 16; ++i) { const int c = (int)blockIdx.x; const int qt = (i & 1) ? 255 - c : c;
                    dsa_select_tile(F, PROJ, (u64*)(WSB + WS_BM64), (unsigned*)(WSB + WS_OCAT) + (size_t)blockIdx.x * 65536, i, qt); }
            }
            SEAM(pb + 1);
        }
        if (IN(pb + 2)) for (int rep = 0; rep < ((l == 0 && DUP == 2) ? 2 : 1); ++rep) { if (rep) xcd_barrier(bar); refresh(F); phase_cmp2(F, (const bf16_t*)(WSB + WS_HID), (const bf16_t*)(WSB + WS_W2_T) + (size_t)l * 2 * 64 * 256, (bf16_t*)(WSB + WS_KCMP)); SEAM(pb + 2); }
        if (IN(pb + 3)) for (int rep = 0; rep < ((l == 0 && DUP == 3) ? 2 : 1); ++rep) { if (rep) xcd_barrier(bar); refresh(F);
            for (int i = F.tid; i < 12 * 128; i += 512) ((LAS float*)(F.lds + AT_LUT))[i] = ((const float*)(WSB + WS_LUT))[i];
            __syncthreads();
            const int c = (int)blockIdx.x;
            if (USE_C) {
                const float lam = ((const float*)(WSB + WS_LAM))[l]; const float lam_init = 0.8f - 0.6f * __expf(-0.3f * (float)l);
#pragma unroll 1
                for (int u = 0; u < 4; ++u) { const int bh = (c & 7) * 8 + (c >> 5), pp = ((c >> 3) & 3) * 2 + (u >> 1); const int qb = (u & 1) ? pp : 15 - pp;
                    refresh(F); unit_C(F, PROJ, OCAT, args.in[10] + l * 128, lam, lam_init, bh >> 2, bh & 3, qb); }
            }
            if (USE_A) {
#pragma unroll 1
                for (int u = 0; u < 4; ++u) { const int b = (c & 7) * 2 + (c >> 7), pp = ((c >> 3) & 15) * 2 + (u >> 1); const int qi = (u & 1) ? pp : 63 - pp;
                    refresh(F); unit_A(F, PROJ, (const u64*)(WSB + WS_BM64), OCAT, b, qi); }
            }
            if (USE_B) {
#pragma unroll 1
                for (int u = 0; u < 4; ++u) { const int b = (c & 7) * 2 + (c >> 7), pp = ((c >> 3) & 15) * 2 + (u >> 1); const int qi = (u & 1) ? pp : 63 - pp;
                    refresh(F); unit_B(F, PROJ, (const bf16_t*)(WSB + WS_KCMP), (const bf16_t*)(WSB + WS_KCMP) + 4096 * 64, OCAT, b, qi); }
            }
            if (!USE_A || !USE_B || !USE_C) {
                for (int row = F.gw; row < NTOK; row += F.NGW) { u32x4* o = (u32x4*)(OCAT + (size_t)row * 1024);
                    for (int q = F.lane; q < 128; q += 64) { const int col = q * 8; const bool z = (col < 256) ? !USE_A : (col < 512 ? !USE_B : !USE_C); if (z) o[q] = (u32x4){0u, 0u, 0u, 0u}; } }
            }
            SEAM(pb + 3);
        }
        if (IN(pb + 4)) for (int rep = 0; rep < ((l == 0 && DUP == 4) ? 2 : 1); ++rep) { if (rep) xcd_barrier(bar); refresh(F);
            const bf16_t* WB = (const bf16_t*)(WSB + WS_WBR_T + (size_t)l * 2 * MiB);
            pg8::StaticOrder S; S.init(NTOK, 1024, F.G, (int)blockIdx.x);
            { pg8::Gemm g{OCAT, WB, 1024, 1024, 1024, 128}; pg8::EpiBranchCat E{MERG, PROJ}; pg8::gemm_phase<pg8::EpiBranchCat, pg8::StaticOrder>(F.lds, g, S, E, F.wave); }
            SEAM(pb + 4);
        }
        if (IN(pb + 5)) for (int rep = 0; rep < ((l == 0 && DUP == 5) ? 2 : 1); ++rep) { if (rep) xcd_barrier(bar); refresh(F);
            pg8::Gemm g{MERG, (const bf16_t*)(WSB + WS_WOUT_T) + (size_t)l * 1024 * 1024, 1024, 1024, 1024, 128}; pg8::StaticOrder S; S.init(NTOK, 1024, F.G, (int)blockIdx.x);
            pg8::EpiWout<(l > 0)> E{X1, (l == 0) ? (const void*)args.in[0] : (const void*)(WSB + WS_X2B), mod_a + 2048};
            pg8::gemm_phase<pg8::EpiWout<(l > 0)>, pg8::StaticOrder>(F.lds, g, S, E, F.wave);
            SEAM(pb + 5);
        }
#define cnt ((unsigned*)(WSB + WS_CTL) + CW_CNT + l * 64)
        if (IN(pb + 6)) for (int rep = 0; rep < ((l == 0 && DUP == 6) ? 2 : 1); ++rep) { if (rep) xcd_barrier(bar); refresh(F); phase_ln1_router(F, X1, args.in[15] + l * 1024, args.in[16] + l * 1024, mod_f, args.in[19] + (size_t)l * 1024 * 32, args.in[20] + l * 32, HB, cnt); SEAM(pb + 6); }
        if (IN(pb + 7)) for (int rep = 0; rep < ((l == 0 && DUP == 7) ? 2 : 1); ++rep) { if (rep) xcd_barrier(bar); refresh(F); phase_gather(F, cnt, HB, (unsigned char*)(WSB + WS_HS8)); SEAM(pb + 7); }
        if (IN(pb + 8)) for (int rep = 0; rep < ((l == 0 && DUP == 8) ? 2 : 1); ++rep) { if (rep) xcd_barrier(bar); refresh(F);
            build_pstart(F, cnt);
            pg8::Gemm g{(const bf16_t*)(WSB + WS_HS8), (const bf16_t*)(WSB + WS_WGU_T + (size_t)l * 32 * 2048 * 1024), 512, 512, 512, 128};
            pg8::MoeOrder S{F.G, (int)blockIdx.x, 8, (int)F.MISC[48], (const volatile LAS int*)(F.MISC + 16)};
            pg8::EpiMoe1 E{(unsigned char*)(WSB + WS_ACT), args.in[22] + (size_t)l * 32 * 2048};
            pg8::gemm_phase<pg8::EpiMoe1, pg8::MoeOrder, true>(F.lds, g, S, E, F.wave);
            SEAM(pb + 8);
        }
        if (IN(pb + 9)) for (int rep = 0; rep < ((l == 0 && DUP == 9) ? 2 : 1); ++rep) { if (rep) xcd_barrier(bar); refresh(F);
            build_pstart(F, cnt);
            pg8::Gemm g{(const bf16_t*)(WSB + WS_ACT), (const bf16_t*)(WSB + WS_WDN_T + (size_t)l * 32 * 1024 * 1024), 512, 512, 512, 128};
            pg8::MoeOrder S{F.G, (int)blockIdx.x, 4, (int)F.MISC[48], (const volatile LAS int*)(F.MISC + 16)};
            pg8::EpiMoe2 E{(bf16_t*)(WSB + WS_HS), args.in[24] + (size_t)l * 32 * 1024};
            pg8::gemm_phase<pg8::EpiMoe2, pg8::MoeOrder, true>(F.lds, g, S, E, F.wave);
            SEAM(pb + 9);
        }
        if (IN(pb + 10)) for (int rep = 0; rep < ((l == 0 && DUP == 10) ? 2 : 1); ++rep) { if (rep) xcd_barrier(bar); refresh(F);
            phase_combine(F, (const bf16_t*)(WSB + WS_HS), X1, mod_f, args.in[25] + l * 1024, args.in[26] + l * 1024, args.out, (l + 1 < DEPTH) ? MOD + (size_t)(2 * l + 2) * 16 * 3072 : nullptr, HB, (unsigned char*)(WSB + WS_HB8), (bf16_t*)(WSB + WS_X2B));
            SEAM(pb + 10);
        }
}

__global__ void __launch_bounds__(512, 2) mega_fwd(Args args) {
    extern __shared__ __attribute__((aligned(16))) unsigned char lds_raw[];
    Frame F;
    F.lds = (LAS unsigned char*)lds_raw; F.MISC = (volatile LAS unsigned*)(F.lds + LDS_MISC);
    F.tid = threadIdx.x; F.lane = F.tid & 63; F.wave = __builtin_amdgcn_readfirstlane(F.tid >> 6); F.wave0 = F.wave;
    F.G = gridDim.x; F.gw = blockIdx.x * 8 + F.wave; F.NGW = F.G * 8;
    F.ws = args.ws; F.ws0 = args.ws; F.ctl = (unsigned*)(args.ws + WS_CTL); F.in = args.in; F.out = args.out;
    for (int u = F.tid; u < (LDS_BYTES - LDS_MISC) / 4; u += 512) F.MISC[u] = 0u;
    __syncthreads();
    XcdBarrier bar = xcd_barrier_post(F.ctl + CW_BAR + args.li * XCD_BAR_WORDS, F.MISC);
    const int lo = args.ph_lo, hi = args.ph_hi;
    if (IN(0)) for (int rep = 0; rep < (DUP == 100 ? 2 : 1); ++rep) { refresh(F); phase_prologue(F); SEAM(0); }
    if (IN(1)) { refresh(F); phase_h0(F, args.in[0], MOD, HB, (unsigned char*)(WSB + WS_HB8)); SEAM(1); }

    run_layer<0>(F, args, bar, lo, hi);
    run_layer<1>(F, args, bar, lo, hi);
#undef IN
#undef SEAM
#undef WSB
#undef PROJ
#undef HB
#undef OCAT
#undef MERG
#undef X1
#undef MOD
#undef xres
#undef mod_a
#undef mod_f
#undef cnt
}

constexpr int N_LAUNCHES = 1;
extern "C" void kernel_launch(void* const* d_in, const int* in_sizes, int n_in, void* d_out, int out_size, void* d_ws, size_t ws_size, hipStream_t stream) {
    static int grid = 0;
    if (grid == 0) {
        if (n_in != 27 || out_size != NTOK * D || ws_size < WS_END) { fprintf(stderr, "kernel_launch: unexpected sizes n_in %d out %d ws %zu (need %zu)\n", n_in, out_size, ws_size, (size_t)WS_END); grid = -1; return; }
        int dev = 0, cus = 0, per_cu = 0;
        if (hipGetDevice(&dev) != hipSuccess || hipDeviceGetAttribute(&cus, hipDeviceAttributeMultiprocessorCount, dev) != hipSuccess) { grid = -1; return; }
        if (hipFuncSetAttribute((const void*)mega_fwd, hipFuncAttributeMaxDynamicSharedMemorySize, LDS_BYTES) != hipSuccess) { fprintf(stderr, "kernel_launch: hipFuncSetAttribute failed\n"); grid = -1; return; }
        if (hipOccupancyMaxActiveBlocksPerMultiprocessor(&per_cu, (const void*)mega_fwd, 512, LDS_BYTES) != hipSuccess || per_cu < 1) fprintf(stderr, "kernel_launch: occupancy query says %d\n", per_cu);
        (void)hipGetLastError();
        grid = cus;
        if (grid != 256) { fprintf(stderr, "kernel_launch: built for 256 CUs, got %d\n", cus); grid = -1; return; }
    }
    if (grid < 0) return;
    (void)hipMemsetAsync((char*)d_ws + WS_CTL, 0, CTL_BYTES, stream);
    Args a{};
    for (int i = 0; i < 27; ++i) a.in[i] = (const float*)d_in[i];
    a.out = (float*)d_out; a.ws = (unsigned char*)d_ws; a.pad = 0;
    for (int li = 0; li < N_LAUNCHES; ++li) {
        a.ph_lo = (N_LAUNCHES == 1) ? 0 : li; a.ph_hi = (N_LAUNCHES == 1) ? N_PHASES : li + 1; a.li = li;
        hipLaunchKernelGGL(mega_fwd, dim3(grid), dim3(512), LDS_BYTES, stream, a);
    }
}
```

```cpp
#include <hip/hip_runtime.h>
#include <cstdio>
#include <cstdint>

#define GAS __attribute__((address_space(1)))
#define LAS __attribute__((address_space(3)))
typedef unsigned short bf16_t;
typedef short bf16x8 __attribute__((ext_vector_type(8)));
typedef short s16x4 __attribute__((ext_vector_type(4)));
typedef float f32x2 __attribute__((ext_vector_type(2)));
typedef float f32x4 __attribute__((ext_vector_type(4)));
typedef float f32x16 __attribute__((ext_vector_type(16)));
typedef unsigned u32x4 __attribute__((ext_vector_type(4)));
typedef unsigned u32x2 __attribute__((ext_vector_type(2)));
typedef unsigned long long u64;

constexpr bool USE_A = true, USE_B = true, USE_C = true;
constexpr bool A_DENSE = false; constexpr bool DSA_FAKE = false;
constexpr int PROBE_ATT = 0;
constexpr int DUP = -1;
constexpr int NB = 16, SEQ = 4096, NTOK = NB * SEQ, D = 1024, DEPTH = 2, NEXP = 32;
constexpr int DP = 2816;
constexpr int D_IN = 5808;
constexpr int C_AQ = 0, C_AK = 256, C_AV = 320, C_IQ = 384, C_IK = 512, C_IW = 544, C_BG = 548, C_BQ = 576, C_BKV = 832, C_CQ = 1216, C_CK = 1728, C_CV = 2240, C_MG = 2752;
constexpr float LOG2E = 1.4426950408889634f;
constexpr float QS = 0.125f * LOG2E;
constexpr float IQS = 0.17677669529663687f;
constexpr float DN_ALPHA = 1.4142135623730951f;
constexpr float LN_EPS = 1e-5f;
constexpr int MOE_ROWS = NTOK * 4 + NEXP * 256;
constexpr float F8_WGU = 256.f, F8_WDN = 512.f, F8_H = 4.f, F8_ACT = 4.f, F8_WIN = 256.f;
constexpr int N_BF = 2816, N_F8 = 3072;

constexpr size_t MiB = 1u << 20;
constexpr size_t WS_CTL = 0, CTL_BYTES = 1 * MiB;
constexpr size_t WS_MOD = 1 * MiB;
constexpr size_t WS_BIAS1 = WS_MOD + 4 * 16 * 3072 * 4;
constexpr size_t WS_LUT = WS_BIAS1 + 4096;
constexpr size_t WS_LAM = WS_LUT + 8192;
constexpr size_t WS_TOKE = 2 * MiB;
constexpr size_t WS_TOKW = 3 * MiB;
constexpr size_t WS_TOKP = 4 * MiB;
constexpr size_t WS_TOKR = 5 * MiB;
constexpr size_t WS_KCMP = 6 * MiB;
constexpr size_t WS_WIN_T = 8 * MiB;
constexpr size_t WS_WBR_T = 31 * MiB;
constexpr size_t WS_WOUT_T = 35 * MiB;
constexpr size_t WS_W1_T = 39 * MiB;
constexpr size_t WS_W2_T = 43 * MiB;
constexpr size_t WS_WGU_T = 44 * MiB;
constexpr size_t WS_WDN_T = 300 * MiB;
constexpr size_t WS_WMG8 = 172 * MiB;
constexpr size_t WS_HB8 = 364 * MiB;
constexpr size_t WS_X1 = 428 * MiB;
constexpr size_t WS_X2B = 556 * MiB;
constexpr size_t WS_HB = 684 * MiB;
constexpr size_t WS_HID = 812 * MiB;
constexpr size_t WS_BIG = 820 * MiB;
constexpr size_t WS_PROJ = WS_BIG;
constexpr size_t WS_MG8 = WS_BIG + 353 * MiB;
constexpr size_t WS_OCAT = WS_BIG + 737 * MiB;
constexpr size_t WS_MERG = WS_OCAT + 128 * MiB;
constexpr size_t WS_BM64 = WS_MERG + 128 * MiB;
constexpr size_t WS_HS = WS_BIG;
constexpr size_t WS_HS8 = WS_BIG + 792 * MiB;
constexpr size_t WS_ACT = WS_BIG + 528 * MiB;
constexpr size_t WS_END = WS_BIG + 1056 * MiB;
static_assert((size_t)(NTOK + 32) * DP * 2 <= 353 * MiB, "proj");
static_assert((size_t)MOE_ROWS * 1024 * 2 <= 528 * MiB, "moe rows");
static_assert(WS_BM64 + 32 * MiB <= WS_END, "ws");
constexpr int CW_CNT = 1024;
constexpr int CW_BAR = 4096;

constexpr int LDS_MISC = 147456;
constexpr int LDS_BYTES = 151552;

#define LDS_WAIT() asm volatile("s_waitcnt lgkmcnt(0)" ::: "memory")
#define VM_WAIT() asm volatile("s_waitcnt vmcnt(0)" ::: "memory")

__device__ __forceinline__ unsigned f2bf(float f) { unsigned u = __builtin_bit_cast(unsigned, f); return (u + 0x7fffu + ((u >> 16) & 1u)) >> 16; }
__device__ __forceinline__ unsigned pk2(float lo, float hi) { return f2bf(lo) | (f2bf(hi) << 16); }
__device__ __forceinline__ float bf2f(unsigned short b) { return __builtin_bit_cast(float, (unsigned)b << 16); }
__device__ __forceinline__ float bflo(unsigned w) { return __builtin_bit_cast(float, w << 16); }
__device__ __forceinline__ float bfhi(unsigned w) { return __builtin_bit_cast(float, w & 0xffff0000u); }
typedef __bf16 bf16x2_t __attribute__((ext_vector_type(2)));
__device__ __forceinline__ unsigned cvt_pk_bf16(float lo, float hi) { return __builtin_bit_cast(unsigned, __builtin_convertvector((f32x2){lo, hi}, bf16x2_t)); }
__device__ __forceinline__ unsigned pk4_fp8(float a, float b, float c, float d) { int r = 0; r = __builtin_amdgcn_cvt_pk_fp8_f32(a, b, r, false); r = __builtin_amdgcn_cvt_pk_fp8_f32(c, d, r, true); return (unsigned)r; }
__device__ __forceinline__ void fp8x8_f32(u32x2 w, float (&f)[8]) { const f32x2 a = __builtin_amdgcn_cvt_pk_f32_fp8((int)w.x, false), b = __builtin_amdgcn_cvt_pk_f32_fp8((int)w.x, true), c = __builtin_amdgcn_cvt_pk_f32_fp8((int)w.y, false), d = __builtin_amdgcn_cvt_pk_f32_fp8((int)w.y, true);
    f[0] = a.x; f[1] = a.y; f[2] = b.x; f[3] = b.y; f[4] = c.x; f[5] = c.y; f[6] = d.x; f[7] = d.y; }
__device__ __forceinline__ float fexp2(float x) { return __builtin_amdgcn_exp2f(x); }
__device__ __forceinline__ float frcp(float x) { return __builtin_amdgcn_rcpf(x); }
__device__ __forceinline__ float fsigmoid(float x) { return frcp(1.f + fexp2(-LOG2E * x)); }
__device__ __forceinline__ float gelu_tanh(float x) { const float u = 0.7978845608028654f * (x + 0.044715f * x * x * x); return x * fsigmoid(2.f * u); }
__device__ __forceinline__ int bperm_i(int idx, int v) { return __builtin_amdgcn_ds_bpermute(idx << 2, v); }
__device__ __forceinline__ float bperm_f(int idx, float v) { return __builtin_bit_cast(float, __builtin_amdgcn_ds_bpermute(idx << 2, __builtin_bit_cast(int, v))); }
__device__ __forceinline__ float other32(float v, int lane) { return bperm_f(lane ^ 32, v); }
__device__ __forceinline__ float sum32(float v, int lane) { return v + bperm_f(lane ^ 32, v); }
__device__ __forceinline__ float max32(float v, int lane) { return fmaxf(v, bperm_f(lane ^ 32, v)); }
__device__ __forceinline__ float shx_f(float v, int mask, int lane) { return bperm_f(lane ^ mask, v); }
__device__ __forceinline__ int shx_i(int v, int mask, int lane) { return bperm_i(lane ^ mask, v); }
__device__ __forceinline__ float wave_sum(float v, int lane) {
#pragma unroll
    for (int o = 1; o < 32; o <<= 1) v += shx_f(v, o, lane);
    return sum32(v, lane);
}

#define XB_TMO      128
#define XB_XCNT(j)  (256  + 64 * (j))
#define XB_XSUB(j)  (1280 + 64 * (j))
#define XB_XGEN(j)  (2304 + 64 * (j))
#define XB_TOP      3328
#define XB_TOPGEN   3392
#define XCD_BAR_WORDS 3456
#define XB_SPIN_CAP (1u << 18)

__device__ __forceinline__ unsigned xb_ld(unsigned* p)              { return __hip_atomic_load(p, __ATOMIC_RELAXED, __HIP_MEMORY_SCOPE_AGENT); }
__device__ __forceinline__ unsigned xb_add(unsigned* p, unsigned v) { return __hip_atomic_fetch_add(p, v, __ATOMIC_RELAXED, __HIP_MEMORY_SCOPE_AGENT); }
__device__ __forceinline__ unsigned xb_xcc_id() { return (unsigned)__builtin_amdgcn_s_getreg((3 << 11) | 20) & 0xFu; }
#define XB_SPIN(cond, bar) do { unsigned _sp = 0; while (cond) { __builtin_amdgcn_s_sleep(1); \
    if ((++_sp & 255u) == 0u) { if (xb_ld(&(bar)[XB_TMO])) break; if (_sp > XB_SPIN_CAP) { atomicAdd(&(bar)[XB_TMO], 1u); break; } } } } while (0)

struct XcdBarrier { unsigned* bar; unsigned x; volatile LAS unsigned* st; };

__device__ __forceinline__ XcdBarrier xcd_barrier_post(unsigned* bar, volatile LAS unsigned* st) {
    XcdBarrier b; b.bar = bar; b.x = xb_xcc_id(); b.st = st;
    if (threadIdx.x == 0) (void)xb_add(&bar[XB_XCNT(b.x)], 1u);
    return b;
}
__device__ __forceinline__ void xcd_barrier_complete(unsigned* bar, unsigned x, unsigned& nloc, unsigned& nx) {
    const unsigned G = gridDim.x * gridDim.y * gridDim.z;
    unsigned sum, cnt, mine, sp = 0u;
    for (;;) {
        sum = 0u; cnt = 0u; mine = 0u;
#pragma unroll
        for (unsigned j = 0; j < 16; ++j) { const unsigned c = xb_ld(&bar[XB_XCNT(j)]); sum += c; cnt += (c > 0u) ? 1u : 0u; mine = (j == x) ? c : mine; }
        if (sum == G) break;
        __builtin_amdgcn_s_sleep(1);
        if ((++sp & 255u) == 0u) { if (xb_ld(&bar[XB_TMO])) break; if (sp > XB_SPIN_CAP) { atomicAdd(&bar[XB_TMO], 1u); break; } }
    }
    nloc = mine > 0u ? mine : 1u; nx = cnt > 0u ? cnt : 1u;
}
__device__ __forceinline__ void xcd_barrier(const XcdBarrier& b) {
    asm volatile("s_waitcnt vmcnt(0)" ::: "memory");
    __syncthreads();
    if (threadIdx.x == 0) {
        unsigned* bar = b.bar;
        __builtin_amdgcn_s_waitcnt(0);
        unsigned nloc = b.st[0], nx = b.st[1];
        if (nloc == 0u) { xcd_barrier_complete(bar, b.x, nloc, nx); b.st[0] = nloc; b.st[1] = nx; }
        const unsigned old = xb_add(&bar[XB_XSUB(b.x)], 1u);
        const unsigned gen = old / nloc;
        if (old + 1u == (gen + 1u) * nloc) {
            __builtin_amdgcn_fence(__ATOMIC_RELEASE, "agent");
            asm volatile("s_waitcnt vmcnt(0)" ::: "memory");
            const unsigned og = xb_add(&bar[XB_TOP], 1u);
            const unsigned tg = og / nx;
            if (og + 1u == (tg + 1u) * nx) xb_add(&bar[XB_TOPGEN], 1u);
            else XB_SPIN(xb_ld(&bar[XB_TOPGEN]) == tg, bar);
            __builtin_amdgcn_fence(__ATOMIC_ACQUIRE, "agent");
            xb_add(&bar[XB_XGEN(b.x)], 1u);
            asm volatile("s_waitcnt vmcnt(0)" ::: "memory");
        } else {
            XB_SPIN(xb_ld(&bar[XB_XGEN(b.x)]) == gen, bar);
            __builtin_amdgcn_fence(__ATOMIC_ACQUIRE, "agent");
            asm volatile("s_waitcnt vmcnt(0)" ::: "memory");
        }
    }
    __syncthreads();
}

__device__ __forceinline__ int fresh_tid(int wave_s) {
    unsigned ones = ~0u; asm volatile("" : "+s"(ones));
    int ln = (int)__builtin_amdgcn_mbcnt_hi(ones, __builtin_amdgcn_mbcnt_lo(ones, 0u)); asm volatile("" : "+v"(ln));
    return wave_s * 64 + ln;
}

namespace pg8 {
typedef int v4i_t __attribute__((ext_vector_type(4)));
typedef int v8i_t __attribute__((ext_vector_type(8)));
constexpr int BM = 256, BK = 64, HALF = 128, HTB = HALF * BK * 2, STAGE_BYTES = 8 * HTB, NXCD = 8, WGM = 8;
__device__ __forceinline__ int lds_byte(int r, int c) { const int st = (r >> 4) * 2 + (c >> 5), rr = r & 15, cc = c & 31, ob = rr * 64 + cc * 2; return st * 1024 + (ob ^ (((ob >> 9) & 1) << 5)); }
__device__ __forceinline__ void stage_rc(int b, int& R, int& C) { const int st = b / 1024, sb = b % 1024, swz = sb ^ (((sb >> 9) & 1) << 5); R = (st >> 1) * 16 + swz / 64; C = (st & 1) * 32 + (swz % 64) / 2; }
__device__ __forceinline__ int perm32(int rho) { const int n = rho >> 4, i = rho & 15; return 8 * (i >> 2) + 4 * n + (i & 3); }

struct Unit { int pm, pn; };
struct Gemm { const bf16_t* A; const bf16_t* Bt; int lda, ldb, K, kstepA; };

struct StaticOrder {
    int nM, nN, nwg, G, c;
    __device__ void init(int M, int N, int G_, int c_) { nM = M / BM; nN = N / BM; nwg = nM * nN; G = G_; c = c_; }
    __device__ bool next(int i, Unit& u) const {
        const long L = (long)i * G + c; if (L >= nwg) return false;
        int wgid = (int)L; { const int q = nwg / NXCD, r = nwg % NXCD, xcd = wgid % NXCD, off = wgid / NXCD; wgid = (xcd < r ? xcd * (q + 1) : r * (q + 1) + (xcd - r) * q) + off; }
        const int nig = WGM * nN, gid = wgid / nig, fm = gid * WGM, gsz = (nM - fm) < WGM ? (nM - fm) : WGM;
        u.pm = fm + ((wgid % nig) % gsz); u.pn = (wgid % nig) / gsz; return true;
    }
    __device__ __forceinline__ const char* a_ptr(const Gemm& g, const Unit& u) const { return (const char*)g.A + (size_t)u.pm * (size_t)(BM * 2) * g.lda; }
    __device__ __forceinline__ const char* b_ptr(const Gemm& g, const Unit& u) const { return (const char*)g.Bt + (size_t)u.pn * (size_t)(BM * 2) * g.ldb; }
};
struct CmpOrder {
    int G, c;
    __device__ bool next(int i, Unit& u) const { const int L = i * G + c; if (L >= 32) return false; u.pn = L >> 4; u.pm = L & 15; return true; }
    __device__ __forceinline__ const char* a_ptr(const Gemm& g, const Unit& u) const { return (const char*)g.A + (size_t)u.pm * (size_t)(BM * 2) * g.lda + u.pn * 128; }
    __device__ __forceinline__ const char* b_ptr(const Gemm& g, const Unit& u) const { return (const char*)g.Bt + (size_t)u.pn * (size_t)(BM * 2) * g.ldb; }
};
struct MoeOrder {
    int G, c, NT, npan; const volatile LAS int* pstart;
    __device__ bool next(int i, Unit& u) const {
        const int ppx = (256 / NT) / 8, x = c & 7, r = c >> 3;
        const int p = i * (256 / NT) + x * ppx + (r % ppx), n = r / ppx; if (p >= npan) return false;
        int e = 0;
#pragma unroll 1
        for (int k = 1; k < 32; ++k) e += (pstart[k] <= p) ? 1 : 0;
        u.pm = p; u.pn = e * NT + n; return true;
    }
    __device__ __forceinline__ const char* a_ptr(const Gemm& g, const Unit& u) const { return (const char*)g.A + (size_t)u.pm * (size_t)(BM * 2) * g.lda; }
    __device__ __forceinline__ const char* b_ptr(const Gemm& g, const Unit& u) const { return (const char*)g.Bt + (size_t)u.pn * (size_t)(BM * 2) * g.ldb; }
};

#define EPI_LOOP_AI_M  _Pragma("unroll") for (int ai = 0; ai < 2; ++ai) _Pragma("unroll") for (int m = 0; m < 4; ++m)

struct EpiProj {
    static constexpr bool PERM = true;
    bf16_t* O; int colbase; float scl;
    __device__ __forceinline__ void operator()(const f32x4 (&acc)[2][2][4][2], const Unit& u, int wr, int wc, int fr, int fq) const {
        const int row0 = u.pm * BM + wr * 64 + fr, col0 = colbase + u.pn * BM + wc * 32 + 8 * fq;
        EPI_LOOP_AI_M { bf16_t* rowp = O + (size_t)(row0 + ai * HALF + m * 16) * DP + col0;
#pragma unroll
            for (int bj = 0; bj < 2; ++bj) { const f32x4 v0 = acc[ai][bj][m][0] * scl, v1 = acc[ai][bj][m][1] * scl;
                u32x4 w; w.x = cvt_pk_bf16(v0[0], v0[1]); w.y = cvt_pk_bf16(v0[2], v0[3]); w.z = cvt_pk_bf16(v1[0], v1[1]); w.w = cvt_pk_bf16(v1[2], v1[3]);
                *(u32x4*)(rowp + bj * HALF) = w; } }
    }
};
struct EpiGate8 {
    static constexpr bool PERM = true;
    unsigned char* O; float scl;
    __device__ __forceinline__ void operator()(const f32x4 (&acc)[2][2][4][2], const Unit& u, int wr, int wc, int fr, int fq) const {
        const int row0 = u.pm * BM + wr * 64 + fr, col0 = u.pn * BM + wc * 32 + 8 * fq;
        EPI_LOOP_AI_M { unsigned char* rowp = O + (size_t)(row0 + ai * HALF + m * 16) * 3072 + col0;
#pragma unroll
            for (int bj = 0; bj < 2; ++bj) { const f32x4 v0 = acc[ai][bj][m][0] * scl, v1 = acc[ai][bj][m][1] * scl;
                *(u32x2*)(rowp + bj * HALF) = (u32x2){pk4_fp8(v0[0], v0[1], v0[2], v0[3]), pk4_fp8(v1[0], v1[1], v1[2], v1[3])}; } }
    }
};
struct EpiCmp1 {
    static constexpr bool PERM = true;
    bf16_t* O; const float* bias;
    __device__ __forceinline__ void operator()(const f32x4 (&acc)[2][2][4][2], const Unit& u, int wr, int wc, int fr, int fq) const {
        const int row0 = u.pm * BM + wr * 64 + fr, col0 = wc * 32 + 8 * fq; const int j = u.pn;
        f32x4 bv[2][2];
#pragma unroll
        for (int bj = 0; bj < 2; ++bj)
#pragma unroll
            for (int n = 0; n < 2; ++n) bv[bj][n] = *(const f32x4*)(bias + j * 256 + col0 + bj * HALF + 4 * n);
        EPI_LOOP_AI_M { bf16_t* rowp = O + ((size_t)j * 4096 + row0 + ai * HALF + m * 16) * 256 + col0;
#pragma unroll
            for (int bj = 0; bj < 2; ++bj) { f32x4 v0 = acc[ai][bj][m][0] + bv[bj][0], v1 = acc[ai][bj][m][1] + bv[bj][1];
#pragma unroll
                for (int q = 0; q < 4; ++q) { v0[q] = gelu_tanh(v0[q]); v1[q] = gelu_tanh(v1[q]); }
                u32x4 w; w.x = cvt_pk_bf16(v0[0], v0[1]); w.y = cvt_pk_bf16(v0[2], v0[3]); w.z = cvt_pk_bf16(v1[0], v1[1]); w.w = cvt_pk_bf16(v1[2], v1[3]);
                *(u32x4*)(rowp + bj * HALF) = w; } }
    }
};
__device__ __forceinline__ float sig_ratio(float a, float b) { return (1.f + fexp2(-LOG2E * b)) * frcp(1.f + fexp2(-LOG2E * a)); }
struct EpiBranchCat {
    static constexpr bool PERM = true, MID = true;
    bf16_t* MG; const unsigned char* G8;
    __device__ __forceinline__ void mid(f32x4 (&acc)[2][2][4][2], const Unit& u, int wr, int wc, int fr, int fq, int seg) const {
        const int row0 = u.pm * BM + wr * 64 + fr, col0 = u.pn * BM + wc * 32 + 8 * fq;
#pragma unroll
        for (int ai = 0; ai < 2; ++ai) {
            u32x2 ga[4][2], gb[4][2];
#pragma unroll
            for (int m = 0; m < 4; ++m) { const size_t row = (size_t)(row0 + ai * HALF + m * 16);
#pragma unroll
                for (int bj = 0; bj < 2; ++bj) { const unsigned char* gp = G8 + row * 3072 + seg * 1024 + col0 + bj * HALF; ga[m][bj] = *(const u32x2*)gp; gb[m][bj] = *(const u32x2*)(gp + 1024); } }
#pragma unroll
            for (int m = 0; m < 4; ++m)
#pragma unroll
                for (int bj = 0; bj < 2; ++bj) { float a[8], b[8]; fp8x8_f32(ga[m][bj], a); fp8x8_f32(gb[m][bj], b); f32x4& v0 = acc[ai][bj][m][0]; f32x4& v1 = acc[ai][bj][m][1];
#pragma unroll
                    for (int q = 0; q < 4; ++q) { v0[q] *= sig_ratio(a[q], b[q]); v1[q] *= sig_ratio(a[4 + q], b[4 + q]); } }
        }
    }
    __device__ __forceinline__ void operator()(const f32x4 (&acc)[2][2][4][2], const Unit& u, int wr, int wc, int fr, int fq) const {
        const int row0 = u.pm * BM + wr * 64 + fr, col0 = u.pn * BM + wc * 32 + 8 * fq;
#pragma unroll
        for (int ai = 0; ai < 2; ++ai) {
            u32x2 gq[4][2];
#pragma unroll
            for (int m = 0; m < 4; ++m) { const size_t row = (size_t)(row0 + ai * HALF + m * 16);
#pragma unroll
                for (int bj = 0; bj < 2; ++bj) gq[m][bj] = *(const u32x2*)(G8 + row * 3072 + 2 * 1024 + col0 + bj * HALF); }
#pragma unroll
            for (int m = 0; m < 4; ++m) { const size_t row = (size_t)(row0 + ai * HALF + m * 16);
#pragma unroll
                for (int bj = 0; bj < 2; ++bj) { float g[8]; fp8x8_f32(gq[m][bj], g); f32x4 v0 = acc[ai][bj][m][0], v1 = acc[ai][bj][m][1];
#pragma unroll
                    for (int q = 0; q < 4; ++q) { v0[q] *= fsigmoid(g[q]); v1[q] *= fsigmoid(g[4 + q]); }
                    u32x4 w; w.x = cvt_pk_bf16(v0[0], v0[1]); w.y = cvt_pk_bf16(v0[2], v0[3]); w.z = cvt_pk_bf16(v1[0], v1[1]); w.w = cvt_pk_bf16(v1[2], v1[3]);
                    *(u32x4*)(MG + row * 1024 + col0 + bj * HALF) = w; } }
        }
    }
};
template <bool XBF> struct EpiWout {
    static constexpr bool PERM = true;
    bf16_t* Z; const void* XR; const float* gate;
    __device__ __forceinline__ void operator()(const f32x4 (&acc)[2][2][4][2], const Unit& u, int wr, int wc, int fr, int fq) const {
        const int row0 = u.pm * BM + wr * 64 + fr, col0 = u.pn * BM + wc * 32 + 8 * fq;
        const int b = (u.pm * BM) >> 12;
        f32x4 gv[2][2];
#pragma unroll
        for (int bj = 0; bj < 2; ++bj)
#pragma unroll
            for (int n = 0; n < 2; ++n) gv[bj][n] = *(const f32x4*)(gate + (size_t)b * 3072 + col0 + bj * HALF + 4 * n) + 1.0f;
#pragma unroll
        for (int ai = 0; ai < 2; ++ai) {
            f32x4 xr[4][2][2];
#pragma unroll
            for (int m = 0; m < 4; ++m) { const size_t ro = (size_t)(row0 + ai * HALF + m * 16) * 1024 + col0;
#pragma unroll
                for (int bj = 0; bj < 2; ++bj) {
                    if (XBF) { const u32x4 q = *(const u32x4*)((const bf16_t*)XR + ro + bj * HALF);
                        xr[m][bj][0] = (f32x4){bflo(q.x), bfhi(q.x), bflo(q.y), bfhi(q.y)}; xr[m][bj][1] = (f32x4){bflo(q.z), bfhi(q.z), bflo(q.w), bfhi(q.w)}; }
                    else { xr[m][bj][0] = *(const f32x4*)((const float*)XR + ro + bj * HALF); xr[m][bj][1] = *(const f32x4*)((const float*)XR + ro + bj * HALF + 4); } } }
            asm volatile("" ::: "memory");
#pragma unroll
            for (int m = 0; m < 4; ++m) { const size_t ro = (size_t)(row0 + ai * HALF + m * 16) * 1024 + col0;
#pragma unroll
                for (int bj = 0; bj < 2; ++bj) { const f32x4 v0 = xr[m][bj][0] * DN_ALPHA + gv[bj][0] * acc[ai][bj][m][0], v1 = xr[m][bj][1] * DN_ALPHA + gv[bj][1] * acc[ai][bj][m][1];
                    u32x4 w; w.x = cvt_pk_bf16(v0[0], v0[1]); w.y = cvt_pk_bf16(v0[2], v0[3]); w.z = cvt_pk_bf16(v1[0], v1[1]); w.w = cvt_pk_bf16(v1[2], v1[3]);
                    *(u32x4*)(Z + ro + bj * HALF) = w; } }
            asm volatile("" ::: "memory");
        }
    }
};
__device__ __forceinline__ float swiglu(float g, float u) { const float gg = fminf(g, 7.f), uu = fminf(fmaxf(u, -7.f), 7.f); return (uu + 1.f) * gg * fsigmoid(1.702f * gg); }
struct EpiMoe1 {
    static constexpr bool PERM = true;
    unsigned char* O; const float* bias;
    __device__ __forceinline__ void operator()(const f32x4 (&acc)[2][2][4][2], const Unit& u, int wr, int wc, int fr, int fq) const {
        const int row0 = u.pm * BM + wr * 64 + fr; const int e = u.pn >> 3, n8 = u.pn & 7; const int cg0 = n8 * BM + wc * 32 + 8 * fq;
        constexpr float isc = 1.f / (F8_H * F8_WGU);
        f32x4 bv[2][2];
#pragma unroll
        for (int bj = 0; bj < 2; ++bj)
#pragma unroll
            for (int n = 0; n < 2; ++n) bv[bj][n] = *(const f32x4*)(bias + (size_t)e * 2048 + cg0 + bj * HALF + 4 * n);
        EPI_LOOP_AI_M { unsigned char* rowp = O + (size_t)(row0 + ai * HALF + m * 16) * 1024 + (cg0 >> 1);
#pragma unroll
            for (int bj = 0; bj < 2; ++bj) { const f32x4 v0 = acc[ai][bj][m][0] * isc + bv[bj][0], v1 = acc[ai][bj][m][1] * isc + bv[bj][1];
                *(unsigned*)(rowp + bj * (HALF / 2)) = pk4_fp8(F8_ACT * swiglu(v0[0], v0[1]), F8_ACT * swiglu(v0[2], v0[3]), F8_ACT * swiglu(v1[0], v1[1]), F8_ACT * swiglu(v1[2], v1[3])); } }
    }
};
struct EpiMoe2 {
    static constexpr bool PERM = true;
    bf16_t* O; const float* bias;
    __device__ __forceinline__ void operator()(const f32x4 (&acc)[2][2][4][2], const Unit& u, int wr, int wc, int fr, int fq) const {
        const int row0 = u.pm * BM + wr * 64 + fr; const int e = u.pn >> 2, n4 = u.pn & 3; const int c0 = n4 * BM + wc * 32 + 8 * fq;
        constexpr float isc = 1.f / (F8_ACT * F8_WDN);
        f32x4 bv[2][2];
#pragma unroll
        for (int bj = 0; bj < 2; ++bj)
#pragma unroll
            for (int n = 0; n < 2; ++n) bv[bj][n] = *(const f32x4*)(bias + (size_t)e * 1024 + c0 + bj * HALF + 4 * n);
        EPI_LOOP_AI_M { bf16_t* rowp = O + (size_t)(row0 + ai * HALF + m * 16) * 1024 + c0;
#pragma unroll
            for (int bj = 0; bj < 2; ++bj) { const f32x4 v0 = acc[ai][bj][m][0] * isc + bv[bj][0], v1 = acc[ai][bj][m][1] * isc + bv[bj][1];
                u32x4 w; w.x = cvt_pk_bf16(v0[0], v0[1]); w.y = cvt_pk_bf16(v0[2], v0[3]); w.z = cvt_pk_bf16(v1[0], v1[1]); w.w = cvt_pk_bf16(v1[2], v1[3]);
                *(u32x4*)(rowp + bj * HALF) = w; } }
    }
};

__device__ __forceinline__ unsigned stage_voff(int tid, int i, int ld, bool perm) {
    int t = tid; asm volatile("" : "+v"(t));
    int R, C; stage_rc(t * 16 + i * 8192, R, C); const int Rb = perm ? ((R & ~31) + perm32(R & 31)) : R;
    return (unsigned)(Rb * ld + C) * 2u;
}
template <class T, class = void> struct has_mid { static constexpr bool value = false; };
template <class T> struct has_mid<T, decltype((void)T::MID)> { static constexpr bool value = T::MID; };
template <class Epi, class Sched, bool FP8 = false>
__device__ __forceinline__ void gemm_phase(LAS unsigned char* lds, const Gemm g, const Sched& S, const Epi& E, int wave_s) {
    const int tid = fresh_tid(wave_s), wid = wave_s, lane = tid & 63, wr = wid >> 2, wc = wid & 3, fr = lane & 15, fq = lane >> 4;
    const int K = g.K, nt = K / BK;
    unsigned voffA[2], voffB[2];
#pragma unroll
    for (int i = 0; i < 2; ++i) { int R, C; stage_rc(tid * 16 + i * 8192, R, C); const int Rb = Epi::PERM ? ((R & ~31) + perm32(R & 31)) : R;
        voffA[i] = (unsigned)(R * g.lda + C) * 2u; voffB[i] = (unsigned)(Rb * g.ldb + C) * 2u; }
    const size_t kstepA = (size_t)g.kstepA, kstepB = (size_t)(BK * 2);
    const size_t hstepA = (size_t)HALF * g.lda * 2, hstepB = (size_t)HALF * g.ldb * 2;
    const unsigned ldsw = (unsigned)wid * 1024u;
    const int aoff = lds_byte(wr * 64 + fr, fq * 8), boff = lds_byte(wc * 32 + fr, fq * 8);
#define PG8_SA(b, h) (((b) * 2 + (h)) * HTB)
#define PG8_SB(b, h) ((4 + (b) * 2 + (h)) * HTB)
#define PG8_VOFF(voff, _i) (FP8 ? stage_voff(tid, _i, (voff) == voffA ? g.lda : g.ldb, (voff) == voffB && Epi::PERM) : (voff)[_i])
#define PG8_STAGE(bufoff, gbase, voff) do { _Pragma("unroll") for (int _i = 0; _i < 2; ++_i) \
        __builtin_amdgcn_global_load_lds((const unsigned*)((const char*)(gbase) + PG8_VOFF(voff, _i)), (LAS unsigned*)(lds + (bufoff) + ldsw + _i * 8192), 16, 0, 0); } while (0)
    const LAS unsigned char* aB = lds + aoff; asm volatile("" : "+v"(aB));
    const LAS unsigned char* bB = lds + 4 * HTB + boff; asm volatile("" : "+v"(bB));
#define PG8_RDA(off) (*(const LAS v4i_t*)(aB + (off)))
#define PG8_RDB(off) (*(const LAS v4i_t*)(bB + (off)))
#define PG8_LDA(dst, b, h) do { _Pragma("unroll") for (int m = 0; m < 4; ++m) dst[m] = __builtin_shufflevector(PG8_RDA(((b) * 2 + (h)) * HTB + m * 2048), PG8_RDA(((b) * 2 + (h)) * HTB + m * 2048 + 1024), 0, 1, 2, 3, 4, 5, 6, 7); } while (0)
#define PG8_LDB(dst, b, h) do { _Pragma("unroll") for (int n = 0; n < 2; ++n) dst[n] = __builtin_shufflevector(PG8_RDB(((b) * 2 + (h)) * HTB + n * 2048), PG8_RDB(((b) * 2 + (h)) * HTB + n * 2048 + 1024), 0, 1, 2, 3, 4, 5, 6, 7); } while (0)
#define PG8_LO(x) __builtin_bit_cast(bf16x8, __builtin_shufflevector(x, x, 0, 1, 2, 3))
#define PG8_HI(x) __builtin_bit_cast(bf16x8, __builtin_shufflevector(x, x, 4, 5, 6, 7))
#define PG8_MMA(ai, bj, At, Bt) do { __builtin_amdgcn_s_setprio(1); _Pragma("unroll") for (int m = 0; m < 4; ++m) _Pragma("unroll") for (int n = 0; n < 2; ++n) { \
        if (FP8) acc[ai][bj][m][n] = __builtin_amdgcn_mfma_scale_f32_16x16x128_f8f6f4(Bt[n], At[m], acc[ai][bj][m][n], 0, 0, 0, 0, 0, 0); \
        else { acc[ai][bj][m][n] = __builtin_amdgcn_mfma_f32_16x16x32_bf16(PG8_LO(Bt[n]), PG8_LO(At[m]), acc[ai][bj][m][n], 0, 0, 0); \
               acc[ai][bj][m][n] = __builtin_amdgcn_mfma_f32_16x16x32_bf16(PG8_HI(Bt[n]), PG8_HI(At[m]), acc[ai][bj][m][n], 0, 0, 0); } } \
        __builtin_amdgcn_s_setprio(0); } while (0)
#define PG8_WAIT_V(n) asm volatile("s_waitcnt vmcnt(" #n ")" ::: "memory")
#define PG8_WAIT_L(n) asm volatile("s_waitcnt lgkmcnt(" #n ")" ::: "memory")
#define PG8_BAR __builtin_amdgcn_s_barrier()
#define PG8_SCHED __builtin_amdgcn_sched_barrier(0)
    Unit cur, nxt; int ui = 0;
    if (!S.next(0, cur)) return;
    f32x4 acc[2][2][4][2];
#pragma unroll
    for (int a = 0; a < 2; ++a)
#pragma unroll
        for (int b = 0; b < 2; ++b)
#pragma unroll
            for (int m = 0; m < 4; ++m)
#pragma unroll
                for (int n = 0; n < 2; ++n) acc[a][b][m][n] = (f32x4){0.f, 0.f, 0.f, 0.f};
    v8i_t At[4], B0[2], B1[2];
    const char* cA = S.a_ptr(g, cur); const char* cB = S.b_ptr(g, cur);
    PG8_STAGE(PG8_SB(0, 0), cB, voffB); PG8_STAGE(PG8_SA(0, 0), cA, voffA); PG8_STAGE(PG8_SB(0, 1), cB + hstepB, voffB); PG8_STAGE(PG8_SA(0, 1), cA + hstepA, voffA);
    if (wr == 1) PG8_BAR;
    PG8_WAIT_V(4); PG8_BAR;
    PG8_STAGE(PG8_SB(1, 0), cB + kstepB, voffB); PG8_STAGE(PG8_SA(1, 0), cA + kstepA, voffA); PG8_STAGE(PG8_SB(1, 1), cB + hstepB + kstepB, voffB);
    PG8_WAIT_V(6); PG8_BAR;
    for (;;) {
        const bool has_next = S.next(ui + 1, nxt);
        const char* nA = has_next ? S.a_ptr(g, nxt) : cA; const char* nB = has_next ? S.b_ptr(g, nxt) : cB;
        for (int t = 0; t < nt; t += 2) {
            if constexpr (has_mid<Epi>::value) { if (t == 4 || t == 8) { const int tz = fresh_tid(wave_s), ln = tz & 63; E.mid(acc, cur, wave_s >> 2, wave_s & 3, ln & 15, ln >> 4, (t >> 2) - 1); } }
            const bool last = (t == nt - 2);
            const char* a1 = cA + (size_t)(t + 1) * kstepA;
            const char* a2 = last ? nA : cA + (size_t)(t + 2) * kstepA; const char* b2 = last ? nB : cB + (size_t)(t + 2) * kstepB;
            const char* a3 = a2 + kstepA; const char* b3 = b2 + kstepB;
            PG8_LDB(B0, 0, 0); PG8_SCHED; PG8_LDA(At, 0, 0); PG8_STAGE(PG8_SA(1, 1), a1 + hstepA, voffA);
            PG8_WAIT_L(8); PG8_BAR; PG8_WAIT_L(0); PG8_MMA(0, 0, At, B0); PG8_BAR; PG8_SCHED;
            PG8_LDB(B1, 0, 1); PG8_STAGE(PG8_SB(0, 0), b2, voffB);
            PG8_BAR; PG8_WAIT_L(0); PG8_MMA(0, 1, At, B1); PG8_BAR;
            PG8_LDA(At, 0, 1); PG8_STAGE(PG8_SA(0, 0), a2, voffA);
            PG8_BAR; PG8_WAIT_L(0); PG8_MMA(1, 0, At, B0); PG8_BAR; PG8_SCHED;
            PG8_STAGE(PG8_SB(0, 1), b2 + hstepB, voffB);
            PG8_WAIT_V(6); PG8_BAR; PG8_MMA(1, 1, At, B1); PG8_BAR;
            PG8_LDB(B0, 1, 0); PG8_SCHED; PG8_LDA(At, 1, 0); PG8_STAGE(PG8_SA(0, 1), a2 + hstepA, voffA);
            PG8_WAIT_L(8); PG8_BAR; PG8_WAIT_L(0); PG8_MMA(0, 0, At, B0); PG8_BAR; PG8_SCHED;
            PG8_LDB(B1, 1, 1); PG8_STAGE(PG8_SB(1, 0), b3, voffB);
            PG8_BAR; PG8_WAIT_L(0); PG8_MMA(0, 1, At, B1); PG8_BAR;
            PG8_LDA(At, 1, 1); PG8_STAGE(PG8_SA(1, 0), a3, voffA);
            PG8_BAR; PG8_WAIT_L(0); PG8_MMA(1, 0, At, B0); PG8_BAR; PG8_SCHED;
            PG8_STAGE(PG8_SB(1, 1), b3 + hstepB, voffB);
            PG8_WAIT_V(6); PG8_BAR; PG8_MMA(1, 1, At, B1); PG8_BAR;
        }
        { const int tz = fresh_tid(wave_s), ln = tz & 63; E(acc, cur, wave_s >> 2, wave_s & 3, ln & 15, ln >> 4); }
        if (!has_next) break;
#pragma unroll
        for (int a = 0; a < 2; ++a)
#pragma unroll
            for (int b = 0; b < 2; ++b)
#pragma unroll
                for (int m = 0; m < 4; ++m)
#pragma unroll
                    for (int n = 0; n < 2; ++n) acc[a][b][m][n] = (f32x4){0.f, 0.f, 0.f, 0.f};
        cur = nxt; cA = nA; cB = nB; ++ui;
    }
    PG8_WAIT_V(0);
    if (wr == 0) PG8_BAR;
    PG8_BAR;
#undef PG8_SA
#undef PG8_SB
#undef PG8_STAGE
#undef PG8_VOFF
#undef PG8_LDA
#undef PG8_LDB
#undef PG8_MMA
#undef PG8_LO
#undef PG8_HI
#undef PG8_RDA
#undef PG8_RDB
#undef PG8_WAIT_V
#undef PG8_WAIT_L
#undef PG8_BAR
#undef PG8_SCHED
}
}

struct Frame {
    LAS unsigned char* lds;
    volatile LAS unsigned* MISC;
    unsigned* ctl;
    unsigned char* ws; unsigned char* ws0;
    const float* const* in;
    float* out;
    int tid, lane, wave, G, gw, NGW, wave0;
};
__device__ __forceinline__ void refresh(Frame& F) {
    unsigned ones = ~0u; asm volatile("" : "+s"(ones));
    int ln = (int)__builtin_amdgcn_mbcnt_hi(ones, __builtin_amdgcn_mbcnt_lo(ones, 0u)); asm volatile("" : "+v"(ln));
    int wv = F.wave0; asm volatile("" : "+s"(wv));
    F.lane = ln; F.wave = wv; F.tid = wv * 64 + ln; F.gw = blockIdx.x * 8 + wv;
    GAS unsigned char* w = (GAS unsigned char*)F.ws0; asm volatile("" : "+s"(w)); F.ws = (unsigned char*)w;
}

__constant__ unsigned char kBucket[128] = {0, 1, 2, 3, 4, 5, 6, 7, 8, 9, 10, 11, 12, 13, 14, 15, 16, 16, 16, 17, 17, 18, 18, 18, 19, 19, 19, 20, 20, 20, 20, 21, 21, 21, 21, 22, 22, 22, 22, 22, 23, 23, 23, 23, 23, 23, 24, 24, 24, 24, 24, 24, 25, 25, 25, 25, 25, 25, 25, 26, 26, 26, 26, 26, 26, 26, 26, 27, 27, 27, 27, 27, 27, 27, 27, 27, 27, 28, 28, 28, 28, 28, 28, 28, 28, 28, 28, 29, 29, 29, 29, 29, 29, 29, 29, 29, 29, 29, 29, 30, 30, 30, 30, 30, 30, 30, 30, 30, 30, 30, 30, 30, 30, 31, 31, 31, 31, 31, 31, 31, 31, 31, 31, 31, 31, 31, 31, 31};

__device__ __forceinline__ int win_src(int n, float& sc) {
    sc = 1.f;
    if (n < 544) { if (n < 256) sc = QS; else if (n >= 384 && n < 512) sc = IQS; return n; }
    if (n < 548) { sc = 0.5f; return n; }
    if (n < 560) return 1188 + (n - 548);
    if (n < 576) return -1;
    if (n < 832) { sc = QS; return 548 + (n - 576); }
    if (n < 1216) return 804 + (n - 832);
    if (n < 1728) { sc = QS; return 1200 + (n - 1216); }
    if (n < 2240) return 1712 + (n - 1728);
    if (n < 2752) return 2224 + (n - 2240);
    if (n < 5824) return 2736 + (n - 2752);
    return -1;
}
template <bool WIN>
__device__ __forceinline__ void p0_transpose_item(const float* W, int K, int Nsrc, int Ndst, bf16_t* WT, LAS float* scr, int item, int lane, int ldt = 0) {
    if (ldt == 0) ldt = K;
    const int nblk = Ndst / 32, kb = item / nblk, nb = item % nblk, k0 = 64 * kb, n0 = 32 * nb;
    if (WIN) { float sc = 1.f; const int src = win_src(n0 + (lane & 31), sc);
#pragma unroll 8
        for (int i = 0; i < 32; ++i) { const int kk = 2 * i + (lane >> 5); scr[kk * 33 + (lane & 31)] = (src >= 0) ? W[(size_t)(k0 + kk) * Nsrc + src] * sc : 0.f; }
    } else {
        f32x4 v[8];
#pragma unroll
        for (int i = 0; i < 8; ++i) v[i] = *(const f32x4*)(W + (size_t)(k0 + 8 * i + (lane >> 3)) * Nsrc + n0 + (lane & 7) * 4);
#pragma unroll
        for (int i = 0; i < 8; ++i) { LAS float* q = scr + (8 * i + (lane >> 3)) * 33 + (lane & 7) * 4; q[0] = v[i].x; q[1] = v[i].y; q[2] = v[i].z; q[3] = v[i].w; }
    }
    LDS_WAIT(); asm volatile("" ::: "memory");
    const int c = lane & 7;
#pragma unroll
    for (int j = 0; j < 4; ++j) { const int n = (lane >> 3) + 8 * j; const LAS float* s = scr + (8 * c) * 33 + n;
        u32x4 o; o.x = pk2(s[0 * 33], s[1 * 33]); o.y = pk2(s[2 * 33], s[3 * 33]); o.z = pk2(s[4 * 33], s[5 * 33]); o.w = pk2(s[6 * 33], s[7 * 33]);
        *(u32x4*)(WT + (size_t)(n0 + n) * ldt + k0 + 8 * c) = o; }
    LDS_WAIT(); asm volatile("" ::: "memory");
}

template <bool WIN>
__device__ __forceinline__ void p0_transpose_item_f8(const float* W, int K, int N, unsigned char* WT, float sc, LAS float* scr, int item, int lane, int Nsrc = 0, int ncol0 = 0) {
    const int nblk = N / 32, kb = item / nblk, nb = item % nblk, k0 = 64 * kb, n0 = 32 * nb;
    if (WIN) { float s1 = 1.f; const int src = win_src(ncol0 + n0 + (lane & 31), s1);
#pragma unroll 8
        for (int i = 0; i < 32; ++i) { const int kk = 2 * i + (lane >> 5); scr[kk * 33 + (lane & 31)] = (src >= 0) ? W[(size_t)(k0 + kk) * Nsrc + src] * (s1 * sc) : 0.f; }
    } else
    { f32x4 v[8];
#pragma unroll
      for (int i = 0; i < 8; ++i) v[i] = *(const f32x4*)(W + (size_t)(k0 + 8 * i + (lane >> 3)) * N + n0 + (lane & 7) * 4);
#pragma unroll
      for (int i = 0; i < 8; ++i) { LAS float* q = scr + (8 * i + (lane >> 3)) * 33 + (lane & 7) * 4; q[0] = v[i].x * sc; q[1] = v[i].y * sc; q[2] = v[i].z * sc; q[3] = v[i].w * sc; } }
    LDS_WAIT(); asm volatile("" ::: "memory");
    const int c = lane & 3;
#pragma unroll
    for (int j = 0; j < 2; ++j) { const int n = (lane >> 2) + 16 * j; const LAS float* q = scr + (16 * c) * 33 + n;
        u32x4 o; o.x = pk4_fp8(q[0 * 33], q[1 * 33], q[2 * 33], q[3 * 33]); o.y = pk4_fp8(q[4 * 33], q[5 * 33], q[6 * 33], q[7 * 33]);
        o.z = pk4_fp8(q[8 * 33], q[9 * 33], q[10 * 33], q[11 * 33]); o.w = pk4_fp8(q[12 * 33], q[13 * 33], q[14 * 33], q[15 * 33]);
        *(u32x4*)(WT + (size_t)(n0 + n) * K + k0 + 16 * c) = o; }
    LDS_WAIT(); asm volatile("" ::: "memory");
}
__device__ __forceinline__ void phase_prologue(Frame& F) {
    const float* const* in = F.in;
    LAS float* scr = (LAS float*)(F.lds + F.wave * 16384);
    constexpr int I_WIN = 16 * (N_BF / 32), I_WMG = 16 * (N_F8 / 32);
    constexpr int I_BA = 4 * 32, I_BC = 8 * 32, I_WO = 16 * 32, I_W1 = 32 * 8, I_W2 = 4 * 2;
    constexpr int I_GU = 16 * 64, I_DN = 16 * 32;
    constexpr int N_GU = 64 * I_GU, N_DN = 64 * I_DN, N_WIN = 2 * I_WIN, N_BA = 2 * I_BA, N_BC = 2 * I_BC, N_WO = 2 * I_WO, N_W1 = 4 * I_W1, N_W2 = 4 * I_W2, N_WMG = 2 * I_WMG;
    constexpr int NITEMS = N_GU + N_DN + N_WIN + N_WMG + 2 * N_BA + N_BC + N_WO + N_W1 + N_W2;
    for (int it = F.gw; it < NITEMS; it += F.NGW) {
        int r = it;
        if (r < N_GU) { const int m = r / I_GU; p0_transpose_item_f8<false>(in[21] + (size_t)m * 1024 * 2048, 1024, 2048, (unsigned char*)(F.ws + WS_WGU_T) + (size_t)m * 2048 * 1024, F8_WGU, scr, r % I_GU, F.lane); continue; } r -= N_GU;
        if (r < N_DN) { const int m = r / I_DN; p0_transpose_item_f8<false>(in[23] + (size_t)m * 1024 * 1024, 1024, 1024, (unsigned char*)(F.ws + WS_WDN_T) + (size_t)m * 1024 * 1024, F8_WDN, scr, r % I_DN, F.lane); continue; } r -= N_DN;
        if (r < N_WIN) { const int m = r / I_WIN; p0_transpose_item<true>(in[5] + (size_t)m * 1024 * D_IN, 1024, D_IN, N_BF, (bf16_t*)(F.ws + WS_WIN_T) + (size_t)m * DP * 1024, scr, r % I_WIN, F.lane); continue; } r -= N_WIN;
        if (r < N_WMG) { const int m = r / I_WMG; p0_transpose_item_f8<true>(in[5] + (size_t)m * 1024 * D_IN, 1024, N_F8, (unsigned char*)(F.ws + WS_WMG8) + (size_t)m * N_F8 * 1024, F8_WIN, scr, r % I_WMG, F.lane, D_IN, C_MG); continue; } r -= N_WMG;
        if (r < N_BA) { const int m = r / I_BA; p0_transpose_item<false>(in[11] + (size_t)m * 256 * 1024, 256, 1024, 1024, (bf16_t*)(F.ws + WS_WBR_T + m * 2 * MiB), scr, r % I_BA, F.lane, 1024); continue; } r -= N_BA;
        if (r < N_BA) { const int m = r / I_BA; p0_transpose_item<false>(in[12] + (size_t)m * 256 * 1024, 256, 1024, 1024, (bf16_t*)(F.ws + WS_WBR_T + m * 2 * MiB) + 256, scr, r % I_BA, F.lane, 1024); continue; } r -= N_BA;
        if (r < N_BC) { const int m = r / I_BC; p0_transpose_item<false>(in[13] + (size_t)m * 512 * 1024, 512, 1024, 1024, (bf16_t*)(F.ws + WS_WBR_T + m * 2 * MiB) + 512, scr, r % I_BC, F.lane, 1024); continue; } r -= N_BC;
        if (r < N_WO) { const int m = r / I_WO; p0_transpose_item<false>(in[14] + (size_t)m * 1024 * 1024, 1024, 1024, 1024, (bf16_t*)(F.ws + WS_WOUT_T) + (size_t)m * 1024 * 1024, scr, r % I_WO, F.lane); continue; } r -= N_WO;
        if (r < N_W1) { const int m = r / I_W1; p0_transpose_item<false>(in[7] + (size_t)m * 2048 * 256, 2048, 256, 256, (bf16_t*)(F.ws + WS_W1_T) + (size_t)m * 256 * 2048, scr, r % I_W1, F.lane); continue; } r -= N_W1;
        { const int m = r / I_W2; p0_transpose_item<false>(in[8] + (size_t)m * 256 * 64, 256, 64, 64, (bf16_t*)(F.ws + WS_W2_T) + (size_t)m * 64 * 256, scr, r % I_W2, F.lane); }
    }
    __syncthreads();
    if (blockIdx.x < 27) {
        LAS float* sc = (LAS float*)F.lds;
        for (int i = F.tid; i < 16 * 1024; i += 512) { const int b = i >> 10, k = i & 1023; const float v = in[1][i]; sc[k * 16 + b] = v * fsigmoid(v); }
        __syncthreads();
        if (F.gw < 192) {
            const int which = F.gw / 48, cb = F.gw % 48, layer = which >> 1, col = cb * 64 + F.lane;
            const float* W = (which & 1 ? in[17] : in[3]) + (size_t)layer * 1024 * 3072;
            const float* Bv = (which & 1 ? in[18] : in[4]) + (size_t)layer * 3072;
            float acc[16];
#pragma unroll
            for (int b = 0; b < 16; ++b) acc[b] = 0.f;
#pragma unroll 4
            for (int k = 0; k < 1024; ++k) { const float w = W[(size_t)k * 3072 + col];
                const f32x4 s0 = *(const LAS f32x4*)(sc + k * 16), s1 = *(const LAS f32x4*)(sc + k * 16 + 4), s2 = *(const LAS f32x4*)(sc + k * 16 + 8), s3 = *(const LAS f32x4*)(sc + k * 16 + 12);
#pragma unroll
                for (int q = 0; q < 4; ++q) { acc[q] += s0[q] * w; acc[4 + q] += s1[q] * w; acc[8 + q] += s2[q] * w; acc[12 + q] += s3[q] * w; } }
            float* mod = (float*)(F.ws + WS_MOD) + (size_t)which * 16 * 3072;
            const float bb = Bv[col];
#pragma unroll
            for (int b = 0; b < 16; ++b) mod[(size_t)b * 3072 + col] = acc[b] + bb;
        } else if (F.gw < 208) {
            const int u = F.gw - 192, m = u >> 2, n = (u & 3) * 64 + F.lane;
            const float* P = in[6] + (size_t)m * 2048; const float* W = in[7] + (size_t)m * 2048 * 256;
            float a = 0.f;
#pragma unroll 8
            for (int r = 0; r < 2048; ++r) a += P[r] * W[(size_t)r * 256 + n];
            ((float*)(F.ws + WS_BIAS1))[m * 256 + n] = a;
        } else if (F.gw == 208) {
            float* lut = (float*)(F.ws + WS_LUT);
            for (int i = F.lane; i < 12 * 128; i += 64) { const int h = i >> 7, d = i & 127; lut[i] = (in[2][kBucket[d] * 12 + h] - in[2][31 * 12 + h]) * LOG2E; }
            for (int l = 0; l < 2; ++l) { const float* dl = in[9] + l * 256;
                const float s1 = wave_sum(dl[F.lane] * dl[64 + F.lane], F.lane), s2 = wave_sum(dl[128 + F.lane] * dl[192 + F.lane], F.lane);
                const float lam_init = 0.8f - 0.6f * __expf(-0.3f * (float)l);
                if (F.lane == 0) ((float*)(F.ws + WS_LAM))[l] = __expf(s1) - __expf(s2) + lam_init; }
        }
    }
}

__device__ __forceinline__ void phase_h0(Frame& F, const float* X, const float* mod, bf16_t* HB, unsigned char* HB8) {
    for (int row = F.gw; row < NTOK; row += F.NGW) { const int b = row >> 12;
        const f32x4* xr = (const f32x4*)(X + (size_t)row * 1024) + F.lane; const f32x4* sh = (const f32x4*)(mod + (size_t)b * 3072) + F.lane; const f32x4* sc = (const f32x4*)(mod + (size_t)b * 3072 + 1024) + F.lane;
        u64* o8 = (u64*)(HB + (size_t)row * 1024) + F.lane; unsigned* q8 = (unsigned*)(HB8 + (size_t)row * 1024) + F.lane;
#pragma unroll
        for (int j = 0; j < 4; ++j) { const f32x4 v = xr[64 * j] * (sc[64 * j] + 1.0f) + sh[64 * j]; o8[64 * j] = (u64)pk2(v.x, v.y) | ((u64)pk2(v.z, v.w) << 32);
            q8[64 * j] = pk4_fp8(F8_H * v.x, F8_H * v.y, F8_H * v.z, F8_H * v.w); } }
}
__device__ __forceinline__ void ln_stats(const f32x4 (&v)[4], float& mean, float& rstd, int lane) {
    float s = 0.f;
#pragma unroll
    for (int j = 0; j < 4; ++j) s += (v[j].x + v[j].y) + (v[j].z + v[j].w);
    mean = wave_sum(s, lane) * (1.f / 1024.f); float s2 = 0.f;
#pragma unroll
    for (int j = 0; j < 4; ++j) { const f32x4 d = v[j] - mean; s2 += (d.x * d.x + d.y * d.y) + (d.z * d.z + d.w * d.w); }
    rstd = 1.f / sqrtf(wave_sum(s2, lane) * (1.f / 1024.f) + LN_EPS);
}

__device__ __forceinline__ void phase_ln1_router(Frame& F, bf16_t* Z, const float* g1, const float* b1, const float* mod, const float* rw, const float* rb, bf16_t* HB, unsigned* cnt) {
    LAS float* rwT = (LAS float*)F.lds;
    for (int i = F.tid; i < 32 * 1024; i += 512) { const int k = i >> 5, e = i & 31; rwT[e * 1024 + k] = rw[i]; }
    __syncthreads();
    const int lane = F.lane, e_l = lane >> 1;
    const float rbias = rb[e_l];
    unsigned slot0 = 0, slot1 = 0; unsigned cnt_local = 0;
    f32x4 gg[4], bb[4];
#pragma unroll
    for (int j = 0; j < 4; ++j) { gg[j] = ((const f32x4*)g1)[lane + 64 * j]; bb[j] = ((const f32x4*)b1)[lane + 64 * j]; }
    int it = 0;
    for (int row = F.gw; row < NTOK; row += F.NGW, ++it) { const int b = row >> 12;
        u32x2* zr = (u32x2*)(Z + (size_t)row * 1024) + lane; const f32x4* sh = (const f32x4*)(mod + (size_t)b * 3072) + lane; const f32x4* sc = (const f32x4*)(mod + (size_t)b * 3072 + 1024) + lane;
        f32x4 v[4];
#pragma unroll
        for (int j = 0; j < 4; ++j) { const u32x2 q = zr[64 * j]; v[j] = (f32x4){bflo(q.x), bfhi(q.x), bflo(q.y), bfhi(q.y)}; }
        float mean, rstd; ln_stats(v, mean, rstd, lane);
        u64* o8 = (u64*)(HB + (size_t)row * 1024) + lane;
        f32x4 h[4];
#pragma unroll
        for (int j = 0; j < 4; ++j) { const f32x4 xn = (v[j] - mean) * rstd * gg[j] + bb[j]; zr[64 * j] = (u32x2){cvt_pk_bf16(xn.x, xn.y), cvt_pk_bf16(xn.z, xn.w)}; h[j] = xn * (sc[64 * j] + 1.0f) + sh[64 * j];
            o8[64 * j] = (u64)pk2(h[j].x, h[j].y) | ((u64)pk2(h[j].z, h[j].w) << 32); }
        float a[32];
#pragma unroll
        for (int e = 0; e < 32; ++e) { float s = 0.f;
#pragma unroll
            for (int j = 0; j < 4; ++j) { const f32x4 w = *(const LAS f32x4*)(rwT + e * 1024 + 4 * lane + 256 * j); s += (h[j].x * w.x + h[j].y * w.y) + (h[j].z * w.z + h[j].w * w.w); }
            a[e] = s; if ((e & 3) == 3) __builtin_amdgcn_sched_barrier(0); }
#pragma unroll
        for (int st = 0; st < 5; ++st) { const int half = 16 >> st, x = 32 >> st; const bool up = (lane & x) != 0;
#pragma unroll
            for (int i = 0; i < half; ++i) { const float send = up ? a[i] : a[i + half], keep = up ? a[i + half] : a[i]; a[i] = keep + (st == 0 ? other32(send, lane) : shx_f(send, x, lane)); } }
        float lg = a[0] + shx_f(a[0], 1, lane) + rbias;
        float tv[4]; int te[4];
#pragma unroll
        for (int k = 0; k < 4; ++k) { float bv = lg; int be = e_l;
#pragma unroll
            for (int x = 2; x < 64; x <<= 1) { const float ov = shx_f(bv, x, lane); const int oe = shx_i(be, x, lane); if (ov > bv || (ov == bv && oe < be)) { bv = ov; be = oe; } }
            tv[k] = bv; te[k] = be; if (e_l == be) lg = -INFINITY; }
        const float e1 = __expf(tv[1] - tv[0]), e2 = __expf(tv[2] - tv[0]), e3 = __expf(tv[3] - tv[0]); const float inv = 1.f / (1.f + e1 + e2 + e3);
        if (lane == 0) { *(int4*)((int*)(F.ws + WS_TOKE) + (size_t)row * 4) = make_int4(te[0], te[1], te[2], te[3]);
            *(f32x4*)((float*)(F.ws + WS_TOKW) + (size_t)row * 4) = (f32x4){inv, e1 * inv, e2 * inv, e3 * inv}; }
#pragma unroll
        for (int k = 0; k < 4; ++k) { const int ek = __builtin_amdgcn_readfirstlane(te[k]); const unsigned rk = (unsigned)__builtin_amdgcn_readlane((int)cnt_local, ek);
            if (lane == ek) ++cnt_local;
            const int idx = it * 4 + k; const unsigned val = ((unsigned)ek << 16) | rk;
            if (lane == (idx & 63)) { if (idx < 64) slot0 = val; else slot1 = val; } }
    }
    unsigned base = 0;
    if (lane < 32) base = __hip_atomic_fetch_add(cnt + lane, cnt_local, __ATOMIC_RELAXED, __HIP_MEMORY_SCOPE_AGENT);
#pragma unroll
    for (int s = 0; s < 2; ++s) { const unsigned val = s ? slot1 : slot0; const int e = (int)(val >> 16); const unsigned pos = (unsigned)bperm_i(e, (int)base) + (val & 0xffffu);
        const int i = (64 * s + lane) >> 2, k = lane & 3; const int row = F.gw + i * F.NGW;
        if (i < it) ((int*)(F.ws + WS_TOKP))[(size_t)row * 4 + k] = (int)pos; }
    __syncthreads();
}

__device__ __forceinline__ void build_pstart(Frame& F, const unsigned* cnt) {
    if (F.tid == 0) { int p = 0; for (int e = 0; e < 32; ++e) { F.MISC[16 + e] = (unsigned)p; p += (int)((__hip_atomic_load(cnt + e, __ATOMIC_RELAXED, __HIP_MEMORY_SCOPE_AGENT) + 255u) >> 8); } F.MISC[48] = (unsigned)p; }
    __syncthreads();
}
__device__ __forceinline__ void phase_gather(Frame& F, const unsigned* cnt, const bf16_t* HB, unsigned char* HS) {
    build_pstart(F, cnt);
    for (int row = F.gw; row < NTOK; row += F.NGW) {
        const int4 te = *(const int4*)((const int*)(F.ws + WS_TOKE) + (size_t)row * 4), tp = *(const int4*)((const int*)(F.ws + WS_TOKP) + (size_t)row * 4);
        const int r0 = (int)F.MISC[16 + te.x] * 256 + tp.x, r1 = (int)F.MISC[16 + te.y] * 256 + tp.y, r2 = (int)F.MISC[16 + te.z] * 256 + tp.z, r3 = (int)F.MISC[16 + te.w] * 256 + tp.w;
        if (F.lane == 0) *(int4*)((int*)(F.ws + WS_TOKR) + (size_t)row * 4) = make_int4(r0, r1, r2, r3);
        const u32x4* src = (const u32x4*)(HB + (size_t)row * 1024) + 2 * F.lane; const u32x4 a = src[0], b = src[1];
        u32x4 v;
        v.x = pk4_fp8(F8_H * bflo(a.x), F8_H * bfhi(a.x), F8_H * bflo(a.y), F8_H * bfhi(a.y)); v.y = pk4_fp8(F8_H * bflo(a.z), F8_H * bfhi(a.z), F8_H * bflo(a.w), F8_H * bfhi(a.w));
        v.z = pk4_fp8(F8_H * bflo(b.x), F8_H * bfhi(b.x), F8_H * bflo(b.y), F8_H * bfhi(b.y)); v.w = pk4_fp8(F8_H * bflo(b.z), F8_H * bfhi(b.z), F8_H * bflo(b.w), F8_H * bfhi(b.w));
        ((u32x4*)(HS + (size_t)r0 * 1024))[F.lane] = v; ((u32x4*)(HS + (size_t)r1 * 1024))[F.lane] = v; ((u32x4*)(HS + (size_t)r2 * 1024))[F.lane] = v; ((u32x4*)(HS + (size_t)r3 * 1024))[F.lane] = v;
    }
    if (blockIdx.x < 32) { const int e = blockIdx.x; const int c = (int)__hip_atomic_load(cnt + e, __ATOMIC_RELAXED, __HIP_MEMORY_SCOPE_AGENT);
        const int rbeg = (int)F.MISC[16 + e] * 256 + c, rend = (int)F.MISC[17 + e] * 256;
        for (int r = rbeg + F.wave; r < rend; r += 8) ((u32x4*)(HS + (size_t)r * 1024))[F.lane] = (u32x4){0u, 0u, 0u, 0u}; }
}
__device__ __forceinline__ void phase_combine(Frame& F, const bf16_t* YS, const bf16_t* X1, const float* modf, const float* g2, const float* b2, float* XO, const float* modn, bf16_t* HB, unsigned char* HB8, bf16_t* X2B) {
    const int lane = F.lane;
    f32x4 gg[4], bb[4];
#pragma unroll
    for (int q = 0; q < 4; ++q) { gg[q] = ((const f32x4*)g2)[128 * (q >> 1) + 2 * lane + (q & 1)]; bb[q] = ((const f32x4*)b2)[128 * (q >> 1) + 2 * lane + (q & 1)]; }
    for (int row = F.gw; row < NTOK; row += F.NGW) { const int b = row >> 12;
        const int4 tr = *(const int4*)((const int*)(F.ws + WS_TOKR) + (size_t)row * 4); const f32x4 tw = *(const f32x4*)((const float*)(F.ws + WS_TOKW) + (size_t)row * 4);
        const int rr[4] = {tr.x, tr.y, tr.z, tr.w}; const float ww[4] = {tw.x, tw.y, tw.z, tw.w};
        u32x4 yq[4][2];
#pragma unroll
        for (int k = 0; k < 4; ++k)
#pragma unroll
            for (int c = 0; c < 2; ++c) yq[k][c] = ((const u32x4*)(YS + (size_t)rr[k] * 1024))[64 * c + lane];
        u32x4 xq[2];
#pragma unroll
        for (int c = 0; c < 2; ++c) xq[c] = ((const u32x4*)(X1 + (size_t)row * 1024))[64 * c + lane];
        const f32x4* gt = (const f32x4*)(modf + (size_t)b * 3072 + 2048);
        f32x4 v[4];
#pragma unroll
        for (int c = 0; c < 2; ++c) { f32x4 y0 = (f32x4){0.f, 0.f, 0.f, 0.f}, y1 = y0;
#pragma unroll
            for (int k = 0; k < 4; ++k) { const u32x4 w = yq[k][c]; y0 += (f32x4){bflo(w.x), bfhi(w.x), bflo(w.y), bfhi(w.y)} * ww[k]; y1 += (f32x4){bflo(w.z), bfhi(w.z), bflo(w.w), bfhi(w.w)} * ww[k]; }
            const u32x4 q = xq[c];
            v[2 * c] = (f32x4){bflo(q.x), bfhi(q.x), bflo(q.y), bfhi(q.y)} * DN_ALPHA + (gt[128 * c + 2 * lane] + 1.0f) * y0;
            v[2 * c + 1] = (f32x4){bflo(q.z), bfhi(q.z), bflo(q.w), bfhi(q.w)} * DN_ALPHA + (gt[128 * c + 2 * lane + 1] + 1.0f) * y1; }
        float mean, rstd; ln_stats(v, mean, rstd, lane);
        if (modn) { const f32x4* sh = (const f32x4*)(modn + (size_t)b * 3072); const f32x4* sc = (const f32x4*)(modn + (size_t)b * 3072 + 1024);
#pragma unroll
            for (int c = 0; c < 2; ++c) { const f32x4 x0 = (v[2 * c] - mean) * rstd * gg[2 * c] + bb[2 * c], x1 = (v[2 * c + 1] - mean) * rstd * gg[2 * c + 1] + bb[2 * c + 1];
                ((u32x4*)(X2B + (size_t)row * 1024))[64 * c + lane] = (u32x4){cvt_pk_bf16(x0.x, x0.y), cvt_pk_bf16(x0.z, x0.w), cvt_pk_bf16(x1.x, x1.y), cvt_pk_bf16(x1.z, x1.w)};
                const f32x4 h0 = x0 * (sc[128 * c + 2 * lane] + 1.0f) + sh[128 * c + 2 * lane], h1 = x1 * (sc[128 * c + 2 * lane + 1] + 1.0f) + sh[128 * c + 2 * lane + 1];
                ((u32x4*)(HB + (size_t)row * 1024))[64 * c + lane] = (u32x4){cvt_pk_bf16(h0.x, h0.y), cvt_pk_bf16(h0.z, h0.w), cvt_pk_bf16(h1.x, h1.y), cvt_pk_bf16(h1.z, h1.w)};
                ((u32x2*)(HB8 + (size_t)row * 1024))[64 * c + lane] = (u32x2){pk4_fp8(F8_H * h0.x, F8_H * h0.y, F8_H * h0.z, F8_H * h0.w), pk4_fp8(F8_H * h1.x, F8_H * h1.y, F8_H * h1.z, F8_H * h1.w)}; }
        } else {
#pragma unroll
            for (int q = 0; q < 4; ++q) ((f32x4*)(XO + (size_t)row * 1024))[128 * (q >> 1) + 2 * lane + (q & 1)] = (v[q] - mean) * rstd * gg[q] + bb[q];
        }
    }
}

__device__ __forceinline__ unsigned okey24(float v) { if (v == 0.f) v = 0.f; unsigned u = __builtin_bit_cast(unsigned, v); u = (u & 0x80000000u) ? ~u : (u | 0x80000000u); return u >> 8; }
__device__ __forceinline__ f32x4 idx_score(const bf16x8 ka, const bf16x8 (&qb)[4], const float (&w4)[4]) {
    f32x4 s = (f32x4){0.f, 0.f, 0.f, 0.f};
#pragma unroll
    for (int h = 0; h < 4; ++h) { const f32x4 c = __builtin_amdgcn_mfma_f32_16x16x32_bf16(ka, qb[h], (f32x4){0.f, 0.f, 0.f, 0.f}, 0, 0, 0);
#pragma unroll
        for (int j = 0; j < 4; ++j) s[j] += w4[h] * fmaxf(c[j], 0.f); }
    return s;
}
__device__ __forceinline__ void scan_row(const volatile LAS unsigned* hw, unsigned need, int lane, int& bin, unsigned& above, unsigned& cntb) {
    unsigned s = 0;
#pragma unroll 8
    for (int i = 0; i < 32; ++i) { const unsigned wv = hw[32 * lane + ((i + lane) & 31)]; s += (wv & 0xffffu) + (wv >> 16); }
    unsigned S = s;
#pragma unroll
    for (int o = 1; o < 64; o <<= 1) { const unsigned t = (unsigned)bperm_i((lane + o) & 63, (int)S); if (lane + o < 64) S += t; }
    const u64 bal = __ballot(S >= need);
    const int L = bal ? 63 - __clzll((long long)bal) : 0;
    const unsigned Snext = (unsigned)bperm_i((L + 1) & 63, (int)S);
    const unsigned aboveL = (L < 63) ? Snext : 0u;
    const int bi = 63 - lane; const unsigned wv = hw[32 * L + (bi >> 1)]; const unsigned c = (bi & 1) ? (wv >> 16) : (wv & 0xffffu);
    unsigned Pj = c;
#pragma unroll
    for (int o = 1; o < 64; o <<= 1) { const unsigned t = (unsigned)bperm_i((lane - o) & 63, (int)Pj); if (lane >= o) Pj += t; }
    Pj += aboveL;
    const u64 hit = __ballot(Pj >= need);
    const int js = hit ? __ffsll((long long)hit) - 1 : 63;
    bin = 64 * L + 63 - js; cntb = (unsigned)bperm_i(js, (int)c); above = (unsigned)bperm_i(js, (int)Pj) - cntb;
}
template <int PASS>
__device__ __forceinline__ void dsa_pass(Frame& F, const bf16_t* kbase, unsigned* KS, const bf16x8 (&qb)[4], const float (&w4)[4], int nkt, int tq, unsigned r_a, unsigned r_b) {
    const int lane = F.lane, fr = lane & 15, fq = lane >> 4;
    LAS unsigned* hist = (LAS unsigned*)F.lds;
    const int kt0 = F.wave; if (kt0 >= nkt) return;
    u32x4* ksl = (u32x4*)KS + lane;
    u32x4 kc[4], kn[4];
#pragma unroll
    for (int u = 0; u < 4; ++u) { kc[u] = (u32x4){0u, 0u, 0u, 0u}; if (kt0 + 8 * u < nkt) kc[u] = (PASS == 1) ? __builtin_bit_cast(u32x4, *(const bf16x8*)(kbase + (size_t)(kt0 + 8 * u) * 16 * DP)) : ksl[(size_t)(kt0 + 8 * u) * 64]; }
    for (int kg = kt0; kg < nkt; kg += 32) {
#pragma unroll
        for (int u = 0; u < 4; ++u) { kn[u] = kc[u]; if (kg + 32 + 8 * u < nkt) kn[u] = (PASS == 1) ? __builtin_bit_cast(u32x4, *(const bf16x8*)(kbase + (size_t)(kg + 32 + 8 * u) * 16 * DP)) : ksl[(size_t)(kg + 32 + 8 * u) * 64]; }
#pragma unroll
        for (int u = 0; u < 4; ++u) { const int kt = kg + 8 * u;
            if (kt < nkt) {
                unsigned kk[4];
                if (PASS == 1) { const f32x4 sc = idx_score(__builtin_bit_cast(bf16x8, kc[u]), qb, w4);
#pragma unroll
                    for (int j = 0; j < 4; ++j) { const int s = kt * 16 + 4 * fq + j; kk[j] = okey24(sc[j]) | ((s <= tq) ? 0x80000000u : 0u); }
                    ksl[(size_t)kt * 64] = (u32x4){kk[0], kk[1], kk[2], kk[3]};
                } else { kk[0] = kc[u].x; kk[1] = kc[u].y; kk[2] = kc[u].z; kk[3] = kc[u].w; }
                unsigned nd = 0, nt_ = 0;
#pragma unroll
                for (int j = 0; j < 4; ++j) { const bool valid = (kk[j] >> 31) != 0u; const unsigned key = kk[j] & 0xffffffu;
                    if (PASS == 1) { if (valid) { const unsigned bin = key >> 12; __hip_atomic_fetch_add(hist + fr * 2048 + (bin >> 1), 1u << (16 * (bin & 1)), __ATOMIC_RELAXED, __HIP_MEMORY_SCOPE_WORKGROUP); } }
                    if (PASS == 2) { if (valid && (key >> 12) == r_a) { const unsigned bin = key & 4095u; __hip_atomic_fetch_add(hist + fr * 2048 + (bin >> 1), 1u << (16 * (bin & 1)), __ATOMIC_RELAXED, __HIP_MEMORY_SCOPE_WORKGROUP); } }
                    if (PASS == 3) { if (valid) { if (DSA_FAKE) nd |= 1u << j; else { nd |= (key > r_a ? 1u : 0u) << j; nt_ |= (key == r_a ? 1u : 0u) << j; } } } }
                if (PASS == 3) { const int sh = 16 * (kt & 1) + 4 * fq; const int wd = fr * 128 + (kt >> 1);
                    if (nd) __hip_atomic_fetch_or(hist + wd, nd << sh, __ATOMIC_RELAXED, __HIP_MEMORY_SCOPE_WORKGROUP);
                    if (nt_) __hip_atomic_fetch_or(hist + 2048 + wd, nt_ << sh, __ATOMIC_RELAXED, __HIP_MEMORY_SCOPE_WORKGROUP); }
            } }
#pragma unroll
        for (int u = 0; u < 4; ++u) kc[u] = kn[u];
    }
}
__device__ __forceinline__ void lds_zero(Frame& F, int bytes) {
    LAS u32x4* p = (LAS u32x4*)F.lds; unsigned z = 0u; asm volatile("" : "+v"(z));
    for (int i = F.tid; i < bytes / 16; i += 512) p[i] = (u32x4){z, z, z, z};
}
__device__ __forceinline__ void dsa_select_tile(Frame& F, const bf16_t* P, u64* BM, unsigned* KS, int b, int qt) {
    volatile LAS unsigned* rinfo = F.MISC + 64;
    volatile LAS unsigned* hist = (volatile LAS unsigned*)F.lds;
    const int lane = F.lane, fr = lane & 15, fq = lane >> 4, w = F.wave;
    const int t0 = qt * 16, nkt = qt + 1; const size_t rowbase = (size_t)b * 4096;
    const bf16_t* qrow = P + (rowbase + t0 + fr) * DP;
    bf16x8 qb[4];
#pragma unroll
    for (int h = 0; h < 4; ++h) qb[h] = *(const bf16x8*)(qrow + C_IQ + h * 32 + 8 * fq);
    const u32x2 iwp = *(const u32x2*)(qrow + C_IW); const float w4[4] = {bflo(iwp.x), bfhi(iwp.x), bflo(iwp.y), bfhi(iwp.y)};
    const bf16_t* kbase = P + (rowbase + fr) * DP + C_IK + 8 * fq;
    const int tq = t0 + fr;
    if (qt >= 16 && !DSA_FAKE) {
        lds_zero(F, 131072); __syncthreads();
        dsa_pass<1>(F, kbase, KS, qb, w4, nkt, tq, 0u, 0u);
        __syncthreads();
#pragma unroll 1
        for (int rr = 0; rr < 2; ++rr) { const int r = 2 * w + rr; int bin; unsigned above, cb; scan_row(hist + r * 2048, 256u, lane, bin, above, cb);
            if (lane == 0) { rinfo[r * 4 + 0] = (unsigned)bin; rinfo[r * 4 + 1] = 256u - above; } }
        __syncthreads();
        lds_zero(F, 131072); __syncthreads();
        dsa_pass<2>(F, kbase, KS, qb, w4, nkt, tq, rinfo[fr * 4 + 0], 0u);
        __syncthreads();
#pragma unroll 1
        for (int rr = 0; rr < 2; ++rr) { const int r = 2 * w + rr; const unsigned b1 = rinfo[r * 4 + 0], rem1 = rinfo[r * 4 + 1]; int bin; unsigned above, cb; scan_row(hist + r * 2048, rem1, lane, bin, above, cb);
            if (lane == 0) { const unsigned take = rem1 - above; rinfo[r * 4 + 0] = (b1 << 12) | (unsigned)bin; rinfo[r * 4 + 1] = take; rinfo[r * 4 + 2] = (cb > take) ? 1u : 0u; } }
        __syncthreads();
    } else {
        if (F.tid < 16) { rinfo[F.tid * 4 + 0] = 0u; rinfo[F.tid * 4 + 1] = 0xffffffffu; rinfo[F.tid * 4 + 2] = 0u; }
        dsa_pass<1>(F, kbase, KS, qb, w4, nkt, tq, 0u, 0u);
        __syncthreads();
    }
    lds_zero(F, 16384); __syncthreads();
    dsa_pass<3>(F, kbase, KS, qb, w4, nkt, tq, rinfo[fr * 4 + 0], 0u);
    __syncthreads();
    volatile LAS u64* FIN = (volatile LAS u64*)(F.lds + 16384);
#pragma unroll 1
    for (int rr = 0; rr < 2; ++rr) { const int r = 2 * w + rr;
        const u64 def = (u64)hist[r * 128 + 2 * lane] | ((u64)hist[r * 128 + 2 * lane + 1] << 32);
        u64 tie = (u64)hist[2048 + r * 128 + 2 * lane] | ((u64)hist[2048 + r * 128 + 2 * lane + 1] << 32);
        if (rinfo[r * 4 + 2]) { const int take = (int)rinfo[r * 4 + 1]; const int c = __popcll(tie); int inc = c;
#pragma unroll
            for (int o = 1; o < 64; o <<= 1) { const int t = bperm_i((lane - o) & 63, inc); if (lane >= o) inc += t; }
            int tk = take - (inc - c); tk = tk < 0 ? 0 : (tk > c ? c : tk);
            while (__popcll(tie) > tk) tie &= ~(1ull << (63 - __clzll((long long)tie))); }
        FIN[lane * 16 + r] = def | tie; }
    __syncthreads();
#pragma unroll
    for (int k = 0; k < 2; ++k) { const int idx = F.tid + 512 * k, l = idx >> 4, r = idx & 15;
        if (l <= (t0 >> 6)) BM[((size_t)(b * 64 + l) * 4096) + t0 + r] = FIN[l * 16 + r]; }
    __builtin_amdgcn_fence(__ATOMIC_ACQUIRE, "agent");
    __syncthreads();
}

#define MFMA32(a, b, c) __builtin_amdgcn_mfma_f32_32x32x16_bf16(a, b, c, 0, 0, 0)
typedef short v4i16_t __attribute__((ext_vector_type(4)));
__device__ __forceinline__ s16x4 vtr(const LAS unsigned char* p) { return __builtin_bit_cast(s16x4, __builtin_amdgcn_ds_read_tr16_b64_v4i16((LAS v4i16_t*)p)); }
constexpr int AT_KBUF = 0, AT_VBUF = 16384, AT_WSF = 49152, AT_LUT = 51200, AT_IMP = 57344, AT_RMASK = 124928, AT_WOR = 125440;
enum { MK_C = 0, MK_A = 1, MK_WIN = 2, MK_SLC = 3, MK_CMP = 4 };
constexpr float ATT_THR = 8.f;

template <int VD> struct AState { f32x16 o[VD / 32]; float m, l; };
template <int VD> __device__ __forceinline__ void astate_init(AState<VD>& s) {
#pragma unroll
    for (int d = 0; d < VD / 32; ++d)
#pragma unroll
        for (int r = 0; r < 16; ++r) s.o[d][r] = 0.f;
    s.m = -1e30f; s.l = 0.f;
}
template <int VD>
__device__ __forceinline__ void stage_kv(LAS unsigned char* kbuf, LAS unsigned char* vbuf, const bf16_t* Kt, int ldk, const bf16_t* Vt, int ldv, int wave, int lane, bool with_v) {
    __builtin_amdgcn_global_load_lds((const unsigned*)(Kt + (size_t)lane * ldk + wave * 8), (LAS unsigned*)(kbuf + wave * 1024), 16, 0, 0);
    if (with_v) {
#pragma unroll
        for (int pc0 = 0; pc0 < VD / 8; pc0 += 8) { const int pc = pc0 + wave;
            __builtin_amdgcn_global_load_lds((const unsigned*)(Vt + (size_t)(16 * (pc & 3) + (lane >> 2)) * ldv + (pc >> 2) * 32 + (lane & 3) * 8), (LAS unsigned*)(vbuf + pc * 1024), 16, 0, 0); }
    }
}
__device__ __forceinline__ void qk_tile(f32x16& S0, f32x16& S1, const bf16x8 (&qr)[4], const LAS unsigned char* kbuf, int r32, int hi) {
    const LAS unsigned char* kp = kbuf + hi * 1024 + r32 * 16;
#pragma unroll
    for (int r = 0; r < 16; ++r) { S0[r] = 0.f; S1[r] = 0.f; }
#pragma unroll
    for (int g = 0; g < 2; ++g) {
        bf16x8 kf[4];
#pragma unroll
        for (int d = 0; d < 2; ++d) { kf[2 * d] = *(const LAS bf16x8*)(kp + (2 * g + d) * 2048); kf[2 * d + 1] = *(const LAS bf16x8*)(kp + (2 * g + d) * 2048 + 512); }
#pragma unroll
        for (int d = 0; d < 2; ++d) { S0 = MFMA32(kf[2 * d], qr[2 * g + d], S0); S1 = MFMA32(kf[2 * d + 1], qr[2 * g + d], S1); }
        if (PROBE_ATT == 2) { f32x16 D0, D1;
#pragma unroll
            for (int r = 0; r < 16; ++r) { D0[r] = 0.f; D1[r] = 0.f; }
#pragma unroll
            for (int d = 0; d < 2; ++d) { D0 = MFMA32(kf[2 * d], qr[2 * g + d], D0); D1 = MFMA32(kf[2 * d + 1], qr[2 * g + d], D1); }
            asm volatile("" :: "v"(D0[0] + D1[0])); }
    }
}
template <int MODE>
__device__ __forceinline__ void apply_mask(f32x16& S0, f32x16& S1, int tq, int key0, int hi, bool near, const LAS float* lut, u64 bits, int aux) {
    const unsigned blo = (unsigned)bits >> (4 * hi), bhi = (unsigned)(bits >> 32) >> (4 * hi);
#pragma unroll
    for (int n = 0; n < 2; ++n)
#pragma unroll
        for (int r = 0; r < 16; ++r) { const int kk0 = (r & 3) + 8 * (r >> 2); const int kk = kk0 + 4 * hi + 32 * n; const int dist = tq - (key0 + kk);
            bool valid;
            if (MODE == MK_C) valid = dist >= 0;
            else if (MODE == MK_A) valid = true;
            else if (MODE == MK_WIN) valid = dist >= 0 && dist < 512;
            else if (MODE == MK_SLC) valid = (aux != 0) && dist >= 0;
            else valid = (key0 + kk) < aux;
            float s = n ? S1[r] : S0[r];
            if (MODE != MK_CMP && near) { const int dc = dist < 0 ? 0 : (dist > 127 ? 127 : dist); s += lut[dc]; }
            if (MODE == MK_A) { const int mk = __builtin_amdgcn_sbfe((int)(n ? bhi : blo), kk0, 1);
                unsigned sb; asm("v_bfi_b32 %0, %1, %2, %3" : "=v"(sb) : "v"(mk), "v"(__builtin_bit_cast(unsigned, s)), "v"(0xff800000u)); s = __builtin_bit_cast(float, sb); }
            else s = valid ? s : -INFINITY;
            if (n) S1[r] = s; else S0[r] = s; }
}
__device__ __forceinline__ float vmax3(float a, float b, float c) { float r; asm("v_max3_f32 %0, %1, %2, %3" : "=v"(r) : "v"(a), "v"(b), "v"(c)); return r; }
__device__ __forceinline__ float vmax2(float a, float b) { float r; asm("v_max_f32 %0, %1, %2" : "=v"(r) : "v"(a), "v"(b)); return r; }
__device__ __forceinline__ float row_max32(const f32x16& S0, const f32x16& S1, int lane) {
    float a = vmax3(S0[0], S0[1], S1[0]), b = vmax3(S0[2], S0[3], S1[1]); a = vmax3(a, S1[2], S1[3]);
#pragma unroll
    for (int r = 4; r < 16; r += 4) { a = vmax3(a, S0[r], S0[r + 1]); b = vmax3(b, S0[r + 2], S0[r + 3]); a = vmax3(a, S1[r], S1[r + 1]); b = vmax3(b, S1[r + 2], S1[r + 3]); }
    return vmax2(a, b);
}
__device__ __forceinline__ void v_load2(bf16x8 (&vf)[2][4], const LAS unsigned char* vbuf, int db0, int lane) {
    const int hi = lane >> 5;
    const LAS unsigned char* vp = vbuf + ((lane >> 4) & 1) * 32 + (lane & 3) * 8 + (4 * hi + ((lane & 15) >> 2)) * 64 + db0 * 4096;
#pragma unroll
    for (int d = 0; d < 2; ++d)
#pragma unroll
        for (int ks = 0; ks < 4; ++ks) { const s16x4 lo = vtr(vp + d * 4096 + ks * 1024), hh = vtr(vp + d * 4096 + ks * 1024 + 512);
            vf[d][ks] = (bf16x8){lo[0], lo[1], lo[2], lo[3], hh[0], hh[1], hh[2], hh[3]}; }
}
__device__ __forceinline__ void p_pack(bf16x8 (&pa)[4], const f32x16& S0, const f32x16& S1) {
#pragma unroll
    for (int ks = 0; ks < 4; ++ks) { u32x4 w;
        if (ks == 0) { w.x = cvt_pk_bf16(S0[0], S0[1]); w.y = cvt_pk_bf16(S0[2], S0[3]); w.z = cvt_pk_bf16(S0[4], S0[5]); w.w = cvt_pk_bf16(S0[6], S0[7]); }
        else if (ks == 1) { w.x = cvt_pk_bf16(S0[8], S0[9]); w.y = cvt_pk_bf16(S0[10], S0[11]); w.z = cvt_pk_bf16(S0[12], S0[13]); w.w = cvt_pk_bf16(S0[14], S0[15]); }
        else if (ks == 2) { w.x = cvt_pk_bf16(S1[0], S1[1]); w.y = cvt_pk_bf16(S1[2], S1[3]); w.z = cvt_pk_bf16(S1[4], S1[5]); w.w = cvt_pk_bf16(S1[6], S1[7]); }
        else { w.x = cvt_pk_bf16(S1[8], S1[9]); w.y = cvt_pk_bf16(S1[10], S1[11]); w.z = cvt_pk_bf16(S1[12], S1[13]); w.w = cvt_pk_bf16(S1[14], S1[15]); }
        pa[ks] = __builtin_bit_cast(bf16x8, w); }
}
template <int VD>
__device__ __forceinline__ void pv_tile(f32x16 (&o)[VD / 32], const f32x16& S0, const f32x16& S1, const bf16x8 (&vf01)[2][4], const LAS unsigned char* vbuf, int lane) {
    bf16x8 pa[4]; p_pack(pa, S0, S1);
    if (VD == 128) {
        bf16x8 va[4], vb[4];
        const int hi = lane >> 5;
        const LAS unsigned char* vp = vbuf + ((lane >> 4) & 1) * 32 + (lane & 3) * 8 + (4 * hi + ((lane & 15) >> 2)) * 64;
#pragma unroll
        for (int ks = 0; ks < 4; ++ks) { const s16x4 lo = vtr(vp + 2 * 4096 + ks * 1024), hh = vtr(vp + 2 * 4096 + ks * 1024 + 512); va[ks] = (bf16x8){lo[0], lo[1], lo[2], lo[3], hh[0], hh[1], hh[2], hh[3]}; }
#pragma unroll
        for (int ks = 0; ks < 4; ++ks) { const s16x4 lo = vtr(vp + 3 * 4096 + ks * 1024), hh = vtr(vp + 3 * 4096 + ks * 1024 + 512); vb[ks] = (bf16x8){lo[0], lo[1], lo[2], lo[3], hh[0], hh[1], hh[2], hh[3]}; }
#pragma unroll
        for (int ks = 0; ks < 4; ++ks) { o[0] = MFMA32(pa[ks], vf01[0][ks], o[0]); o[1] = MFMA32(pa[ks], vf01[1][ks], o[1]); }
        __builtin_amdgcn_sched_barrier(0);
#pragma unroll
        for (int ks = 0; ks < 4; ++ks) { o[(VD == 128) ? 2 : 0] = MFMA32(pa[ks], va[ks], o[(VD == 128) ? 2 : 0]); o[(VD == 128) ? 3 : 0] = MFMA32(pa[ks], vb[ks], o[(VD == 128) ? 3 : 0]); }
    } else {
#pragma unroll
        for (int ks = 0; ks < 4; ++ks)
#pragma unroll
            for (int d = 0; d < 2; ++d) o[d] = MFMA32(pa[ks], vf01[d][ks], o[d]);
    }
}
template <int ND>
__device__ __forceinline__ void scale_rows(f32x16 (&o)[ND], float f, LAS float* wsf, int lane) {
    const int hi = lane >> 5;
    wsf[lane & 31] = f;
#pragma unroll
    for (int g = 0; g < 4; ++g) { const f32x4 a = *(const LAS f32x4*)(wsf + 8 * g + 4 * hi);
#pragma unroll
        for (int d = 0; d < ND; ++d)
#pragma unroll
            for (int i = 0; i < 4; ++i) o[d][4 * g + i] *= a[i]; }
}
template <int VD, bool PV>
__device__ __forceinline__ void softmax_step(AState<VD>& st, f32x16& S0, f32x16& S1, const LAS unsigned char* vbuf, LAS float* wsf, int lane) {
    bf16x8 vf01[2][4];
    if (PV) { v_load2(vf01, vbuf, 0, lane); __builtin_amdgcn_sched_barrier(0); }
    const float mx = row_max32(S0, S1, lane);
    if (__any(mx - st.m > ATT_THR)) { const float mnew = vmax2(st.m, vmax2(mx, bperm_f(lane ^ 32, mx))); const float alpha = fexp2(st.m - mnew); st.l *= alpha; st.m = mnew;
        if (PV) scale_rows<VD / 32>(st.o, alpha, wsf, lane); }
    float sum = 0.f;
#pragma unroll
    for (int r = 0; r < 16; ++r) { S0[r] = fexp2(S0[r] - st.m); S1[r] = fexp2(S1[r] - st.m); }
#pragma unroll
    for (int r = 0; r < 16; ++r) sum += S0[r];
#pragma unroll
    for (int r = 0; r < 16; ++r) sum += S1[r];
    st.l += sum;
    if (PROBE_ATT == 1) { float dm = 0.f;
#pragma unroll
        for (int r = 0; r < 16; ++r) { float t0 = S0[r], t1 = S1[r]; asm volatile("" : "+v"(t0), "+v"(t1)); dm += fexp2(t0 - st.m) + fexp2(t1 - st.m); }
        asm volatile("" :: "v"(dm)); }
    if (PV) pv_tile<VD>(st.o, S0, S1, vf01, vbuf, lane);
}
template <int ND>
__device__ __forceinline__ void finish_add(f32x16 (&acc)[ND], const f32x16 (&o)[ND], float l, float gate, LAS float* wsf, int lane) {
    const int hi = lane >> 5;
    const float lt = sum32(l, lane); const float f = lt > 0.f ? gate / lt : 0.f;
    wsf[lane & 31] = f;
#pragma unroll
    for (int g = 0; g < 4; ++g) { const f32x4 a = *(const LAS f32x4*)(wsf + 8 * g + 4 * hi);
#pragma unroll
        for (int d = 0; d < ND; ++d)
#pragma unroll
            for (int i = 0; i < 4; ++i) acc[d][4 * g + i] += o[d][4 * g + i] * a[i]; }
}

__device__ __forceinline__ int crow(int r, int hi) { return (r & 3) + 8 * (r >> 2) + 4 * hi; }

__device__ __forceinline__ void unit_C(Frame& F, const bf16_t* P, bf16_t* OC, const float* gnorm, float lam, float lam_init, int b, int h, int qb) {
    const int lane = F.lane, r32 = lane & 31, hi = lane >> 5, w = F.wave;
    LAS unsigned char* lds = F.lds; LAS float* wsf = (LAS float*)(lds + AT_WSF) + w * 64; const LAS float* lut = (const LAS float*)(lds + AT_LUT) + (8 + h) * 128;
    const int q0 = qb * 256, tw0 = q0 + 32 * w, tq = tw0 + r32; const size_t rowbase = (size_t)b * 4096;
    const int NT = 4 * qb + 4, my_last = (tw0 + 31) >> 6;
    LAS unsigned* kpl = (LAS unsigned*)(lds + AT_IMP) + w * 2048 + lane;
    AState<128> st;
#pragma unroll 1
    for (int j = 0; j < 2; ++j) {
        const bf16_t* Qp = P + (rowbase + tq) * DP + C_CQ + h * 128 + j * 64;
        bf16x8 qr[4];
#pragma unroll
        for (int d0 = 0; d0 < 4; ++d0) qr[d0] = *(const bf16x8*)(Qp + d0 * 16 + hi * 8);
        const bf16_t* Kb = P + rowbase * DP + C_CK + h * 128 + j * 64; const bf16_t* Vb = P + rowbase * DP + C_CV + h * 128;
        astate_init(st);
        stage_kv<128>(lds + AT_KBUF, lds + AT_VBUF, Kb, DP, Vb, DP, w, lane, true);
#pragma unroll 1
        for (int kt = 0; kt < NT; ++kt) {
            VM_WAIT(); __syncthreads();
            const int cb = kt & 1;
            if (kt + 1 < NT) stage_kv<128>(lds + AT_KBUF + (cb ^ 1) * 8192, lds + AT_VBUF + (cb ^ 1) * 16384, Kb + (size_t)(kt + 1) * 64 * DP, DP, Vb + (size_t)(kt + 1) * 64 * DP, DP, w, lane, true);
            if (kt <= my_last) {
                f32x16 S0, S1; qk_tile(S0, S1, qr, lds + AT_KBUF + cb * 8192, r32, hi);
                const int key0 = kt * 64; const bool near = (tw0 - (key0 + 63)) < 113;
                if (near) apply_mask<MK_C>(S0, S1, tq, key0, hi, true, lut, 0ull, 0);
                softmax_step<128, true>(st, S0, S1, lds + AT_VBUF + cb * 16384, wsf, lane);
            }
        }
        __syncthreads();
        const float lt = sum32(st.l, lane);
        if (j == 0) { scale_rows<4>(st.o, 1.f / lt, wsf, lane);
#pragma unroll
            for (int d = 0; d < 4; ++d)
#pragma unroll
                for (int r = 0; r < 8; ++r) kpl[(d * 8 + r) * 64] = cvt_pk_bf16(st.o[d][2 * r], st.o[d][2 * r + 1]);
        } else { scale_rows<4>(st.o, -lam / lt, wsf, lane);
#pragma unroll
            for (int d = 0; d < 4; ++d)
#pragma unroll
                for (int r = 0; r < 8; ++r) { const unsigned kw = kpl[(d * 8 + r) * 64]; st.o[d][2 * r] += bflo(kw); st.o[d][2 * r + 1] += bfhi(kw); } }
    }
    f32x16 (&keep)[4] = st.o;
    float gch[4];
#pragma unroll
    for (int d = 0; d < 4; ++d) gch[d] = gnorm[32 * d + r32] * (1.f - lam_init);
    GAS bf16_t* orow = (GAS bf16_t*)OC + (rowbase + tw0) * 1024 + 512 + h * 128 + r32; asm volatile("" : "+v"(orow)); int hs = hi; asm volatile("" : "+v"(hs));
#pragma unroll
    for (int r = 0; r < 16; ++r) { float ss = keep[0][r] * keep[0][r] + keep[1][r] * keep[1][r] + keep[2][r] * keep[2][r] + keep[3][r] * keep[3][r];
        ss += shx_f(ss, 1, lane); ss += shx_f(ss, 2, lane); ss += shx_f(ss, 4, lane); ss += shx_f(ss, 8, lane); ss += shx_f(ss, 16, lane);
        const float sc = 1.f / sqrtf(ss * (1.f / 128.f) + LN_EPS);
#pragma unroll
        for (int d = 0; d < 4; ++d) orow[crow(r, hs) * 1024 + 32 * d] = (bf16_t)f2bf(keep[d][r] * sc * gch[d]); }
}

__device__ __forceinline__ void unit_A(Frame& F, const bf16_t* P, const u64* BM, bf16_t* OC, int b, int qi) {
    const int lane = F.lane, r32 = lane & 31, hi = lane >> 5, w = F.wave, h = w & 3, rg = w >> 2;
    LAS unsigned char* lds = F.lds; LAS float* wsf = (LAS float*)(lds + AT_WSF) + w * 64; const LAS float* lut = (const LAS float*)(lds + AT_LUT) + h * 128;
    const int q0 = qi * 64, tw0 = q0 + 32 * rg, tq = tw0 + r32; const size_t rowbase = (size_t)b * 4096;
    const int NT = qi + 1;
    const bf16_t* Qp = P + (rowbase + tq) * DP + C_AQ + h * 64;
    bf16x8 qr[4];
#pragma unroll
    for (int d0 = 0; d0 < 4; ++d0) qr[d0] = *(const bf16x8*)(Qp + d0 * 16 + hi * 8);
    const bf16_t* Kb = P + rowbase * DP + C_AK; const bf16_t* Vb = P + rowbase * DP + C_AV;
    const u64* bmp = BM + (size_t)b * 64 * 4096 + tq;
    u64 bits = bmp[0];
    AState<64> st; astate_init(st);
    stage_kv<64>(lds + AT_KBUF, lds + AT_VBUF, Kb, DP, Vb, DP, w, lane, true);
#pragma unroll 1
    for (int kt = 0; kt < NT; ++kt) {
        VM_WAIT(); __syncthreads();
        const int cb = kt & 1;
        u64 nbits = 0ull;
        if (kt + 1 < NT) { stage_kv<64>(lds + AT_KBUF + (cb ^ 1) * 8192, lds + AT_VBUF + (cb ^ 1) * 16384, Kb + (size_t)(kt + 1) * 64 * DP, DP, Vb + (size_t)(kt + 1) * 64 * DP, DP, w, lane, true);
            nbits = bmp[(size_t)(kt + 1) * 4096]; }
        f32x16 S0, S1; qk_tile(S0, S1, qr, lds + AT_KBUF + cb * 8192, r32, hi);
        const int key0 = kt * 64; const bool near = (tw0 - (key0 + 63)) < 113;
        if (A_DENSE) { if (near) apply_mask<MK_C>(S0, S1, tq, key0, hi, true, lut, 0ull, 0); } else apply_mask<MK_A>(S0, S1, tq, key0, hi, near, lut, bits, 0);
        softmax_step<64, true>(st, S0, S1, lds + AT_VBUF + cb * 16384, wsf, lane);
        bits = nbits;
    }
    __syncthreads();
    f32x16 acc[2];
#pragma unroll
    for (int d = 0; d < 2; ++d)
#pragma unroll
        for (int r = 0; r < 16; ++r) acc[d][r] = 0.f;
    const float lt = sum32(st.l, lane);
    finish_add<2>(acc, st.o, 0.5f, lt > 0.f ? 1.f / lt : 0.f, wsf, lane);
    GAS bf16_t* orow = (GAS bf16_t*)OC + (rowbase + tw0) * 1024 + h * 64 + r32; asm volatile("" : "+v"(orow)); int hs = hi; asm volatile("" : "+v"(hs));
#pragma unroll
    for (int r = 0; r < 16; ++r)
#pragma unroll
        for (int d = 0; d < 2; ++d) orow[crow(r, hs) * 1024 + 32 * d] = (bf16_t)f2bf(acc[d][r]);
}

constexpr int IMP_LD = 65;
__device__ __forceinline__ void unit_B(Frame& F, const bf16_t* P, const bf16_t* KC, const bf16_t* VC, bf16_t* OC, int b, int qi) {
    const int lane = F.lane, r32 = lane & 31, hi = lane >> 5, w = F.wave, h = w & 3, rg = w >> 2;
    LAS unsigned char* lds = F.lds; LAS float* wsf = (LAS float*)(lds + AT_WSF) + w * 64; const LAS float* lut = (const LAS float*)(lds + AT_LUT) + (4 + h) * 128;
    LAS float* imp = (LAS float*)(lds + AT_IMP); volatile LAS u64* rmask = (volatile LAS u64*)(lds + AT_RMASK); volatile LAS u64* wor = (volatile LAS u64*)(lds + AT_WOR);
    const int q0 = qi * 64, cur = qi, tw0 = q0 + 32 * rg, tq = tw0 + r32, urow = 32 * rg + r32; const size_t rowbase = (size_t)b * 4096;
    const bf16_t* prow = P + (rowbase + tq) * DP;
    bf16x8 qr[4];
#pragma unroll
    for (int d0 = 0; d0 < 4; ++d0) qr[d0] = *(const bf16x8*)(prow + C_BQ + h * 64 + d0 * 16 + hi * 8);
    const float g0 = fsigmoid(bf2f(prow[C_BG + h * 3 + 0])), g1 = fsigmoid(bf2f(prow[C_BG + h * 3 + 1])), g2 = fsigmoid(bf2f(prow[C_BG + h * 3 + 2]));
    f32x16 ob[2];
#pragma unroll
    for (int d = 0; d < 2; ++d)
#pragma unroll
        for (int r = 0; r < 16; ++r) ob[d][r] = 0.f;
    {
        const int ncv = tq >= 31 ? ((tq - 31) >> 4) + 1 : 0;
        const int ncv_max = ((q0 + 63 - 31) >> 4) + 1, NTc = (ncv_max + 63) >> 6;
        const bf16_t* Kc = KC + (size_t)b * 256 * 64; const bf16_t* Vc = VC + (size_t)b * 256 * 64;
        AState<64> st; astate_init(st);
        stage_kv<64>(lds + AT_KBUF, lds + AT_VBUF, Kc, 64, Vc, 64, w, lane, false);
#pragma unroll 1
        for (int kt = 0; kt < NTc; ++kt) {
            VM_WAIT(); __syncthreads();
            const int cb = kt & 1;
            if (kt + 1 < NTc) stage_kv<64>(lds + AT_KBUF + (cb ^ 1) * 8192, lds + AT_VBUF + (cb ^ 1) * 16384, Kc + (size_t)(kt + 1) * 64 * 64, 64, Vc, 64, w, lane, false);
            f32x16 S0, S1; qk_tile(S0, S1, qr, lds + AT_KBUF + cb * 8192, r32, hi);
            apply_mask<MK_CMP>(S0, S1, tq, kt * 64, hi, false, lut, 0ull, ncv);
            softmax_step<64, false>(st, S0, S1, lds + AT_VBUF, wsf, lane);
        }
        __syncthreads();
        const float lt = sum32(st.l, lane); const float inv = lt > 0.f ? 1.f / lt : 0.f; const float mfin = st.m;
        f32x16 oc[2];
#pragma unroll
        for (int d = 0; d < 2; ++d)
#pragma unroll
            for (int r = 0; r < 16; ++r) oc[d][r] = 0.f;
        float carry = 0.f;
        stage_kv<64>(lds + AT_KBUF, lds + AT_VBUF, Kc, 64, Vc, 64, w, lane, true);
#pragma unroll 1
        for (int kt = 0; kt < NTc; ++kt) {
            VM_WAIT(); __syncthreads();
            const int cb = kt & 1;
            if (kt + 1 < NTc) stage_kv<64>(lds + AT_KBUF + (cb ^ 1) * 8192, lds + AT_VBUF + (cb ^ 1) * 16384, Kc + (size_t)(kt + 1) * 64 * 64, 64, Vc + (size_t)(kt + 1) * 64 * 64, 64, w, lane, true);
            f32x16 S0, S1; qk_tile(S0, S1, qr, lds + AT_KBUF + cb * 8192, r32, hi);
            apply_mask<MK_CMP>(S0, S1, tq, kt * 64, hi, false, lut, 0ull, ncv);
#pragma unroll
            for (int r = 0; r < 16; ++r) { S0[r] = fexp2(S0[r] - mfin) * inv; S1[r] = fexp2(S1[r] - mfin) * inv; }
            float own[2][4], pl[2][4];
#pragma unroll
            for (int g = 0; g < 4; ++g) { own[0][g] = (S0[4 * g] + S0[4 * g + 1]) + (S0[4 * g + 2] + S0[4 * g + 3]); own[1][g] = (S1[4 * g] + S1[4 * g + 1]) + (S1[4 * g + 2] + S1[4 * g + 3]);
                pl[0][g] = other32(S0[4 * g + 3], lane); pl[1][g] = other32(S1[4 * g + 3], lane); }
#pragma unroll
            for (int n = 0; n < 2; ++n)
#pragma unroll
                for (int g = 0; g < 4; ++g) { const int J = 16 * kt + 8 * n + 2 * g + hi;
                    const float prev0 = (g > 0) ? pl[n][g > 0 ? g - 1 : 0] : (n == 1 ? pl[0][3] : carry);
                    const float prev = hi ? pl[n][g] : prev0;
                    imp[(h * 64 + urow) * IMP_LD + J] = own[n][g] + prev; }
            carry = pl[1][3];
            { bf16x8 vf01[2][4]; v_load2(vf01, lds + AT_VBUF + cb * 16384, 0, lane); pv_tile<64>(oc, S0, S1, vf01, lds + AT_VBUF + cb * 16384, lane); }
        }
        finish_add<2>(ob, oc, 0.5f, g0, wsf, lane);
        __syncthreads();
    }
    {
        const int nf = cur >= 2 ? 3 : cur + 1, nfree = 16 - nf; u64 worl = 0ull;
#pragma unroll 1
        for (int rr = 0; rr < 8; ++rr) { const int row = 8 * w + rr; const int j = lane;
            const float v = (imp[(0 * 64 + row) * IMP_LD + j] + imp[(1 * 64 + row) * IMP_LD + j]) + (imp[(2 * 64 + row) * IMP_LD + j] + imp[(3 * 64 + row) * IMP_LD + j]);
            const bool cand = (j >= 1) && (j <= cur - 2);
            int rank = 0;
#pragma unroll 1
            for (int k = 1; k <= cur - 2; ++k) { const float vk = bperm_f(k, v); rank += (vk > v || (vk == v && k < j)) ? 1 : 0; }
            const bool forced = (j <= cur) && (j == 0 || j == cur || j == cur - 1);
            const bool sel = forced || (cand && rank < nfree);
            const u64 mk = __ballot(sel);
            if (lane == 0) rmask[row] = mk;
            worl |= mk; }
        if (lane == 0) wor[w] = worl;
        __syncthreads();
    }
    const u64 myrm = rmask[urow];
    u64 un = 0ull;
#pragma unroll
    for (int k = 0; k < 8; ++k) un |= wor[k];
    {
        const bf16_t* Kb = P + rowbase * DP + C_BKV + 2 * 64; const bf16_t* Vb = P + rowbase * DP + C_BKV + 3 * 64;
        AState<64> st; astate_init(st);
        const int nsel = __popcll(un);
        int j = __ffsll((long long)un) - 1; un &= un - 1;
        stage_kv<64>(lds + AT_KBUF, lds + AT_VBUF, Kb + (size_t)j * 64 * DP, DP, Vb + (size_t)j * 64 * DP, DP, w, lane, true);
#pragma unroll 1
        for (int i = 0; i < nsel; ++i) {
            VM_WAIT(); __syncthreads();
            const int cb = i & 1;
            int jn = -1;
            if (un) { jn = __ffsll((long long)un) - 1; un &= un - 1;
                stage_kv<64>(lds + AT_KBUF + (cb ^ 1) * 8192, lds + AT_VBUF + (cb ^ 1) * 16384, Kb + (size_t)jn * 64 * DP, DP, Vb + (size_t)jn * 64 * DP, DP, w, lane, true); }
            const int rowsel = (int)((myrm >> j) & 1ull);
            if (__any(rowsel)) {
                f32x16 S0, S1; qk_tile(S0, S1, qr, lds + AT_KBUF + cb * 8192, r32, hi);
                const int key0 = j * 64; const bool near = (tw0 - (key0 + 63)) < 113;
                if (near || j == cur || !__all(rowsel)) apply_mask<MK_SLC>(S0, S1, tq, key0, hi, near, lut, 0ull, rowsel);
                softmax_step<64, true>(st, S0, S1, lds + AT_VBUF + cb * 16384, wsf, lane);
            }
            j = jn;
        }
        __syncthreads();
        const float lt = sum32(st.l, lane);
        finish_add<2>(ob, st.o, 0.5f, lt > 0.f ? g1 / lt : 0.f, wsf, lane);
    }
    {
        const bf16_t* Kb = P + rowbase * DP + C_BKV + 4 * 64; const bf16_t* Vb = P + rowbase * DP + C_BKV + 5 * 64;
        AState<64> st; astate_init(st);
        const int kt0 = cur >= 8 ? cur - 8 : 0;
        stage_kv<64>(lds + AT_KBUF, lds + AT_VBUF, Kb + (size_t)kt0 * 64 * DP, DP, Vb + (size_t)kt0 * 64 * DP, DP, w, lane, true);
#pragma unroll 1
        for (int kt = kt0; kt <= cur; ++kt) {
            VM_WAIT(); __syncthreads();
            const int cb = (kt - kt0) & 1;
            if (kt + 1 <= cur) stage_kv<64>(lds + AT_KBUF + (cb ^ 1) * 8192, lds + AT_VBUF + (cb ^ 1) * 16384, Kb + (size_t)(kt + 1) * 64 * DP, DP, Vb + (size_t)(kt + 1) * 64 * DP, DP, w, lane, true);
            f32x16 S0, S1; qk_tile(S0, S1, qr, lds + AT_KBUF + cb * 8192, r32, hi);
            const int key0 = kt * 64; const bool near = (tw0 - (key0 + 63)) < 113;
            const bool allv = (key0 + 63 <= tw0) && (tw0 + 31 - key0 < 512);
            if (near || !allv) apply_mask<MK_WIN>(S0, S1, tq, key0, hi, near, lut, 0ull, 0);
            softmax_step<64, true>(st, S0, S1, lds + AT_VBUF + cb * 16384, wsf, lane);
        }
        __syncthreads();
        const float lt = sum32(st.l, lane);
        finish_add<2>(ob, st.o, 0.5f, lt > 0.f ? g2 / lt : 0.f, wsf, lane);
    }
    GAS bf16_t* orow = (GAS bf16_t*)OC + (rowbase + tw0) * 1024 + 256 + h * 64 + r32; asm volatile("" : "+v"(orow)); int hs = hi; asm volatile("" : "+v"(hs));
#pragma unroll
    for (int r = 0; r < 16; ++r)
#pragma unroll
        for (int d = 0; d < 2; ++d) orow[crow(r, hs) * 1024 + 32 * d] = (bf16_t)f2bf(ob[d][r]);
}

__device__ __forceinline__ void phase_cmp2(Frame& F, const bf16_t* HID, const bf16_t* W2T, bf16_t* KC) {
    const int lane = F.lane, fr = lane & 15, fq = lane >> 4;
    for (int task = F.gw; task < 512; task += F.NGW) { const int j = task >> 8, row0 = (task & 255) * 16;
        f32x4 acc[4];
#pragma unroll
        for (int n = 0; n < 4; ++n) acc[n] = (f32x4){0.f, 0.f, 0.f, 0.f};
#pragma unroll
        for (int ks = 0; ks < 8; ++ks) { const bf16x8 a = *(const bf16x8*)(HID + ((size_t)j * 4096 + row0 + fr) * 256 + ks * 32 + 8 * fq);
#pragma unroll
            for (int n = 0; n < 4; ++n) { const bf16x8 bb = *(const bf16x8*)(W2T + ((size_t)j * 64 + n * 16 + fr) * 256 + ks * 32 + 8 * fq);
                acc[n] = __builtin_amdgcn_mfma_f32_16x16x32_bf16(a, bb, acc[n], 0, 0, 0); } }
#pragma unroll
        for (int n = 0; n < 4; ++n)
#pragma unroll
            for (int jj = 0; jj < 4; ++jj) KC[((size_t)j * 4096 + row0 + 4 * fq + jj) * 64 + n * 16 + fr] = (bf16_t)f2bf(acc[n][jj]);
    }
}

constexpr int PH_PER_LAYER = 11, N_PHASES = 2 + DEPTH * PH_PER_LAYER;
struct Args { const float* in[27]; float* out; unsigned char* ws; int ph_lo, ph_hi, li, pad; };

#define IN(k) (lo <= (k) && (k) < hi)
#define SEAM(k) do { if (IN((k) + 1)) xcd_barrier(bar); } while (0)
#define WSB (F.ws)
#define PROJ ((bf16_t*)(WSB + WS_PROJ))
#define HB ((bf16_t*)(WSB + WS_HB))
#define OCAT ((bf16_t*)(WSB + WS_OCAT))
#define MERG ((bf16_t*)(WSB + WS_MERG))
#define X1 ((bf16_t*)(WSB + WS_X1))
#define MOD ((const float*)(WSB + WS_MOD))

template <int l>
__device__ __forceinline__ void run_layer(Frame& F, const Args& args, const XcdBarrier& bar, int lo, int hi) {
        const int pb = 2 + l * PH_PER_LAYER;
#define xres ((l == 0) ? args.in[0] : (const float*)args.out)
#define mod_a (MOD + (size_t)(2 * l) * 16 * 3072)
#define mod_f (MOD + (size_t)(2 * l + 1) * 16 * 3072)
        if (IN(pb + 0)) for (int rep = 0; rep < ((l == 0 && DUP == 0) ? 2 : 1); ++rep) { if (rep) xcd_barrier(bar); refresh(F);
            { pg8::Gemm g{HB, (const bf16_t*)(WSB + WS_WIN_T) + (size_t)l * DP * 1024, 1024, 1024, 1024, 128}; pg8::StaticOrder S; S.init(NTOK, N_BF, F.G, (int)blockIdx.x);
              pg8::EpiProj E{PROJ, 0, 1.f};
              pg8::gemm_phase<pg8::EpiProj, pg8::StaticOrder>(F.lds, g, S, E, F.wave); }
            { pg8::Gemm g{(const bf16_t*)(WSB + WS_HB8), (const bf16_t*)(WSB + WS_WMG8 + (size_t)l * N_F8 * 1024), 512, 512, 512, 128}; pg8::StaticOrder S; S.init(NTOK, N_F8, F.G, (int)blockIdx.x);
              pg8::EpiGate8 E{(unsigned char*)(WSB + WS_MG8), 1.f / (F8_H * F8_WIN)};
              pg8::gemm_phase<pg8::EpiGate8, pg8::StaticOrder, true>(F.lds, g, S, E, F.wave); }
            if (blockIdx.x == 255) { u32x4* z = (u32x4*)(PROJ + (size_t)NTOK * DP); for (int i = F.tid; i < 32 * DP * 2 / 16; i += 512) z[i] = (u32x4){0u, 0u, 0u, 0u}; }
            SEAM(pb + 0);
        }
        if (IN(pb + 1)) for (int rep = 0; rep < ((l == 0 && DUP == 1) ? 2 : 1); ++rep) { if (rep) xcd_barrier(bar); refresh(F);
            { pg8::Gemm g{PROJ + C_BKV, (const bf16_t*)(WSB + WS_W1_T) + (size_t)l * 2 * 256 * 2048, 16 * DP, 2048, 2048, DP * 2}; pg8::CmpOrder S{F.G, (int)blockIdx.x};
              pg8::EpiCmp1 E{(bf16_t*)(WSB + WS_HID), (const float*)(WSB + WS_BIAS1) + l * 512};
              pg8::gemm_phase<pg8::EpiCmp1, pg8::CmpOrder>(F.lds, g, S, E, F.wave); }
            __syncthreads();
            if (USE_A) {
#pragma unroll 1
                for (int i = 0; i < 16; ++i) { const int c = (int)blockIdx.x; const int qt = (i & 1) ? 255 - c : c;
                    dsa_select_tile(F, PROJ, (u64*)(WSB + WS_BM64), (unsigned*)(WSB + WS_OCAT) + (size_t)blockIdx.x * 65536, i, qt); }
            }
            SEAM(pb + 1);
        }
        if (IN(pb + 2)) for (int rep = 0; rep < ((l == 0 && DUP == 2) ? 2 : 1); ++rep) { if (rep) xcd_barrier(bar); refresh(F); phase_cmp2(F, (const bf16_t*)(WSB + WS_HID), (const bf16_t*)(WSB + WS_W2_T) + (size_t)l * 2 * 64 * 256, (bf16_t*)(WSB + WS_KCMP)); SEAM(pb + 2); }
        if (IN(pb + 3)) for (int rep = 0; rep < ((l == 0 && DUP == 3) ? 2 : 1); ++rep) { if (rep) xcd_barrier(bar); refresh(F);
            for (int i = F.tid; i < 12 * 128; i += 512) ((LAS float*)(F.lds + AT_LUT))[i] = ((const float*)(WSB + WS_LUT))[i];
            __syncthreads();
            const int c = (int)blockIdx.x;
            if (USE_C) {
                const float lam = ((const float*)(WSB + WS_LAM))[l]; const float lam_init = 0.8f - 0.6f * __expf(-0.3f * (float)l);
#pragma unroll 1
                for (int u = 0; u < 4; ++u) { const int bh = (c & 7) * 8 + (c >> 5), pp = ((c >> 3) & 3) * 2 + (u >> 1); const int qb = (u & 1) ? pp : 15 - pp;
                    refresh(F); unit_C(F, PROJ, OCAT, args.in[10] + l * 128, lam, lam_init, bh >> 2, bh & 3, qb); }
            }
            if (USE_A) {
#pragma unroll 1
                for (int u = 0; u < 4; ++u) { const int b = (c & 7) * 2 + (c >> 7), pp = ((c >> 3) & 15) * 2 + (u >> 1); const int qi = (u & 1) ? pp : 63 - pp;
                    refresh(F); unit_A(F, PROJ, (const u64*)(WSB + WS_BM64), OCAT, b, qi); }
            }
            if (USE_B) {
#pragma unroll 1
                for (int u = 0; u < 4; ++u) { const int b = (c & 7) * 2 + (c >> 7), pp = ((c >> 3) & 15) * 2 + (u >> 1); const int qi = (u & 1) ? pp : 63 - pp;
                    refresh(F); unit_B(F, PROJ, (const bf16_t*)(WSB + WS_KCMP), (const bf16_t*)(WSB + WS_KCMP) + 4096 * 64, OCAT, b, qi); }
            }
            if (!USE_A || !USE_B || !USE_C) {
                for (int row = F.gw; row < NTOK; row += F.NGW) { u32x4* o = (u32x4*)(OCAT + (size_t)row * 1024);
                    for (int q = F.lane; q < 128; q += 64) { const int col = q * 8; const bool z = (col < 256) ? !USE_A : (col < 512 ? !USE_B : !USE_C); if (z) o[q] = (u32x4){0u, 0u, 0u, 0u}; } }
            }
            SEAM(pb + 3);
        }
        if (IN(pb + 4)) for (int rep = 0; rep < ((l == 0 && DUP == 4) ? 2 : 1); ++rep) { if (rep) xcd_barrier(bar); refresh(F);
            const bf16_t* WB = (const bf16_t*)(WSB + WS_WBR_T + (size_t)l * 2 * MiB);
            pg8::StaticOrder S; S.init(NTOK, 1024, F.G, (int)blockIdx.x);
            { pg8::Gemm g{OCAT, WB, 1024, 1024, 1024, 128}; pg8::EpiBranchCat E{MERG, (const unsigned char*)(WSB + WS_MG8)}; pg8::gemm_phase<pg8::EpiBranchCat, pg8::StaticOrder>(F.lds, g, S, E, F.wave); }
            SEAM(pb + 4);
        }
        if (IN(pb + 5)) for (int rep = 0; rep < ((l == 0 && DUP == 5) ? 2 : 1); ++rep) { if (rep) xcd_barrier(bar); refresh(F);
            pg8::Gemm g{MERG, (const bf16_t*)(WSB + WS_WOUT_T) + (size_t)l * 1024 * 1024, 1024, 1024, 1024, 128}; pg8::StaticOrder S; S.init(NTOK, 1024, F.G, (int)blockIdx.x);
            pg8::EpiWout<(l > 0)> E{X1, (l == 0) ? (const void*)args.in[0] : (const void*)(WSB + WS_X2B), mod_a + 2048};
            pg8::gemm_phase<pg8::EpiWout<(l > 0)>, pg8::StaticOrder>(F.lds, g, S, E, F.wave);
            SEAM(pb + 5);
        }
#define cnt ((unsigned*)(WSB + WS_CTL) + CW_CNT + l * 64)
        if (IN(pb + 6)) for (int rep = 0; rep < ((l == 0 && DUP == 6) ? 2 : 1); ++rep) { if (rep) xcd_barrier(bar); refresh(F); phase_ln1_router(F, X1, args.in[15] + l * 1024, args.in[16] + l * 1024, mod_f, args.in[19] + (size_t)l * 1024 * 32, args.in[20] + l * 32, HB, cnt); SEAM(pb + 6); }
        if (IN(pb + 7)) for (int rep = 0; rep < ((l == 0 && DUP == 7) ? 2 : 1); ++rep) { if (rep) xcd_barrier(bar); refresh(F); phase_gather(F, cnt, HB, (unsigned char*)(WSB + WS_HS8)); SEAM(pb + 7); }
        if (IN(pb + 8)) for (int rep = 0; rep < ((l == 0 && DUP == 8) ? 2 : 1); ++rep) { if (rep) xcd_barrier(bar); refresh(F);
            build_pstart(F, cnt);
            pg8::Gemm g{(const bf16_t*)(WSB + WS_HS8), (const bf16_t*)(WSB + WS_WGU_T + (size_t)l * 32 * 2048 * 1024), 512, 512, 512, 128};
            pg8::MoeOrder S{F.G, (int)blockIdx.x, 8, (int)F.MISC[48], (const volatile LAS int*)(F.MISC + 16)};
            pg8::EpiMoe1 E{(unsigned char*)(WSB + WS_ACT), args.in[22] + (size_t)l * 32 * 2048};
            pg8::gemm_phase<pg8::EpiMoe1, pg8::MoeOrder, true>(F.lds, g, S, E, F.wave);
            SEAM(pb + 8);
        }
        if (IN(pb + 9)) for (int rep = 0; rep < ((l == 0 && DUP == 9) ? 2 : 1); ++rep) { if (rep) xcd_barrier(bar); refresh(F);
            build_pstart(F, cnt);
            pg8::Gemm g{(const bf16_t*)(WSB + WS_ACT), (const bf16_t*)(WSB + WS_WDN_T + (size_t)l * 32 * 1024 * 1024), 512, 512, 512, 128};
            pg8::MoeOrder S{F.G, (int)blockIdx.x, 4, (int)F.MISC[48], (const volatile LAS int*)(F.MISC + 16)};
            pg8::EpiMoe2 E{(bf16_t*)(WSB + WS_HS), args.in[24] + (size_t)l * 32 * 1024};
            pg8::gemm_phase<pg8::EpiMoe2, pg8::MoeOrder, true>(F.lds, g, S, E, F.wave);
            SEAM(pb + 9);
        }
        if (IN(pb + 10)) for (int rep = 0; rep < ((l == 0 && DUP == 10) ? 2 : 1); ++rep) { if (rep) xcd_barrier(bar); refresh(F);
            phase_combine(F, (const bf16_t*)(WSB + WS_HS), X1, mod_f, args.in[25] + l * 1024, args.in[26] + l * 1024, args.out, (l + 1 < DEPTH) ? MOD + (size_t)(2 * l + 2) * 16 * 3072 : nullptr, HB, (unsigned char*)(WSB + WS_HB8), (bf16_t*)(WSB + WS_X2B));
            SEAM(pb + 10);
        }
}

__global__ void __launch_bounds__(512, 2) mega_fwd(Args args) {
    extern __shared__ __attribute__((aligned(16))) unsigned char lds_raw[];
    Frame F;
    F.lds = (LAS unsigned char*)lds_raw; F.MISC = (volatile LAS unsigned*)(F.lds + LDS_MISC);
    F.tid = threadIdx.x; F.lane = F.tid & 63; F.wave = __builtin_amdgcn_readfirstlane(F.tid >> 6); F.wave0 = F.wave;
    F.G = gridDim.x; F.gw = blockIdx.x * 8 + F.wave; F.NGW = F.G * 8;
    F.ws = args.ws; F.ws0 = args.ws; F.ctl = (unsigned*)(args.ws + WS_CTL); F.in = args.in; F.out = args.out;
    for (int u = F.tid; u < (LDS_BYTES - LDS_MISC) / 4; u += 512) F.MISC[u] = 0u;
    __syncthreads();
    XcdBarrier bar = xcd_barrier_post(F.ctl + CW_BAR + args.li * XCD_BAR_WORDS, F.MISC);
    const int lo = args.ph_lo, hi = args.ph_hi;
    if (IN(0)) for (int rep = 0; rep < (DUP == 100 ? 2 : 1); ++rep) { refresh(F); phase_prologue(F); SEAM(0); }
    if (IN(1)) { refresh(F); phase_h0(F, args.in[0], MOD, HB, (unsigned char*)(WSB + WS_HB8)); SEAM(1); }

    run_layer<0>(F, args, bar, lo, hi);
    run_layer<1>(F, args, bar, lo, hi);
#undef IN
#undef SEAM
#undef WSB
#undef PROJ
#undef HB
#undef OCAT
#undef MERG
#undef X1
#undef MOD
#undef xres
#undef mod_a
#undef mod_f
#undef cnt
}

constexpr int N_LAUNCHES = 1;
extern "C" void kernel_launch(void* const* d_in, const int* in_sizes, int n_in, void* d_out, int out_size, void* d_ws, size_t ws_size, hipStream_t stream) {
    static int grid = 0;
    if (grid == 0) {
        if (n_in != 27 || out_size != NTOK * D || ws_size < WS_END) { fprintf(stderr, "kernel_launch: unexpected sizes n_in %d out %d ws %zu (need %zu)\n", n_in, out_size, ws_size, (size_t)WS_END); grid = -1; return; }
        int dev = 0, cus = 0, per_cu = 0;
        if (hipGetDevice(&dev) != hipSuccess || hipDeviceGetAttribute(&cus, hipDeviceAttributeMultiprocessorCount, dev) != hipSuccess) { grid = -1; return; }
        if (hipFuncSetAttribute((const void*)mega_fwd, hipFuncAttributeMaxDynamicSharedMemorySize, LDS_BYTES) != hipSuccess) { fprintf(stderr, "kernel_launch: hipFuncSetAttribute failed\n"); grid = -1; return; }
        if (hipOccupancyMaxActiveBlocksPerMultiprocessor(&per_cu, (const void*)mega_fwd, 512, LDS_BYTES) != hipSuccess || per_cu < 1) fprintf(stderr, "kernel_launch: occupancy query says %d\n", per_cu);
        (void)hipGetLastError();
        grid = cus;
        if (grid != 256) { fprintf(stderr, "kernel_launch: built for 256 CUs, got %d\n", cus); grid = -1; return; }
    }
    if (grid < 0) return;
    (void)hipMemsetAsync((char*)d_ws + WS_CTL, 0, CTL_BYTES, stream);
    Args a{};
    for (int i = 0; i < 27; ++i) a.in[i] = (const float*)d_in[i];
    a.out = (float*)d_out; a.ws = (unsigned char*)d_ws; a.pad = 0;
    for (int li = 0; li < N_LAUNCHES; ++li) {
        a.ph_lo = (N_LAUNCHES == 1) ? 0 : li; a.ph_hi = (N_LAUNCHES == 1) ? N_PHASES : li + 1; a.li = li;
        hipLaunchKernelGGL(mega_fwd, dim3(grid), dim3(512), LDS_BYTES, stream, a);
    }
}
```

```cpp
#include <hip/hip_runtime.h>
#include <cstdio>
#include <cstdint>

#define GAS __attribute__((address_space(1)))
#define LAS __attribute__((address_space(3)))
typedef unsigned short bf16_t;
typedef short bf16x8 __attribute__((ext_vector_type(8)));
typedef short s16x4 __attribute__((ext_vector_type(4)));
typedef float f32x2 __attribute__((ext_vector_type(2)));
typedef float f32x4 __attribute__((ext_vector_type(4)));
typedef float f32x16 __attribute__((ext_vector_type(16)));
typedef unsigned u32x4 __attribute__((ext_vector_type(4)));
typedef unsigned u32x2 __attribute__((ext_vector_type(2)));
typedef unsigned long long u64;

constexpr bool USE_A = true, USE_B = true, USE_C = true;
constexpr bool A_DENSE = false; constexpr bool DSA_FAKE = false;
constexpr int PROBE_ATT = 0;
constexpr int DUP = -1;
constexpr int NB = 16, SEQ = 4096, NTOK = NB * SEQ, D = 1024, DEPTH = 2, NEXP = 32;
constexpr int DP = 2816;
constexpr int D_IN = 5808;
constexpr int C_AQ = 0, C_AK = 256, C_AV = 320, C_IQ = 384, C_IK = 512, C_IW = 544, C_BG = 548, C_BQ = 576, C_BKV = 832, C_CQ = 1216, C_CK = 1728, C_CV = 2240, C_MG = 2752;
constexpr float LOG2E = 1.4426950408889634f;
constexpr float QS = 0.125f * LOG2E;
constexpr float IQS = 0.17677669529663687f;
constexpr float DN_ALPHA = 1.4142135623730951f;
constexpr float LN_EPS = 1e-5f;
constexpr int MOE_ROWS = NTOK * 4 + NEXP * 256;
constexpr float F8_WGU = 256.f, F8_WDN = 512.f, F8_H = 4.f, F8_ACT = 4.f, F8_WIN = 256.f;
constexpr int N_BF = 2816, N_F8 = 3072;

constexpr size_t MiB = 1u << 20;
constexpr size_t WS_CTL = 0, CTL_BYTES = 1 * MiB;
constexpr size_t WS_MOD = 1 * MiB;
constexpr size_t WS_BIAS1 = WS_MOD + 4 * 16 * 3072 * 4;
constexpr size_t WS_LUT = WS_BIAS1 + 4096;
constexpr size_t WS_LAM = WS_LUT + 8192;
constexpr size_t WS_TOKE = 2 * MiB;
constexpr size_t WS_TOKW = 3 * MiB;
constexpr size_t WS_TOKP = 4 * MiB;
constexpr size_t WS_TOKR = 5 * MiB;
constexpr size_t WS_KCMP = 6 * MiB;
constexpr size_t WS_WIN_T = 8 * MiB;
constexpr size_t WS_WBR_T = 31 * MiB;
constexpr size_t WS_WOUT_T = 35 * MiB;
constexpr size_t WS_W1_T = 39 * MiB;
constexpr size_t WS_W2_T = 43 * MiB;
constexpr size_t WS_WGU_T = 44 * MiB;
constexpr size_t WS_WDN_T = 300 * MiB;
constexpr size_t WS_WMG8 = 172 * MiB;
constexpr size_t WS_HB8 = 364 * MiB;
constexpr size_t WS_X1 = 428 * MiB;
constexpr size_t WS_X2B = 556 * MiB;
constexpr size_t WS_HB = 684 * MiB;
constexpr size_t WS_HID = 812 * MiB;
constexpr size_t WS_BIG = 820 * MiB;
constexpr size_t WS_PROJ = WS_BIG;
constexpr size_t WS_MG8 = WS_BIG + 353 * MiB;
constexpr size_t WS_OCAT = WS_BIG + 737 * MiB;
constexpr size_t WS_MERG = WS_OCAT + 128 * MiB;
constexpr size_t WS_BM64 = WS_MERG + 128 * MiB;
constexpr size_t WS_HS = WS_BIG;
constexpr size_t WS_HS8 = WS_BIG + 792 * MiB;
constexpr size_t WS_ACT = WS_BIG + 528 * MiB;
constexpr size_t WS_END = WS_BIG + 1056 * MiB;
static_assert((size_t)(NTOK + 32) * DP * 2 <= 353 * MiB, "proj");
static_assert((size_t)MOE_ROWS * 1024 * 2 <= 528 * MiB, "moe rows");
static_assert(WS_BM64 + 32 * MiB <= WS_END, "ws");
constexpr int CW_CNT = 1024;
constexpr int CW_BAR = 4096;

constexpr int LDS_MISC = 147456;
constexpr int LDS_BYTES = 151552;

#define LDS_WAIT() asm volatile("s_waitcnt lgkmcnt(0)" ::: "memory")
#define VM_WAIT() asm volatile("s_waitcnt vmcnt(0)" ::: "memory")

__device__ __forceinline__ unsigned f2bf(float f) { unsigned u = __builtin_bit_cast(unsigned, f); return (u + 0x7fffu + ((u >> 16) & 1u)) >> 16; }
__device__ __forceinline__ unsigned pk2(float lo, float hi) { return f2bf(lo) | (f2bf(hi) << 16); }
__device__ __forceinline__ float bf2f(unsigned short b) { return __builtin_bit_cast(float, (unsigned)b << 16); }
__device__ __forceinline__ float bflo(unsigned w) { return __builtin_bit_cast(float, w << 16); }
__device__ __forceinline__ float bfhi(unsigned w) { return __builtin_bit_cast(float, w & 0xffff0000u); }
typedef __bf16 bf16x2_t __attribute__((ext_vector_type(2)));
__device__ __forceinline__ unsigned cvt_pk_bf16(float lo, float hi) { return __builtin_bit_cast(unsigned, __builtin_convertvector((f32x2){lo, hi}, bf16x2_t)); }
__device__ __forceinline__ unsigned pk4_fp8(float a, float b, float c, float d) { int r = 0; r = __builtin_amdgcn_cvt_pk_fp8_f32(a, b, r, false); r = __builtin_amdgcn_cvt_pk_fp8_f32(c, d, r, true); return (unsigned)r; }
__device__ __forceinline__ void fp8x8_f32(u32x2 w, float (&f)[8]) { const f32x2 a = __builtin_amdgcn_cvt_pk_f32_fp8((int)w.x, false), b = __builtin_amdgcn_cvt_pk_f32_fp8((int)w.x, true), c = __builtin_amdgcn_cvt_pk_f32_fp8((int)w.y, false), d = __builtin_amdgcn_cvt_pk_f32_fp8((int)w.y, true);
    f[0] = a.x; f[1] = a.y; f[2] = b.x; f[3] = b.y; f[4] = c.x; f[5] = c.y; f[6] = d.x; f[7] = d.y; }
__device__ __forceinline__ float fexp2(float x) { return __builtin_amdgcn_exp2f(x); }
__device__ __forceinline__ float frcp(float x) { return __builtin_amdgcn_rcpf(x); }
__device__ __forceinline__ float fsigmoid(float x) { return frcp(1.f + fexp2(-LOG2E * x)); }
__device__ __forceinline__ float gelu_tanh(float x) { const float u = 0.7978845608028654f * (x + 0.044715f * x * x * x); return x * fsigmoid(2.f * u); }
__device__ __forceinline__ int bperm_i(int idx, int v) { return __builtin_amdgcn_ds_bpermute(idx << 2, v); }
__device__ __forceinline__ float bperm_f(int idx, float v) { return __builtin_bit_cast(float, __builtin_amdgcn_ds_bpermute(idx << 2, __builtin_bit_cast(int, v))); }
__device__ __forceinline__ float other32(float v, int lane) { return bperm_f(lane ^ 32, v); }
__device__ __forceinline__ float sum32(float v, int lane) { return v + bperm_f(lane ^ 32, v); }
__device__ __forceinline__ float max32(float v, int lane) { return fmaxf(v, bperm_f(lane ^ 32, v)); }
__device__ __forceinline__ float shx_f(float v, int mask, int lane) { return bperm_f(lane ^ mask, v); }
__device__ __forceinline__ int shx_i(int v, int mask, int lane) { return bperm_i(lane ^ mask, v); }
__device__ __forceinline__ float wave_sum(float v, int lane) {
#pragma unroll
    for (int o = 1; o < 32; o <<= 1) v += shx_f(v, o, lane);
    return sum32(v, lane);
}

#define XB_TMO      128
#define XB_XCNT(j)  (256  + 64 * (j))
#define XB_XSUB(j)  (1280 + 64 * (j))
#define XB_XGEN(j)  (2304 + 64 * (j))
#define XB_TOP      3328
#define XB_TOPGEN   3392
#define XCD_BAR_WORDS 3456
#define XB_SPIN_CAP (1u << 18)

__device__ __forceinline__ unsigned xb_ld(unsigned* p)              { return __hip_atomic_load(p, __ATOMIC_RELAXED, __HIP_MEMORY_SCOPE_AGENT); }
__device__ __forceinline__ unsigned xb_add(unsigned* p, unsigned v) { return __hip_atomic_fetch_add(p, v, __ATOMIC_RELAXED, __HIP_MEMORY_SCOPE_AGENT); }
__device__ __forceinline__ unsigned xb_xcc_id() { return (unsigned)__builtin_amdgcn_s_getreg((3 << 11) | 20) & 0xFu; }
#define XB_SPIN(cond, bar) do { unsigned _sp = 0; while (cond) { __builtin_amdgcn_s_sleep(1); \
    if ((++_sp & 255u) == 0u) { if (xb_ld(&(bar)[XB_TMO])) break; if (_sp > XB_SPIN_CAP) { atomicAdd(&(bar)[XB_TMO], 1u); break; } } } } while (0)

struct XcdBarrier { unsigned* bar; unsigned x; volatile LAS unsigned* st; };

__device__ __forceinline__ XcdBarrier xcd_barrier_post(unsigned* bar, volatile LAS unsigned* st) {
    XcdBarrier b; b.bar = bar; b.x = xb_xcc_id(); b.st = st;
    if (threadIdx.x == 0) (void)xb_add(&bar[XB_XCNT(b.x)], 1u);
    return b;
}
__device__ __forceinline__ void xcd_barrier_complete(unsigned* bar, unsigned x, unsigned& nloc, unsigned& nx) {
    const unsigned G = gridDim.x * gridDim.y * gridDim.z;
    unsigned sum, cnt, mine, sp = 0u;
    for (;;) {
        sum = 0u; cnt = 0u; mine = 0u;
#pragma unroll
        for (unsigned j = 0; j < 16; ++j) { const unsigned c = xb_ld(&bar[XB_XCNT(j)]); sum += c; cnt += (c > 0u) ? 1u : 0u; mine = (j == x) ? c : mine; }
        if (sum == G) break;
        __builtin_amdgcn_s_sleep(1);
        if ((++sp & 255u) == 0u) { if (xb_ld(&bar[XB_TMO])) break; if (sp > XB_SPIN_CAP) { atomicAdd(&bar[XB_TMO], 1u); break; } }
    }
    nloc = mine > 0u ? mine : 1u; nx = cnt > 0u ? cnt : 1u;
}
__device__ __forceinline__ void xcd_barrier(const XcdBarrier& b) {
    asm volatile("s_waitcnt vmcnt(0)" ::: "memory");
    __syncthreads();
    if (threadIdx.x == 0) {
        unsigned* bar = b.bar;
        __builtin_amdgcn_s_waitcnt(0);
        unsigned nloc = b.st[0], nx = b.st[1];
        if (nloc == 0u) { xcd_barrier_complete(bar, b.x, nloc, nx); b.st[0] = nloc; b.st[1] = nx; }
        const unsigned old = xb_add(&bar[XB_XSUB(b.x)], 1u);
        const unsigned gen = old / nloc;
        if (old + 1u == (gen + 1u) * nloc) {
            __builtin_amdgcn_fence(__ATOMIC_RELEASE, "agent");
            asm volatile("s_waitcnt vmcnt(0)" ::: "memory");
            const unsigned og = xb_add(&bar[XB_TOP], 1u);
            const unsigned tg = og / nx;
            if (og + 1u == (tg + 1u) * nx) xb_add(&bar[XB_TOPGEN], 1u);
            else XB_SPIN(xb_ld(&bar[XB_TOPGEN]) == tg, bar);
            __builtin_amdgcn_fence(__ATOMIC_ACQUIRE, "agent");
            xb_add(&bar[XB_XGEN(b.x)], 1u);
            asm volatile("s_waitcnt vmcnt(0)" ::: "memory");
        } else {
            XB_SPIN(xb_ld(&bar[XB_XGEN(b.x)]) == gen, bar);
            __builtin_amdgcn_fence(__ATOMIC_ACQUIRE, "agent");
            asm volatile("s_waitcnt vmcnt(0)" ::: "memory");
        }
    }
    __syncthreads();
}

__device__ __forceinline__ int fresh_tid(int wave_s) {
    unsigned ones = ~0u; asm volatile("" : "+s"(ones));
    int ln = (int)__builtin_amdgcn_mbcnt_hi(ones, __builtin_amdgcn_mbcnt_lo(ones, 0u)); asm volatile("" : "+v"(ln));
    return wave_s * 64 + ln;
}

namespace pg8 {
typedef int v4i_t __attribute__((ext_vector_type(4)));
typedef int v8i_t __attribute__((ext_vector_type(8)));
constexpr int BM = 256, BK = 64, HALF = 128, HTB = HALF * BK * 2, STAGE_BYTES = 8 * HTB, NXCD = 8, WGM = 8;
__device__ __forceinline__ int lds_byte(int r, int c) { const int st = (r >> 4) * 2 + (c >> 5), rr = r & 15, cc = c & 31, ob = rr * 64 + cc * 2; return st * 1024 + (ob ^ (((ob >> 9) & 1) << 5)); }
__device__ __forceinline__ void stage_rc(int b, int& R, int& C) { const int st = b / 1024, sb = b % 1024, swz = sb ^ (((sb >> 9) & 1) << 5); R = (st >> 1) * 16 + swz / 64; C = (st & 1) * 32 + (swz % 64) / 2; }
__device__ __forceinline__ int perm32(int rho) { const int n = rho >> 4, i = rho & 15; return 8 * (i >> 2) + 4 * n + (i & 3); }

struct Unit { int pm, pn; };
struct Gemm { const bf16_t* A; const bf16_t* Bt; int lda, ldb, K, kstepA; };

struct StaticOrder {
    int nM, nN, nwg, G, c;
    __device__ void init(int M, int N, int G_, int c_) { nM = M / BM; nN = N / BM; nwg = nM * nN; G = G_; c = c_; }
    __device__ bool next(int i, Unit& u) const {
        const long L = (long)i * G + c; if (L >= nwg) return false;
        int wgid = (int)L; { const int q = nwg / NXCD, r = nwg % NXCD, xcd = wgid % NXCD, off = wgid / NXCD; wgid = (xcd < r ? xcd * (q + 1) : r * (q + 1) + (xcd - r) * q) + off; }
        const int nig = WGM * nN, gid = wgid / nig, fm = gid * WGM, gsz = (nM - fm) < WGM ? (nM - fm) : WGM;
        u.pm = fm + ((wgid % nig) % gsz); u.pn = (wgid % nig) / gsz; return true;
    }
    __device__ __forceinline__ const char* a_ptr(const Gemm& g, const Unit& u) const { return (const char*)g.A + (size_t)u.pm * (size_t)(BM * 2) * g.lda; }
    __device__ __forceinline__ const char* b_ptr(const Gemm& g, const Unit& u) const { return (const char*)g.Bt + (size_t)u.pn * (size_t)(BM * 2) * g.ldb; }
};
struct CmpOrder {
    int G, c;
    __device__ bool next(int i, Unit& u) const { const int L = i * G + c; if (L >= 32) return false; u.pn = L >> 4; u.pm = L & 15; return true; }
    __device__ __forceinline__ const char* a_ptr(const Gemm& g, const Unit& u) const { return (const char*)g.A + (size_t)u.pm * (size_t)(BM * 2) * g.lda + u.pn * 128; }
    __device__ __forceinline__ const char* b_ptr(const Gemm& g, const Unit& u) const { return (const char*)g.Bt + (size_t)u.pn * (size_t)(BM * 2) * g.ldb; }
};
struct MoeOrder {
    int G, c, NT, npan; const volatile LAS int* pstart;
    __device__ bool next(int i, Unit& u) const {
        const int ppx = (256 / NT) / 8, x = c & 7, r = c >> 3;
        const int p = i * (256 / NT) + x * ppx + (r % ppx), n = r / ppx; if (p >= npan) return false;
        int e = 0;
#pragma unroll 1
        for (int k = 1; k < 32; ++k) e += (pstart[k] <= p) ? 1 : 0;
        u.pm = p; u.pn = e * NT + n; return true;
    }
    __device__ __forceinline__ const char* a_ptr(const Gemm& g, const Unit& u) const { return (const char*)g.A + (size_t)u.pm * (size_t)(BM * 2) * g.lda; }
    __device__ __forceinline__ const char* b_ptr(const Gemm& g, const Unit& u) const { return (const char*)g.Bt + (size_t)u.pn * (size_t)(BM * 2) * g.ldb; }
};

#define EPI_LOOP_AI_M  _Pragma("unroll") for (int ai = 0; ai < 2; ++ai) _Pragma("unroll") for (int m = 0; m < 4; ++m)

struct EpiProj {
    static constexpr bool PERM = true;
    bf16_t* O; int colbase; float scl;
    __device__ __forceinline__ void operator()(const f32x4 (&acc)[2][2][4][2], const Unit& u, int wr, int wc, int fr, int fq) const {
        const int row0 = u.pm * BM + wr * 64 + fr, col0 = colbase + u.pn * BM + wc * 32 + 8 * fq;
        EPI_LOOP_AI_M { bf16_t* rowp = O + (size_t)(row0 + ai * HALF + m * 16) * DP + col0;
#pragma unroll
            for (int bj = 0; bj < 2; ++bj) { const f32x4 v0 = acc[ai][bj][m][0] * scl, v1 = acc[ai][bj][m][1] * scl;
                u32x4 w; w.x = cvt_pk_bf16(v0[0], v0[1]); w.y = cvt_pk_bf16(v0[2], v0[3]); w.z = cvt_pk_bf16(v1[0], v1[1]); w.w = cvt_pk_bf16(v1[2], v1[3]);
                *(u32x4*)(rowp + bj * HALF) = w; } }
    }
};
struct EpiGate8 {
    static constexpr bool PERM = true;
    unsigned char* O; float scl;
    __device__ __forceinline__ void operator()(const f32x4 (&acc)[2][2][4][2], const Unit& u, int wr, int wc, int fr, int fq) const {
        const int row0 = u.pm * BM + wr * 64 + fr, col0 = u.pn * BM + wc * 32 + 8 * fq;
        EPI_LOOP_AI_M { unsigned char* rowp = O + (size_t)(row0 + ai * HALF + m * 16) * 3072 + col0;
#pragma unroll
            for (int bj = 0; bj < 2; ++bj) { const f32x4 v0 = acc[ai][bj][m][0] * scl, v1 = acc[ai][bj][m][1] * scl;
                *(u32x2*)(rowp + bj * HALF) = (u32x2){pk4_fp8(v0[0], v0[1], v0[2], v0[3]), pk4_fp8(v1[0], v1[1], v1[2], v1[3])}; } }
    }
};
struct EpiCmp1 {
    static constexpr bool PERM = true;
    bf16_t* O; const float* bias;
    __device__ __forceinline__ void operator()(const f32x4 (&acc)[2][2][4][2], const Unit& u, int wr, int wc, int fr, int fq) const {
        const int row0 = u.pm * BM + wr * 64 + fr, col0 = wc * 32 + 8 * fq; const int j = u.pn;
        f32x4 bv[2][2];
#pragma unroll
        for (int bj = 0; bj < 2; ++bj)
#pragma unroll
            for (int n = 0; n < 2; ++n) bv[bj][n] = *(const f32x4*)(bias + j * 256 + col0 + bj * HALF + 4 * n);
        EPI_LOOP_AI_M { bf16_t* rowp = O + ((size_t)j * 4096 + row0 + ai * HALF + m * 16) * 256 + col0;
#pragma unroll
            for (int bj = 0; bj < 2; ++bj) { f32x4 v0 = acc[ai][bj][m][0] + bv[bj][0], v1 = acc[ai][bj][m][1] + bv[bj][1];
#pragma unroll
                for (int q = 0; q < 4; ++q) { v0[q] = gelu_tanh(v0[q]); v1[q] = gelu_tanh(v1[q]); }
                u32x4 w; w.x = cvt_pk_bf16(v0[0], v0[1]); w.y = cvt_pk_bf16(v0[2], v0[3]); w.z = cvt_pk_bf16(v1[0], v1[1]); w.w = cvt_pk_bf16(v1[2], v1[3]);
                *(u32x4*)(rowp + bj * HALF) = w; } }
    }
};
__device__ __forceinline__ float sig_ratio(float a, float b) { return (1.f + fexp2(-LOG2E * b)) * frcp(1.f + fexp2(-LOG2E * a)); }
struct EpiBranchCat {
    static constexpr bool PERM = true, MID = true;
    bf16_t* MG; const unsigned char* G8;
    __device__ __forceinline__ void mid(f32x4 (&acc)[2][2][4][2], const Unit& u, int wr, int wc, int fr, int fq, int seg) const {
        const int row0 = u.pm * BM + wr * 64 + fr, col0 = u.pn * BM + wc * 32 + 8 * fq;
#pragma unroll
        for (int ai = 0; ai < 2; ++ai) {
            u32x2 ga[4][2], gb[4][2];
#pragma unroll
            for (int m = 0; m < 4; ++m) { const size_t row = (size_t)(row0 + ai * HALF + m * 16);
#pragma unroll
                for (int bj = 0; bj < 2; ++bj) { const unsigned char* gp = G8 + row * 3072 + seg * 1024 + col0 + bj * HALF; ga[m][bj] = *(const u32x2*)gp; gb[m][bj] = *(const u32x2*)(gp + 1024); } }
#pragma unroll
            for (int m = 0; m < 4; ++m)
#pragma unroll
                for (int bj = 0; bj < 2; ++bj) { float a[8], b[8]; fp8x8_f32(ga[m][bj], a); fp8x8_f32(gb[m][bj], b); f32x4& v0 = acc[ai][bj][m][0]; f32x4& v1 = acc[ai][bj][m][1];
#pragma unroll
                    for (int q = 0; q < 4; ++q) { v0[q] *= sig_ratio(a[q], b[q]); v1[q] *= sig_ratio(a[4 + q], b[4 + q]); } }
        }
    }
    __device__ __forceinline__ void operator()(const f32x4 (&acc)[2][2][4][2], const Unit& u, int wr, int wc, int fr, int fq) const {
        const int row0 = u.pm * BM + wr * 64 + fr, col0 = u.pn * BM + wc * 32 + 8 * fq;
#pragma unroll
        for (int ai = 0; ai < 2; ++ai) {
            u32x2 gq[4][2];
#pragma unroll
            for (int m = 0; m < 4; ++m) { const size_t row = (size_t)(row0 + ai * HALF + m * 16);
#pragma unroll
                for (int bj = 0; bj < 2; ++bj) gq[m][bj] = *(const u32x2*)(G8 + row * 3072 + 2 * 1024 + col0 + bj * HALF); }
#pragma unroll
            for (int m = 0; m < 4; ++m) { const size_t row = (size_t)(row0 + ai * HALF + m * 16);
#pragma unroll
                for (int bj = 0; bj < 2; ++bj) { float g[8]; fp8x8_f32(gq[m][bj], g); f32x4 v0 = acc[ai][bj][m][0], v1 = acc[ai][bj][m][1];
#pragma unroll
                    for (int q = 0; q < 4; ++q) { v0[q] *= fsigmoid(g[q]); v1[q] *= fsigmoid(g[4 + q]); }
                    u32x4 w; w.x = cvt_pk_bf16(v0[0], v0[1]); w.y = cvt_pk_bf16(v0[2], v0[3]); w.z = cvt_pk_bf16(v1[0], v1[1]); w.w = cvt_pk_bf16(v1[2], v1[3]);
                    *(u32x4*)(MG + row * 1024 + col0 + bj * HALF) = w; } }
        }
    }
};
template <bool XBF> struct EpiWout {
    static constexpr bool PERM = true;
    bf16_t* Z; const void* XR; const float* gate;
    __device__ __forceinline__ void operator()(const f32x4 (&acc)[2][2][4][2], const Unit& u, int wr, int wc, int fr, int fq) const {
        const int row0 = u.pm * BM + wr * 64 + fr, col0 = u.pn * BM + wc * 32 + 8 * fq;
        const int b = (u.pm * BM) >> 12;
        f32x4 gv[2][2];
#pragma unroll
        for (int bj = 0; bj < 2; ++bj)
#pragma unroll
            for (int n = 0; n < 2; ++n) gv[bj][n] = *(const f32x4*)(gate + (size_t)b * 3072 + col0 + bj * HALF + 4 * n) + 1.0f;
#pragma unroll
        for (int ai = 0; ai < 2; ++ai) {
            f32x4 xr[4][2][2];
#pragma unroll
            for (int m = 0; m < 4; ++m) { const size_t ro = (size_t)(row0 + ai * HALF + m * 16) * 1024 + col0;
#pragma unroll
                for (int bj = 0; bj < 2; ++bj) {
                    if (XBF) { const u32x4 q = *(const u32x4*)((const bf16_t*)XR + ro + bj * HALF);
                        xr[m][bj][0] = (f32x4){bflo(q.x), bfhi(q.x), bflo(q.y), bfhi(q.y)}; xr[m][bj][1] = (f32x4){bflo(q.z), bfhi(q.z), bflo(q.w), bfhi(q.w)}; }
                    else { xr[m][bj][0] = *(const f32x4*)((const float*)XR + ro + bj * HALF); xr[m][bj][1] = *(const f32x4*)((const float*)XR + ro + bj * HALF + 4); } } }
            asm volatile("" ::: "memory");
#pragma unroll
            for (int m = 0; m < 4; ++m) { const size_t ro = (size_t)(row0 + ai * HALF + m * 16) * 1024 + col0;
#pragma unroll
                for (int bj = 0; bj < 2; ++bj) { const f32x4 v0 = xr[m][bj][0] * DN_ALPHA + gv[bj][0] * acc[ai][bj][m][0], v1 = xr[m][bj][1] * DN_ALPHA + gv[bj][1] * acc[ai][bj][m][1];
                    u32x4 w; w.x = cvt_pk_bf16(v0[0], v0[1]); w.y = cvt_pk_bf16(v0[2], v0[3]); w.z = cvt_pk_bf16(v1[0], v1[1]); w.w = cvt_pk_bf16(v1[2], v1[3]);
                    *(u32x4*)(Z + ro + bj * HALF) = w; } }
            asm volatile("" ::: "memory");
        }
    }
};
__device__ __forceinline__ float swiglu(float g, float u) { const float gg = fminf(g, 7.f), uu = fminf(fmaxf(u, -7.f), 7.f); return (uu + 1.f) * gg * fsigmoid(1.702f * gg); }
struct EpiMoe1 {
    static constexpr bool PERM = true;
    unsigned char* O; const float* bias;
    __device__ __forceinline__ void operator()(const f32x4 (&acc)[2][2][4][2], const Unit& u, int wr, int wc, int fr, int fq) const {
        const int row0 = u.pm * BM + wr * 64 + fr; const int e = u.pn >> 3, n8 = u.pn & 7; const int cg0 = n8 * BM + wc * 32 + 8 * fq;
        constexpr float isc = 1.f / (F8_H * F8_WGU);
        f32x4 bv[2][2];
#pragma unroll
        for (int bj = 0; bj < 2; ++bj)
#pragma unroll
            for (int n = 0; n < 2; ++n) bv[bj][n] = *(const f32x4*)(bias + (size_t)e * 2048 + cg0 + bj * HALF + 4 * n);
        EPI_LOOP_AI_M { unsigned char* rowp = O + (size_t)(row0 + ai * HALF + m * 16) * 1024 + (cg0 >> 1);
#pragma unroll
            for (int bj = 0; bj < 2; ++bj) { const f32x4 v0 = acc[ai][bj][m][0] * isc + bv[bj][0], v1 = acc[ai][bj][m][1] * isc + bv[bj][1];
                *(unsigned*)(rowp + bj * (HALF / 2)) = pk4_fp8(F8_ACT * swiglu(v0[0], v0[1]), F8_ACT * swiglu(v0[2], v0[3]), F8_ACT * swiglu(v1[0], v1[1]), F8_ACT * swiglu(v1[2], v1[3])); } }
    }
};
struct EpiMoe2 {
    static constexpr bool PERM = true;
    bf16_t* O; const float* bias;
    __device__ __forceinline__ void operator()(const f32x4 (&acc)[2][2][4][2], const Unit& u, int wr, int wc, int fr, int fq) const {
        const int row0 = u.pm * BM + wr * 64 + fr; const int e = u.pn >> 2, n4 = u.pn & 3; const int c0 = n4 * BM + wc * 32 + 8 * fq;
        constexpr float isc = 1.f / (F8_ACT * F8_WDN);
        f32x4 bv[2][2];
#pragma unroll
        for (int bj = 0; bj < 2; ++bj)
#pragma unroll
            for (int n = 0; n < 2; ++n) bv[bj][n] = *(const f32x4*)(bias + (size_t)e * 1024 + c0 + bj * HALF + 4 * n);
        EPI_LOOP_AI_M { bf16_t* rowp = O + (size_t)(row0 + ai * HALF + m * 16) * 1024 + c0;
#pragma unroll
            for (int bj = 0; bj < 2; ++bj) { const f32x4 v0 = acc[ai][bj][m][0] * isc + bv[bj][0], v1 = acc[ai][bj][m][1] * isc + bv[bj][1];
                u32x4 w; w.x = cvt_pk_bf16(v0[0], v0[1]); w.y = cvt_pk_bf16(v0[2], v0[3]); w.z = cvt_pk_bf16(v1[0], v1[1]); w.w = cvt_pk_bf16(v1[2], v1[3]);
                *(u32x4*)(rowp + bj * HALF) = w; } }
    }
};

__device__ __forceinline__ unsigned stage_voff(int tid, int i, int ld, bool perm) {
    int t = tid; asm volatile("" : "+v"(t));
    int R, C; stage_rc(t * 16 + i * 8192, R, C); const int Rb = perm ? ((R & ~31) + perm32(R & 31)) : R;
    return (unsigned)(Rb * ld + C) * 2u;
}
template <class T, class = void> struct has_mid { static constexpr bool value = false; };
template <class T> struct has_mid<T, decltype((void)T::MID)> { static constexpr bool value = T::MID; };
template <class Epi, class Sched, bool FP8 = false>
__device__ __forceinline__ void gemm_phase(LAS unsigned char* lds, const Gemm g, const Sched& S, const Epi& E, int wave_s) {
    const int tid = fresh_tid(wave_s), wid = wave_s, lane = tid & 63, wr = wid >> 2, wc = wid & 3, fr = lane & 15, fq = lane >> 4;
    const int K = g.K, nt = K / BK;
    unsigned voffA[2], voffB[2];
#pragma unroll
    for (int i = 0; i < 2; ++i) { int R, C; stage_rc(tid * 16 + i * 8192, R, C); const int Rb = Epi::PERM ? ((R & ~31) + perm32(R & 31)) : R;
        voffA[i] = (unsigned)(R * g.lda + C) * 2u; voffB[i] = (unsigned)(Rb * g.ldb + C) * 2u; }
    const size_t kstepA = (size_t)g.kstepA, kstepB = (size_t)(BK * 2);
    const size_t hstepA = (size_t)HALF * g.lda * 2, hstepB = (size_t)HALF * g.ldb * 2;
    const unsigned ldsw = (unsigned)wid * 1024u;
    const int aoff = lds_byte(wr * 64 + fr, fq * 8), boff = lds_byte(wc * 32 + fr, fq * 8);
#define PG8_SA(b, h) (((b) * 2 + (h)) * HTB)
#define PG8_SB(b, h) ((4 + (b) * 2 + (h)) * HTB)
#define PG8_VOFF(voff, _i) (FP8 ? stage_voff(tid, _i, (voff) == voffA ? g.lda : g.ldb, (voff) == voffB && Epi::PERM) : (voff)[_i])
#define PG8_STAGE(bufoff, gbase, voff) do { _Pragma("unroll") for (int _i = 0; _i < 2; ++_i) \
        __builtin_amdgcn_global_load_lds((const unsigned*)((const char*)(gbase) + PG8_VOFF(voff, _i)), (LAS unsigned*)(lds + (bufoff) + ldsw + _i * 8192), 16, 0, 0); } while (0)
    const LAS unsigned char* aB = lds + aoff; asm volatile("" : "+v"(aB));
    const LAS unsigned char* bB = lds + 4 * HTB + boff; asm volatile("" : "+v"(bB));
#define PG8_RDA(off) (*(const LAS v4i_t*)(aB + (off)))
#define PG8_RDB(off) (*(const LAS v4i_t*)(bB + (off)))
#define PG8_LDA(dst, b, h) do { _Pragma("unroll") for (int m = 0; m < 4; ++m) dst[m] = __builtin_shufflevector(PG8_RDA(((b) * 2 + (h)) * HTB + m * 2048), PG8_RDA(((b) * 2 + (h)) * HTB + m * 2048 + 1024), 0, 1, 2, 3, 4, 5, 6, 7); } while (0)
#define PG8_LDB(dst, b, h) do { _Pragma("unroll") for (int n = 0; n < 2; ++n) dst[n] = __builtin_shufflevector(PG8_RDB(((b) * 2 + (h)) * HTB + n * 2048), PG8_RDB(((b) * 2 + (h)) * HTB + n * 2048 + 1024), 0, 1, 2, 3, 4, 5, 6, 7); } while (0)
#define PG8_LO(x) __builtin_bit_cast(bf16x8, __builtin_shufflevector(x, x, 0, 1, 2, 3))
#define PG8_HI(x) __builtin_bit_cast(bf16x8, __builtin_shufflevector(x, x, 4, 5, 6, 7))
#define PG8_MMA(ai, bj, At, Bt) do { __builtin_amdgcn_s_setprio(1); _Pragma("unroll") for (int m = 0; m < 4; ++m) _Pragma("unroll") for (int n = 0; n < 2; ++n) { \
        if (FP8) acc[ai][bj][m][n] = __builtin_amdgcn_mfma_scale_f32_16x16x128_f8f6f4(Bt[n], At[m], acc[ai][bj][m][n], 0, 0, 0, 0, 0, 0); \
        else { acc[ai][bj][m][n] = __builtin_amdgcn_mfma_f32_16x16x32_bf16(PG8_LO(Bt[n]), PG8_LO(At[m]), acc[ai][bj][m][n], 0, 0, 0); \
               acc[ai][bj][m][n] = __builtin_amdgcn_mfma_f32_16x16x32_bf16(PG8_HI(Bt[n]), PG8_HI(At[m]), acc[ai][bj][m][n], 0, 0, 0); } } \
        __builtin_amdgcn_s_setprio(0); } while (0)
#define PG8_WAIT_V(n) asm volatile("s_waitcnt vmcnt(" #n ")" ::: "memory")
#define PG8_WAIT_L(n) asm volatile("s_waitcnt lgkmcnt(" #n ")" ::: "memory")
#define PG8_BAR __builtin_amdgcn_s_barrier()
#define PG8_SCHED __builtin_amdgcn_sched_barrier(0)
    Unit cur, nxt; int ui = 0;
    if (!S.next(0, cur)) return;
    f32x4 acc[2][2][4][2];
#pragma unroll
    for (int a = 0; a < 2; ++a)
#pragma unroll
        for (int b = 0; b < 2; ++b)
#pragma unroll
            for (int m = 0; m < 4; ++m)
#pragma unroll
                for (int n = 0; n < 2; ++n) acc[a][b][m][n] = (f32x4){0.f, 0.f, 0.f, 0.f};
    v8i_t At[4], B0[2], B1[2];
    const char* cA = S.a_ptr(g, cur); const char* cB = S.b_ptr(g, cur);
    PG8_STAGE(PG8_SB(0, 0), cB, voffB); PG8_STAGE(PG8_SA(0, 0), cA, voffA); PG8_STAGE(PG8_SB(0, 1), cB + hstepB, voffB); PG8_STAGE(PG8_SA(0, 1), cA + hstepA, voffA);
    if (wr == 1) PG8_BAR;
    PG8_WAIT_V(4); PG8_BAR;
    PG8_STAGE(PG8_SB(1, 0), cB + kstepB, voffB); PG8_STAGE(PG8_SA(1, 0), cA + kstepA, voffA); PG8_STAGE(PG8_SB(1, 1), cB + hstepB + kstepB, voffB);
    PG8_WAIT_V(6); PG8_BAR;
    for (;;) {
        const bool has_next = S.next(ui + 1, nxt);
        const char* nA = has_next ? S.a_ptr(g, nxt) : cA; const char* nB = has_next ? S.b_ptr(g, nxt) : cB;
        for (int t = 0; t < nt; t += 2) {
            if constexpr (has_mid<Epi>::value) { if (t == 4 || t == 8) { const int tz = fresh_tid(wave_s), ln = tz & 63; E.mid(acc, cur, wave_s >> 2, wave_s & 3, ln & 15, ln >> 4, (t >> 2) - 1); } }
            const bool last = (t == nt - 2);
            const char* a1 = cA + (size_t)(t + 1) * kstepA;
            const char* a2 = last ? nA : cA + (size_t)(t + 2) * kstepA; const char* b2 = last ? nB : cB + (size_t)(t + 2) * kstepB;
            const char* a3 = a2 + kstepA; const char* b3 = b2 + kstepB;
            PG8_LDB(B0, 0, 0); PG8_SCHED; PG8_LDA(At, 0, 0); PG8_STAGE(PG8_SA(1, 1), a1 + hstepA, voffA);
            PG8_WAIT_L(8); PG8_BAR; PG8_WAIT_L(0); PG8_MMA(0, 0, At, B0); PG8_BAR; PG8_SCHED;
            PG8_LDB(B1, 0, 1); PG8_STAGE(PG8_SB(0, 0), b2, voffB);
            PG8_BAR; PG8_WAIT_L(0); PG8_MMA(0, 1, At, B1); PG8_BAR;
            PG8_LDA(At, 0, 1); PG8_STAGE(PG8_SA(0, 0), a2, voffA);
            PG8_BAR; PG8_WAIT_L(0); PG8_MMA(1, 0, At, B0); PG8_BAR; PG8_SCHED;
            PG8_STAGE(PG8_SB(0, 1), b2 + hstepB, voffB);
            PG8_WAIT_V(6); PG8_BAR; PG8_MMA(1, 1, At, B1); PG8_BAR;
            PG8_LDB(B0, 1, 0); PG8_SCHED; PG8_LDA(At, 1, 0); PG8_STAGE(PG8_SA(0, 1), a2 + hstepA, voffA);
            PG8_WAIT_L(8); PG8_BAR; PG8_WAIT_L(0); PG8_MMA(0, 0, At, B0); PG8_BAR; PG8_SCHED;
            PG8_LDB(B1, 1, 1); PG8_STAGE(PG8_SB(1, 0), b3, voffB);
            PG8_BAR; PG8_WAIT_L(0); PG8_MMA(0, 1, At, B1); PG8_BAR;
            PG8_LDA(At, 1, 1); PG8_STAGE(PG8_SA(1, 0), a3, voffA);
            PG8_BAR; PG8_WAIT_L(0); PG8_MMA(1, 0, At, B0); PG8_BAR; PG8_SCHED;
            PG8_STAGE(PG8_SB(1, 1), b3 + hstepB, voffB);
            PG8_WAIT_V(6); PG8_BAR; PG8_MMA(1, 1, At, B1); PG8_BAR;
        }
        { const int tz = fresh_tid(wave_s), ln = tz & 63; E(acc, cur, wave_s >> 2, wave_s & 3, ln & 15, ln >> 4); }
        if (!has_next) break;
#pragma unroll
        for (int a = 0; a < 2; ++a)
#pragma unroll
            for (int b = 0; b < 2; ++b)
#pragma unroll
                for (int m = 0; m < 4; ++m)
#pragma unroll
                    for (int n = 0; n < 2; ++n) acc[a][b][m][n] = (f32x4){0.f, 0.f, 0.f, 0.f};
        cur = nxt; cA = nA; cB = nB; ++ui;
    }
    PG8_WAIT_V(0);
    if (wr == 0) PG8_BAR;
    PG8_BAR;
#undef PG8_SA
#undef PG8_SB
#undef PG8_STAGE
#undef PG8_VOFF
#undef PG8_LDA
#undef PG8_LDB
#undef PG8_MMA
#undef PG8_LO
#undef PG8_HI
#undef PG8_RDA
#undef PG8_RDB
#undef PG8_WAIT_V
#undef PG8_WAIT_L
#undef PG8_BAR
#undef PG8_SCHED
}
}

struct Frame {
    LAS unsigned char* lds;
    volatile LAS unsigned* MISC;
    unsigned* ctl;
    unsigned char* ws; unsigned char* ws0;
    const float* const* in;
    float* out;
    int tid, lane, wave, G, gw, NGW, wave0;
};
__device__ __forceinline__ void refresh(Frame& F) {
    unsigned ones = ~0u; asm volatile("" : "+s"(ones));
    int ln = (int)__builtin_amdgcn_mbcnt_hi(ones, __builtin_amdgcn_mbcnt_lo(ones, 0u)); asm volatile("" : "+v"(ln));
    int wv = F.wave0; asm volatile("" : "+s"(wv));
    F.lane = ln; F.wave = wv; F.tid = wv * 64 + ln; F.gw = blockIdx.x * 8 + wv;
    GAS unsigned char* w = (GAS unsigned char*)F.ws0; asm volatile("" : "+s"(w)); F.ws = (unsigned char*)w;
}

__constant__ unsigned char kBucket[128] = {0, 1, 2, 3, 4, 5, 6, 7, 8, 9, 10, 11, 12, 13, 14, 15, 16, 16, 16, 17, 17, 18, 18, 18, 19, 19, 19, 20, 20, 20, 20, 21, 21, 21, 21, 22, 22, 22, 22, 22, 23, 23, 23, 23, 23, 23, 24, 24, 24, 24, 24, 24, 25, 25, 25, 25, 25, 25, 25, 26, 26, 26, 26, 26, 26, 26, 26, 27, 27, 27, 27, 27, 27, 27, 27, 27, 27, 28, 28, 28, 28, 28, 28, 28, 28, 28, 28, 29, 29, 29, 29, 29, 29, 29, 29, 29, 29, 29, 29, 30, 30, 30, 30, 30, 30, 30, 30, 30, 30, 30, 30, 30, 30, 31, 31, 31, 31, 31, 31, 31, 31, 31, 31, 31, 31, 31, 31, 31};

__device__ __forceinline__ int win_src(int n, float& sc) {
    sc = 1.f;
    if (n < 544) { if (n < 256) sc = QS; else if (n >= 384 && n < 512) sc = IQS; return n; }
    if (n < 548) { sc = 0.5f; return n; }
    if (n < 560) return 1188 + (n - 548);
    if (n < 576) return -1;
    if (n < 832) { sc = QS; return 548 + (n - 576); }
    if (n < 1216) return 804 + (n - 832);
    if (n < 1728) { sc = QS; return 1200 + (n - 1216); }
    if (n < 2240) return 1712 + (n - 1728);
    if (n < 2752) return 2224 + (n - 2240);
    if (n < 5824) return 2736 + (n - 2752);
    return -1;
}
template <bool WIN>
__device__ __forceinline__ void p0_transpose_item(const float* W, int K, int Nsrc, int Ndst, bf16_t* WT, LAS float* scr, int item, int lane, int ldt = 0) {
    if (ldt == 0) ldt = K;
    const int nblk = Ndst / 32, kb = item / nblk, nb = item % nblk, k0 = 64 * kb, n0 = 32 * nb;
    if (WIN) { float sc = 1.f; const int src = win_src(n0 + (lane & 31), sc);
#pragma unroll 8
        for (int i = 0; i < 32; ++i) { const int kk = 2 * i + (lane >> 5); scr[kk * 33 + (lane & 31)] = (src >= 0) ? W[(size_t)(k0 + kk) * Nsrc + src] * sc : 0.f; }
    } else {
        f32x4 v[8];
#pragma unroll
        for (int i = 0; i < 8; ++i) v[i] = *(const f32x4*)(W + (size_t)(k0 + 8 * i + (lane >> 3)) * Nsrc + n0 + (lane & 7) * 4);
#pragma unroll
        for (int i = 0; i < 8; ++i) { LAS float* q = scr + (8 * i + (lane >> 3)) * 33 + (lane & 7) * 4; q[0] = v[i].x; q[1] = v[i].y; q[2] = v[i].z; q[3] = v[i].w; }
    }
    LDS_WAIT(); asm volatile("" ::: "memory");
    const int c = lane & 7;
#pragma unroll
    for (int j = 0; j < 4; ++j) { const int n = (lane >> 3) + 8 * j; const LAS float* s = scr + (8 * c) * 33 + n;
        u32x4 o; o.x = pk2(s[0 * 33], s[1 * 33]); o.y = pk2(s[2 * 33], s[3 * 33]); o.z = pk2(s[4 * 33], s[5 * 33]); o.w = pk2(s[6 * 33], s[7 * 33]);
        *(u32x4*)(WT + (size_t)(n0 + n) * ldt + k0 + 8 * c) = o; }
    LDS_WAIT(); asm volatile("" ::: "memory");
}

template <bool WIN>
__device__ __forceinline__ void p0_transpose_item_f8(const float* W, int K, int N, unsigned char* WT, float sc, LAS float* scr, int item, int lane, int Nsrc = 0, int ncol0 = 0) {
    const int nblk = N / 32, kb = item / nblk, nb = item % nblk, k0 = 64 * kb, n0 = 32 * nb;
    if (WIN) { float s1 = 1.f; const int src = win_src(ncol0 + n0 + (lane & 31), s1);
#pragma unroll 8
        for (int i = 0; i < 32; ++i) { const int kk = 2 * i + (lane >> 5); scr[kk * 33 + (lane & 31)] = (src >= 0) ? W[(size_t)(k0 + kk) * Nsrc + src] * (s1 * sc) : 0.f; }
    } else
    { f32x4 v[8];
#pragma unroll
      for (int i = 0; i < 8; ++i) v[i] = *(const f32x4*)(W + (size_t)(k0 + 8 * i + (lane >> 3)) * N + n0 + (lane & 7) * 4);
#pragma unroll
      for (int i = 0; i < 8; ++i) { LAS float* q = scr + (8 * i + (lane >> 3)) * 33 + (lane & 7) * 4; q[0] = v[i].x * sc; q[1] = v[i].y * sc; q[2] = v[i].z * sc; q[3] = v[i].w * sc; } }
    LDS_WAIT(); asm volatile("" ::: "memory");
    const int c = lane & 3;
#pragma unroll
    for (int j = 0; j < 2; ++j) { const int n = (lane >> 2) + 16 * j; const LAS float* q = scr + (16 * c) * 33 + n;
        u32x4 o; o.x = pk4_fp8(q[0 * 33], q[1 * 33], q[2 * 33], q[3 * 33]); o.y = pk4_fp8(q[4 * 33], q[5 * 33], q[6 * 33], q[7 * 33]);
        o.z = pk4_fp8(q[8 * 33], q[9 * 33], q[10 * 33], q[11 * 33]); o.w = pk4_fp8(q[12 * 33], q[13 * 33], q[14 * 33], q[15 * 33]);
        *(u32x4*)(WT + (size_t)(n0 + n) * K + k0 + 16 * c) = o; }
    LDS_WAIT(); asm volatile("" ::: "memory");
}
__device__ __forceinline__ void phase_prologue(Frame& F) {
    const float* const* in = F.in;
    LAS float* scr = (LAS float*)(F.lds + F.wave * 16384);
    constexpr int I_WIN = 16 * (N_BF / 32), I_WMG = 16 * (N_F8 / 32);
    constexpr int I_BA = 4 * 32, I_BC = 8 * 32, I_WO = 16 * 32, I_W1 = 32 * 8, I_W2 = 4 * 2;
    constexpr int I_GU = 16 * 64, I_DN = 16 * 32;
    constexpr int N_GU = 64 * I_GU, N_DN = 64 * I_DN, N_WIN = 2 * I_WIN, N_BA = 2 * I_BA, N_BC = 2 * I_BC, N_WO = 2 * I_WO, N_W1 = 4 * I_W1, N_W2 = 4 * I_W2, N_WMG = 2 * I_WMG;
    constexpr int NITEMS = N_GU + N_DN + N_WIN + N_WMG + 2 * N_BA + N_BC + N_WO + N_W1 + N_W2;
    for (int it = F.gw; it < NITEMS; it += F.NGW) {
        int r = it;
        if (r < N_GU) { const int m = r / I_GU; p0_transpose_item_f8<false>(in[21] + (size_t)m * 1024 * 2048, 1024, 2048, (unsigned char*)(F.ws + WS_WGU_T) + (size_t)m * 2048 * 1024, F8_WGU, scr, r % I_GU, F.lane); continue; } r -= N_GU;
        if (r < N_DN) { const int m = r / I_DN; p0_transpose_item_f8<false>(in[23] + (size_t)m * 1024 * 1024, 1024, 1024, (unsigned char*)(F.ws + WS_WDN_T) + (size_t)m * 1024 * 1024, F8_WDN, scr, r % I_DN, F.lane); continue; } r -= N_DN;
        if (r < N_WIN) { const int m = r / I_WIN; p0_transpose_item<true>(in[5] + (size_t)m * 1024 * D_IN, 1024, D_IN, N_BF, (bf16_t*)(F.ws + WS_WIN_T) + (size_t)m * DP * 1024, scr, r % I_WIN, F.lane); continue; } r -= N_WIN;
        if (r < N_WMG) { const int m = r / I_WMG; p0_transpose_item_f8<true>(in[5] + (size_t)m * 1024 * D_IN, 1024, N_F8, (unsigned char*)(F.ws + WS_WMG8) + (size_t)m * N_F8 * 1024, F8_WIN, scr, r % I_WMG, F.lane, D_IN, C_MG); continue; } r -= N_WMG;
        if (r < N_BA) { const int m = r / I_BA; p0_transpose_item<false>(in[11] + (size_t)m * 256 * 1024, 256, 1024, 1024, (bf16_t*)(F.ws + WS_WBR_T + m * 2 * MiB), scr, r % I_BA, F.lane, 1024); continue; } r -= N_BA;
        if (r < N_BA) { const int m = r / I_BA; p0_transpose_item<false>(in[12] + (size_t)m * 256 * 1024, 256, 1024, 1024, (bf16_t*)(F.ws + WS_WBR_T + m * 2 * MiB) + 256, scr, r % I_BA, F.lane, 1024); continue; } r -= N_BA;
        if (r < N_BC) { const int m = r / I_BC; p0_transpose_item<false>(in[13] + (size_t)m * 512 * 1024, 512, 1024, 1024, (bf16_t*)(F.ws + WS_WBR_T + m * 2 * MiB) + 512, scr, r % I_BC, F.lane, 1024); continue; } r -= N_BC;
        if (r < N_WO) { const int m = r / I_WO; p0_transpose_item<false>(in[14] + (size_t)m * 1024 * 1024, 1024, 1024, 1024, (bf16_t*)(F.ws + WS_WOUT_T) + (size_t)m * 1024 * 1024, scr, r % I_WO, F.lane); continue; } r -= N_WO;
        if (r < N_W1) { const int m = r / I_W1; p0_transpose_item<false>(in[7] + (size_t)m * 2048 * 256, 2048, 256, 256, (bf16_t*)(F.ws + WS_W1_T) + (size_t)m * 256 * 2048, scr, r % I_W1, F.lane); continue; } r -= N_W1;
        { const int m = r / I_W2; p0_transpose_item<false>(in[8] + (size_t)m * 256 * 64, 256, 64, 64, (bf16_t*)(F.ws + WS_W2_T) + (size_t)m * 64 * 256, scr, r % I_W2, F.lane); }
    }
    __syncthreads();
    if (blockIdx.x < 27) {
        LAS float* sc = (LAS float*)F.lds;
        for (int i = F.tid; i < 16 * 1024; i += 512) { const int b = i >> 10, k = i & 1023; const float v = in[1][i]; sc[k * 16 + b] = v * fsigmoid(v); }
        __syncthreads();
        if (F.gw < 192) {
            const int which = F.gw / 48, cb = F.gw % 48, layer = which >> 1, col = cb * 64 + F.lane;
            const float* W = (which & 1 ? in[17] : in[3]) + (size_t)layer * 1024 * 3072;
            const float* Bv = (which & 1 ? in[18] : in[4]) + (size_t)layer * 3072;
            float acc[16];
#pragma unroll
            for (int b = 0; b < 16; ++b) acc[b] = 0.f;
#pragma unroll 4
            for (int k = 0; k < 1024; ++k) { const float w = W[(size_t)k * 3072 + col];
                const f32x4 s0 = *(const LAS f32x4*)(sc + k * 16), s1 = *(const LAS f32x4*)(sc + k * 16 + 4), s2 = *(const LAS f32x4*)(sc + k * 16 + 8), s3 = *(const LAS f32x4*)(sc + k * 16 + 12);
#pragma unroll
                for (int q = 0; q < 4; ++q) { acc[q] += s0[q] * w; acc[4 + q] += s1[q] * w; acc[8 + q] += s2[q] * w; acc[12 + q] += s3[q] * w; } }
            float* mod = (float*)(F.ws + WS_MOD) + (size_t)which * 16 * 3072;
            const float bb = Bv[col];
#pragma unroll
            for (int b = 0; b < 16; ++b) mod[(size_t)b * 3072 + col] = acc[b] + bb;
        } else if (F.gw < 208) {
            const int u = F.gw - 192, m = u >> 2, n = (u & 3) * 64 + F.lane;
            const float* P = in[6] + (size_t)m * 2048; const float* W = in[7] + (size_t)m * 2048 * 256;
            float a = 0.f;
#pragma unroll 8
            for (int r = 0; r < 2048; ++r) a += P[r] * W[(size_t)r * 256 + n];
            ((float*)(F.ws + WS_BIAS1))[m * 256 + n] = a;
        } else if (F.gw == 208) {
            float* lut = (float*)(F.ws + WS_LUT);
            for (int i = F.lane; i < 12 * 128; i += 64) { const int h = i >> 7, d = i & 127; lut[i] = (in[2][kBucket[d] * 12 + h] - in[2][31 * 12 + h]) * LOG2E; }
            for (int l = 0; l < 2; ++l) { const float* dl = in[9] + l * 256;
                const float s1 = wave_sum(dl[F.lane] * dl[64 + F.lane], F.lane), s2 = wave_sum(dl[128 + F.lane] * dl[192 + F.lane], F.lane);
                const float lam_init = 0.8f - 0.6f * __expf(-0.3f * (float)l);
                if (F.lane == 0) ((float*)(F.ws + WS_LAM))[l] = __expf(s1) - __expf(s2) + lam_init; }
        }
    }
}

__device__ __forceinline__ void phase_h0(Frame& F, const float* X, const float* mod, bf16_t* HB, unsigned char* HB8) {
    for (int row = F.gw; row < NTOK; row += F.NGW) { const int b = row >> 12;
        const f32x4* xr = (const f32x4*)(X + (size_t)row * 1024) + F.lane; const f32x4* sh = (const f32x4*)(mod + (size_t)b * 3072) + F.lane; const f32x4* sc = (const f32x4*)(mod + (size_t)b * 3072 + 1024) + F.lane;
        u64* o8 = (u64*)(HB + (size_t)row * 1024) + F.lane; unsigned* q8 = (unsigned*)(HB8 + (size_t)row * 1024) + F.lane;
#pragma unroll
        for (int j = 0; j < 4; ++j) { const f32x4 v = xr[64 * j] * (sc[64 * j] + 1.0f) + sh[64 * j]; o8[64 * j] = (u64)pk2(v.x, v.y) | ((u64)pk2(v.z, v.w) << 32);
            q8[64 * j] = pk4_fp8(F8_H * v.x, F8_H * v.y, F8_H * v.z, F8_H * v.w); } }
}
__device__ __forceinline__ void ln_stats(const f32x4 (&v)[4], float& mean, float& rstd, int lane) {
    float s = 0.f;
#pragma unroll
    for (int j = 0; j < 4; ++j) s += (v[j].x + v[j].y) + (v[j].z + v[j].w);
    mean = wave_sum(s, lane) * (1.f / 1024.f); float s2 = 0.f;
#pragma unroll
    for (int j = 0; j < 4; ++j) { const f32x4 d = v[j] - mean; s2 += (d.x * d.x + d.y * d.y) + (d.z * d.z + d.w * d.w); }
    rstd = 1.f / sqrtf(wave_sum(s2, lane) * (1.f / 1024.f) + LN_EPS);
}

__device__ __forceinline__ void phase_ln1_router(Frame& F, bf16_t* Z, const float* g1, const float* b1, const float* mod, const float* rw, const float* rb, bf16_t* HB, unsigned* cnt) {
    LAS float* rwT = (LAS float*)F.lds;
    for (int i = F.tid; i < 32 * 1024; i += 512) { const int k = i >> 5, e = i & 31; rwT[e * 1024 + k] = rw[i]; }
    __syncthreads();
    const int lane = F.lane, e_l = lane >> 1;
    const float rbias = rb[e_l];
    unsigned slot0 = 0, slot1 = 0; unsigned cnt_local = 0;
    f32x4 gg[4], bb[4];
#pragma unroll
    for (int j = 0; j < 4; ++j) { gg[j] = ((const f32x4*)g1)[lane + 64 * j]; bb[j] = ((const f32x4*)b1)[lane + 64 * j]; }
    int it = 0;
    for (int row = F.gw; row < NTOK; row += F.NGW, ++it) { const int b = row >> 12;
        u32x2* zr = (u32x2*)(Z + (size_t)row * 1024) + lane; const f32x4* sh = (const f32x4*)(mod + (size_t)b * 3072) + lane; const f32x4* sc = (const f32x4*)(mod + (size_t)b * 3072 + 1024) + lane;
        f32x4 v[4];
#pragma unroll
        for (int j = 0; j < 4; ++j) { const u32x2 q = zr[64 * j]; v[j] = (f32x4){bflo(q.x), bfhi(q.x), bflo(q.y), bfhi(q.y)}; }
        float mean, rstd; ln_stats(v, mean, rstd, lane);
        u64* o8 = (u64*)(HB + (size_t)row * 1024) + lane;
        f32x4 h[4];
#pragma unroll
        for (int j = 0; j < 4; ++j) { const f32x4 xn = (v[j] - mean) * rstd * gg[j] + bb[j]; zr[64 * j] = (u32x2){cvt_pk_bf16(xn.x, xn.y), cvt_pk_bf16(xn.z, xn.w)}; h[j] = xn * (sc[64 * j] + 1.0f) + sh[64 * j];
            o8[64 * j] = (u64)pk2(h[j].x, h[j].y) | ((u64)pk2(h[j].z, h[j].w) << 32); }
        float a[32];
#pragma unroll
        for (int e = 0; e < 32; ++e) { float s = 0.f;
#pragma unroll
            for (int j = 0; j < 4; ++j) { const f32x4 w = *(const LAS f32x4*)(rwT + e * 1024 + 4 * lane + 256 * j); s += (h[j].x * w.x + h[j].y * w.y) + (h[j].z * w.z + h[j].w * w.w); }
            a[e] = s; if ((e & 3) == 3) __builtin_amdgcn_sched_barrier(0); }
#pragma unroll
        for (int st = 0; st < 5; ++st) { const int half = 16 >> st, x = 32 >> st; const bool up = (lane & x) != 0;
#pragma unroll
            for (int i = 0; i < half; ++i) { const float send = up ? a[i] : a[i + half], keep = up ? a[i + half] : a[i]; a[i] = keep + (st == 0 ? other32(send, lane) : shx_f(send, x, lane)); } }
        float lg = a[0] + shx_f(a[0], 1, lane) + rbias;
        float tv[4]; int te[4];
#pragma unroll
        for (int k = 0; k < 4; ++k) { float bv = lg; int be = e_l;
#pragma unroll
            for (int x = 2; x < 64; x <<= 1) { const float ov = shx_f(bv, x, lane); const int oe = shx_i(be, x, lane); if (ov > bv || (ov == bv && oe < be)) { bv = ov; be = oe; } }
            tv[k] = bv; te[k] = be; if (e_l == be) lg = -INFINITY; }
        const float e1 = __expf(tv[1] - tv[0]), e2 = __expf(tv[2] - tv[0]), e3 = __expf(tv[3] - tv[0]); const float inv = 1.f / (1.f + e1 + e2 + e3);
        if (lane == 0) { *(int4*)((int*)(F.ws + WS_TOKE) + (size_t)row * 4) = make_int4(te[0], te[1], te[2], te[3]);
            *(f32x4*)((float*)(F.ws + WS_TOKW) + (size_t)row * 4) = (f32x4){inv, e1 * inv, e2 * inv, e3 * inv}; }
#pragma unroll
        for (int k = 0; k < 4; ++k) { const int ek = __builtin_amdgcn_readfirstlane(te[k]); const unsigned rk = (unsigned)__builtin_amdgcn_readlane((int)cnt_local, ek);
            if (lane == ek) ++cnt_local;
            const int idx = it * 4 + k; const unsigned val = ((unsigned)ek << 16) | rk;
            if (lane == (idx & 63)) { if (idx < 64) slot0 = val; else slot1 = val; } }
    }
    unsigned base = 0;
    if (lane < 32) base = __hip_atomic_fetch_add(cnt + lane, cnt_local, __ATOMIC_RELAXED, __HIP_MEMORY_SCOPE_AGENT);
#pragma unroll
    for (int s = 0; s < 2; ++s) { const unsigned val = s ? slot1 : slot0; const int e = (int)(val >> 16); const unsigned pos = (unsigned)bperm_i(e, (int)base) + (val & 0xffffu);
        const int i = (64 * s + lane) >> 2, k = lane & 3; const int row = F.gw + i * F.NGW;
        if (i < it) ((int*)(F.ws + WS_TOKP))[(size_t)row * 4 + k] = (int)pos; }
    __syncthreads();
}

__device__ __forceinline__ void build_pstart(Frame& F, const unsigned* cnt) {
    if (F.tid == 0) { int p = 0; for (int e = 0; e < 32; ++e) { F.MISC[16 + e] = (unsigned)p; p += (int)((__hip_atomic_load(cnt + e, __ATOMIC_RELAXED, __HIP_MEMORY_SCOPE_AGENT) + 255u) >> 8); } F.MISC[48] = (unsigned)p; }
    __syncthreads();
}
__device__ __forceinline__ void phase_gather(Frame& F, const unsigned* cnt, const bf16_t* HB, unsigned char* HS) {
    build_pstart(F, cnt);
    for (int row = F.gw; row < NTOK; row += F.NGW) {
        const int4 te = *(const int4*)((const int*)(F.ws + WS_TOKE) + (size_t)row * 4), tp = *(const int4*)((const int*)(F.ws + WS_TOKP) + (size_t)row * 4);
        const int r0 = (int)F.MISC[16 + te.x] * 256 + tp.x, r1 = (int)F.MISC[16 + te.y] * 256 + tp.y, r2 = (int)F.MISC[16 + te.z] * 256 + tp.z, r3 = (int)F.MISC[16 + te.w] * 256 + tp.w;
        if (F.lane == 0) *(int4*)((int*)(F.ws + WS_TOKR) + (size_t)row * 4) = make_int4(r0, r1, r2, r3);
        const u32x4* src = (const u32x4*)(HB + (size_t)row * 1024) + 2 * F.lane; const u32x4 a = src[0], b = src[1];
        u32x4 v;
        v.x = pk4_fp8(F8_H * bflo(a.x), F8_H * bfhi(a.x), F8_H * bflo(a.y), F8_H * bfhi(a.y)); v.y = pk4_fp8(F8_H * bflo(a.z), F8_H * bfhi(a.z), F8_H * bflo(a.w), F8_H * bfhi(a.w));
        v.z = pk4_fp8(F8_H * bflo(b.x), F8_H * bfhi(b.x), F8_H * bflo(b.y), F8_H * bfhi(b.y)); v.w = pk4_fp8(F8_H * bflo(b.z), F8_H * bfhi(b.z), F8_H * bflo(b.w), F8_H * bfhi(b.w));
        ((u32x4*)(HS + (size_t)r0 * 1024))[F.lane] = v; ((u32x4*)(HS + (size_t)r1 * 1024))[F.lane] = v; ((u32x4*)(HS + (size_t)r2 * 1024))[F.lane] = v; ((u32x4*)(HS + (size_t)r3 * 1024))[F.lane] = v;
    }
    if (blockIdx.x < 32) { const int e = blockIdx.x; const int c = (int)__hip_atomic_load(cnt + e, __ATOMIC_RELAXED, __HIP_MEMORY_SCOPE_AGENT);
        const int rbeg = (int)F.MISC[16 + e] * 256 + c, rend = (int)F.MISC[17 + e] * 256;
        for (int r = rbeg + F.wave; r < rend; r += 8) ((u32x4*)(HS + (size_t)r * 1024))[F.lane] = (u32x4){0u, 0u, 0u, 0u}; }
}
__device__ __forceinline__ void phase_combine(Frame& F, const bf16_t* YS, const bf16_t* X1, const float* modf, const float* g2, const float* b2, float* XO, const float* modn, bf16_t* HB, unsigned char* HB8, bf16_t* X2B) {
    const int lane = F.lane;
    f32x4 gg[4], bb[4];
#pragma unroll
    for (int q = 0; q < 4; ++q) { gg[q] = ((const f32x4*)g2)[128 * (q >> 1) + 2 * lane + (q & 1)]; bb[q] = ((const f32x4*)b2)[128 * (q >> 1) + 2 * lane + (q & 1)]; }
    for (int row = F.gw; row < NTOK; row += F.NGW) { const int b = row >> 12;
        const int4 tr = *(const int4*)((const int*)(F.ws + WS_TOKR) + (size_t)row * 4); const f32x4 tw = *(const f32x4*)((const float*)(F.ws + WS_TOKW) + (size_t)row * 4);
        const int rr[4] = {tr.x, tr.y, tr.z, tr.w}; const float ww[4] = {tw.x, tw.y, tw.z, tw.w};
        u32x4 yq[4][2];
#pragma unroll
        for (int k = 0; k < 4; ++k)
#pragma unroll
            for (int c = 0; c < 2; ++c) yq[k][c] = ((const u32x4*)(YS + (size_t)rr[k] * 1024))[64 * c + lane];
        u32x4 xq[2];
#pragma unroll
        for (int c = 0; c < 2; ++c) xq[c] = ((const u32x4*)(X1 + (size_t)row * 1024))[64 * c + lane];
        const f32x4* gt = (const f32x4*)(modf + (size_t)b * 3072 + 2048);
        f32x4 v[4];
#pragma unroll
        for (int c = 0; c < 2; ++c) { f32x4 y0 = (f32x4){0.f, 0.f, 0.f, 0.f}, y1 = y0;
#pragma unroll
            for (int k = 0; k < 4; ++k) { const u32x4 w = yq[k][c]; y0 += (f32x4){bflo(w.x), bfhi(w.x), bflo(w.y), bfhi(w.y)} * ww[k]; y1 += (f32x4){bflo(w.z), bfhi(w.z), bflo(w.w), bfhi(w.w)} * ww[k]; }
            const u32x4 q = xq[c];
            v[2 * c] = (f32x4){bflo(q.x), bfhi(q.x), bflo(q.y), bfhi(q.y)} * DN_ALPHA + (gt[128 * c + 2 * lane] + 1.0f) * y0;
            v[2 * c + 1] = (f32x4){bflo(q.z), bfhi(q.z), bflo(q.w), bfhi(q.w)} * DN_ALPHA + (gt[128 * c + 2 * lane + 1] + 1.0f) * y1; }
        float mean, rstd; ln_stats(v, mean, rstd, lane);
        if (modn) { const f32x4* sh = (const f32x4*)(modn + (size_t)b * 3072); const f32x4* sc = (const f32x4*)(modn + (size_t)b * 3072 + 1024);
#pragma unroll
            for (int c = 0; c < 2; ++c) { const f32x4 x0 = (v[2 * c] - mean) * rstd * gg[2 * c] + bb[2 * c], x1 = (v[2 * c + 1] - mean) * rstd * gg[2 * c + 1] + bb[2 * c + 1];
                ((u32x4*)(X2B + (size_t)row * 1024))[64 * c + lane] = (u32x4){cvt_pk_bf16(x0.x, x0.y), cvt_pk_bf16(x0.z, x0.w), cvt_pk_bf16(x1.x, x1.y), cvt_pk_bf16(x1.z, x1.w)};
                const f32x4 h0 = x0 * (sc[128 * c + 2 * lane] + 1.0f) + sh[128 * c + 2 * lane], h1 = x1 * (sc[128 * c + 2 * lane + 1] + 1.0f) + sh[128 * c + 2 * lane + 1];
                ((u32x4*)(HB + (size_t)row * 1024))[64 * c + lane] = (u32x4){cvt_pk_bf16(h0.x, h0.y), cvt_pk_bf16(h0.z, h0.w), cvt_pk_bf16(h1.x, h1.y), cvt_pk_bf16(h1.z, h1.w)};
                ((u32x2*)(HB8 + (size_t)row * 1024))[64 * c + lane] = (u32x2){pk4_fp8(F8_H * h0.x, F8_H * h0.y, F8_H * h0.z, F8_H * h0.w), pk4_fp8(F8_H * h1.x, F8_H * h1.y, F8_H * h1.z, F8_H * h1.w)}; }
        } else {
#pragma unroll
            for (int q = 0; q < 4; ++q) ((f32x4*)(XO + (size_t)row * 1024))[128 * (q >> 1) + 2 * lane + (q & 1)] = (v[q] - mean) * rstd * gg[q] + bb[q];
        }
    }
}

__device__ __forceinline__ unsigned okey16(float v) { unsigned u = __builtin_bit_cast(unsigned, v); u = (u & 0x80000000u) ? ~u : (u | 0x80000000u); return u >> 16; }
__device__ __forceinline__ f32x4 idx_score(const bf16x8 ka, const bf16x8 (&qb)[4], const float (&w4)[4]) {
    f32x4 s = (f32x4){0.f, 0.f, 0.f, 0.f};
#pragma unroll
    for (int h = 0; h < 4; ++h) { const f32x4 c = __builtin_amdgcn_mfma_f32_16x16x32_bf16(ka, qb[h], (f32x4){0.f, 0.f, 0.f, 0.f}, 0, 0, 0);
#pragma unroll
        for (int j = 0; j < 4; ++j) s[j] += w4[h] * fmaxf(c[j], 0.f); }
    return s;
}
constexpr int DS_HIST = 32768;
__device__ __forceinline__ void scan_row(const volatile LAS unsigned* hw, unsigned need, int lane, int& bin, unsigned& above, unsigned& cntb) {
    const unsigned c0 = hw[4 * lane], c1 = hw[4 * lane + 1], c2 = hw[4 * lane + 2], c3 = hw[4 * lane + 3];
    unsigned S = (c0 + c1) + (c2 + c3);
#pragma unroll
    for (int o = 1; o < 64; o <<= 1) { const unsigned t = (unsigned)bperm_i((lane + o) & 63, (int)S); if (lane + o < 64) S += t; }
    const u64 bal = __ballot(S >= need);
    const int L = bal ? 63 - __clzll((long long)bal) : 0;
    const unsigned Snext = (unsigned)bperm_i((L + 1) & 63, (int)S);
    unsigned run = (L < 63) ? Snext : 0u;
    const unsigned d3 = (unsigned)bperm_i(L, (int)c3), d2 = (unsigned)bperm_i(L, (int)c2), d1 = (unsigned)bperm_i(L, (int)c1), d0 = (unsigned)bperm_i(L, (int)c0);
    if (run + d3 >= need) { bin = 4 * L + 3; above = run; cntb = d3; return; } run += d3;
    if (run + d2 >= need) { bin = 4 * L + 2; above = run; cntb = d2; return; } run += d2;
    if (run + d1 >= need) { bin = 4 * L + 1; above = run; cntb = d1; return; } run += d1;
    bin = 4 * L; above = run; cntb = d0;
}
template <int PASS, bool ALLSEL>
__device__ __forceinline__ void dsa_pass(Frame& F, const bf16_t* kbase, unsigned* KS, const bf16x8 (&qb)[4], const float (&w4)[4], int nkt, int tq, unsigned r_a) {
    const int lane = F.lane, fr = lane & 15, fq = lane >> 4;
    LAS unsigned* hist = (LAS unsigned*)(F.lds + DS_HIST); LAS unsigned* bm = (LAS unsigned*)F.lds;
    const int kt0 = F.wave; if (kt0 >= nkt) return;
    u32x2* ksl = (u32x2*)KS + lane;
    if (PASS == 3 && ALLSEL) {
        for (int kt = kt0; kt < nkt; kt += 8) { unsigned nd = 0;
#pragma unroll
            for (int j = 0; j < 4; ++j) nd |= ((kt * 16 + 4 * fq + j) <= tq ? 1u : 0u) << j;
            if (nd) __hip_atomic_fetch_or(bm + fr * 128 + (kt >> 1), nd << (16 * (kt & 1) + 4 * fq), __ATOMIC_RELAXED, __HIP_MEMORY_SCOPE_WORKGROUP); }
        return;
    }
    u32x4 kc[4], kn[4];
#pragma unroll
    for (int u = 0; u < 4; ++u) { kc[u] = (u32x4){0u, 0u, 0u, 0u}; if (kt0 + 8 * u < nkt) { if (PASS == 1) kc[u] = __builtin_bit_cast(u32x4, *(const bf16x8*)(kbase + (size_t)(kt0 + 8 * u) * 16 * DP)); else { const u32x2 q = ksl[(size_t)(kt0 + 8 * u) * 64]; kc[u].x = q.x; kc[u].y = q.y; } } }
    for (int kg = kt0; kg < nkt; kg += 32) {
#pragma unroll
        for (int u = 0; u < 4; ++u) { kn[u] = kc[u]; if (kg + 32 + 8 * u < nkt) { if (PASS == 1) kn[u] = __builtin_bit_cast(u32x4, *(const bf16x8*)(kbase + (size_t)(kg + 32 + 8 * u) * 16 * DP)); else { const u32x2 q = ksl[(size_t)(kg + 32 + 8 * u) * 64]; kn[u].x = q.x; kn[u].y = q.y; } } }
#pragma unroll
        for (int u = 0; u < 4; ++u) { const int kt = kg + 8 * u;
            if (kt < nkt) {
                unsigned kk[4];
                if (PASS == 1) { const f32x4 sc = idx_score(__builtin_bit_cast(bf16x8, kc[u]), qb, w4);
#pragma unroll
                    for (int j = 0; j < 4; ++j) kk[j] = okey16(sc[j]);
                    ksl[(size_t)kt * 64] = (u32x2){kk[0] | (kk[1] << 16), kk[2] | (kk[3] << 16)};
                } else { kk[0] = kc[u].x & 0xffffu; kk[1] = kc[u].x >> 16; kk[2] = kc[u].y & 0xffffu; kk[3] = kc[u].y >> 16; }
                const bool diag = (kt == nkt - 1);
                unsigned nd = 0, nt_ = 0;
#pragma unroll
                for (int j = 0; j < 4; ++j) { const bool valid = !diag || (kt * 16 + 4 * fq + j) <= tq; const unsigned key = kk[j];
                    if (PASS == 1) { if (valid) __hip_atomic_fetch_add(hist + fr * 256 + (key >> 8), 1u, __ATOMIC_RELAXED, __HIP_MEMORY_SCOPE_WORKGROUP); }
                    if (PASS == 2) { if (valid && (key >> 8) == r_a) __hip_atomic_fetch_add(hist + fr * 256 + (key & 255u), 1u, __ATOMIC_RELAXED, __HIP_MEMORY_SCOPE_WORKGROUP); }
                    if (PASS == 3) { if (valid) { nd |= (key > r_a ? 1u : 0u) << j; nt_ |= (key == r_a ? 1u : 0u) << j; } } }
                if (PASS == 3) { const int sh = 16 * (kt & 1) + 4 * fq; const int wd = fr * 128 + (kt >> 1);
                    if (nd) __hip_atomic_fetch_or(bm + wd, nd << sh, __ATOMIC_RELAXED, __HIP_MEMORY_SCOPE_WORKGROUP);
                    if (nt_) __hip_atomic_fetch_or(bm + 2048 + wd, nt_ << sh, __ATOMIC_RELAXED, __HIP_MEMORY_SCOPE_WORKGROUP); }
            } }
#pragma unroll
        for (int u = 0; u < 4; ++u) kc[u] = kn[u];
    }
}
__device__ __forceinline__ void lds_zero(Frame& F, int off, int bytes) {
    LAS u32x4* p = (LAS u32x4*)(F.lds + off); unsigned z = 0u; asm volatile("" : "+v"(z));
    for (int i = F.tid; i < bytes / 16; i += 512) p[i] = (u32x4){z, z, z, z};
}
__device__ __forceinline__ void dsa_select_tile(Frame& F, const bf16_t* P, u64* BM, unsigned* KS, int b, int qt) {
    volatile LAS unsigned* rinfo = F.MISC + 64;
    volatile LAS unsigned* bm = (volatile LAS unsigned*)F.lds; volatile LAS unsigned* hist = (volatile LAS unsigned*)(F.lds + DS_HIST);
    const int lane = F.lane, fr = lane & 15, fq = lane >> 4, w = F.wave;
    const int t0 = qt * 16, nkt = qt + 1; const size_t rowbase = (size_t)b * 4096;
    const bf16_t* qrow = P + (rowbase + t0 + fr) * DP;
    bf16x8 qb[4];
#pragma unroll
    for (int h = 0; h < 4; ++h) qb[h] = *(const bf16x8*)(qrow + C_IQ + h * 32 + 8 * fq);
    const u32x2 iwp = *(const u32x2*)(qrow + C_IW); const float w4[4] = {bflo(iwp.x), bfhi(iwp.x), bflo(iwp.y), bfhi(iwp.y)};
    const bf16_t* kbase = P + (rowbase + fr) * DP + C_IK + 8 * fq;
    const int tq = t0 + fr;
    lds_zero(F, 0, 16384);
    if (qt >= 16) {
        lds_zero(F, DS_HIST, 16384); __syncthreads();
        dsa_pass<1, false>(F, kbase, KS, qb, w4, nkt, tq, 0u);
        __syncthreads();
#pragma unroll 1
        for (int rr = 0; rr < 2; ++rr) { const int r = 2 * w + rr; int bin; unsigned above, cb; scan_row(hist + r * 256, 256u, lane, bin, above, cb);
            if (lane == 0) { rinfo[r * 4 + 0] = (unsigned)bin; rinfo[r * 4 + 1] = 256u - above; } }
        __syncthreads();
        lds_zero(F, DS_HIST, 16384); __syncthreads();
        dsa_pass<2, false>(F, kbase, KS, qb, w4, nkt, tq, rinfo[fr * 4 + 0]);
        __syncthreads();
#pragma unroll 1
        for (int rr = 0; rr < 2; ++rr) { const int r = 2 * w + rr; const unsigned b1 = rinfo[r * 4 + 0], rem1 = rinfo[r * 4 + 1]; int bin; unsigned above, cb; scan_row(hist + r * 256, rem1, lane, bin, above, cb);
            if (lane == 0) { const unsigned take = rem1 - above; rinfo[r * 4 + 0] = (b1 << 8) | (unsigned)bin; rinfo[r * 4 + 1] = take; rinfo[r * 4 + 2] = (cb > take) ? 1u : 0u; } }
        __syncthreads();
        dsa_pass<3, false>(F, kbase, KS, qb, w4, nkt, tq, rinfo[fr * 4 + 0]);
    } else {
        if (F.tid < 16) { rinfo[F.tid * 4 + 0] = 0u; rinfo[F.tid * 4 + 1] = 0xffffffffu; rinfo[F.tid * 4 + 2] = 0u; }
        __syncthreads();
        dsa_pass<3, true>(F, kbase, KS, qb, w4, nkt, tq, 0u);
    }
    __syncthreads();
    volatile LAS u64* FIN = (volatile LAS u64*)(F.lds + 16384);
#pragma unroll 1
    for (int rr = 0; rr < 2; ++rr) { const int r = 2 * w + rr;
        const u64 def = (u64)bm[r * 128 + 2 * lane] | ((u64)bm[r * 128 + 2 * lane + 1] << 32);
        u64 tie = (u64)bm[2048 + r * 128 + 2 * lane] | ((u64)bm[2048 + r * 128 + 2 * lane + 1] << 32);
        if (rinfo[r * 4 + 2]) { const int take = (int)rinfo[r * 4 + 1]; const int c = __popcll(tie); int inc = c;
#pragma unroll
            for (int o = 1; o < 64; o <<= 1) { const int t = bperm_i((lane - o) & 63, inc); if (lane >= o) inc += t; }
            int tk = take - (inc - c); tk = tk < 0 ? 0 : (tk > c ? c : tk);
            while (__popcll(tie) > tk) tie &= ~(1ull << (63 - __clzll((long long)tie))); }
        FIN[lane * 16 + r] = def | tie; }
    __syncthreads();
#pragma unroll
    for (int k = 0; k < 2; ++k) { const int idx = F.tid + 512 * k, l = idx >> 4, r = idx & 15;
        if (l <= (t0 >> 6)) BM[((size_t)(b * 64 + l) * 4096) + t0 + r] = FIN[l * 16 + r]; }
    __builtin_amdgcn_fence(__ATOMIC_ACQUIRE, "agent");
    __syncthreads();
}

#define MFMA32(a, b, c) __builtin_amdgcn_mfma_f32_32x32x16_bf16(a, b, c, 0, 0, 0)
typedef short v4i16_t __attribute__((ext_vector_type(4)));
__device__ __forceinline__ s16x4 vtr(const LAS unsigned char* p) { return __builtin_bit_cast(s16x4, __builtin_amdgcn_ds_read_tr16_b64_v4i16((LAS v4i16_t*)p)); }
constexpr int AT_KBUF = 0, AT_VBUF = 16384, AT_WSF = 49152, AT_LUT = 51200, AT_IMP = 57344, AT_RMASK = 124928, AT_WOR = 125440;
enum { MK_C = 0, MK_A = 1, MK_WIN = 2, MK_SLC = 3, MK_CMP = 4 };
constexpr float ATT_THR = 8.f;

template <int VD> struct AState { f32x16 o[VD / 32]; float m, l; };
template <int VD> __device__ __forceinline__ void astate_init(AState<VD>& s) {
#pragma unroll
    for (int d = 0; d < VD / 32; ++d)
#pragma unroll
        for (int r = 0; r < 16; ++r) s.o[d][r] = 0.f;
    s.m = -1e30f; s.l = 0.f;
}
template <int VD>
__device__ __forceinline__ void stage_kv(LAS unsigned char* kbuf, LAS unsigned char* vbuf, const bf16_t* Kt, int ldk, const bf16_t* Vt, int ldv, int wave, int lane, bool with_v) {
    __builtin_amdgcn_global_load_lds((const unsigned*)(Kt + (size_t)lane * ldk + wave * 8), (LAS unsigned*)(kbuf + wave * 1024), 16, 0, 0);
    if (with_v) {
#pragma unroll
        for (int pc0 = 0; pc0 < VD / 8; pc0 += 8) { const int pc = pc0 + wave;
            __builtin_amdgcn_global_load_lds((const unsigned*)(Vt + (size_t)(16 * (pc & 3) + (lane >> 2)) * ldv + (pc >> 2) * 32 + (lane & 3) * 8), (LAS unsigned*)(vbuf + pc * 1024), 16, 0, 0); }
    }
}
__device__ __forceinline__ void qk_tile(f32x16& S0, f32x16& S1, const bf16x8 (&qr)[4], const LAS unsigned char* kbuf, int r32, int hi) {
    const LAS unsigned char* kp = kbuf + hi * 1024 + r32 * 16;
#pragma unroll
    for (int r = 0; r < 16; ++r) { S0[r] = 0.f; S1[r] = 0.f; }
#pragma unroll
    for (int g = 0; g < 2; ++g) {
        bf16x8 kf[4];
#pragma unroll
        for (int d = 0; d < 2; ++d) { kf[2 * d] = *(const LAS bf16x8*)(kp + (2 * g + d) * 2048); kf[2 * d + 1] = *(const LAS bf16x8*)(kp + (2 * g + d) * 2048 + 512); }
#pragma unroll
        for (int d = 0; d < 2; ++d) { S0 = MFMA32(kf[2 * d], qr[2 * g + d], S0); S1 = MFMA32(kf[2 * d + 1], qr[2 * g + d], S1); }
        if (PROBE_ATT == 2) { f32x16 D0, D1;
#pragma unroll
            for (int r = 0; r < 16; ++r) { D0[r] = 0.f; D1[r] = 0.f; }
#pragma unroll
            for (int d = 0; d < 2; ++d) { D0 = MFMA32(kf[2 * d], qr[2 * g + d], D0); D1 = MFMA32(kf[2 * d + 1], qr[2 * g + d], D1); }
            asm volatile("" :: "v"(D0[0] + D1[0])); }
    }
}
template <int MODE>
__device__ __forceinline__ void apply_mask(f32x16& S0, f32x16& S1, int tq, int key0, int hi, bool near, const LAS float* lut, u64 bits, int aux) {
    const unsigned blo = (unsigned)bits >> (4 * hi), bhi = (unsigned)(bits >> 32) >> (4 * hi);
#pragma unroll
    for (int n = 0; n < 2; ++n)
#pragma unroll
        for (int r = 0; r < 16; ++r) { const int kk0 = (r & 3) + 8 * (r >> 2); const int kk = kk0 + 4 * hi + 32 * n; const int dist = tq - (key0 + kk);
            bool valid;
            if (MODE == MK_C) valid = dist >= 0;
            else if (MODE == MK_A) valid = true;
            else if (MODE == MK_WIN) valid = dist >= 0 && dist < 512;
            else if (MODE == MK_SLC) valid = (aux != 0) && dist >= 0;
            else valid = (key0 + kk) < aux;
            float s = n ? S1[r] : S0[r];
            if (MODE != MK_CMP && near) { const int dc = dist < 0 ? 0 : (dist > 127 ? 127 : dist); s += lut[dc]; }
            if (MODE == MK_A) { const int mk = __builtin_amdgcn_sbfe((int)(n ? bhi : blo), kk0, 1);
                unsigned sb; asm("v_bfi_b32 %0, %1, %2, %3" : "=v"(sb) : "v"(mk), "v"(__builtin_bit_cast(unsigned, s)), "v"(0xff800000u)); s = __builtin_bit_cast(float, sb); }
            else s = valid ? s : -INFINITY;
            if (n) S1[r] = s; else S0[r] = s; }
}
__device__ __forceinline__ float vmax3(float a, float b, float c) { float r; asm("v_max3_f32 %0, %1, %2, %3" : "=v"(r) : "v"(a), "v"(b), "v"(c)); return r; }
__device__ __forceinline__ float vmax2(float a, float b) { float r; asm("v_max_f32 %0, %1, %2" : "=v"(r) : "v"(a), "v"(b)); return r; }
__device__ __forceinline__ float row_max32(const f32x16& S0, const f32x16& S1, int lane) {
    float a = vmax3(S0[0], S0[1], S1[0]), b = vmax3(S0[2], S0[3], S1[1]); a = vmax3(a, S1[2], S1[3]);
#pragma unroll
    for (int r = 4; r < 16; r += 4) { a = vmax3(a, S0[r], S0[r + 1]); b = vmax3(b, S0[r + 2], S0[r + 3]); a = vmax3(a, S1[r], S1[r + 1]); b = vmax3(b, S1[r + 2], S1[r + 3]); }
    return vmax2(a, b);
}
__device__ __forceinline__ void v_load2(bf16x8 (&vf)[2][4], const LAS unsigned char* vbuf, int db0, int lane) {
    const int hi = lane >> 5;
    const LAS unsigned char* vp = vbuf + ((lane >> 4) & 1) * 32 + (lane & 3) * 8 + (4 * hi + ((lane & 15) >> 2)) * 64 + db0 * 4096;
#pragma unroll
    for (int d = 0; d < 2; ++d)
#pragma unroll
        for (int ks = 0; ks < 4; ++ks) { const s16x4 lo = vtr(vp + d * 4096 + ks * 1024), hh = vtr(vp + d * 4096 + ks * 1024 + 512);
            vf[d][ks] = (bf16x8){lo[0], lo[1], lo[2], lo[3], hh[0], hh[1], hh[2], hh[3]}; }
}
__device__ __forceinline__ void p_pack(bf16x8 (&pa)[4], const f32x16& S0, const f32x16& S1) {
#pragma unroll
    for (int ks = 0; ks < 4; ++ks) { u32x4 w;
        if (ks == 0) { w.x = cvt_pk_bf16(S0[0], S0[1]); w.y = cvt_pk_bf16(S0[2], S0[3]); w.z = cvt_pk_bf16(S0[4], S0[5]); w.w = cvt_pk_bf16(S0[6], S0[7]); }
        else if (ks == 1) { w.x = cvt_pk_bf16(S0[8], S0[9]); w.y = cvt_pk_bf16(S0[10], S0[11]); w.z = cvt_pk_bf16(S0[12], S0[13]); w.w = cvt_pk_bf16(S0[14], S0[15]); }
        else if (ks == 2) { w.x = cvt_pk_bf16(S1[0], S1[1]); w.y = cvt_pk_bf16(S1[2], S1[3]); w.z = cvt_pk_bf16(S1[4], S1[5]); w.w = cvt_pk_bf16(S1[6], S1[7]); }
        else { w.x = cvt_pk_bf16(S1[8], S1[9]); w.y = cvt_pk_bf16(S1[10], S1[11]); w.z = cvt_pk_bf16(S1[12], S1[13]); w.w = cvt_pk_bf16(S1[14], S1[15]); }
        pa[ks] = __builtin_bit_cast(bf16x8, w); }
}
template <int VD>
__device__ __forceinline__ void pv_tile(f32x16 (&o)[VD / 32], const f32x16& S0, const f32x16& S1, const bf16x8 (&vf01)[2][4], const LAS unsigned char* vbuf, int lane) {
    bf16x8 pa[4]; p_pack(pa, S0, S1);
    if (VD == 128) {
        bf16x8 va[4], vb[4];
        const int hi = lane >> 5;
        const LAS unsigned char* vp = vbuf + ((lane >> 4) & 1) * 32 + (lane & 3) * 8 + (4 * hi + ((lane & 15) >> 2)) * 64;
#pragma unroll
        for (int ks = 0; ks < 4; ++ks) { const s16x4 lo = vtr(vp + 2 * 4096 + ks * 1024), hh = vtr(vp + 2 * 4096 + ks * 1024 + 512); va[ks] = (bf16x8){lo[0], lo[1], lo[2], lo[3], hh[0], hh[1], hh[2], hh[3]}; }
#pragma unroll
        for (int ks = 0; ks < 4; ++ks) { const s16x4 lo = vtr(vp + 3 * 4096 + ks * 1024), hh = vtr(vp + 3 * 4096 + ks * 1024 + 512); vb[ks] = (bf16x8){lo[0], lo[1], lo[2], lo[3], hh[0], hh[1], hh[2], hh[3]}; }
#pragma unroll
        for (int ks = 0; ks < 4; ++ks) { o[0] = MFMA32(pa[ks], vf01[0][ks], o[0]); o[1] = MFMA32(pa[ks], vf01[1][ks], o[1]); }
        __builtin_amdgcn_sched_barrier(0);
#pragma unroll
        for (int ks = 0; ks < 4; ++ks) { o[(VD == 128) ? 2 : 0] = MFMA32(pa[ks], va[ks], o[(VD == 128) ? 2 : 0]); o[(VD == 128) ? 3 : 0] = MFMA32(pa[ks], vb[ks], o[(VD == 128) ? 3 : 0]); }
    } else {
#pragma unroll
        for (int ks = 0; ks < 4; ++ks)
#pragma unroll
            for (int d = 0; d < 2; ++d) o[d] = MFMA32(pa[ks], vf01[d][ks], o[d]);
    }
}
template <int ND>
__device__ __forceinline__ void scale_rows(f32x16 (&o)[ND], float f, LAS float* wsf, int lane) {
    const int hi = lane >> 5;
    wsf[lane & 31] = f;
#pragma unroll
    for (int g = 0; g < 4; ++g) { const f32x4 a = *(const LAS f32x4*)(wsf + 8 * g + 4 * hi);
#pragma unroll
        for (int d = 0; d < ND; ++d)
#pragma unroll
            for (int i = 0; i < 4; ++i) o[d][4 * g + i] *= a[i]; }
}
template <int VD, bool PV>
__device__ __forceinline__ void softmax_step(AState<VD>& st, f32x16& S0, f32x16& S1, const LAS unsigned char* vbuf, LAS float* wsf, int lane) {
    bf16x8 vf01[2][4];
    if (PV) { v_load2(vf01, vbuf, 0, lane); __builtin_amdgcn_sched_barrier(0); }
    const float mx = row_max32(S0, S1, lane);
    if (__any(mx - st.m > ATT_THR)) { const float mnew = vmax2(st.m, vmax2(mx, bperm_f(lane ^ 32, mx))); const float alpha = fexp2(st.m - mnew); st.l *= alpha; st.m = mnew;
        if (PV) scale_rows<VD / 32>(st.o, alpha, wsf, lane); }
    float sum = 0.f;
#pragma unroll
    for (int r = 0; r < 16; ++r) { S0[r] = fexp2(S0[r] - st.m); S1[r] = fexp2(S1[r] - st.m); }
#pragma unroll
    for (int r = 0; r < 16; ++r) sum += S0[r];
#pragma unroll
    for (int r = 0; r < 16; ++r) sum += S1[r];
    st.l += sum;
    if (PROBE_ATT == 1) { float dm = 0.f;
#pragma unroll
        for (int r = 0; r < 16; ++r) { float t0 = S0[r], t1 = S1[r]; asm volatile("" : "+v"(t0), "+v"(t1)); dm += fexp2(t0 - st.m) + fexp2(t1 - st.m); }
        asm volatile("" :: "v"(dm)); }
    if (PV) pv_tile<VD>(st.o, S0, S1, vf01, vbuf, lane);
}
template <int ND>
__device__ __forceinline__ void finish_add(f32x16 (&acc)[ND], const f32x16 (&o)[ND], float l, float gate, LAS float* wsf, int lane) {
    const int hi = lane >> 5;
    const float lt = sum32(l, lane); const float f = lt > 0.f ? gate / lt : 0.f;
    wsf[lane & 31] = f;
#pragma unroll
    for (int g = 0; g < 4; ++g) { const f32x4 a = *(const LAS f32x4*)(wsf + 8 * g + 4 * hi);
#pragma unroll
        for (int d = 0; d < ND; ++d)
#pragma unroll
            for (int i = 0; i < 4; ++i) acc[d][4 * g + i] += o[d][4 * g + i] * a[i]; }
}

__device__ __forceinline__ int crow(int r, int hi) { return (r & 3) + 8 * (r >> 2) + 4 * hi; }

__device__ __forceinline__ void unit_C(Frame& F, const bf16_t* P, bf16_t* OC, const float* gnorm, float lam, float lam_init, int b, int h, int qb) {
    const int lane = F.lane, r32 = lane & 31, hi = lane >> 5, w = F.wave;
    LAS unsigned char* lds = F.lds; LAS float* wsf = (LAS float*)(lds + AT_WSF) + w * 64; const LAS float* lut = (const LAS float*)(lds + AT_LUT) + (8 + h) * 128;
    const int q0 = qb * 256, tw0 = q0 + 32 * w, tq = tw0 + r32; const size_t rowbase = (size_t)b * 4096;
    const int NT = 4 * qb + 4, my_last = (tw0 + 31) >> 6;
    LAS unsigned* kpl = (LAS unsigned*)(lds + AT_IMP) + w * 2048 + lane;
    AState<128> st;
#pragma unroll 1
    for (int j = 0; j < 2; ++j) {
        const bf16_t* Qp = P + (rowbase + tq) * DP + C_CQ + h * 128 + j * 64;
        bf16x8 qr[4];
#pragma unroll
        for (int d0 = 0; d0 < 4; ++d0) qr[d0] = *(const bf16x8*)(Qp + d0 * 16 + hi * 8);
        const bf16_t* Kb = P + rowbase * DP + C_CK + h * 128 + j * 64; const bf16_t* Vb = P + rowbase * DP + C_CV + h * 128;
        astate_init(st);
        stage_kv<128>(lds + AT_KBUF, lds + AT_VBUF, Kb, DP, Vb, DP, w, lane, true);
#pragma unroll 1
        for (int kt = 0; kt < NT; ++kt) {
            VM_WAIT(); __syncthreads();
            const int cb = kt & 1;
            if (kt + 1 < NT) stage_kv<128>(lds + AT_KBUF + (cb ^ 1) * 8192, lds + AT_VBUF + (cb ^ 1) * 16384, Kb + (size_t)(kt + 1) * 64 * DP, DP, Vb + (size_t)(kt + 1) * 64 * DP, DP, w, lane, true);
            if (kt <= my_last) {
                f32x16 S0, S1; qk_tile(S0, S1, qr, lds + AT_KBUF + cb * 8192, r32, hi);
                const int key0 = kt * 64; const bool near = (tw0 - (key0 + 63)) < 113;
                if (near) apply_mask<MK_C>(S0, S1, tq, key0, hi, true, lut, 0ull, 0);
                softmax_step<128, true>(st, S0, S1, lds + AT_VBUF + cb * 16384, wsf, lane);
            }
        }
        __syncthreads();
        const float lt = sum32(st.l, lane);
        if (j == 0) { scale_rows<4>(st.o, 1.f / lt, wsf, lane);
#pragma unroll
            for (int d = 0; d < 4; ++d)
#pragma unroll
                for (int r = 0; r < 8; ++r) kpl[(d * 8 + r) * 64] = cvt_pk_bf16(st.o[d][2 * r], st.o[d][2 * r + 1]);
        } else { scale_rows<4>(st.o, -lam / lt, wsf, lane);
#pragma unroll
            for (int d = 0; d < 4; ++d)
#pragma unroll
                for (int r = 0; r < 8; ++r) { const unsigned kw = kpl[(d * 8 + r) * 64]; st.o[d][2 * r] += bflo(kw); st.o[d][2 * r + 1] += bfhi(kw); } }
    }
    f32x16 (&keep)[4] = st.o;
    float gch[4];
#pragma unroll
    for (int d = 0; d < 4; ++d) gch[d] = gnorm[32 * d + r32] * (1.f - lam_init);
    GAS bf16_t* orow = (GAS bf16_t*)OC + (rowbase + tw0) * 1024 + 512 + h * 128 + r32; asm volatile("" : "+v"(orow)); int hs = hi; asm volatile("" : "+v"(hs));
#pragma unroll
    for (int r = 0; r < 16; ++r) { float ss = keep[0][r] * keep[0][r] + keep[1][r] * keep[1][r] + keep[2][r] * keep[2][r] + keep[3][r] * keep[3][r];
        ss += shx_f(ss, 1, lane); ss += shx_f(ss, 2, lane); ss += shx_f(ss, 4, lane); ss += shx_f(ss, 8, lane); ss += shx_f(ss, 16, lane);
        const float sc = 1.f / sqrtf(ss * (1.f / 128.f) + LN_EPS);
#pragma unroll
        for (int d = 0; d < 4; ++d) orow[crow(r, hs) * 1024 + 32 * d] = (bf16_t)f2bf(keep[d][r] * sc * gch[d]); }
}

__device__ __forceinline__ void unit_A(Frame& F, const bf16_t* P, const u64* BM, bf16_t* OC, int b, int qi) {
    const int lane = F.lane, r32 = lane & 31, hi = lane >> 5, w = F.wave, h = w & 3, rg = w >> 2;
    LAS unsigned char* lds = F.lds; LAS float* wsf = (LAS float*)(lds + AT_WSF) + w * 64; const LAS float* lut = (const LAS float*)(lds + AT_LUT) + h * 128;
    const int q0 = qi * 64, tw0 = q0 + 32 * rg, tq = tw0 + r32; const size_t rowbase = (size_t)b * 4096;
    const int NT = qi + 1;
    const bf16_t* Qp = P + (rowbase + tq) * DP + C_AQ + h * 64;
    bf16x8 qr[4];
#pragma unroll
    for (int d0 = 0; d0 < 4; ++d0) qr[d0] = *(const bf16x8*)(Qp + d0 * 16 + hi * 8);
    const bf16_t* Kb = P + rowbase * DP + C_AK; const bf16_t* Vb = P + rowbase * DP + C_AV;
    const u64* bmp = BM + (size_t)b * 64 * 4096 + tq;
    u64 bits = bmp[0];
    AState<64> st; astate_init(st);
    stage_kv<64>(lds + AT_KBUF, lds + AT_VBUF, Kb, DP, Vb, DP, w, lane, true);
#pragma unroll 1
    for (int kt = 0; kt < NT; ++kt) {
        VM_WAIT(); __syncthreads();
        const int cb = kt & 1;
        u64 nbits = 0ull;
        if (kt + 1 < NT) { stage_kv<64>(lds + AT_KBUF + (cb ^ 1) * 8192, lds + AT_VBUF + (cb ^ 1) * 16384, Kb + (size_t)(kt + 1) * 64 * DP, DP, Vb + (size_t)(kt + 1) * 64 * DP, DP, w, lane, true);
            nbits = bmp[(size_t)(kt + 1) * 4096]; }
        f32x16 S0, S1; qk_tile(S0, S1, qr, lds + AT_KBUF + cb * 8192, r32, hi);
        const int key0 = kt * 64; const bool near = (tw0 - (key0 + 63)) < 113;
        if (A_DENSE) { if (near) apply_mask<MK_C>(S0, S1, tq, key0, hi, true, lut, 0ull, 0); } else apply_mask<MK_A>(S0, S1, tq, key0, hi, near, lut, bits, 0);
        softmax_step<64, true>(st, S0, S1, lds + AT_VBUF + cb * 16384, wsf, lane);
        bits = nbits;
    }
    __syncthreads();
    f32x16 acc[2];
#pragma unroll
    for (int d = 0; d < 2; ++d)
#pragma unroll
        for (int r = 0; r < 16; ++r) acc[d][r] = 0.f;
    const float lt = sum32(st.l, lane);
    finish_add<2>(acc, st.o, 0.5f, lt > 0.f ? 1.f / lt : 0.f, wsf, lane);
    GAS bf16_t* orow = (GAS bf16_t*)OC + (rowbase + tw0) * 1024 + h * 64 + r32; asm volatile("" : "+v"(orow)); int hs = hi; asm volatile("" : "+v"(hs));
#pragma unroll
    for (int r = 0; r < 16; ++r)
#pragma unroll
        for (int d = 0; d < 2; ++d) orow[crow(r, hs) * 1024 + 32 * d] = (bf16_t)f2bf(acc[d][r]);
}

constexpr int IMP_LD = 65;
__device__ __forceinline__ void unit_B(Frame& F, const bf16_t* P, const bf16_t* KC, const bf16_t* VC, bf16_t* OC, int b, int qi) {
    const int lane = F.lane, r32 = lane & 31, hi = lane >> 5, w = F.wave, h = w & 3, rg = w >> 2;
    LAS unsigned char* lds = F.lds; LAS float* wsf = (LAS float*)(lds + AT_WSF) + w * 64; const LAS float* lut = (const LAS float*)(lds + AT_LUT) + (4 + h) * 128;
    LAS float* imp = (LAS float*)(lds + AT_IMP); volatile LAS u64* rmask = (volatile LAS u64*)(lds + AT_RMASK); volatile LAS u64* wor = (volatile LAS u64*)(lds + AT_WOR);
    const int q0 = qi * 64, cur = qi, tw0 = q0 + 32 * rg, tq = tw0 + r32, urow = 32 * rg + r32; const size_t rowbase = (size_t)b * 4096;
    const bf16_t* prow = P + (rowbase + tq) * DP;
    bf16x8 qr[4];
#pragma unroll
    for (int d0 = 0; d0 < 4; ++d0) qr[d0] = *(const bf16x8*)(prow + C_BQ + h * 64 + d0 * 16 + hi * 8);
    const float g0 = fsigmoid(bf2f(prow[C_BG + h * 3 + 0])), g1 = fsigmoid(bf2f(prow[C_BG + h * 3 + 1])), g2 = fsigmoid(bf2f(prow[C_BG + h * 3 + 2]));
    f32x16 ob[2];
#pragma unroll
    for (int d = 0; d < 2; ++d)
#pragma unroll
        for (int r = 0; r < 16; ++r) ob[d][r] = 0.f;
    {
        const int ncv = tq >= 31 ? ((tq - 31) >> 4) + 1 : 0;
        const int ncv_max = ((q0 + 63 - 31) >> 4) + 1, NTc = (ncv_max + 63) >> 6;
        const bf16_t* Kc = KC + (size_t)b * 256 * 64; const bf16_t* Vc = VC + (size_t)b * 256 * 64;
        AState<64> st; astate_init(st);
        stage_kv<64>(lds + AT_KBUF, lds + AT_VBUF, Kc, 64, Vc, 64, w, lane, false);
#pragma unroll 1
        for (int kt = 0; kt < NTc; ++kt) {
            VM_WAIT(); __syncthreads();
            const int cb = kt & 1;
            if (kt + 1 < NTc) stage_kv<64>(lds + AT_KBUF + (cb ^ 1) * 8192, lds + AT_VBUF + (cb ^ 1) * 16384, Kc + (size_t)(kt + 1) * 64 * 64, 64, Vc, 64, w, lane, false);
            f32x16 S0, S1; qk_tile(S0, S1, qr, lds + AT_KBUF + cb * 8192, r32, hi);
            apply_mask<MK_CMP>(S0, S1, tq, kt * 64, hi, false, lut, 0ull, ncv);
            softmax_step<64, false>(st, S0, S1, lds + AT_VBUF, wsf, lane);
        }
        __syncthreads();
        const float lt = sum32(st.l, lane); const float inv = lt > 0.f ? 1.f / lt : 0.f; const float mfin = st.m;
        f32x16 oc[2];
#pragma unroll
        for (int d = 0; d < 2; ++d)
#pragma unroll
            for (int r = 0; r < 16; ++r) oc[d][r] = 0.f;
        float carry = 0.f;
        stage_kv<64>(lds + AT_KBUF, lds + AT_VBUF, Kc, 64, Vc, 64, w, lane, true);
#pragma unroll 1
        for (int kt = 0; kt < NTc; ++kt) {
            VM_WAIT(); __syncthreads();
            const int cb = kt & 1;
            if (kt + 1 < NTc) stage_kv<64>(lds + AT_KBUF + (cb ^ 1) * 8192, lds + AT_VBUF + (cb ^ 1) * 16384, Kc + (size_t)(kt + 1) * 64 * 64, 64, Vc + (size_t)(kt + 1) * 64 * 64, 64, w, lane, true);
            f32x16 S0, S1; qk_tile(S0, S1, qr, lds + AT_KBUF + cb * 8192, r32, hi);
            apply_mask<MK_CMP>(S0, S1, tq, kt * 64, hi, false, lut, 0ull, ncv);
#pragma unroll
            for (int r = 0; r < 16; ++r) { S0[r] = fexp2(S0[r] - mfin) * inv; S1[r] = fexp2(S1[r] - mfin) * inv; }
            float own[2][4], pl[2][4];
#pragma unroll
            for (int g = 0; g < 4; ++g) { own[0][g] = (S0[4 * g] + S0[4 * g + 1]) + (S0[4 * g + 2] + S0[4 * g + 3]); own[1][g] = (S1[4 * g] + S1[4 * g + 1]) + (S1[4 * g + 2] + S1[4 * g + 3]);
                pl[0][g] = other32(S0[4 * g + 3], lane); pl[1][g] = other32(S1[4 * g + 3], lane); }
#pragma unroll
            for (int n = 0; n < 2; ++n)
#pragma unroll
                for (int g = 0; g < 4; ++g) { const int J = 16 * kt + 8 * n + 2 * g + hi;
                    const float prev0 = (g > 0) ? pl[n][g > 0 ? g - 1 : 0] : (n == 1 ? pl[0][3] : carry);
                    const float prev = hi ? pl[n][g] : prev0;
                    imp[(h * 64 + urow) * IMP_LD + J] = own[n][g] + prev; }
            carry = pl[1][3];
            { bf16x8 vf01[2][4]; v_load2(vf01, lds + AT_VBUF + cb * 16384, 0, lane); pv_tile<64>(oc, S0, S1, vf01, lds + AT_VBUF + cb * 16384, lane); }
        }
        finish_add<2>(ob, oc, 0.5f, g0, wsf, lane);
        __syncthreads();
    }
    {
        const int nf = cur >= 2 ? 3 : cur + 1, nfree = 16 - nf; u64 worl = 0ull;
#pragma unroll 1
        for (int rr = 0; rr < 8; ++rr) { const int row = 8 * w + rr; const int j = lane;
            const float v = (imp[(0 * 64 + row) * IMP_LD + j] + imp[(1 * 64 + row) * IMP_LD + j]) + (imp[(2 * 64 + row) * IMP_LD + j] + imp[(3 * 64 + row) * IMP_LD + j]);
            const bool cand = (j >= 1) && (j <= cur - 2);
            int rank = 0;
#pragma unroll 1
            for (int k = 1; k <= cur - 2; ++k) { const float vk = bperm_f(k, v); rank += (vk > v || (vk == v && k < j)) ? 1 : 0; }
            const bool forced = (j <= cur) && (j == 0 || j == cur || j == cur - 1);
            const bool sel = forced || (cand && rank < nfree);
            const u64 mk = __ballot(sel);
            if (lane == 0) rmask[row] = mk;
            worl |= mk; }
        if (lane == 0) wor[w] = worl;
        __syncthreads();
    }
    const u64 myrm = rmask[urow];
    u64 un = 0ull;
#pragma unroll
    for (int k = 0; k < 8; ++k) un |= wor[k];
    {
        const bf16_t* Kb = P + rowbase * DP + C_BKV + 2 * 64; const bf16_t* Vb = P + rowbase * DP + C_BKV + 3 * 64;
        AState<64> st; astate_init(st);
        const int nsel = __popcll(un);
        int j = __ffsll((long long)un) - 1; un &= un - 1;
        stage_kv<64>(lds + AT_KBUF, lds + AT_VBUF, Kb + (size_t)j * 64 * DP, DP, Vb + (size_t)j * 64 * DP, DP, w, lane, true);
#pragma unroll 1
        for (int i = 0; i < nsel; ++i) {
            VM_WAIT(); __syncthreads();
            const int cb = i & 1;
            int jn = -1;
            if (un) { jn = __ffsll((long long)un) - 1; un &= un - 1;
                stage_kv<64>(lds + AT_KBUF + (cb ^ 1) * 8192, lds + AT_VBUF + (cb ^ 1) * 16384, Kb + (size_t)jn * 64 * DP, DP, Vb + (size_t)jn * 64 * DP, DP, w, lane, true); }
            const int rowsel = (int)((myrm >> j) & 1ull);
            if (__any(rowsel)) {
                f32x16 S0, S1; qk_tile(S0, S1, qr, lds + AT_KBUF + cb * 8192, r32, hi);
                const int key0 = j * 64; const bool near = (tw0 - (key0 + 63)) < 113;
                if (near || j == cur || !__all(rowsel)) apply_mask<MK_SLC>(S0, S1, tq, key0, hi, near, lut, 0ull, rowsel);
                softmax_step<64, true>(st, S0, S1, lds + AT_VBUF + cb * 16384, wsf, lane);
            }
            j = jn;
        }
        __syncthreads();
        const float lt = sum32(st.l, lane);
        finish_add<2>(ob, st.o, 0.5f, lt > 0.f ? g1 / lt : 0.f, wsf, lane);
    }
    {
        const bf16_t* Kb = P + rowbase * DP + C_BKV + 4 * 64; const bf16_t* Vb = P + rowbase * DP + C_BKV + 5 * 64;
        AState<64> st; astate_init(st);
        const int kt0 = cur >= 8 ? cur - 8 : 0;
        stage_kv<64>(lds + AT_KBUF, lds + AT_VBUF, Kb + (size_t)kt0 * 64 * DP, DP, Vb + (size_t)kt0 * 64 * DP, DP, w, lane, true);
#pragma unroll 1
        for (int kt = kt0; kt <= cur; ++kt) {
            VM_WAIT(); __syncthreads();
            const int cb = (kt - kt0) & 1;
            if (kt + 1 <= cur) stage_kv<64>(lds + AT_KBUF + (cb ^ 1) * 8192, lds + AT_VBUF + (cb ^ 1) * 16384, Kb + (size_t)(kt + 1) * 64 * DP, DP, Vb + (size_t)(kt + 1) * 64 * DP, DP, w, lane, true);
            f32x16 S0, S1; qk_tile(S0, S1, qr, lds + AT_KBUF + cb * 8192, r32, hi);
            const int key0 = kt * 64; const bool near = (tw0 - (key0 + 63)) < 113;
            const bool allv = (key0 + 63 <= tw0) && (tw0 + 31 - key0 < 512);
            if (near || !allv) apply_mask<MK_WIN>(S0, S1, tq, key0, hi, near, lut, 0ull, 0);
            softmax_step<64, true>(st, S0, S1, lds + AT_VBUF + cb * 16384, wsf, lane);
        }
        __syncthreads();
        const float lt = sum32(st.l, lane);
        finish_add<2>(ob, st.o, 0.5f, lt > 0.f ? g2 / lt : 0.f, wsf, lane);
    }
    GAS bf16_t* orow = (GAS bf16_t*)OC + (rowbase + tw0) * 1024 + 256 + h * 64 + r32; asm volatile("" : "+v"(orow)); int hs = hi; asm volatile("" : "+v"(hs));
#pragma unroll
    for (int r = 0; r < 16; ++r)
#pragma unroll
        for (int d = 0; d < 2; ++d) orow[crow(r, hs) * 1024 + 32 * d] = (bf16_t)f2bf(ob[d][r]);
}

__device__ __forceinline__ void phase_cmp2(Frame& F, const bf16_t* HID, const bf16_t* W2T, bf16_t* KC) {
    const int lane = F.lane, fr = lane & 15, fq = lane >> 4;
    for (int task = F.gw; task < 512; task += F.NGW) { const int j = task >> 8, row0 = (task & 255) * 16;
        f32x4 acc[4];
#pragma unroll
        for (int n = 0; n < 4; ++n) acc[n] = (f32x4){0.f, 0.f, 0.f, 0.f};
#pragma unroll
        for (int ks = 0; ks < 8; ++ks) { const bf16x8 a = *(const bf16x8*)(HID + ((size_t)j * 4096 + row0 + fr) * 256 + ks * 32 + 8 * fq);
#pragma unroll
            for (int n = 0; n < 4; ++n) { const bf16x8 bb = *(const bf16x8*)(W2T + ((size_t)j * 64 + n * 16 + fr) * 256 + ks * 32 + 8 * fq);
                acc[n] = __builtin_amdgcn_mfma_f32_16x16x32_bf16(a, bb, acc[n], 0, 0, 0); } }
#pragma unroll
        for (int n = 0; n < 4; ++n)
#pragma unroll
            for (int jj = 0; jj < 4; ++jj) KC[((size_t)j * 4096 + row0 + 4 * fq + jj) * 64 + n * 16 + fr] = (bf16_t)f2bf(acc[n][jj]);
    }
}

constexpr int PH_PER_LAYER = 11, N_PHASES = 2 + DEPTH * PH_PER_LAYER;
struct Args { const float* in[27]; float* out; unsigned char* ws; int ph_lo, ph_hi, li, pad; };

#define IN(k) (lo <= (k) && (k) < hi)
#define SEAM(k) do { if (IN((k) + 1)) xcd_barrier(bar); } while (0)
#define WSB (F.ws)
#define PROJ ((bf16_t*)(WSB + WS_PROJ))
#define HB ((bf16_t*)(WSB + WS_HB))
#define OCAT ((bf16_t*)(WSB + WS_OCAT))
#define MERG ((bf16_t*)(WSB + WS_MERG))
#define X1 ((bf16_t*)(WSB + WS_X1))
#define MOD ((const float*)(WSB + WS_MOD))

template <int l>
__device__ __forceinline__ void run_layer(Frame& F, const Args& args, const XcdBarrier& bar, int lo, int hi) {
        const int pb = 2 + l * PH_PER_LAYER;
#define xres ((l == 0) ? args.in[0] : (const float*)args.out)
#define mod_a (MOD + (size_t)(2 * l) * 16 * 3072)
#define mod_f (MOD + (size_t)(2 * l + 1) * 16 * 3072)
        if (IN(pb + 0)) for (int rep = 0; rep < ((l == 0 && DUP == 0) ? 2 : 1); ++rep) { if (rep) xcd_barrier(bar); refresh(F);
            { pg8::Gemm g{HB, (const bf16_t*)(WSB + WS_WIN_T) + (size_t)l * DP * 1024, 1024, 1024, 1024, 128}; pg8::StaticOrder S; S.init(NTOK, N_BF, F.G, (int)blockIdx.x);
              pg8::EpiProj E{PROJ, 0, 1.f};
              pg8::gemm_phase<pg8::EpiProj, pg8::StaticOrder>(F.lds, g, S, E, F.wave); }
            { pg8::Gemm g{(const bf16_t*)(WSB + WS_HB8), (const bf16_t*)(WSB + WS_WMG8 + (size_t)l * N_F8 * 1024), 512, 512, 512, 128}; pg8::StaticOrder S; S.init(NTOK, N_F8, F.G, (int)blockIdx.x);
              pg8::EpiGate8 E{(unsigned char*)(WSB + WS_MG8), 1.f / (F8_H * F8_WIN)};
              pg8::gemm_phase<pg8::EpiGate8, pg8::StaticOrder, true>(F.lds, g, S, E, F.wave); }
            if (blockIdx.x == 255) { u32x4* z = (u32x4*)(PROJ + (size_t)NTOK * DP); for (int i = F.tid; i < 32 * DP * 2 / 16; i += 512) z[i] = (u32x4){0u, 0u, 0u, 0u}; }
            SEAM(pb + 0);
        }
        if (IN(pb + 1)) for (int rep = 0; rep < ((l == 0 && DUP == 1) ? 2 : 1); ++rep) { if (rep) xcd_barrier(bar); refresh(F);
            { pg8::Gemm g{PROJ + C_BKV, (const bf16_t*)(WSB + WS_W1_T) + (size_t)l * 2 * 256 * 2048, 16 * DP, 2048, 2048, DP * 2}; pg8::CmpOrder S{F.G, (int)blockIdx.x};
              pg8::EpiCmp1 E{(bf16_t*)(WSB + WS_HID), (const float*)(WSB + WS_BIAS1) + l * 512};
              pg8::gemm_phase<pg8::EpiCmp1, pg8::CmpOrder>(F.lds, g, S, E, F.wave); }
            __syncthreads();
            if (USE_A) {
#pragma unroll 1
                for (int i = 0; i < 16; ++i) { const int c = (int)blockIdx.x; const int qt = (i & 1) ? 255 - c : c;
                    dsa_select_tile(F, PROJ, (u64*)(WSB + WS_BM64), (unsigned*)(WSB + WS_OCAT) + (size_t)blockIdx.x * 65536, i, qt); }
            }
            SEAM(pb + 1);
        }
        if (IN(pb + 2)) for (int rep = 0; rep < ((l == 0 && DUP == 2) ? 2 : 1); ++rep) { if (rep) xcd_barrier(bar); refresh(F); phase_cmp2(F, (const bf16_t*)(WSB + WS_HID), (const bf16_t*)(WSB + WS_W2_T) + (size_t)l * 2 * 64 * 256, (bf16_t*)(WSB + WS_KCMP)); SEAM(pb + 2); }
        if (IN(pb + 3)) for (int rep = 0; rep < ((l == 0 && DUP == 3) ? 2 : 1); ++rep) { if (rep) xcd_barrier(bar); refresh(F);
            for (int i = F.tid; i < 12 * 128; i += 512) ((LAS float*)(F.lds + AT_LUT))[i] = ((const float*)(WSB + WS_LUT))[i];
            __syncthreads();
            const int c = (int)blockIdx.x;
            if (USE_C) {
                const float lam = ((const float*)(WSB + WS_LAM))[l]; const float lam_init = 0.8f - 0.6f * __expf(-0.3f * (float)l);
#pragma unroll 1
                for (int u = 0; u < 4; ++u) { const int bh = (c & 7) * 8 + (c >> 5), pp = ((c >> 3) & 3) * 2 + (u >> 1); const int qb = (u & 1) ? pp : 15 - pp;
                    refresh(F); unit_C(F, PROJ, OCAT, args.in[10] + l * 128, lam, lam_init, bh >> 2, bh & 3, qb); }
            }
            if (USE_A) {
#pragma unroll 1
                for (int u = 0; u < 4; ++u) { const int b = (c & 7) * 2 + (c >> 7), pp = ((c >> 3) & 15) * 2 + (u >> 1); const int qi = (u & 1) ? pp : 63 - pp;
                    refresh(F); unit_A(F, PROJ, (const u64*)(WSB + WS_BM64), OCAT, b, qi); }
            }
            if (USE_B) {
#pragma unroll 1
                for (int u = 0; u < 4; ++u) { const int b = (c & 7) * 2 + (c >> 7), pp = ((c >> 3) & 15) * 2 + (u >> 1); const int qi = (u & 1) ? pp : 63 - pp;
                    refresh(F); unit_B(F, PROJ, (const bf16_t*)(WSB + WS_KCMP), (const bf16_t*)(WSB + WS_KCMP) + 4096 * 64, OCAT, b, qi); }
            }
            if (!USE_A || !USE_B || !USE_C) {
                for (int row = F.gw; row < NTOK; row += F.NGW) { u32x4* o = (u32x4*)(OCAT + (size_t)row * 1024);
                    for (int q = F.lane; q < 128; q += 64) { const int col = q * 8; const bool z = (col < 256) ? !USE_A : (col < 512 ? !USE_B : !USE_C); if (z) o[q] = (u32x4){0u, 0u, 0u, 0u}; } }
            }
            SEAM(pb + 3);
        }
        if (IN(pb + 4)) for (int rep = 0; rep < ((l == 0 && DUP == 4) ? 2 : 1); ++rep) { if (rep) xcd_barrier(bar); refresh(F);
            const bf16_t* WB = (const bf16_t*)(WSB + WS_WBR_T + (size_t)l * 2 * MiB);
            pg8::StaticOrder S; S.init(NTOK, 1024, F.G, (int)blockIdx.x);
            { pg8::Gemm g{OCAT, WB, 1024, 1024, 1024, 128}; pg8::EpiBranchCat E{MERG, (const unsigned char*)(WSB + WS_MG8)}; pg8::gemm_phase<pg8::EpiBranchCat, pg8::StaticOrder>(F.lds, g, S, E, F.wave); }
            SEAM(pb + 4);
        }
        if (IN(pb + 5)) for (int rep = 0; rep < ((l == 0 && DUP == 5) ? 2 : 1); ++rep) { if (rep) xcd_barrier(bar); refresh(F);
            pg8::Gemm g{MERG, (const bf16_t*)(WSB + WS_WOUT_T) + (size_t)l * 1024 * 1024, 1024, 1024, 1024, 128}; pg8::StaticOrder S; S.init(NTOK, 1024, F.G, (int)blockIdx.x);
            pg8::EpiWout<(l > 0)> E{X1, (l == 0) ? (const void*)args.in[0] : (const void*)(WSB + WS_X2B), mod_a + 2048};
            pg8::gemm_phase<pg8::EpiWout<(l > 0)>, pg8::StaticOrder>(F.lds, g, S, E, F.wave);
            SEAM(pb + 5);
        }
#define cnt ((unsigned*)(WSB + WS_CTL) + CW_CNT + l * 64)
        if (IN(pb + 6)) for (int rep = 0; rep < ((l == 0 && DUP == 6) ? 2 : 1); ++rep) { if (rep) xcd_barrier(bar); refresh(F); phase_ln1_router(F, X1, args.in[15] + l * 1024, args.in[16] + l * 1024, mod_f, args.in[19] + (size_t)l * 1024 * 32, args.in[20] + l * 32, HB, cnt); SEAM(pb + 6); }
        if (IN(pb + 7)) for (int rep = 0; rep < ((l == 0 && DUP == 7) ? 2 : 1); ++rep) { if (rep) xcd_barrier(bar); refresh(F); phase_gather(F, cnt, HB, (unsigned char*)(WSB + WS_HS8)); SEAM(pb + 7); }
        if (IN(pb + 8)) for (int rep = 0; rep < ((l == 0 && DUP == 8) ? 2 : 1); ++rep) { if (rep) xcd_barrier(bar); refresh(F);
            build_pstart(F, cnt);
            pg8::Gemm g{(const bf16_t*)(WSB + WS_HS8), (const bf16_t*)(WSB + WS_WGU_T + (size_t)l * 32 * 2048 * 1024), 512, 512, 512, 128};
            pg8::MoeOrder S{F.G, (int)blockIdx.x, 8, (int)F.MISC[48], (const volatile LAS int*)(F.MISC + 16)};
            pg8::EpiMoe1 E{(unsigned char*)(WSB + WS_ACT), args.in[22] + (size_t)l * 32 * 2048};
            pg8::gemm_phase<pg8::EpiMoe1, pg8::MoeOrder, true>(F.lds, g, S, E, F.wave);
            SEAM(pb + 8);
        }
        if (IN(pb + 9)) for (int rep = 0; rep < ((l == 0 && DUP == 9) ? 2 : 1); ++rep) { if (rep) xcd_barrier(bar); refresh(F);
            build_pstart(F, cnt);
            pg8::Gemm g{(const bf16_t*)(WSB + WS_ACT), (const bf16_t*)(WSB + WS_WDN_T + (size_t)l * 32 * 1024 * 1024), 512, 512, 512, 128};
            pg8::MoeOrder S{F.G, (int)blockIdx.x, 4, (int)F.MISC[48], (const volatile LAS int*)(F.MISC + 16)};
            pg8::EpiMoe2 E{(bf16_t*)(WSB + WS_HS), args.in[24] + (size_t)l * 32 * 1024};
            pg8::gemm_phase<pg8::EpiMoe2, pg8::MoeOrder, true>(F.lds, g, S, E, F.wave);
            SEAM(pb + 9);
        }
        if (IN(pb + 10)) for (int rep = 0; rep < ((l == 0 && DUP == 10) ? 2 : 1); ++rep) { if (rep) xcd_barrier(bar); refresh(F);
            phase_combine(F, (const bf16_t*)(WSB + WS_HS), X1, mod_f, args.in[25] + l * 1024, args.in[26] + l * 1024, args.out, (l + 1 < DEPTH) ? MOD + (size_t)(2 * l + 2) * 16 * 3072 : nullptr, HB, (unsigned char*)(WSB + WS_HB8), (bf16_t*)(WSB + WS_X2B));
            SEAM(pb + 10);
        }
}

__global__ void __launch_bounds__(512, 2) mega_fwd(Args args) {
    extern __shared__ __attribute__((aligned(16))) unsigned char lds_raw[];
    Frame F;
    F.lds = (LAS unsigned char*)lds_raw; F.MISC = (volatile LAS unsigned*)(F.lds + LDS_MISC);
    F.tid = threadIdx.x; F.lane = F.tid & 63; F.wave = __builtin_amdgcn_readfirstlane(F.tid >> 6); F.wave0 = F.wave;
    F.G = gridDim.x; F.gw = blockIdx.x * 8 + F.wave; F.NGW = F.G * 8;
    F.ws = args.ws; F.ws0 = args.ws; F.ctl = (unsigned*)(args.ws + WS_CTL); F.in = args.in; F.out = args.out;
    for (int u = F.tid; u < (LDS_BYTES - LDS_MISC) / 4; u += 512) F.MISC[u] = 0u;
    __syncthreads();
    XcdBarrier bar = xcd_barrier_post(F.ctl + CW_BAR + args.li * XCD_BAR_WORDS, F.MISC);
    const int lo = args.ph_lo, hi = args.ph_hi;
    if (IN(0)) for (int rep = 0; rep < (DUP == 100 ? 2 : 1); ++rep) { refresh(F); phase_prologue(F); SEAM(0); }
    if (IN(1)) { refresh(F); phase_h0(F, args.in[0], MOD, HB, (unsigned char*)(WSB + WS_HB8)); SEAM(1); }

    run_layer<0>(F, args, bar, lo, hi);
    run_layer<1>(F, args, bar, lo, hi);
#undef IN
#undef SEAM
#undef WSB
#undef PROJ
#undef HB
#undef OCAT
#undef MERG
#undef X1
#undef MOD
#undef xres
#undef mod_a
#undef mod_f
#undef cnt
}

constexpr int N_LAUNCHES = 1;
extern "C" void kernel_launch(void* const* d_in, const int* in_sizes, int n_in, void* d_out, int out_size, void* d_ws, size_t ws_size, hipStream_t stream) {
    static int grid = 0;
    if (grid == 0) {
        if (n_in != 27 || out_size != NTOK * D || ws_size < WS_END) { fprintf(stderr, "kernel_launch: unexpected sizes n_in %d out %d ws %zu (need %zu)\n", n_in, out_size, ws_size, (size_t)WS_END); grid = -1; return; }
        int dev = 0, cus = 0, per_cu = 0;
        if (hipGetDevice(&dev) != hipSuccess || hipDeviceGetAttribute(&cus, hipDeviceAttributeMultiprocessorCount, dev) != hipSuccess) { grid = -1; return; }
        if (hipFuncSetAttribute((const void*)mega_fwd, hipFuncAttributeMaxDynamicSharedMemorySize, LDS_BYTES) != hipSuccess) { fprintf(stderr, "kernel_launch: hipFuncSetAttribute failed\n"); grid = -1; return; }
        if (hipOccupancyMaxActiveBlocksPerMultiprocessor(&per_cu, (const void*)mega_fwd, 512, LDS_BYTES) != hipSuccess || per_cu < 1) fprintf(stderr, "kernel_launch: occupancy query says %d\n", per_cu);
        (void)hipGetLastError();
        grid = cus;
        if (grid != 256) { fprintf(stderr, "kernel_launch: built for 256 CUs, got %d\n", cus); grid = -1; return; }
    }
    if (grid < 0) return;
    (void)hipMemsetAsync((char*)d_ws + WS_CTL, 0, CTL_BYTES, stream);
    Args a{};
    for (int i = 0; i < 27; ++i) a.in[i] = (const float*)d_in[i];
    a.out = (float*)d_out; a.ws = (unsigned char*)d_ws; a.pad = 0;
    for (int li = 0; li < N_LAUNCHES; ++li) {
        a.ph_lo = (N_LAUNCHES == 1) ? 0 : li; a.ph_hi = (N_LAUNCHES == 1) ? N_PHASES : li + 1; a.li = li;
        hipLaunchKernelGGL(mega_fwd, dim3(grid), dim3(512), LDS_BYTES, stream, a);
    }
}
```

```cpp
#include <hip/hip_runtime.h>
#include <cstdio>
#include <cstdint>

#define GAS __attribute__((address_space(1)))
#define LAS __attribute__((address_space(3)))
typedef unsigned short bf16_t;
typedef short bf16x8 __attribute__((ext_vector_type(8)));
typedef short s16x4 __attribute__((ext_vector_type(4)));
typedef float f32x2 __attribute__((ext_vector_type(2)));
typedef float f32x4 __attribute__((ext_vector_type(4)));
typedef float f32x16 __attribute__((ext_vector_type(16)));
typedef unsigned u32x4 __attribute__((ext_vector_type(4)));
typedef unsigned u32x2 __attribute__((ext_vector_type(2)));
typedef unsigned long long u64;

constexpr bool USE_A = true, USE_B = true, USE_C = true;
constexpr bool A_DENSE = false; constexpr bool DSA_FAKE = false;
constexpr int PROBE_ATT = 0;
constexpr int DUP = -1;
constexpr int NB = 16, SEQ = 4096, NTOK = NB * SEQ, D = 1024, DEPTH = 2, NEXP = 32;
constexpr int DP = 2816;
constexpr int D_IN = 5808;
constexpr int C_AQ = 0, C_AK = 256, C_AV = 320, C_IQ = 384, C_IK = 512, C_IW = 544, C_BG = 548, C_BQ = 576, C_BKV = 832, C_CQ = 1216, C_CK = 1728, C_CV = 2240, C_MG = 2752;
constexpr float LOG2E = 1.4426950408889634f;
constexpr float QS = 0.125f * LOG2E;
constexpr float IQS = 0.17677669529663687f;
constexpr float DN_ALPHA = 1.4142135623730951f;
constexpr float LN_EPS = 1e-5f;
constexpr int MOE_ROWS = NTOK * 4 + NEXP * 256;
constexpr float F8_WGU = 256.f, F8_WDN = 512.f, F8_H = 4.f, F8_ACT = 4.f, F8_WIN = 256.f;
constexpr int N_BF = 2816, N_F8 = 3072;

constexpr size_t MiB = 1u << 20;
constexpr size_t WS_CTL = 0, CTL_BYTES = 1 * MiB;
constexpr size_t WS_MOD = 1 * MiB;
constexpr size_t WS_BIAS1 = WS_MOD + 4 * 16 * 3072 * 4;
constexpr size_t WS_LUT = WS_BIAS1 + 4096;
constexpr size_t WS_LAM = WS_LUT + 8192;
constexpr size_t WS_TOKE = 2 * MiB;
constexpr size_t WS_TOKW = 3 * MiB;
constexpr size_t WS_TOKP = 4 * MiB;
constexpr size_t WS_TOKR = 5 * MiB;
constexpr size_t WS_KCMP = 6 * MiB;
constexpr size_t WS_WIN_T = 8 * MiB;
constexpr size_t WS_WBR_T = 31 * MiB;
constexpr size_t WS_WOUT_T = 35 * MiB;
constexpr size_t WS_W1_T = 39 * MiB;
constexpr size_t WS_W2_T = 43 * MiB;
constexpr size_t WS_WGU_T = 44 * MiB;
constexpr size_t WS_WDN_T = 300 * MiB;
constexpr size_t WS_WMG8 = 172 * MiB;
constexpr size_t WS_HB8 = 364 * MiB;
constexpr size_t WS_X1 = 428 * MiB;
constexpr size_t WS_X2B = 556 * MiB;
constexpr size_t WS_HB = 684 * MiB;
constexpr size_t WS_HID = 812 * MiB;
constexpr size_t WS_BIG = 820 * MiB;
constexpr size_t WS_PROJ = WS_BIG;
constexpr size_t WS_MG8 = WS_BIG + 353 * MiB;
constexpr size_t WS_OCAT = WS_BIG + 737 * MiB;
constexpr size_t WS_MERG = WS_OCAT + 128 * MiB;
constexpr size_t WS_BM64 = WS_MERG + 128 * MiB;
constexpr size_t WS_HS = WS_BIG;
constexpr size_t WS_HS8 = WS_BIG + 792 * MiB;
constexpr size_t WS_ACT = WS_BIG + 528 * MiB;
constexpr size_t WS_END = WS_BIG + 1056 * MiB;
static_assert((size_t)(NTOK + 32) * DP * 2 <= 353 * MiB, "proj");
static_assert((size_t)MOE_ROWS * 1024 * 2 <= 528 * MiB, "moe rows");
static_assert(WS_BM64 + 32 * MiB <= WS_END, "ws");
constexpr int CW_CNT = 1024;
constexpr int CW_BAR = 4096;

constexpr int LDS_MISC = 147456;
constexpr int LDS_BYTES = 151552;

#define LDS_WAIT() asm volatile("s_waitcnt lgkmcnt(0)" ::: "memory")
#define VM_WAIT() asm volatile("s_waitcnt vmcnt(0)" ::: "memory")

__device__ __forceinline__ unsigned f2bf(float f) { unsigned u = __builtin_bit_cast(unsigned, f); return (u + 0x7fffu + ((u >> 16) & 1u)) >> 16; }
__device__ __forceinline__ unsigned pk2(float lo, float hi) { return f2bf(lo) | (f2bf(hi) << 16); }
__device__ __forceinline__ float bf2f(unsigned short b) { return __builtin_bit_cast(float, (unsigned)b << 16); }
__device__ __forceinline__ float bflo(unsigned w) { return __builtin_bit_cast(float, w << 16); }
__device__ __forceinline__ float bfhi(unsigned w) { return __builtin_bit_cast(float, w & 0xffff0000u); }
typedef __bf16 bf16x2_t __attribute__((ext_vector_type(2)));
__device__ __forceinline__ unsigned cvt_pk_bf16(float lo, float hi) { return __builtin_bit_cast(unsigned, __builtin_convertvector((f32x2){lo, hi}, bf16x2_t)); }
__device__ __forceinline__ unsigned pk4_fp8(float a, float b, float c, float d) { int r = 0; r = __builtin_amdgcn_cvt_pk_fp8_f32(a, b, r, false); r = __builtin_amdgcn_cvt_pk_fp8_f32(c, d, r, true); return (unsigned)r; }
__device__ __forceinline__ void fp8x8_f32(u32x2 w, float (&f)[8]) { const f32x2 a = __builtin_amdgcn_cvt_pk_f32_fp8((int)w.x, false), b = __builtin_amdgcn_cvt_pk_f32_fp8((int)w.x, true), c = __builtin_amdgcn_cvt_pk_f32_fp8((int)w.y, false), d = __builtin_amdgcn_cvt_pk_f32_fp8((int)w.y, true);
    f[0] = a.x; f[1] = a.y; f[2] = b.x; f[3] = b.y; f[4] = c.x; f[5] = c.y; f[6] = d.x; f[7] = d.y; }
__device__ __forceinline__ float fexp2(float x) { return __builtin_amdgcn_exp2f(x); }
__device__ __forceinline__ float frcp(float x) { return __builtin_amdgcn_rcpf(x); }
__device__ __forceinline__ float fsigmoid(float x) { return frcp(1.f + fexp2(-LOG2E * x)); }
__device__ __forceinline__ float gelu_tanh(float x) { const float u = 0.7978845608028654f * (x + 0.044715f * x * x * x); return x * fsigmoid(2.f * u); }
__device__ __forceinline__ int bperm_i(int idx, int v) { return __builtin_amdgcn_ds_bpermute(idx << 2, v); }
__device__ __forceinline__ float bperm_f(int idx, float v) { return __builtin_bit_cast(float, __builtin_amdgcn_ds_bpermute(idx << 2, __builtin_bit_cast(int, v))); }
__device__ __forceinline__ float other32(float v, int lane) { return bperm_f(lane ^ 32, v); }
__device__ __forceinline__ float sum32(float v, int lane) { return v + bperm_f(lane ^ 32, v); }
__device__ __forceinline__ float max32(float v, int lane) { return fmaxf(v, bperm_f(lane ^ 32, v)); }
__device__ __forceinline__ float shx_f(float v, int mask, int lane) { return bperm_f(lane ^ mask, v); }
__device__ __forceinline__ int shx_i(int v, int mask, int lane) { return bperm_i(lane ^ mask, v); }
template <int CTRL> __device__ __forceinline__ float dpp_f(float v) { return __builtin_bit_cast(float, __builtin_amdgcn_update_dpp(0, __builtin_bit_cast(int, v), CTRL, 0xF, 0xF, true)); }
__device__ __forceinline__ float wave_sum(float v, int lane) {
    v += dpp_f<0xB1>(v); v += dpp_f<0x4E>(v); v += dpp_f<0x141>(v); v += dpp_f<0x140>(v);
    v += __builtin_bit_cast(float, __builtin_amdgcn_update_dpp(0, __builtin_bit_cast(int, v), 0x142, 0xA, 0xF, false));
    v += __builtin_bit_cast(float, __builtin_amdgcn_update_dpp(0, __builtin_bit_cast(int, v), 0x143, 0xC, 0xF, false));
    return __builtin_bit_cast(float, __builtin_amdgcn_readlane(__builtin_bit_cast(int, v), 63));
}
__device__ __forceinline__ float wave_max(float v) {
    v = fmaxf(v, dpp_f<0xB1>(v)); v = fmaxf(v, dpp_f<0x4E>(v)); v = fmaxf(v, dpp_f<0x141>(v)); v = fmaxf(v, dpp_f<0x140>(v));
    const int vi = __builtin_bit_cast(int, v);
    v = fmaxf(v, __builtin_bit_cast(float, __builtin_amdgcn_update_dpp(vi, vi, 0x142, 0xA, 0xF, false)));
    const int vj = __builtin_bit_cast(int, v);
    v = fmaxf(v, __builtin_bit_cast(float, __builtin_amdgcn_update_dpp(vj, vj, 0x143, 0xC, 0xF, false)));
    return __builtin_bit_cast(float, __builtin_amdgcn_readlane(__builtin_bit_cast(int, v), 63));
}

#define XB_TMO      128
#define XB_XCNT(j)  (256  + 64 * (j))
#define XB_XSUB(j)  (1280 + 64 * (j))
#define XB_XGEN(j)  (2304 + 64 * (j))
#define XB_TOP      3328
#define XB_TOPGEN   3392
#define XCD_BAR_WORDS 3456
#define XB_SPIN_CAP (1u << 18)

__device__ __forceinline__ unsigned xb_ld(unsigned* p)              { return __hip_atomic_load(p, __ATOMIC_RELAXED, __HIP_MEMORY_SCOPE_AGENT); }
__device__ __forceinline__ unsigned xb_add(unsigned* p, unsigned v) { return __hip_atomic_fetch_add(p, v, __ATOMIC_RELAXED, __HIP_MEMORY_SCOPE_AGENT); }
__device__ __forceinline__ unsigned xb_xcc_id() { return (unsigned)__builtin_amdgcn_s_getreg((3 << 11) | 20) & 0xFu; }
#define XB_SPIN(cond, bar) do { unsigned _sp = 0; while (cond) { __builtin_amdgcn_s_sleep(1); \
    if ((++_sp & 255u) == 0u) { if (xb_ld(&(bar)[XB_TMO])) break; if (_sp > XB_SPIN_CAP) { atomicAdd(&(bar)[XB_TMO], 1u); break; } } } } while (0)

struct XcdBarrier { unsigned* bar; unsigned x; volatile LAS unsigned* st; };

__device__ __forceinline__ XcdBarrier xcd_barrier_post(unsigned* bar, volatile LAS unsigned* st) {
    XcdBarrier b; b.bar = bar; b.x = xb_xcc_id(); b.st = st;
    if (threadIdx.x == 0) (void)xb_add(&bar[XB_XCNT(b.x)], 1u);
    return b;
}
__device__ __forceinline__ void xcd_barrier_complete(unsigned* bar, unsigned x, unsigned& nloc, unsigned& nx) {
    const unsigned G = gridDim.x * gridDim.y * gridDim.z;
    unsigned sum, cnt, mine, sp = 0u;
    for (;;) {
        sum = 0u; cnt = 0u; mine = 0u;
#pragma unroll
        for (unsigned j = 0; j < 16; ++j) { const unsigned c = xb_ld(&bar[XB_XCNT(j)]); sum += c; cnt += (c > 0u) ? 1u : 0u; mine = (j == x) ? c : mine; }
        if (sum == G) break;
        __builtin_amdgcn_s_sleep(1);
        if ((++sp & 255u) == 0u) { if (xb_ld(&bar[XB_TMO])) break; if (sp > XB_SPIN_CAP) { atomicAdd(&bar[XB_TMO], 1u); break; } }
    }
    nloc = mine > 0u ? mine : 1u; nx = cnt > 0u ? cnt : 1u;
}
__device__ __forceinline__ void xcd_barrier(const XcdBarrier& b) {
    asm volatile("s_waitcnt vmcnt(0)" ::: "memory");
    __syncthreads();
    if (threadIdx.x == 0) {
        unsigned* bar = b.bar;
        __builtin_amdgcn_s_waitcnt(0);
        unsigned nloc = b.st[0], nx = b.st[1];
        if (nloc == 0u) { xcd_barrier_complete(bar, b.x, nloc, nx); b.st[0] = nloc; b.st[1] = nx; }
        const unsigned old = xb_add(&bar[XB_XSUB(b.x)], 1u);
        const unsigned gen = old / nloc;
        if (old + 1u == (gen + 1u) * nloc) {
            __builtin_amdgcn_fence(__ATOMIC_RELEASE, "agent");
            asm volatile("s_waitcnt vmcnt(0)" ::: "memory");
            const unsigned og = xb_add(&bar[XB_TOP], 1u);
            const unsigned tg = og / nx;
            if (og + 1u == (tg + 1u) * nx) xb_add(&bar[XB_TOPGEN], 1u);
            else XB_SPIN(xb_ld(&bar[XB_TOPGEN]) == tg, bar);
            __builtin_amdgcn_fence(__ATOMIC_ACQUIRE, "agent");
            xb_add(&bar[XB_XGEN(b.x)], 1u);
            asm volatile("s_waitcnt vmcnt(0)" ::: "memory");
        } else {
            XB_SPIN(xb_ld(&bar[XB_XGEN(b.x)]) == gen, bar);
            __builtin_amdgcn_fence(__ATOMIC_ACQUIRE, "agent");
            asm volatile("s_waitcnt vmcnt(0)" ::: "memory");
        }
    }
    __syncthreads();
}

__device__ __forceinline__ int fresh_tid(int wave_s) {
    unsigned ones = ~0u; asm volatile("" : "+s"(ones));
    int ln = (int)__builtin_amdgcn_mbcnt_hi(ones, __builtin_amdgcn_mbcnt_lo(ones, 0u)); asm volatile("" : "+v"(ln));
    return wave_s * 64 + ln;
}

namespace pg8 {
typedef int v4i_t __attribute__((ext_vector_type(4)));
typedef int v8i_t __attribute__((ext_vector_type(8)));
constexpr int BM = 256, BK = 64, HALF = 128, HTB = HALF * BK * 2, STAGE_BYTES = 8 * HTB, NXCD = 8, WGM = 8;
__device__ __forceinline__ int lds_byte(int r, int c) { const int st = (r >> 4) * 2 + (c >> 5), rr = r & 15, cc = c & 31, ob = rr * 64 + cc * 2; return st * 1024 + (ob ^ (((ob >> 9) & 1) << 5)); }
__device__ __forceinline__ void stage_rc(int b, int& R, int& C) { const int st = b / 1024, sb = b % 1024, swz = sb ^ (((sb >> 9) & 1) << 5); R = (st >> 1) * 16 + swz / 64; C = (st & 1) * 32 + (swz % 64) / 2; }
__device__ __forceinline__ int perm32(int rho) { const int n = rho >> 4, i = rho & 15; return 8 * (i >> 2) + 4 * n + (i & 3); }

struct Unit { int pm, pn; };
struct Gemm { const bf16_t* A; const bf16_t* Bt; int lda, ldb, K, kstepA; };

struct StaticOrder {
    int nM, nN, nwg, G, c;
    __device__ void init(int M, int N, int G_, int c_) { nM = M / BM; nN = N / BM; nwg = nM * nN; G = G_; c = c_; }
    __device__ bool next(int i, Unit& u) const {
        const long L = (long)i * G + c; if (L >= nwg) return false;
        int wgid = (int)L; { const int q = nwg / NXCD, r = nwg % NXCD, xcd = wgid % NXCD, off = wgid / NXCD; wgid = (xcd < r ? xcd * (q + 1) : r * (q + 1) + (xcd - r) * q) + off; }
        const int nig = WGM * nN, gid = wgid / nig, fm = gid * WGM, gsz = (nM - fm) < WGM ? (nM - fm) : WGM;
        u.pm = fm + ((wgid % nig) % gsz); u.pn = (wgid % nig) / gsz; return true;
    }
    __device__ __forceinline__ const char* a_ptr(const Gemm& g, const Unit& u) const { return (const char*)g.A + (size_t)u.pm * (size_t)(BM * 2) * g.lda; }
    __device__ __forceinline__ const char* b_ptr(const Gemm& g, const Unit& u) const { return (const char*)g.Bt + (size_t)u.pn * (size_t)(BM * 2) * g.ldb; }
};
struct CmpOrder {
    int G, c;
    __device__ bool next(int i, Unit& u) const { const int L = i * G + c; if (L >= 32) return false; u.pn = L >> 4; u.pm = L & 15; return true; }
    __device__ __forceinline__ const char* a_ptr(const Gemm& g, const Unit& u) const { return (const char*)g.A + (size_t)u.pm * (size_t)(BM * 2) * g.lda + u.pn * 128; }
    __device__ __forceinline__ const char* b_ptr(const Gemm& g, const Unit& u) const { return (const char*)g.Bt + (size_t)u.pn * (size_t)(BM * 2) * g.ldb; }
};
struct MoeOrder {
    int G, c, NT, npan; const volatile LAS int* pstart;
    __device__ bool next(int i, Unit& u) const {
        const int ppx = (256 / NT) / 8, x = c & 7, r = c >> 3;
        const int p = i * (256 / NT) + x * ppx + (r % ppx), n = r / ppx; if (p >= npan) return false;
        int e = 0;
#pragma unroll 1
        for (int k = 1; k < 32; ++k) e += (pstart[k] <= p) ? 1 : 0;
        u.pm = p; u.pn = e * NT + n; return true;
    }
    __device__ __forceinline__ const char* a_ptr(const Gemm& g, const Unit& u) const { return (const char*)g.A + (size_t)u.pm * (size_t)(BM * 2) * g.lda; }
    __device__ __forceinline__ const char* b_ptr(const Gemm& g, const Unit& u) const { return (const char*)g.Bt + (size_t)u.pn * (size_t)(BM * 2) * g.ldb; }
};

#define EPI_LOOP_AI_M  _Pragma("unroll") for (int ai = 0; ai < 2; ++ai) _Pragma("unroll") for (int m = 0; m < 4; ++m)

struct EpiProj {
    static constexpr bool PERM = true;
    bf16_t* O; int colbase; float scl;
    __device__ __forceinline__ void operator()(const f32x4 (&acc)[2][2][4][2], const Unit& u, int wr, int wc, int fr, int fq) const {
        const int row0 = u.pm * BM + wr * 64 + fr, col0 = colbase + u.pn * BM + wc * 32 + 8 * fq;
        EPI_LOOP_AI_M { bf16_t* rowp = O + (size_t)(row0 + ai * HALF + m * 16) * DP + col0;
#pragma unroll
            for (int bj = 0; bj < 2; ++bj) { const f32x4 v0 = acc[ai][bj][m][0] * scl, v1 = acc[ai][bj][m][1] * scl;
                u32x4 w; w.x = cvt_pk_bf16(v0[0], v0[1]); w.y = cvt_pk_bf16(v0[2], v0[3]); w.z = cvt_pk_bf16(v1[0], v1[1]); w.w = cvt_pk_bf16(v1[2], v1[3]);
                *(u32x4*)(rowp + bj * HALF) = w; } }
    }
};
struct EpiGate8 {
    static constexpr bool PERM = true;
    unsigned char* O; float scl;
    __device__ __forceinline__ void operator()(const f32x4 (&acc)[2][2][4][2], const Unit& u, int wr, int wc, int fr, int fq) const {
        const int row0 = u.pm * BM + wr * 64 + fr, col0 = u.pn * BM + wc * 32 + 8 * fq;
        EPI_LOOP_AI_M { unsigned char* rowp = O + (size_t)(row0 + ai * HALF + m * 16) * 3072 + col0;
#pragma unroll
            for (int bj = 0; bj < 2; ++bj) { const f32x4 v0 = acc[ai][bj][m][0] * scl, v1 = acc[ai][bj][m][1] * scl;
                *(u32x2*)(rowp + bj * HALF) = (u32x2){pk4_fp8(v0[0], v0[1], v0[2], v0[3]), pk4_fp8(v1[0], v1[1], v1[2], v1[3])}; } }
    }
};
struct EpiCmp1 {
    static constexpr bool PERM = true;
    bf16_t* O; const float* bias;
    __device__ __forceinline__ void operator()(const f32x4 (&acc)[2][2][4][2], const Unit& u, int wr, int wc, int fr, int fq) const {
        const int row0 = u.pm * BM + wr * 64 + fr, col0 = wc * 32 + 8 * fq; const int j = u.pn;
        f32x4 bv[2][2];
#pragma unroll
        for (int bj = 0; bj < 2; ++bj)
#pragma unroll
            for (int n = 0; n < 2; ++n) bv[bj][n] = *(const f32x4*)(bias + j * 256 + col0 + bj * HALF + 4 * n);
        EPI_LOOP_AI_M { bf16_t* rowp = O + ((size_t)j * 4096 + row0 + ai * HALF + m * 16) * 256 + col0;
#pragma unroll
            for (int bj = 0; bj < 2; ++bj) { f32x4 v0 = acc[ai][bj][m][0] + bv[bj][0], v1 = acc[ai][bj][m][1] + bv[bj][1];
#pragma unroll
                for (int q = 0; q < 4; ++q) { v0[q] = gelu_tanh(v0[q]); v1[q] = gelu_tanh(v1[q]); }
                u32x4 w; w.x = cvt_pk_bf16(v0[0], v0[1]); w.y = cvt_pk_bf16(v0[2], v0[3]); w.z = cvt_pk_bf16(v1[0], v1[1]); w.w = cvt_pk_bf16(v1[2], v1[3]);
                *(u32x4*)(rowp + bj * HALF) = w; } }
    }
};
__device__ __forceinline__ float sig_ratio(float a, float b) { return (1.f + fexp2(-LOG2E * b)) * frcp(1.f + fexp2(-LOG2E * a)); }
struct EpiBranchCat {
    static constexpr bool PERM = true, MID = true;
    bf16_t* MG; const unsigned char* G8;
    __device__ __forceinline__ void mid(f32x4 (&acc)[2][2][4][2], const Unit& u, int wr, int wc, int fr, int fq, int seg) const {
        const int row0 = u.pm * BM + wr * 64 + fr, col0 = u.pn * BM + wc * 32 + 8 * fq;
#pragma unroll
        for (int ai = 0; ai < 2; ++ai) {
            u32x2 ga[4][2], gb[4][2];
#pragma unroll
            for (int m = 0; m < 4; ++m) { const size_t row = (size_t)(row0 + ai * HALF + m * 16);
#pragma unroll
                for (int bj = 0; bj < 2; ++bj) { const unsigned char* gp = G8 + row * 3072 + seg * 1024 + col0 + bj * HALF; ga[m][bj] = *(const u32x2*)gp; gb[m][bj] = *(const u32x2*)(gp + 1024); } }
#pragma unroll
            for (int m = 0; m < 4; ++m)
#pragma unroll
                for (int bj = 0; bj < 2; ++bj) { float a[8], b[8]; fp8x8_f32(ga[m][bj], a); fp8x8_f32(gb[m][bj], b); f32x4& v0 = acc[ai][bj][m][0]; f32x4& v1 = acc[ai][bj][m][1];
#pragma unroll
                    for (int q = 0; q < 4; ++q) { v0[q] *= sig_ratio(a[q], b[q]); v1[q] *= sig_ratio(a[4 + q], b[4 + q]); } }
        }
    }
    __device__ __forceinline__ void operator()(const f32x4 (&acc)[2][2][4][2], const Unit& u, int wr, int wc, int fr, int fq) const {
        const int row0 = u.pm * BM + wr * 64 + fr, col0 = u.pn * BM + wc * 32 + 8 * fq;
#pragma unroll
        for (int ai = 0; ai < 2; ++ai) {
            u32x2 gq[4][2];
#pragma unroll
            for (int m = 0; m < 4; ++m) { const size_t row = (size_t)(row0 + ai * HALF + m * 16);
#pragma unroll
                for (int bj = 0; bj < 2; ++bj) gq[m][bj] = *(const u32x2*)(G8 + row * 3072 + 2 * 1024 + col0 + bj * HALF); }
#pragma unroll
            for (int m = 0; m < 4; ++m) { const size_t row = (size_t)(row0 + ai * HALF + m * 16);
#pragma unroll
                for (int bj = 0; bj < 2; ++bj) { float g[8]; fp8x8_f32(gq[m][bj], g); f32x4 v0 = acc[ai][bj][m][0], v1 = acc[ai][bj][m][1];
#pragma unroll
                    for (int q = 0; q < 4; ++q) { v0[q] *= fsigmoid(g[q]); v1[q] *= fsigmoid(g[4 + q]); }
                    u32x4 w; w.x = cvt_pk_bf16(v0[0], v0[1]); w.y = cvt_pk_bf16(v0[2], v0[3]); w.z = cvt_pk_bf16(v1[0], v1[1]); w.w = cvt_pk_bf16(v1[2], v1[3]);
                    *(u32x4*)(MG + row * 1024 + col0 + bj * HALF) = w; } }
        }
    }
};
template <bool XBF> struct EpiWout {
    static constexpr bool PERM = true;
    bf16_t* Z; const void* XR; const float* gate;
    __device__ __forceinline__ void operator()(const f32x4 (&acc)[2][2][4][2], const Unit& u, int wr, int wc, int fr, int fq) const {
        const int row0 = u.pm * BM + wr * 64 + fr, col0 = u.pn * BM + wc * 32 + 8 * fq;
        const int b = (u.pm * BM) >> 12;
        f32x4 gv[2][2];
#pragma unroll
        for (int bj = 0; bj < 2; ++bj)
#pragma unroll
            for (int n = 0; n < 2; ++n) gv[bj][n] = *(const f32x4*)(gate + (size_t)b * 3072 + col0 + bj * HALF + 4 * n) + 1.0f;
#pragma unroll
        for (int ai = 0; ai < 2; ++ai) {
            f32x4 xr[4][2][2];
#pragma unroll
            for (int m = 0; m < 4; ++m) { const size_t ro = (size_t)(row0 + ai * HALF + m * 16) * 1024 + col0;
#pragma unroll
                for (int bj = 0; bj < 2; ++bj) {
                    if (XBF) { const u32x4 q = *(const u32x4*)((const bf16_t*)XR + ro + bj * HALF);
                        xr[m][bj][0] = (f32x4){bflo(q.x), bfhi(q.x), bflo(q.y), bfhi(q.y)}; xr[m][bj][1] = (f32x4){bflo(q.z), bfhi(q.z), bflo(q.w), bfhi(q.w)}; }
                    else { xr[m][bj][0] = *(const f32x4*)((const float*)XR + ro + bj * HALF); xr[m][bj][1] = *(const f32x4*)((const float*)XR + ro + bj * HALF + 4); } } }
            asm volatile("" ::: "memory");
#pragma unroll
            for (int m = 0; m < 4; ++m) { const size_t ro = (size_t)(row0 + ai * HALF + m * 16) * 1024 + col0;
#pragma unroll
                for (int bj = 0; bj < 2; ++bj) { const f32x4 v0 = xr[m][bj][0] * DN_ALPHA + gv[bj][0] * acc[ai][bj][m][0], v1 = xr[m][bj][1] * DN_ALPHA + gv[bj][1] * acc[ai][bj][m][1];
                    u32x4 w; w.x = cvt_pk_bf16(v0[0], v0[1]); w.y = cvt_pk_bf16(v0[2], v0[3]); w.z = cvt_pk_bf16(v1[0], v1[1]); w.w = cvt_pk_bf16(v1[2], v1[3]);
                    *(u32x4*)(Z + ro + bj * HALF) = w; } }
            asm volatile("" ::: "memory");
        }
    }
};
__device__ __forceinline__ float swiglu(float g, float u) { const float gg = fminf(g, 7.f), uu = fminf(fmaxf(u, -7.f), 7.f); return (uu + 1.f) * gg * fsigmoid(1.702f * gg); }
struct EpiMoe1 {
    static constexpr bool PERM = true;
    unsigned char* O; const float* bias;
    __device__ __forceinline__ void operator()(const f32x4 (&acc)[2][2][4][2], const Unit& u, int wr, int wc, int fr, int fq) const {
        const int row0 = u.pm * BM + wr * 64 + fr; const int e = u.pn >> 3, n8 = u.pn & 7; const int cg0 = n8 * BM + wc * 32 + 8 * fq;
        constexpr float isc = 1.f / (F8_H * F8_WGU);
        f32x4 bv[2][2];
#pragma unroll
        for (int bj = 0; bj < 2; ++bj)
#pragma unroll
            for (int n = 0; n < 2; ++n) bv[bj][n] = *(const f32x4*)(bias + (size_t)e * 2048 + cg0 + bj * HALF + 4 * n);
        EPI_LOOP_AI_M { unsigned char* rowp = O + (size_t)(row0 + ai * HALF + m * 16) * 1024 + (cg0 >> 1);
#pragma unroll
            for (int bj = 0; bj < 2; ++bj) { const f32x4 v0 = acc[ai][bj][m][0] * isc + bv[bj][0], v1 = acc[ai][bj][m][1] * isc + bv[bj][1];
                *(unsigned*)(rowp + bj * (HALF / 2)) = pk4_fp8(F8_ACT * swiglu(v0[0], v0[1]), F8_ACT * swiglu(v0[2], v0[3]), F8_ACT * swiglu(v1[0], v1[1]), F8_ACT * swiglu(v1[2], v1[3])); } }
    }
};
struct EpiMoe2 {
    static constexpr bool PERM = true;
    bf16_t* O; const float* bias;
    __device__ __forceinline__ void operator()(const f32x4 (&acc)[2][2][4][2], const Unit& u, int wr, int wc, int fr, int fq) const {
        const int row0 = u.pm * BM + wr * 64 + fr; const int e = u.pn >> 2, n4 = u.pn & 3; const int c0 = n4 * BM + wc * 32 + 8 * fq;
        constexpr float isc = 1.f / (F8_ACT * F8_WDN);
        f32x4 bv[2][2];
#pragma unroll
        for (int bj = 0; bj < 2; ++bj)
#pragma unroll
            for (int n = 0; n < 2; ++n) bv[bj][n] = *(const f32x4*)(bias + (size_t)e * 1024 + c0 + bj * HALF + 4 * n);
        EPI_LOOP_AI_M { bf16_t* rowp = O + (size_t)(row0 + ai * HALF + m * 16) * 1024 + c0;
#pragma unroll
            for (int bj = 0; bj < 2; ++bj) { const f32x4 v0 = acc[ai][bj][m][0] * isc + bv[bj][0], v1 = acc[ai][bj][m][1] * isc + bv[bj][1];
                u32x4 w; w.x = cvt_pk_bf16(v0[0], v0[1]); w.y = cvt_pk_bf16(v0[2], v0[3]); w.z = cvt_pk_bf16(v1[0], v1[1]); w.w = cvt_pk_bf16(v1[2], v1[3]);
                *(u32x4*)(rowp + bj * HALF) = w; } }
    }
};

__device__ __forceinline__ unsigned stage_voff(int tid, int i, int ld, bool perm) {
    int t = tid; asm volatile("" : "+v"(t));
    int R, C; stage_rc(t * 16 + i * 8192, R, C); const int Rb = perm ? ((R & ~31) + perm32(R & 31)) : R;
    return (unsigned)(Rb * ld + C) * 2u;
}
template <class T, class = void> struct has_mid { static constexpr bool value = false; };
template <class T> struct has_mid<T, decltype((void)T::MID)> { static constexpr bool value = T::MID; };
template <class Epi, class Sched, bool FP8 = false>
__device__ __forceinline__ void gemm_phase(LAS unsigned char* lds, const Gemm g, const Sched& S, const Epi& E, int wave_s) {
    const int tid = fresh_tid(wave_s), wid = wave_s, lane = tid & 63, wr = wid >> 2, wc = wid & 3, fr = lane & 15, fq = lane >> 4;
    const int K = g.K, nt = K / BK;
    unsigned voffA[2], voffB[2];
#pragma unroll
    for (int i = 0; i < 2; ++i) { int R, C; stage_rc(tid * 16 + i * 8192, R, C); const int Rb = Epi::PERM ? ((R & ~31) + perm32(R & 31)) : R;
        voffA[i] = (unsigned)(R * g.lda + C) * 2u; voffB[i] = (unsigned)(Rb * g.ldb + C) * 2u; }
    const size_t kstepA = (size_t)g.kstepA, kstepB = (size_t)(BK * 2);
    const size_t hstepA = (size_t)HALF * g.lda * 2, hstepB = (size_t)HALF * g.ldb * 2;
    const unsigned ldsw = (unsigned)wid * 1024u;
    const int aoff = lds_byte(wr * 64 + fr, fq * 8), boff = lds_byte(wc * 32 + fr, fq * 8);
#define PG8_SA(b, h) (((b) * 2 + (h)) * HTB)
#define PG8_SB(b, h) ((4 + (b) * 2 + (h)) * HTB)
#define PG8_VOFF(voff, _i) (FP8 ? stage_voff(tid, _i, (voff) == voffA ? g.lda : g.ldb, (voff) == voffB && Epi::PERM) : (voff)[_i])
#define PG8_STAGE(bufoff, gbase, voff) do { _Pragma("unroll") for (int _i = 0; _i < 2; ++_i) \
        __builtin_amdgcn_global_load_lds((const unsigned*)((const char*)(gbase) + PG8_VOFF(voff, _i)), (LAS unsigned*)(lds + (bufoff) + ldsw + _i * 8192), 16, 0, 0); } while (0)
    const LAS unsigned char* aB = lds + aoff; asm volatile("" : "+v"(aB));
    const LAS unsigned char* bB = lds + 4 * HTB + boff; asm volatile("" : "+v"(bB));
#define PG8_RDA(off) (*(const LAS v4i_t*)(aB + (off)))
#define PG8_RDB(off) (*(const LAS v4i_t*)(bB + (off)))
#define PG8_LDA(dst, b, h) do { _Pragma("unroll") for (int m = 0; m < 4; ++m) dst[m] = __builtin_shufflevector(PG8_RDA(((b) * 2 + (h)) * HTB + m * 2048), PG8_RDA(((b) * 2 + (h)) * HTB + m * 2048 + 1024), 0, 1, 2, 3, 4, 5, 6, 7); } while (0)
#define PG8_LDB(dst, b, h) do { _Pragma("unroll") for (int n = 0; n < 2; ++n) dst[n] = __builtin_shufflevector(PG8_RDB(((b) * 2 + (h)) * HTB + n * 2048), PG8_RDB(((b) * 2 + (h)) * HTB + n * 2048 + 1024), 0, 1, 2, 3, 4, 5, 6, 7); } while (0)
#define PG8_LO(x) __builtin_bit_cast(bf16x8, __builtin_shufflevector(x, x, 0, 1, 2, 3))
#define PG8_HI(x) __builtin_bit_cast(bf16x8, __builtin_shufflevector(x, x, 4, 5, 6, 7))
#define PG8_MMA(ai, bj, At, Bt) do { __builtin_amdgcn_s_setprio(1); _Pragma("unroll") for (int m = 0; m < 4; ++m) _Pragma("unroll") for (int n = 0; n < 2; ++n) { \
        if (FP8) acc[ai][bj][m][n] = __builtin_amdgcn_mfma_scale_f32_16x16x128_f8f6f4(Bt[n], At[m], acc[ai][bj][m][n], 0, 0, 0, 0, 0, 0); \
        else { acc[ai][bj][m][n] = __builtin_amdgcn_mfma_f32_16x16x32_bf16(PG8_LO(Bt[n]), PG8_LO(At[m]), acc[ai][bj][m][n], 0, 0, 0); \
               acc[ai][bj][m][n] = __builtin_amdgcn_mfma_f32_16x16x32_bf16(PG8_HI(Bt[n]), PG8_HI(At[m]), acc[ai][bj][m][n], 0, 0, 0); } } \
        __builtin_amdgcn_s_setprio(0); } while (0)
#define PG8_WAIT_V(n) asm volatile("s_waitcnt vmcnt(" #n ")" ::: "memory")
#define PG8_WAIT_L(n) asm volatile("s_waitcnt lgkmcnt(" #n ")" ::: "memory")
#define PG8_BAR __builtin_amdgcn_s_barrier()
#define PG8_SCHED __builtin_amdgcn_sched_barrier(0)
    Unit cur, nxt; int ui = 0;
    if (!S.next(0, cur)) return;
    f32x4 acc[2][2][4][2];
#pragma unroll
    for (int a = 0; a < 2; ++a)
#pragma unroll
        for (int b = 0; b < 2; ++b)
#pragma unroll
            for (int m = 0; m < 4; ++m)
#pragma unroll
                for (int n = 0; n < 2; ++n) acc[a][b][m][n] = (f32x4){0.f, 0.f, 0.f, 0.f};
    v8i_t At[4], B0[2], B1[2];
    const char* cA = S.a_ptr(g, cur); const char* cB = S.b_ptr(g, cur);
    PG8_STAGE(PG8_SB(0, 0), cB, voffB); PG8_STAGE(PG8_SA(0, 0), cA, voffA); PG8_STAGE(PG8_SB(0, 1), cB + hstepB, voffB); PG8_STAGE(PG8_SA(0, 1), cA + hstepA, voffA);
    if (wr == 1) PG8_BAR;
    PG8_WAIT_V(4); PG8_BAR;
    PG8_STAGE(PG8_SB(1, 0), cB + kstepB, voffB); PG8_STAGE(PG8_SA(1, 0), cA + kstepA, voffA); PG8_STAGE(PG8_SB(1, 1), cB + hstepB + kstepB, voffB);
    PG8_WAIT_V(6); PG8_BAR;
    for (;;) {
        const bool has_next = S.next(ui + 1, nxt);
        const char* nA = has_next ? S.a_ptr(g, nxt) : cA; const char* nB = has_next ? S.b_ptr(g, nxt) : cB;
        for (int t = 0; t < nt; t += 2) {
            if constexpr (has_mid<Epi>::value) { if (t == 4 || t == 8) { const int tz = fresh_tid(wave_s), ln = tz & 63; E.mid(acc, cur, wave_s >> 2, wave_s & 3, ln & 15, ln >> 4, (t >> 2) - 1); } }
            const bool last = (t == nt - 2);
            const char* a1 = cA + (size_t)(t + 1) * kstepA;
            const char* a2 = last ? nA : cA + (size_t)(t + 2) * kstepA; const char* b2 = last ? nB : cB + (size_t)(t + 2) * kstepB;
            const char* a3 = a2 + kstepA; const char* b3 = b2 + kstepB;
            PG8_LDB(B0, 0, 0); PG8_SCHED; PG8_LDA(At, 0, 0); PG8_STAGE(PG8_SA(1, 1), a1 + hstepA, voffA);
            PG8_WAIT_L(8); PG8_BAR; PG8_WAIT_L(0); PG8_MMA(0, 0, At, B0); PG8_BAR; PG8_SCHED;
            PG8_LDB(B1, 0, 1); PG8_STAGE(PG8_SB(0, 0), b2, voffB);
            PG8_BAR; PG8_WAIT_L(0); PG8_MMA(0, 1, At, B1); PG8_BAR;
            PG8_LDA(At, 0, 1); PG8_STAGE(PG8_SA(0, 0), a2, voffA);
            PG8_BAR; PG8_WAIT_L(0); PG8_MMA(1, 0, At, B0); PG8_BAR; PG8_SCHED;
            PG8_STAGE(PG8_SB(0, 1), b2 + hstepB, voffB);
            PG8_WAIT_V(6); PG8_BAR; PG8_MMA(1, 1, At, B1); PG8_BAR;
            PG8_LDB(B0, 1, 0); PG8_SCHED; PG8_LDA(At, 1, 0); PG8_STAGE(PG8_SA(0, 1), a2 + hstepA, voffA);
            PG8_WAIT_L(8); PG8_BAR; PG8_WAIT_L(0); PG8_MMA(0, 0, At, B0); PG8_BAR; PG8_SCHED;
            PG8_LDB(B1, 1, 1); PG8_STAGE(PG8_SB(1, 0), b3, voffB);
            PG8_BAR; PG8_WAIT_L(0); PG8_MMA(0, 1, At, B1); PG8_BAR;
            PG8_LDA(At, 1, 1); PG8_STAGE(PG8_SA(1, 0), a3, voffA);
            PG8_BAR; PG8_WAIT_L(0); PG8_MMA(1, 0, At, B0); PG8_BAR; PG8_SCHED;
            PG8_STAGE(PG8_SB(1, 1), b3 + hstepB, voffB);
            PG8_WAIT_V(6); PG8_BAR; PG8_MMA(1, 1, At, B1); PG8_BAR;
        }
        { const int tz = fresh_tid(wave_s), ln = tz & 63; E(acc, cur, wave_s >> 2, wave_s & 3, ln & 15, ln >> 4); }
        if (!has_next) break;
#pragma unroll
        for (int a = 0; a < 2; ++a)
#pragma unroll
            for (int b = 0; b < 2; ++b)
#pragma unroll
                for (int m = 0; m < 4; ++m)
#pragma unroll
                    for (int n = 0; n < 2; ++n) acc[a][b][m][n] = (f32x4){0.f, 0.f, 0.f, 0.f};
        cur = nxt; cA = nA; cB = nB; ++ui;
    }
    PG8_WAIT_V(0);
    if (wr == 0) PG8_BAR;
    PG8_BAR;
#undef PG8_SA
#undef PG8_SB
#undef PG8_STAGE
#undef PG8_VOFF
#undef PG8_LDA
#undef PG8_LDB
#undef PG8_MMA
#undef PG8_LO
#undef PG8_HI
#undef PG8_RDA
#undef PG8_RDB
#undef PG8_WAIT_V
#undef PG8_WAIT_L
#undef PG8_BAR
#undef PG8_SCHED
}
}

struct Frame {
    LAS unsigned char* lds;
    volatile LAS unsigned* MISC;
    unsigned* ctl;
    unsigned char* ws; unsigned char* ws0;
    const float* const* in;
    float* out;
    int tid, lane, wave, G, gw, NGW, wave0;
};
__device__ __forceinline__ void refresh(Frame& F) {
    unsigned ones = ~0u; asm volatile("" : "+s"(ones));
    int ln = (int)__builtin_amdgcn_mbcnt_hi(ones, __builtin_amdgcn_mbcnt_lo(ones, 0u)); asm volatile("" : "+v"(ln));
    int wv = F.wave0; asm volatile("" : "+s"(wv));
    F.lane = ln; F.wave = wv; F.tid = wv * 64 + ln; F.gw = blockIdx.x * 8 + wv;
    GAS unsigned char* w = (GAS unsigned char*)F.ws0; asm volatile("" : "+s"(w)); F.ws = (unsigned char*)w;
}

__constant__ unsigned char kBucket[128] = {0, 1, 2, 3, 4, 5, 6, 7, 8, 9, 10, 11, 12, 13, 14, 15, 16, 16, 16, 17, 17, 18, 18, 18, 19, 19, 19, 20, 20, 20, 20, 21, 21, 21, 21, 22, 22, 22, 22, 22, 23, 23, 23, 23, 23, 23, 24, 24, 24, 24, 24, 24, 25, 25, 25, 25, 25, 25, 25, 26, 26, 26, 26, 26, 26, 26, 26, 27, 27, 27, 27, 27, 27, 27, 27, 27, 27, 28, 28, 28, 28, 28, 28, 28, 28, 28, 28, 29, 29, 29, 29, 29, 29, 29, 29, 29, 29, 29, 29, 30, 30, 30, 30, 30, 30, 30, 30, 30, 30, 30, 30, 30, 30, 31, 31, 31, 31, 31, 31, 31, 31, 31, 31, 31, 31, 31, 31, 31};

__device__ __forceinline__ int win_src(int n, float& sc) {
    sc = 1.f;
    if (n < 544) { if (n < 256) sc = QS; else if (n >= 384 && n < 512) sc = IQS; return n; }
    if (n < 548) { sc = 0.5f; return n; }
    if (n < 560) return 1188 + (n - 548);
    if (n < 576) return -1;
    if (n < 832) { sc = QS; return 548 + (n - 576); }
    if (n < 1216) return 804 + (n - 832);
    if (n < 1728) { sc = QS; return 1200 + (n - 1216); }
    if (n < 2240) return 1712 + (n - 1728);
    if (n < 2752) return 2224 + (n - 2240);
    if (n < 5824) return 2736 + (n - 2752);
    return -1;
}
template <bool WIN>
__device__ __forceinline__ void p0_transpose_item(const float* W, int K, int Nsrc, int Ndst, bf16_t* WT, LAS float* scr, int item, int lane, int ldt = 0) {
    if (ldt == 0) ldt = K;
    const int nblk = Ndst / 32, kb = item / nblk, nb = item % nblk, k0 = 64 * kb, n0 = 32 * nb;
    if (WIN) { float sc = 1.f; const int src = win_src(n0 + (lane & 31), sc);
#pragma unroll 8
        for (int i = 0; i < 32; ++i) { const int kk = 2 * i + (lane >> 5); scr[kk * 33 + (lane & 31)] = (src >= 0) ? W[(size_t)(k0 + kk) * Nsrc + src] * sc : 0.f; }
    } else {
        f32x4 v[8];
#pragma unroll
        for (int i = 0; i < 8; ++i) v[i] = *(const f32x4*)(W + (size_t)(k0 + 8 * i + (lane >> 3)) * Nsrc + n0 + (lane & 7) * 4);
#pragma unroll
        for (int i = 0; i < 8; ++i) { LAS float* q = scr + (8 * i + (lane >> 3)) * 33 + (lane & 7) * 4; q[0] = v[i].x; q[1] = v[i].y; q[2] = v[i].z; q[3] = v[i].w; }
    }
    LDS_WAIT(); asm volatile("" ::: "memory");
    const int c = lane & 7;
#pragma unroll
    for (int j = 0; j < 4; ++j) { const int n = (lane >> 3) + 8 * j; const LAS float* s = scr + (8 * c) * 33 + n;
        u32x4 o; o.x = pk2(s[0 * 33], s[1 * 33]); o.y = pk2(s[2 * 33], s[3 * 33]); o.z = pk2(s[4 * 33], s[5 * 33]); o.w = pk2(s[6 * 33], s[7 * 33]);
        *(u32x4*)(WT + (size_t)(n0 + n) * ldt + k0 + 8 * c) = o; }
    LDS_WAIT(); asm volatile("" ::: "memory");
}

template <bool WIN>
__device__ __forceinline__ void p0_transpose_item_f8(const float* W, int K, int N, unsigned char* WT, float sc, LAS float* scr, int item, int lane, int Nsrc = 0, int ncol0 = 0) {
    const int nblk = N / 32, kb = item / nblk, nb = item % nblk, k0 = 64 * kb, n0 = 32 * nb;
    if (WIN) { float s1 = 1.f; const int src = win_src(ncol0 + n0 + (lane & 31), s1);
#pragma unroll 8
        for (int i = 0; i < 32; ++i) { const int kk = 2 * i + (lane >> 5); scr[kk * 33 + (lane & 31)] = (src >= 0) ? W[(size_t)(k0 + kk) * Nsrc + src] * (s1 * sc) : 0.f; }
    } else
    { f32x4 v[8];
#pragma unroll
      for (int i = 0; i < 8; ++i) v[i] = *(const f32x4*)(W + (size_t)(k0 + 8 * i + (lane >> 3)) * N + n0 + (lane & 7) * 4);
#pragma unroll
      for (int i = 0; i < 8; ++i) { LAS float* q = scr + (8 * i + (lane >> 3)) * 33 + (lane & 7) * 4; q[0] = v[i].x * sc; q[1] = v[i].y * sc; q[2] = v[i].z * sc; q[3] = v[i].w * sc; } }
    LDS_WAIT(); asm volatile("" ::: "memory");
    const int c = lane & 3;
#pragma unroll
    for (int j = 0; j < 2; ++j) { const int n = (lane >> 2) + 16 * j; const LAS float* q = scr + (16 * c) * 33 + n;
        u32x4 o; o.x = pk4_fp8(q[0 * 33], q[1 * 33], q[2 * 33], q[3 * 33]); o.y = pk4_fp8(q[4 * 33], q[5 * 33], q[6 * 33], q[7 * 33]);
        o.z = pk4_fp8(q[8 * 33], q[9 * 33], q[10 * 33], q[11 * 33]); o.w = pk4_fp8(q[12 * 33], q[13 * 33], q[14 * 33], q[15 * 33]);
        *(u32x4*)(WT + (size_t)(n0 + n) * K + k0 + 16 * c) = o; }
    LDS_WAIT(); asm volatile("" ::: "memory");
}
__device__ __forceinline__ void phase_prologue(Frame& F) {
    const float* const* in = F.in;
    LAS float* scr = (LAS float*)(F.lds + F.wave * 16384);
    constexpr int I_WIN = 16 * (N_BF / 32), I_WMG = 16 * (N_F8 / 32);
    constexpr int I_BA = 4 * 32, I_BC = 8 * 32, I_WO = 16 * 32, I_W1 = 32 * 8, I_W2 = 4 * 2;
    constexpr int I_GU = 16 * 64, I_DN = 16 * 32;
    constexpr int N_GU = 64 * I_GU, N_DN = 64 * I_DN, N_WIN = 2 * I_WIN, N_BA = 2 * I_BA, N_BC = 2 * I_BC, N_WO = 2 * I_WO, N_W1 = 4 * I_W1, N_W2 = 4 * I_W2, N_WMG = 2 * I_WMG;
    constexpr int NITEMS = N_GU + N_DN + N_WIN + N_WMG + 2 * N_BA + N_BC + N_WO + N_W1 + N_W2;
    for (int it = F.gw; it < NITEMS; it += F.NGW) {
        int r = it;
        if (r < N_GU) { const int m = r / I_GU; p0_transpose_item_f8<false>(in[21] + (size_t)m * 1024 * 2048, 1024, 2048, (unsigned char*)(F.ws + WS_WGU_T) + (size_t)m * 2048 * 1024, F8_WGU, scr, r % I_GU, F.lane); continue; } r -= N_GU;
        if (r < N_DN) { const int m = r / I_DN; p0_transpose_item_f8<false>(in[23] + (size_t)m * 1024 * 1024, 1024, 1024, (unsigned char*)(F.ws + WS_WDN_T) + (size_t)m * 1024 * 1024, F8_WDN, scr, r % I_DN, F.lane); continue; } r -= N_DN;
        if (r < N_WIN) { const int m = r / I_WIN; p0_transpose_item<true>(in[5] + (size_t)m * 1024 * D_IN, 1024, D_IN, N_BF, (bf16_t*)(F.ws + WS_WIN_T) + (size_t)m * DP * 1024, scr, r % I_WIN, F.lane); continue; } r -= N_WIN;
        if (r < N_WMG) { const int m = r / I_WMG; p0_transpose_item_f8<true>(in[5] + (size_t)m * 1024 * D_IN, 1024, N_F8, (unsigned char*)(F.ws + WS_WMG8) + (size_t)m * N_F8 * 1024, F8_WIN, scr, r % I_WMG, F.lane, D_IN, C_MG); continue; } r -= N_WMG;
        if (r < N_BA) { const int m = r / I_BA; p0_transpose_item<false>(in[11] + (size_t)m * 256 * 1024, 256, 1024, 1024, (bf16_t*)(F.ws + WS_WBR_T + m * 2 * MiB), scr, r % I_BA, F.lane, 1024); continue; } r -= N_BA;
        if (r < N_BA) { const int m = r / I_BA; p0_transpose_item<false>(in[12] + (size_t)m * 256 * 1024, 256, 1024, 1024, (bf16_t*)(F.ws + WS_WBR_T + m * 2 * MiB) + 256, scr, r % I_BA, F.lane, 1024); continue; } r -= N_BA;
        if (r < N_BC) { const int m = r / I_BC; p0_transpose_item<false>(in[13] + (size_t)m * 512 * 1024, 512, 1024, 1024, (bf16_t*)(F.ws + WS_WBR_T + m * 2 * MiB) + 512, scr, r % I_BC, F.lane, 1024); continue; } r -= N_BC;
        if (r < N_WO) { const int m = r / I_WO; p0_transpose_item<false>(in[14] + (size_t)m * 1024 * 1024, 1024, 1024, 1024, (bf16_t*)(F.ws + WS_WOUT_T) + (size_t)m * 1024 * 1024, scr, r % I_WO, F.lane); continue; } r -= N_WO;
        if (r < N_W1) { const int m = r / I_W1; p0_transpose_item<false>(in[7] + (size_t)m * 2048 * 256, 2048, 256, 256, (bf16_t*)(F.ws + WS_W1_T) + (size_t)m * 256 * 2048, scr, r % I_W1, F.lane); continue; } r -= N_W1;
        { const int m = r / I_W2; p0_transpose_item<false>(in[8] + (size_t)m * 256 * 64, 256, 64, 64, (bf16_t*)(F.ws + WS_W2_T) + (size_t)m * 64 * 256, scr, r % I_W2, F.lane); }
    }
    __syncthreads();
    if (blockIdx.x < 27) {
        LAS float* sc = (LAS float*)F.lds;
        for (int i = F.tid; i < 16 * 1024; i += 512) { const int b = i >> 10, k = i & 1023; const float v = in[1][i]; sc[k * 16 + b] = v * fsigmoid(v); }
        __syncthreads();
        if (F.gw < 192) {
            const int which = F.gw / 48, cb = F.gw % 48, layer = which >> 1, col = cb * 64 + F.lane;
            const float* W = (which & 1 ? in[17] : in[3]) + (size_t)layer * 1024 * 3072;
            const float* Bv = (which & 1 ? in[18] : in[4]) + (size_t)layer * 3072;
            float acc[16];
#pragma unroll
            for (int b = 0; b < 16; ++b) acc[b] = 0.f;
#pragma unroll 4
            for (int k = 0; k < 1024; ++k) { const float w = W[(size_t)k * 3072 + col];
                const f32x4 s0 = *(const LAS f32x4*)(sc + k * 16), s1 = *(const LAS f32x4*)(sc + k * 16 + 4), s2 = *(const LAS f32x4*)(sc + k * 16 + 8), s3 = *(const LAS f32x4*)(sc + k * 16 + 12);
#pragma unroll
                for (int q = 0; q < 4; ++q) { acc[q] += s0[q] * w; acc[4 + q] += s1[q] * w; acc[8 + q] += s2[q] * w; acc[12 + q] += s3[q] * w; } }
            float* mod = (float*)(F.ws + WS_MOD) + (size_t)which * 16 * 3072;
            const float bb = Bv[col];
#pragma unroll
            for (int b = 0; b < 16; ++b) mod[(size_t)b * 3072 + col] = acc[b] + bb;
        } else if (F.gw < 208) {
            const int u = F.gw - 192, m = u >> 2, n = (u & 3) * 64 + F.lane;
            const float* P = in[6] + (size_t)m * 2048; const float* W = in[7] + (size_t)m * 2048 * 256;
            float a = 0.f;
#pragma unroll 8
            for (int r = 0; r < 2048; ++r) a += P[r] * W[(size_t)r * 256 + n];
            ((float*)(F.ws + WS_BIAS1))[m * 256 + n] = a;
        } else if (F.gw == 208) {
            float* lut = (float*)(F.ws + WS_LUT);
            for (int i = F.lane; i < 12 * 128; i += 64) { const int h = i >> 7, d = i & 127; lut[i] = (in[2][kBucket[d] * 12 + h] - in[2][31 * 12 + h]) * LOG2E; }
            for (int l = 0; l < 2; ++l) { const float* dl = in[9] + l * 256;
                const float s1 = wave_sum(dl[F.lane] * dl[64 + F.lane], F.lane), s2 = wave_sum(dl[128 + F.lane] * dl[192 + F.lane], F.lane);
                const float lam_init = 0.8f - 0.6f * __expf(-0.3f * (float)l);
                if (F.lane == 0) ((float*)(F.ws + WS_LAM))[l] = __expf(s1) - __expf(s2) + lam_init; }
        }
    }
}

__device__ __forceinline__ void phase_h0(Frame& F, const float* X, const float* mod, bf16_t* HB, unsigned char* HB8) {
    for (int row = F.gw; row < NTOK; row += F.NGW) { const int b = row >> 12;
        const f32x4* xr = (const f32x4*)(X + (size_t)row * 1024) + F.lane; const f32x4* sh = (const f32x4*)(mod + (size_t)b * 3072) + F.lane; const f32x4* sc = (const f32x4*)(mod + (size_t)b * 3072 + 1024) + F.lane;
        u64* o8 = (u64*)(HB + (size_t)row * 1024) + F.lane; unsigned* q8 = (unsigned*)(HB8 + (size_t)row * 1024) + F.lane;
#pragma unroll
        for (int j = 0; j < 4; ++j) { const f32x4 v = xr[64 * j] * (sc[64 * j] + 1.0f) + sh[64 * j]; o8[64 * j] = (u64)pk2(v.x, v.y) | ((u64)pk2(v.z, v.w) << 32);
            q8[64 * j] = pk4_fp8(F8_H * v.x, F8_H * v.y, F8_H * v.z, F8_H * v.w); } }
}
__device__ __forceinline__ void ln_stats(const f32x4 (&v)[4], float& mean, float& rstd, int lane) {
    float s = 0.f;
#pragma unroll
    for (int j = 0; j < 4; ++j) s += (v[j].x + v[j].y) + (v[j].z + v[j].w);
    mean = wave_sum(s, lane) * (1.f / 1024.f); float s2 = 0.f;
#pragma unroll
    for (int j = 0; j < 4; ++j) { const f32x4 d = v[j] - mean; s2 += (d.x * d.x + d.y * d.y) + (d.z * d.z + d.w * d.w); }
    rstd = 1.f / sqrtf(wave_sum(s2, lane) * (1.f / 1024.f) + LN_EPS);
}

__device__ __forceinline__ void phase_ln1_router(Frame& F, bf16_t* Z, const float* g1, const float* b1, const float* mod, const float* rw, const float* rb, bf16_t* HB, unsigned* cnt) {
    LAS float* rwT = (LAS float*)F.lds;
    for (int i = F.tid; i < 32 * 1024; i += 512) { const int k = i >> 5, e = i & 31; rwT[e * 1024 + k] = rw[i]; }
    __syncthreads();
    const int lane = F.lane, e_l = lane >> 1;
    const float rbias = rb[e_l];
    unsigned slot0 = 0, slot1 = 0; unsigned cnt_local = 0;
    f32x4 gg[4], bb[4];
#pragma unroll
    for (int j = 0; j < 4; ++j) { gg[j] = ((const f32x4*)g1)[lane + 64 * j]; bb[j] = ((const f32x4*)b1)[lane + 64 * j]; }
    constexpr int NIT = NTOK / (2 * 2048);
    u32x2 zq[2][4];
#pragma unroll
    for (int r = 0; r < 2; ++r)
#pragma unroll
        for (int j = 0; j < 4; ++j) zq[r][j] = ((const u32x2*)(Z + (size_t)(F.gw + r * 2048) * 1024))[lane + 64 * j];
#pragma unroll 1
    for (int it = 0; it < NIT; ++it) { const int b = it; const int row0 = F.gw + it * 4096;
        const f32x4* sh = (const f32x4*)(mod + (size_t)b * 3072) + lane; const f32x4* sc = (const f32x4*)(mod + (size_t)b * 3072 + 1024) + lane;
        f32x4 v[2][4];
#pragma unroll
        for (int r = 0; r < 2; ++r)
#pragma unroll
            for (int j = 0; j < 4; ++j) { const u32x2 q = zq[r][j]; v[r][j] = (f32x4){bflo(q.x), bfhi(q.x), bflo(q.y), bfhi(q.y)}; }
        if (it + 1 < NIT) {
#pragma unroll
            for (int r = 0; r < 2; ++r)
#pragma unroll
                for (int j = 0; j < 4; ++j) zq[r][j] = ((const u32x2*)(Z + (size_t)(row0 + 4096 + r * 2048) * 1024))[lane + 64 * j];
        }
        f32x4 scj[4], shj[4];
#pragma unroll
        for (int j = 0; j < 4; ++j) { scj[j] = sc[64 * j] + 1.0f; shj[j] = sh[64 * j]; }
        f32x4 h[2][4];
#pragma unroll
        for (int r = 0; r < 2; ++r) { const int row = row0 + r * 2048;
            float mean, rstd; ln_stats(v[r], mean, rstd, lane);
            u32x2* zr = (u32x2*)(Z + (size_t)row * 1024) + lane; u64* o8 = (u64*)(HB + (size_t)row * 1024) + lane;
#pragma unroll
            for (int j = 0; j < 4; ++j) { const f32x4 xn = (v[r][j] - mean) * rstd * gg[j] + bb[j]; zr[64 * j] = (u32x2){cvt_pk_bf16(xn.x, xn.y), cvt_pk_bf16(xn.z, xn.w)}; h[r][j] = xn * scj[j] + shj[j];
                o8[64 * j] = (u64)pk2(h[r][j].x, h[r][j].y) | ((u64)pk2(h[r][j].z, h[r][j].w) << 32); } }
        f32x2 hp[4][4];
#pragma unroll
        for (int j = 0; j < 4; ++j) { hp[j][0] = (f32x2){h[0][j].x, h[1][j].x}; hp[j][1] = (f32x2){h[0][j].y, h[1][j].y}; hp[j][2] = (f32x2){h[0][j].z, h[1][j].z}; hp[j][3] = (f32x2){h[0][j].w, h[1][j].w}; }
        float a[2][32];
#pragma unroll
        for (int e = 0; e < 32; ++e) { f32x2 s0 = (f32x2){0.f, 0.f}, s1 = s0;
#pragma unroll
            for (int j = 0; j < 4; ++j) { const f32x4 w = *(const LAS f32x4*)(rwT + e * 1024 + 4 * lane + 256 * j);
                s0 += hp[j][0] * (f32x2){w.x, w.x}; s1 += hp[j][1] * (f32x2){w.y, w.y}; s0 += hp[j][2] * (f32x2){w.z, w.z}; s1 += hp[j][3] * (f32x2){w.w, w.w}; }
            s0 += s1; a[0][e] = s0.x; a[1][e] = s0.y; if ((e & 3) == 3) __builtin_amdgcn_sched_barrier(0); }
#pragma unroll
        for (int r = 0; r < 2; ++r) { const int row = row0 + r * 2048; const int i = 2 * it + r;
#pragma unroll
            for (int st = 0; st < 5; ++st) { const int half = 16 >> st, x = 32 >> st; const bool up = (lane & x) != 0;
#pragma unroll
                for (int q = 0; q < half; ++q) { const float send = up ? a[r][q] : a[r][q + half], keep = up ? a[r][q + half] : a[r][q];
                    a[r][q] = keep + (st == 0 ? other32(send, lane) : st == 1 ? shx_f(send, 16, lane) : st == 2 ? dpp_f<0x128>(send) : st == 3 ? dpp_f<0x141>(send) : dpp_f<0x4E>(send)); } }
            float lg = a[r][0] + dpp_f<0xB1>(a[r][0]) + rbias;
            float tv[4]; int te[4];
#pragma unroll
            for (int k = 0; k < 4; ++k) { const float mx = wave_max(lg); const u64 bal = __ballot(lg == mx); const int be = (__ffsll((long long)bal) - 1) >> 1;
                tv[k] = mx; te[k] = be; if (e_l == be) lg = -INFINITY; }
            const float e1 = __expf(tv[1] - tv[0]), e2 = __expf(tv[2] - tv[0]), e3 = __expf(tv[3] - tv[0]); const float inv = 1.f / (1.f + e1 + e2 + e3);
            if (lane == 0) { *(int4*)((int*)(F.ws + WS_TOKE) + (size_t)row * 4) = make_int4(te[0], te[1], te[2], te[3]);
                *(f32x4*)((float*)(F.ws + WS_TOKW) + (size_t)row * 4) = (f32x4){inv, e1 * inv, e2 * inv, e3 * inv}; }
#pragma unroll
            for (int k = 0; k < 4; ++k) { const int ek = __builtin_amdgcn_readfirstlane(te[k]); const unsigned rk = (unsigned)__builtin_amdgcn_readlane((int)cnt_local, ek);
                if (lane == ek) ++cnt_local;
                const int idx = i * 4 + k; const unsigned val = ((unsigned)ek << 16) | rk;
                if (lane == (idx & 63)) { if (idx < 64) slot0 = val; else slot1 = val; } }
        }
    }
    unsigned base = 0;
    if (lane < 32) base = __hip_atomic_fetch_add(cnt + lane, cnt_local, __ATOMIC_RELAXED, __HIP_MEMORY_SCOPE_AGENT);
#pragma unroll
    for (int s2 = 0; s2 < 2; ++s2) { const unsigned val = s2 ? slot1 : slot0; const int e = (int)(val >> 16); const unsigned pos = (unsigned)bperm_i(e, (int)base) + (val & 0xffffu);
        const int i = (64 * s2 + lane) >> 2, k = lane & 3; const int row = F.gw + (i >> 1) * 4096 + (i & 1) * 2048;
        ((int*)(F.ws + WS_TOKP))[(size_t)row * 4 + k] = (int)pos; }
    __syncthreads();
}

__device__ __forceinline__ void build_pstart(Frame& F, const unsigned* cnt) {
    if (F.tid == 0) { int p = 0; for (int e = 0; e < 32; ++e) { F.MISC[16 + e] = (unsigned)p; p += (int)((__hip_atomic_load(cnt + e, __ATOMIC_RELAXED, __HIP_MEMORY_SCOPE_AGENT) + 255u) >> 8); } F.MISC[48] = (unsigned)p; }
    __syncthreads();
}
__device__ __forceinline__ void phase_gather(Frame& F, const unsigned* cnt, const bf16_t* HB, unsigned char* HS) {
    build_pstart(F, cnt);
    for (int row = F.gw; row < NTOK; row += F.NGW) {
        const int4 te = *(const int4*)((const int*)(F.ws + WS_TOKE) + (size_t)row * 4), tp = *(const int4*)((const int*)(F.ws + WS_TOKP) + (size_t)row * 4);
        const int r0 = (int)F.MISC[16 + te.x] * 256 + tp.x, r1 = (int)F.MISC[16 + te.y] * 256 + tp.y, r2 = (int)F.MISC[16 + te.z] * 256 + tp.z, r3 = (int)F.MISC[16 + te.w] * 256 + tp.w;
        if (F.lane == 0) *(int4*)((int*)(F.ws + WS_TOKR) + (size_t)row * 4) = make_int4(r0, r1, r2, r3);
        const u32x4* src = (const u32x4*)(HB + (size_t)row * 1024) + 2 * F.lane; const u32x4 a = src[0], b = src[1];
        u32x4 v;
        v.x = pk4_fp8(F8_H * bflo(a.x), F8_H * bfhi(a.x), F8_H * bflo(a.y), F8_H * bfhi(a.y)); v.y = pk4_fp8(F8_H * bflo(a.z), F8_H * bfhi(a.z), F8_H * bflo(a.w), F8_H * bfhi(a.w));
        v.z = pk4_fp8(F8_H * bflo(b.x), F8_H * bfhi(b.x), F8_H * bflo(b.y), F8_H * bfhi(b.y)); v.w = pk4_fp8(F8_H * bflo(b.z), F8_H * bfhi(b.z), F8_H * bflo(b.w), F8_H * bfhi(b.w));
        ((u32x4*)(HS + (size_t)r0 * 1024))[F.lane] = v; ((u32x4*)(HS + (size_t)r1 * 1024))[F.lane] = v; ((u32x4*)(HS + (size_t)r2 * 1024))[F.lane] = v; ((u32x4*)(HS + (size_t)r3 * 1024))[F.lane] = v;
    }
    if (blockIdx.x < 32) { const int e = blockIdx.x; const int c = (int)__hip_atomic_load(cnt + e, __ATOMIC_RELAXED, __HIP_MEMORY_SCOPE_AGENT);
        const int rbeg = (int)F.MISC[16 + e] * 256 + c, rend = (int)F.MISC[17 + e] * 256;
        for (int r = rbeg + F.wave; r < rend; r += 8) ((u32x4*)(HS + (size_t)r * 1024))[F.lane] = (u32x4){0u, 0u, 0u, 0u}; }
}
__device__ __forceinline__ void phase_combine(Frame& F, const bf16_t* YS, const bf16_t* X1, const float* modf, const float* g2, const float* b2, float* XO, const float* modn, bf16_t* HB, unsigned char* HB8, bf16_t* X2B) {
    const int lane = F.lane;
    f32x4 gg[4], bb[4];
#pragma unroll
    for (int q = 0; q < 4; ++q) { gg[q] = ((const f32x4*)g2)[128 * (q >> 1) + 2 * lane + (q & 1)]; bb[q] = ((const f32x4*)b2)[128 * (q >> 1) + 2 * lane + (q & 1)]; }
    constexpr int NIT = NTOK / 2048;
    const int* TR = (const int*)(F.ws + WS_TOKR); const float* TW = (const float*)(F.ws + WS_TOKW);
    int4 tr_n = *(const int4*)(TR + (size_t)F.gw * 4); f32x4 tw_n = *(const f32x4*)(TW + (size_t)F.gw * 4);
    u32x4 yq[4][2], xq[2]; f32x4 tw_c = tw_n;
    { const int rr[4] = {tr_n.x, tr_n.y, tr_n.z, tr_n.w};
#pragma unroll
        for (int k = 0; k < 4; ++k)
#pragma unroll
            for (int c = 0; c < 2; ++c) yq[k][c] = ((const u32x4*)(YS + (size_t)rr[k] * 1024))[64 * c + lane];
#pragma unroll
        for (int c = 0; c < 2; ++c) xq[c] = ((const u32x4*)(X1 + (size_t)F.gw * 1024))[64 * c + lane]; }
    tr_n = *(const int4*)(TR + (size_t)(F.gw + 2048) * 4); tw_n = *(const f32x4*)(TW + (size_t)(F.gw + 2048) * 4);
#pragma unroll 1
    for (int it = 0; it < NIT; ++it) { const int row = F.gw + it * 2048; const int b = row >> 12;
        const int rown = (it + 1 < NIT) ? row + 2048 : row, rownn = (it + 2 < NIT) ? row + 4096 : row;
        u32x4 yn[4][2], xn[2];
        { const int rr[4] = {tr_n.x, tr_n.y, tr_n.z, tr_n.w};
#pragma unroll
            for (int k = 0; k < 4; ++k)
#pragma unroll
                for (int c = 0; c < 2; ++c) yn[k][c] = ((const u32x4*)(YS + (size_t)rr[k] * 1024))[64 * c + lane];
#pragma unroll
            for (int c = 0; c < 2; ++c) xn[c] = ((const u32x4*)(X1 + (size_t)rown * 1024))[64 * c + lane]; }
        const int4 tr_nn = *(const int4*)(TR + (size_t)rownn * 4); const f32x4 tw_nn = *(const f32x4*)(TW + (size_t)rownn * 4);
        const float ww[4] = {tw_c.x, tw_c.y, tw_c.z, tw_c.w};
        const f32x4* gt = (const f32x4*)(modf + (size_t)b * 3072 + 2048);
        f32x4 v[4];
#pragma unroll
        for (int c = 0; c < 2; ++c) { f32x4 y0 = (f32x4){0.f, 0.f, 0.f, 0.f}, y1 = y0;
#pragma unroll
            for (int k = 0; k < 4; ++k) { const u32x4 w = yq[k][c]; y0 += (f32x4){bflo(w.x), bfhi(w.x), bflo(w.y), bfhi(w.y)} * ww[k]; y1 += (f32x4){bflo(w.z), bfhi(w.z), bflo(w.w), bfhi(w.w)} * ww[k]; }
            const u32x4 q = xq[c];
            v[2 * c] = (f32x4){bflo(q.x), bfhi(q.x), bflo(q.y), bfhi(q.y)} * DN_ALPHA + (gt[128 * c + 2 * lane] + 1.0f) * y0;
            v[2 * c + 1] = (f32x4){bflo(q.z), bfhi(q.z), bflo(q.w), bfhi(q.w)} * DN_ALPHA + (gt[128 * c + 2 * lane + 1] + 1.0f) * y1; }
        float mean, rstd; ln_stats(v, mean, rstd, lane);
        if (modn) { const f32x4* sh = (const f32x4*)(modn + (size_t)b * 3072); const f32x4* sc = (const f32x4*)(modn + (size_t)b * 3072 + 1024);
#pragma unroll
            for (int c = 0; c < 2; ++c) { const f32x4 x0 = (v[2 * c] - mean) * rstd * gg[2 * c] + bb[2 * c], x1 = (v[2 * c + 1] - mean) * rstd * gg[2 * c + 1] + bb[2 * c + 1];
                ((u32x4*)(X2B + (size_t)row * 1024))[64 * c + lane] = (u32x4){cvt_pk_bf16(x0.x, x0.y), cvt_pk_bf16(x0.z, x0.w), cvt_pk_bf16(x1.x, x1.y), cvt_pk_bf16(x1.z, x1.w)};
                const f32x4 h0 = x0 * (sc[128 * c + 2 * lane] + 1.0f) + sh[128 * c + 2 * lane], h1 = x1 * (sc[128 * c + 2 * lane + 1] + 1.0f) + sh[128 * c + 2 * lane + 1];
                ((u32x4*)(HB + (size_t)row * 1024))[64 * c + lane] = (u32x4){cvt_pk_bf16(h0.x, h0.y), cvt_pk_bf16(h0.z, h0.w), cvt_pk_bf16(h1.x, h1.y), cvt_pk_bf16(h1.z, h1.w)};
                ((u32x2*)(HB8 + (size_t)row * 1024))[64 * c + lane] = (u32x2){pk4_fp8(F8_H * h0.x, F8_H * h0.y, F8_H * h0.z, F8_H * h0.w), pk4_fp8(F8_H * h1.x, F8_H * h1.y, F8_H * h1.z, F8_H * h1.w)}; }
        } else {
#pragma unroll
            for (int q = 0; q < 4; ++q) ((f32x4*)(XO + (size_t)row * 1024))[128 * (q >> 1) + 2 * lane + (q & 1)] = (v[q] - mean) * rstd * gg[q] + bb[q];
        }
#pragma unroll
        for (int k = 0; k < 4; ++k)
#pragma unroll
            for (int c = 0; c < 2; ++c) yq[k][c] = yn[k][c];
        xq[0] = xn[0]; xq[1] = xn[1]; tw_c = tw_n; tr_n = tr_nn; tw_n = tw_nn;
    }
}

__device__ __forceinline__ unsigned okey16(float v) { unsigned u = __builtin_bit_cast(unsigned, v); u = (u & 0x80000000u) ? ~u : (u | 0x80000000u); return u >> 16; }
__device__ __forceinline__ f32x4 idx_score(const bf16x8 ka, const bf16x8 (&qb)[4], const float (&w4)[4]) {
    f32x4 s = (f32x4){0.f, 0.f, 0.f, 0.f};
#pragma unroll
    for (int h = 0; h < 4; ++h) { const f32x4 c = __builtin_amdgcn_mfma_f32_16x16x32_bf16(ka, qb[h], (f32x4){0.f, 0.f, 0.f, 0.f}, 0, 0, 0);
#pragma unroll
        for (int j = 0; j < 4; ++j) s[j] += w4[h] * fmaxf(c[j], 0.f); }
    return s;
}
constexpr int DS_HIST = 32768;
__device__ __forceinline__ void scan_row(const volatile LAS unsigned* hw, unsigned need, int lane, int& bin, unsigned& above, unsigned& cntb) {
    const unsigned c0 = hw[4 * lane], c1 = hw[4 * lane + 1], c2 = hw[4 * lane + 2], c3 = hw[4 * lane + 3];
    unsigned S = (c0 + c1) + (c2 + c3);
#pragma unroll
    for (int o = 1; o < 64; o <<= 1) { const unsigned t = (unsigned)bperm_i((lane + o) & 63, (int)S); if (lane + o < 64) S += t; }
    const u64 bal = __ballot(S >= need);
    const int L = bal ? 63 - __clzll((long long)bal) : 0;
    const unsigned Snext = (unsigned)bperm_i((L + 1) & 63, (int)S);
    unsigned run = (L < 63) ? Snext : 0u;
    const unsigned d3 = (unsigned)bperm_i(L, (int)c3), d2 = (unsigned)bperm_i(L, (int)c2), d1 = (unsigned)bperm_i(L, (int)c1), d0 = (unsigned)bperm_i(L, (int)c0);
    if (run + d3 >= need) { bin = 4 * L + 3; above = run; cntb = d3; return; } run += d3;
    if (run + d2 >= need) { bin = 4 * L + 2; above = run; cntb = d2; return; } run += d2;
    if (run + d1 >= need) { bin = 4 * L + 1; above = run; cntb = d1; return; } run += d1;
    bin = 4 * L; above = run; cntb = d0;
}
template <int PASS, bool ALLSEL>
__device__ __forceinline__ void dsa_pass(Frame& F, const bf16_t* kbase, unsigned* KS, const bf16x8 (&qb)[4], const float (&w4)[4], int nkt, int tq, unsigned r_a) {
    const int lane = F.lane, fr = lane & 15, fq = lane >> 4;
    LAS unsigned* hist = (LAS unsigned*)(F.lds + DS_HIST); LAS unsigned* bm = (LAS unsigned*)F.lds;
    const int kt0 = F.wave; if (kt0 >= nkt) return;
    u32x2* ksl = (u32x2*)KS + lane;
    if (PASS == 3 && ALLSEL) {
        for (int kt = kt0; kt < nkt; kt += 8) { unsigned nd = 0;
#pragma unroll
            for (int j = 0; j < 4; ++j) nd |= ((kt * 16 + 4 * fq + j) <= tq ? 1u : 0u) << j;
            if (nd) __hip_atomic_fetch_or(bm + fr * 128 + (kt >> 1), nd << (16 * (kt & 1) + 4 * fq), __ATOMIC_RELAXED, __HIP_MEMORY_SCOPE_WORKGROUP); }
        return;
    }
    u32x4 kc[4], kn[4];
#pragma unroll
    for (int u = 0; u < 4; ++u) { kc[u] = (u32x4){0u, 0u, 0u, 0u}; if (kt0 + 8 * u < nkt) { if (PASS == 1) kc[u] = __builtin_bit_cast(u32x4, *(const bf16x8*)(kbase + (size_t)(kt0 + 8 * u) * 16 * DP)); else { const u32x2 q = ksl[(size_t)(kt0 + 8 * u) * 64]; kc[u].x = q.x; kc[u].y = q.y; } } }
    for (int kg = kt0; kg < nkt; kg += 32) {
#pragma unroll
        for (int u = 0; u < 4; ++u) { kn[u] = kc[u]; if (kg + 32 + 8 * u < nkt) { if (PASS == 1) kn[u] = __builtin_bit_cast(u32x4, *(const bf16x8*)(kbase + (size_t)(kg + 32 + 8 * u) * 16 * DP)); else { const u32x2 q = ksl[(size_t)(kg + 32 + 8 * u) * 64]; kn[u].x = q.x; kn[u].y = q.y; } } }
#pragma unroll
        for (int u = 0; u < 4; ++u) { const int kt = kg + 8 * u;
            if (kt < nkt) {
                unsigned kk[4];
                if (PASS == 1) { const f32x4 sc = idx_score(__builtin_bit_cast(bf16x8, kc[u]), qb, w4);
#pragma unroll
                    for (int j = 0; j < 4; ++j) kk[j] = okey16(sc[j]);
                    ksl[(size_t)kt * 64] = (u32x2){kk[0] | (kk[1] << 16), kk[2] | (kk[3] << 16)};
                } else { kk[0] = kc[u].x & 0xffffu; kk[1] = kc[u].x >> 16; kk[2] = kc[u].y & 0xffffu; kk[3] = kc[u].y >> 16; }
                const bool diag = (kt == nkt - 1);
                unsigned nd = 0, nt_ = 0;
#pragma unroll
                for (int j = 0; j < 4; ++j) { const bool valid = !diag || (kt * 16 + 4 * fq + j) <= tq; const unsigned key = kk[j];
                    if (PASS == 1) { if (valid) __hip_atomic_fetch_add(hist + fr * 256 + (key >> 8), 1u, __ATOMIC_RELAXED, __HIP_MEMORY_SCOPE_WORKGROUP); }
                    if (PASS == 2) { if (valid && (key >> 8) == r_a) __hip_atomic_fetch_add(hist + fr * 256 + (key & 255u), 1u, __ATOMIC_RELAXED, __HIP_MEMORY_SCOPE_WORKGROUP); }
                    if (PASS == 3) { if (valid) { nd |= (key > r_a ? 1u : 0u) << j; nt_ |= (key == r_a ? 1u : 0u) << j; } } }
                if (PASS == 3) { const int sh = 16 * (kt & 1) + 4 * fq; const int wd = fr * 128 + (kt >> 1);
                    if (nd) __hip_atomic_fetch_or(bm + wd, nd << sh, __ATOMIC_RELAXED, __HIP_MEMORY_SCOPE_WORKGROUP);
                    if (nt_) __hip_atomic_fetch_or(bm + 2048 + wd, nt_ << sh, __ATOMIC_RELAXED, __HIP_MEMORY_SCOPE_WORKGROUP); }
            } }
#pragma unroll
        for (int u = 0; u < 4; ++u) kc[u] = kn[u];
    }
}
__device__ __forceinline__ void lds_zero(Frame& F, int off, int bytes) {
    LAS u32x4* p = (LAS u32x4*)(F.lds + off); unsigned z = 0u; asm volatile("" : "+v"(z));
    for (int i = F.tid; i < bytes / 16; i += 512) p[i] = (u32x4){z, z, z, z};
}
__device__ __forceinline__ void dsa_select_tile(Frame& F, const bf16_t* P, u64* BM, unsigned* KS, int b, int qt) {
    volatile LAS unsigned* rinfo = F.MISC + 64;
    volatile LAS unsigned* bm = (volatile LAS unsigned*)F.lds; volatile LAS unsigned* hist = (volatile LAS unsigned*)(F.lds + DS_HIST);
    const int lane = F.lane, fr = lane & 15, fq = lane >> 4, w = F.wave;
    const int t0 = qt * 16, nkt = qt + 1; const size_t rowbase = (size_t)b * 4096;
    const bf16_t* qrow = P + (rowbase + t0 + fr) * DP;
    bf16x8 qb[4];
#pragma unroll
    for (int h = 0; h < 4; ++h) qb[h] = *(const bf16x8*)(qrow + C_IQ + h * 32 + 8 * fq);
    const u32x2 iwp = *(const u32x2*)(qrow + C_IW); const float w4[4] = {bflo(iwp.x), bfhi(iwp.x), bflo(iwp.y), bfhi(iwp.y)};
    const bf16_t* kbase = P + (rowbase + fr) * DP + C_IK + 8 * fq;
    const int tq = t0 + fr;
    lds_zero(F, 0, 16384);
    if (qt >= 16) {
        lds_zero(F, DS_HIST, 16384); __syncthreads();
        dsa_pass<1, false>(F, kbase, KS, qb, w4, nkt, tq, 0u);
        __syncthreads();
#pragma unroll 1
        for (int rr = 0; rr < 2; ++rr) { const int r = 2 * w + rr; int bin; unsigned above, cb; scan_row(hist + r * 256, 256u, lane, bin, above, cb);
            if (lane == 0) { rinfo[r * 4 + 0] = (unsigned)bin; rinfo[r * 4 + 1] = 256u - above; } }
        __syncthreads();
        lds_zero(F, DS_HIST, 16384); __syncthreads();
        dsa_pass<2, false>(F, kbase, KS, qb, w4, nkt, tq, rinfo[fr * 4 + 0]);
        __syncthreads();
#pragma unroll 1
        for (int rr = 0; rr < 2; ++rr) { const int r = 2 * w + rr; const unsigned b1 = rinfo[r * 4 + 0], rem1 = rinfo[r * 4 + 1]; int bin; unsigned above, cb; scan_row(hist + r * 256, rem1, lane, bin, above, cb);
            if (lane == 0) { const unsigned take = rem1 - above; rinfo[r * 4 + 0] = (b1 << 8) | (unsigned)bin; rinfo[r * 4 + 1] = take; rinfo[r * 4 + 2] = (cb > take) ? 1u : 0u; } }
        __syncthreads();
        dsa_pass<3, false>(F, kbase, KS, qb, w4, nkt, tq, rinfo[fr * 4 + 0]);
    } else {
        if (F.tid < 16) { rinfo[F.tid * 4 + 0] = 0u; rinfo[F.tid * 4 + 1] = 0xffffffffu; rinfo[F.tid * 4 + 2] = 0u; }
        __syncthreads();
        dsa_pass<3, true>(F, kbase, KS, qb, w4, nkt, tq, 0u);
    }
    __syncthreads();
    volatile LAS u64* FIN = (volatile LAS u64*)(F.lds + 16384);
#pragma unroll 1
    for (int rr = 0; rr < 2; ++rr) { const int r = 2 * w + rr;
        const u64 def = (u64)bm[r * 128 + 2 * lane] | ((u64)bm[r * 128 + 2 * lane + 1] << 32);
        u64 tie = (u64)bm[2048 + r * 128 + 2 * lane] | ((u64)bm[2048 + r * 128 + 2 * lane + 1] << 32);
        if (rinfo[r * 4 + 2]) { const int take = (int)rinfo[r * 4 + 1]; const int c = __popcll(tie); int inc = c;
#pragma unroll
            for (int o = 1; o < 64; o <<= 1) { const int t = bperm_i((lane - o) & 63, inc); if (lane >= o) inc += t; }
            int tk = take - (inc - c); tk = tk < 0 ? 0 : (tk > c ? c : tk);
            while (__popcll(tie) > tk) tie &= ~(1ull << (63 - __clzll((long long)tie))); }
        FIN[lane * 16 + r] = def | tie; }
    __syncthreads();
#pragma unroll
    for (int k = 0; k < 2; ++k) { const int idx = F.tid + 512 * k, l = idx >> 4, r = idx & 15;
        if (l <= (t0 >> 6)) BM[((size_t)(b * 64 + l) * 4096) + t0 + r] = FIN[l * 16 + r]; }
    __builtin_amdgcn_fence(__ATOMIC_ACQUIRE, "agent");
    __syncthreads();
}

#define MFMA32(a, b, c) __builtin_amdgcn_mfma_f32_32x32x16_bf16(a, b, c, 0, 0, 0)
typedef short v4i16_t __attribute__((ext_vector_type(4)));
__device__ __forceinline__ s16x4 vtr(const LAS unsigned char* p) { return __builtin_bit_cast(s16x4, __builtin_amdgcn_ds_read_tr16_b64_v4i16((LAS v4i16_t*)p)); }
constexpr int AT_KBUF = 0, AT_VBUF = 16384, AT_WSF = 49152, AT_LUT = 51200, AT_IMP = 57344, AT_RMASK = 124928, AT_WOR = 125440;
enum { MK_C = 0, MK_A = 1, MK_WIN = 2, MK_SLC = 3, MK_CMP = 4 };
constexpr float ATT_THR = 8.f;

template <int VD> struct AState { f32x16 o[VD / 32]; float m, l; };
template <int VD> __device__ __forceinline__ void astate_init(AState<VD>& s) {
#pragma unroll
    for (int d = 0; d < VD / 32; ++d)
#pragma unroll
        for (int r = 0; r < 16; ++r) s.o[d][r] = 0.f;
    s.m = -1e30f; s.l = 0.f;
}
template <int VD>
__device__ __forceinline__ void stage_kv(LAS unsigned char* kbuf, LAS unsigned char* vbuf, const bf16_t* Kt, int ldk, const bf16_t* Vt, int ldv, int wave, int lane, bool with_v) {
    __builtin_amdgcn_global_load_lds((const unsigned*)(Kt + (size_t)lane * ldk + wave * 8), (LAS unsigned*)(kbuf + wave * 1024), 16, 0, 0);
    if (with_v) {
#pragma unroll
        for (int pc0 = 0; pc0 < VD / 8; pc0 += 8) { const int pc = pc0 + wave;
            __builtin_amdgcn_global_load_lds((const unsigned*)(Vt + (size_t)(16 * (pc & 3) + (lane >> 2)) * ldv + (pc >> 2) * 32 + (lane & 3) * 8), (LAS unsigned*)(vbuf + pc * 1024), 16, 0, 0); }
    }
}
__device__ __forceinline__ void qk_tile(f32x16& S0, f32x16& S1, const bf16x8 (&qr)[4], const LAS unsigned char* kbuf, int r32, int hi) {
    const LAS unsigned char* kp = kbuf + hi * 1024 + r32 * 16;
#pragma unroll
    for (int r = 0; r < 16; ++r) { S0[r] = 0.f; S1[r] = 0.f; }
#pragma unroll
    for (int g = 0; g < 2; ++g) {
        bf16x8 kf[4];
#pragma unroll
        for (int d = 0; d < 2; ++d) { kf[2 * d] = *(const LAS bf16x8*)(kp + (2 * g + d) * 2048); kf[2 * d + 1] = *(const LAS bf16x8*)(kp + (2 * g + d) * 2048 + 512); }
#pragma unroll
        for (int d = 0; d < 2; ++d) { S0 = MFMA32(kf[2 * d], qr[2 * g + d], S0); S1 = MFMA32(kf[2 * d + 1], qr[2 * g + d], S1); }
        if (PROBE_ATT == 2) { f32x16 D0, D1;
#pragma unroll
            for (int r = 0; r < 16; ++r) { D0[r] = 0.f; D1[r] = 0.f; }
#pragma unroll
            for (int d = 0; d < 2; ++d) { D0 = MFMA32(kf[2 * d], qr[2 * g + d], D0); D1 = MFMA32(kf[2 * d + 1], qr[2 * g + d], D1); }
            asm volatile("" :: "v"(D0[0] + D1[0])); }
    }
}
template <int MODE>
__device__ __forceinline__ void apply_mask(f32x16& S0, f32x16& S1, int tq, int key0, int hi, bool near, const LAS float* lut, u64 bits, int aux) {
    const unsigned blo = (unsigned)bits >> (4 * hi), bhi = (unsigned)(bits >> 32) >> (4 * hi);
#pragma unroll
    for (int n = 0; n < 2; ++n)
#pragma unroll
        for (int r = 0; r < 16; ++r) { const int kk0 = (r & 3) + 8 * (r >> 2); const int kk = kk0 + 4 * hi + 32 * n; const int dist = tq - (key0 + kk);
            bool valid;
            if (MODE == MK_C) valid = dist >= 0;
            else if (MODE == MK_A) valid = true;
            else if (MODE == MK_WIN) valid = dist >= 0 && dist < 512;
            else if (MODE == MK_SLC) valid = (aux != 0) && dist >= 0;
            else valid = (key0 + kk) < aux;
            float s = n ? S1[r] : S0[r];
            if (MODE != MK_CMP && near) { const int dc = dist < 0 ? 0 : (dist > 127 ? 127 : dist); s += lut[dc]; }
            if (MODE == MK_A) { const int mk = __builtin_amdgcn_sbfe((int)(n ? bhi : blo), kk0, 1);
                unsigned sb; asm("v_bfi_b32 %0, %1, %2, %3" : "=v"(sb) : "v"(mk), "v"(__builtin_bit_cast(unsigned, s)), "v"(0xff800000u)); s = __builtin_bit_cast(float, sb); }
            else s = valid ? s : -INFINITY;
            if (n) S1[r] = s; else S0[r] = s; }
}
__device__ __forceinline__ float vmax3(float a, float b, float c) { float r; asm("v_max3_f32 %0, %1, %2, %3" : "=v"(r) : "v"(a), "v"(b), "v"(c)); return r; }
__device__ __forceinline__ float vmax2(float a, float b) { float r; asm("v_max_f32 %0, %1, %2" : "=v"(r) : "v"(a), "v"(b)); return r; }
__device__ __forceinline__ float row_max32(const f32x16& S0, const f32x16& S1, int lane) {
    float a = vmax3(S0[0], S0[1], S1[0]), b = vmax3(S0[2], S0[3], S1[1]); a = vmax3(a, S1[2], S1[3]);
#pragma unroll
    for (int r = 4; r < 16; r += 4) { a = vmax3(a, S0[r], S0[r + 1]); b = vmax3(b, S0[r + 2], S0[r + 3]); a = vmax3(a, S1[r], S1[r + 1]); b = vmax3(b, S1[r + 2], S1[r + 3]); }
    return vmax2(a, b);
}
__device__ __forceinline__ void v_load2(bf16x8 (&vf)[2][4], const LAS unsigned char* vbuf, int db0, int lane) {
    const int hi = lane >> 5;
    const LAS unsigned char* vp = vbuf + ((lane >> 4) & 1) * 32 + (lane & 3) * 8 + (4 * hi + ((lane & 15) >> 2)) * 64 + db0 * 4096;
#pragma unroll
    for (int d = 0; d < 2; ++d)
#pragma unroll
        for (int ks = 0; ks < 4; ++ks) { const s16x4 lo = vtr(vp + d * 4096 + ks * 1024), hh = vtr(vp + d * 4096 + ks * 1024 + 512);
            vf[d][ks] = (bf16x8){lo[0], lo[1], lo[2], lo[3], hh[0], hh[1], hh[2], hh[3]}; }
}
__device__ __forceinline__ void p_pack(bf16x8 (&pa)[4], const f32x16& S0, const f32x16& S1) {
#pragma unroll
    for (int ks = 0; ks < 4; ++ks) { u32x4 w;
        if (ks == 0) { w.x = cvt_pk_bf16(S0[0], S0[1]); w.y = cvt_pk_bf16(S0[2], S0[3]); w.z = cvt_pk_bf16(S0[4], S0[5]); w.w = cvt_pk_bf16(S0[6], S0[7]); }
        else if (ks == 1) { w.x = cvt_pk_bf16(S0[8], S0[9]); w.y = cvt_pk_bf16(S0[10], S0[11]); w.z = cvt_pk_bf16(S0[12], S0[13]); w.w = cvt_pk_bf16(S0[14], S0[15]); }
        else if (ks == 2) { w.x = cvt_pk_bf16(S1[0], S1[1]); w.y = cvt_pk_bf16(S1[2], S1[3]); w.z = cvt_pk_bf16(S1[4], S1[5]); w.w = cvt_pk_bf16(S1[6], S1[7]); }
        else { w.x = cvt_pk_bf16(S1[8], S1[9]); w.y = cvt_pk_bf16(S1[10], S1[11]); w.z = cvt_pk_bf16(S1[12], S1[13]); w.w = cvt_pk_bf16(S1[14], S1[15]); }
        pa[ks] = __builtin_bit_cast(bf16x8, w); }
}
template <int VD>
__device__ __forceinline__ void pv_tile(f32x16 (&o)[VD / 32], const f32x16& S0, const f32x16& S1, const bf16x8 (&vf01)[2][4], const LAS unsigned char* vbuf, int lane) {
    bf16x8 pa[4]; p_pack(pa, S0, S1);
    if (VD == 128) {
        bf16x8 va[4], vb[4];
        const int hi = lane >> 5;
        const LAS unsigned char* vp = vbuf + ((lane >> 4) & 1) * 32 + (lane & 3) * 8 + (4 * hi + ((lane & 15) >> 2)) * 64;
#pragma unroll
        for (int ks = 0; ks < 4; ++ks) { const s16x4 lo = vtr(vp + 2 * 4096 + ks * 1024), hh = vtr(vp + 2 * 4096 + ks * 1024 + 512); va[ks] = (bf16x8){lo[0], lo[1], lo[2], lo[3], hh[0], hh[1], hh[2], hh[3]}; }
#pragma unroll
        for (int ks = 0; ks < 4; ++ks) { const s16x4 lo = vtr(vp + 3 * 4096 + ks * 1024), hh = vtr(vp + 3 * 4096 + ks * 1024 + 512); vb[ks] = (bf16x8){lo[0], lo[1], lo[2], lo[3], hh[0], hh[1], hh[2], hh[3]}; }
#pragma unroll
        for (int ks = 0; ks < 4; ++ks) { o[0] = MFMA32(pa[ks], vf01[0][ks], o[0]); o[1] = MFMA32(pa[ks], vf01[1][ks], o[1]); }
        __builtin_amdgcn_sched_barrier(0);
#pragma unroll
        for (int ks = 0; ks < 4; ++ks) { o[(VD == 128) ? 2 : 0] = MFMA32(pa[ks], va[ks], o[(VD == 128) ? 2 : 0]); o[(VD == 128) ? 3 : 0] = MFMA32(pa[ks], vb[ks], o[(VD == 128) ? 3 : 0]); }
    } else {
#pragma unroll
        for (int ks = 0; ks < 4; ++ks)
#pragma unroll
            for (int d = 0; d < 2; ++d) o[d] = MFMA32(pa[ks], vf01[d][ks], o[d]);
    }
}
template <int ND>
__device__ __forceinline__ void scale_rows(f32x16 (&o)[ND], float f, LAS float* wsf, int lane) {
    const int hi = lane >> 5;
    wsf[lane & 31] = f;
#pragma unroll
    for (int g = 0; g < 4; ++g) { const f32x4 a = *(const LAS f32x4*)(wsf + 8 * g + 4 * hi);
#pragma unroll
        for (int d = 0; d < ND; ++d)
#pragma unroll
            for (int i = 0; i < 4; ++i) o[d][4 * g + i] *= a[i]; }
}
template <int VD, bool PV>
__device__ __forceinline__ void softmax_step(AState<VD>& st, f32x16& S0, f32x16& S1, const LAS unsigned char* vbuf, LAS float* wsf, int lane) {
    bf16x8 vf01[2][4];
    if (PV) { v_load2(vf01, vbuf, 0, lane); __builtin_amdgcn_sched_barrier(0); }
    const float mx = row_max32(S0, S1, lane);
    if (__any(mx - st.m > ATT_THR)) { const float mnew = vmax2(st.m, vmax2(mx, bperm_f(lane ^ 32, mx))); const float alpha = fexp2(st.m - mnew); st.l *= alpha; st.m = mnew;
        if (PV) scale_rows<VD / 32>(st.o, alpha, wsf, lane); }
    float sum = 0.f;
#pragma unroll
    for (int r = 0; r < 16; ++r) { S0[r] = fexp2(S0[r] - st.m); S1[r] = fexp2(S1[r] - st.m); }
#pragma unroll
    for (int r = 0; r < 16; ++r) sum += S0[r];
#pragma unroll
    for (int r = 0; r < 16; ++r) sum += S1[r];
    st.l += sum;
    if (PROBE_ATT == 1) { float dm = 0.f;
#pragma unroll
        for (int r = 0; r < 16; ++r) { float t0 = S0[r], t1 = S1[r]; asm volatile("" : "+v"(t0), "+v"(t1)); dm += fexp2(t0 - st.m) + fexp2(t1 - st.m); }
        asm volatile("" :: "v"(dm)); }
    if (PV) pv_tile<VD>(st.o, S0, S1, vf01, vbuf, lane);
}
template <int ND>
__device__ __forceinline__ void finish_add(f32x16 (&acc)[ND], const f32x16 (&o)[ND], float l, float gate, LAS float* wsf, int lane) {
    const int hi = lane >> 5;
    const float lt = sum32(l, lane); const float f = lt > 0.f ? gate / lt : 0.f;
    wsf[lane & 31] = f;
#pragma unroll
    for (int g = 0; g < 4; ++g) { const f32x4 a = *(const LAS f32x4*)(wsf + 8 * g + 4 * hi);
#pragma unroll
        for (int d = 0; d < ND; ++d)
#pragma unroll
            for (int i = 0; i < 4; ++i) acc[d][4 * g + i] += o[d][4 * g + i] * a[i]; }
}

__device__ __forceinline__ int crow(int r, int hi) { return (r & 3) + 8 * (r >> 2) + 4 * hi; }

__device__ __forceinline__ void unit_C(Frame& F, const bf16_t* P, bf16_t* OC, const float* gnorm, float lam, float lam_init, int b, int h, int qb) {
    const int lane = F.lane, r32 = lane & 31, hi = lane >> 5, w = F.wave;
    LAS unsigned char* lds = F.lds; LAS float* wsf = (LAS float*)(lds + AT_WSF) + w * 64; const LAS float* lut = (const LAS float*)(lds + AT_LUT) + (8 + h) * 128;
    const int q0 = qb * 256, tw0 = q0 + 32 * w, tq = tw0 + r32; const size_t rowbase = (size_t)b * 4096;
    const int NT = 4 * qb + 4, my_last = (tw0 + 31) >> 6;
    LAS unsigned* kpl = (LAS unsigned*)(lds + AT_IMP) + w * 2048 + lane;
    AState<128> st;
#pragma unroll 1
    for (int j = 0; j < 2; ++j) {
        const bf16_t* Qp = P + (rowbase + tq) * DP + C_CQ + h * 128 + j * 64;
        bf16x8 qr[4];
#pragma unroll
        for (int d0 = 0; d0 < 4; ++d0) qr[d0] = *(const bf16x8*)(Qp + d0 * 16 + hi * 8);
        const bf16_t* Kb = P + rowbase * DP + C_CK + h * 128 + j * 64; const bf16_t* Vb = P + rowbase * DP + C_CV + h * 128;
        astate_init(st);
        stage_kv<128>(lds + AT_KBUF, lds + AT_VBUF, Kb, DP, Vb, DP, w, lane, true);
#pragma unroll 1
        for (int kt = 0; kt < NT; ++kt) {
            VM_WAIT(); __syncthreads();
            const int cb = kt & 1;
            if (kt + 1 < NT) stage_kv<128>(lds + AT_KBUF + (cb ^ 1) * 8192, lds + AT_VBUF + (cb ^ 1) * 16384, Kb + (size_t)(kt + 1) * 64 * DP, DP, Vb + (size_t)(kt + 1) * 64 * DP, DP, w, lane, true);
            if (kt <= my_last) {
                f32x16 S0, S1; qk_tile(S0, S1, qr, lds + AT_KBUF + cb * 8192, r32, hi);
                const int key0 = kt * 64; const bool near = (tw0 - (key0 + 63)) < 113;
                if (near) apply_mask<MK_C>(S0, S1, tq, key0, hi, true, lut, 0ull, 0);
                softmax_step<128, true>(st, S0, S1, lds + AT_VBUF + cb * 16384, wsf, lane);
            }
        }
        __syncthreads();
        const float lt = sum32(st.l, lane);
        if (j == 0) { scale_rows<4>(st.o, 1.f / lt, wsf, lane);
#pragma unroll
            for (int d = 0; d < 4; ++d)
#pragma unroll
                for (int r = 0; r < 8; ++r) kpl[(d * 8 + r) * 64] = cvt_pk_bf16(st.o[d][2 * r], st.o[d][2 * r + 1]);
        } else { scale_rows<4>(st.o, -lam / lt, wsf, lane);
#pragma unroll
            for (int d = 0; d < 4; ++d)
#pragma unroll
                for (int r = 0; r < 8; ++r) { const unsigned kw = kpl[(d * 8 + r) * 64]; st.o[d][2 * r] += bflo(kw); st.o[d][2 * r + 1] += bfhi(kw); } }
    }
    f32x16 (&keep)[4] = st.o;
    float gch[4];
#pragma unroll
    for (int d = 0; d < 4; ++d) gch[d] = gnorm[32 * d + r32] * (1.f - lam_init);
    GAS bf16_t* orow = (GAS bf16_t*)OC + (rowbase + tw0) * 1024 + 512 + h * 128 + r32; asm volatile("" : "+v"(orow)); int hs = hi; asm volatile("" : "+v"(hs));
#pragma unroll
    for (int r = 0; r < 16; ++r) { float ss = keep[0][r] * keep[0][r] + keep[1][r] * keep[1][r] + keep[2][r] * keep[2][r] + keep[3][r] * keep[3][r];
        ss += shx_f(ss, 1, lane); ss += shx_f(ss, 2, lane); ss += shx_f(ss, 4, lane); ss += shx_f(ss, 8, lane); ss += shx_f(ss, 16, lane);
        const float sc = 1.f / sqrtf(ss * (1.f / 128.f) + LN_EPS);
#pragma unroll
        for (int d = 0; d < 4; ++d) orow[crow(r, hs) * 1024 + 32 * d] = (bf16_t)f2bf(keep[d][r] * sc * gch[d]); }
}

__device__ __forceinline__ void unit_A(Frame& F, const bf16_t* P, const u64* BM, bf16_t* OC, int b, int qi) {
    const int lane = F.lane, r32 = lane & 31, hi = lane >> 5, w = F.wave, h = w & 3, rg = w >> 2;
    LAS unsigned char* lds = F.lds; LAS float* wsf = (LAS float*)(lds + AT_WSF) + w * 64; const LAS float* lut = (const LAS float*)(lds + AT_LUT) + h * 128;
    const int q0 = qi * 64, tw0 = q0 + 32 * rg, tq = tw0 + r32; const size_t rowbase = (size_t)b * 4096;
    const int NT = qi + 1;
    const bf16_t* Qp = P + (rowbase + tq) * DP + C_AQ + h * 64;
    bf16x8 qr[4];
#pragma unroll
    for (int d0 = 0; d0 < 4; ++d0) qr[d0] = *(const bf16x8*)(Qp + d0 * 16 + hi * 8);
    const bf16_t* Kb = P + rowbase * DP + C_AK; const bf16_t* Vb = P + rowbase * DP + C_AV;
    const u64* bmp = BM + (size_t)b * 64 * 4096 + tq;
    u64 bits = bmp[0];
    AState<64> st; astate_init(st);
    stage_kv<64>(lds + AT_KBUF, lds + AT_VBUF, Kb, DP, Vb, DP, w, lane, true);
#pragma unroll 1
    for (int kt = 0; kt < NT; ++kt) {
        VM_WAIT(); __syncthreads();
        const int cb = kt & 1;
        u64 nbits = 0ull;
        if (kt + 1 < NT) { stage_kv<64>(lds + AT_KBUF + (cb ^ 1) * 8192, lds + AT_VBUF + (cb ^ 1) * 16384, Kb + (size_t)(kt + 1) * 64 * DP, DP, Vb + (size_t)(kt + 1) * 64 * DP, DP, w, lane, true);
            nbits = bmp[(size_t)(kt + 1) * 4096]; }
        f32x16 S0, S1; qk_tile(S0, S1, qr, lds + AT_KBUF + cb * 8192, r32, hi);
        const int key0 = kt * 64; const bool near = (tw0 - (key0 + 63)) < 113;
        if (A_DENSE) { if (near) apply_mask<MK_C>(S0, S1, tq, key0, hi, true, lut, 0ull, 0); } else apply_mask<MK_A>(S0, S1, tq, key0, hi, near, lut, bits, 0);
        softmax_step<64, true>(st, S0, S1, lds + AT_VBUF + cb * 16384, wsf, lane);
        bits = nbits;
    }
    __syncthreads();
    f32x16 acc[2];
#pragma unroll
    for (int d = 0; d < 2; ++d)
#pragma unroll
        for (int r = 0; r < 16; ++r) acc[d][r] = 0.f;
    const float lt = sum32(st.l, lane);
    finish_add<2>(acc, st.o, 0.5f, lt > 0.f ? 1.f / lt : 0.f, wsf, lane);
    GAS bf16_t* orow = (GAS bf16_t*)OC + (rowbase + tw0) * 1024 + h * 64 + r32; asm volatile("" : "+v"(orow)); int hs = hi; asm volatile("" : "+v"(hs));
#pragma unroll
    for (int r = 0; r < 16; ++r)
#pragma unroll
        for (int d = 0; d < 2; ++d) orow[crow(r, hs) * 1024 + 32 * d] = (bf16_t)f2bf(acc[d][r]);
}

constexpr int IMP_LD = 65;
__device__ __forceinline__ void unit_B(Frame& F, const bf16_t* P, const bf16_t* KC, const bf16_t* VC, bf16_t* OC, int b, int qi) {
    const int lane = F.lane, r32 = lane & 31, hi = lane >> 5, w = F.wave, h = w & 3, rg = w >> 2;
    LAS unsigned char* lds = F.lds; LAS float* wsf = (LAS float*)(lds + AT_WSF) + w * 64; const LAS float* lut = (const LAS float*)(lds + AT_LUT) + (4 + h) * 128;
    LAS float* imp = (LAS float*)(lds + AT_IMP); volatile LAS u64* rmask = (volatile LAS u64*)(lds + AT_RMASK); volatile LAS u64* wor = (volatile LAS u64*)(lds + AT_WOR);
    const int q0 = qi * 64, cur = qi, tw0 = q0 + 32 * rg, tq = tw0 + r32, urow = 32 * rg + r32; const size_t rowbase = (size_t)b * 4096;
    const bf16_t* prow = P + (rowbase + tq) * DP;
    bf16x8 qr[4];
#pragma unroll
    for (int d0 = 0; d0 < 4; ++d0) qr[d0] = *(const bf16x8*)(prow + C_BQ + h * 64 + d0 * 16 + hi * 8);
    const float g0 = fsigmoid(bf2f(prow[C_BG + h * 3 + 0])), g1 = fsigmoid(bf2f(prow[C_BG + h * 3 + 1])), g2 = fsigmoid(bf2f(prow[C_BG + h * 3 + 2]));
    f32x16 ob[2];
#pragma unroll
    for (int d = 0; d < 2; ++d)
#pragma unroll
        for (int r = 0; r < 16; ++r) ob[d][r] = 0.f;
    {
        const int ncv = tq >= 31 ? ((tq - 31) >> 4) + 1 : 0;
        const int ncv_max = ((q0 + 63 - 31) >> 4) + 1, NTc = (ncv_max + 63) >> 6;
        const bf16_t* Kc = KC + (size_t)b * 256 * 64; const bf16_t* Vc = VC + (size_t)b * 256 * 64;
        AState<64> st; astate_init(st);
        stage_kv<64>(lds + AT_KBUF, lds + AT_VBUF, Kc, 64, Vc, 64, w, lane, false);
#pragma unroll 1
        for (int kt = 0; kt < NTc; ++kt) {
            VM_WAIT(); __syncthreads();
            const int cb = kt & 1;
            if (kt + 1 < NTc) stage_kv<64>(lds + AT_KBUF + (cb ^ 1) * 8192, lds + AT_VBUF + (cb ^ 1) * 16384, Kc + (size_t)(kt + 1) * 64 * 64, 64, Vc, 64, w, lane, false);
            f32x16 S0, S1; qk_tile(S0, S1, qr, lds + AT_KBUF + cb * 8192, r32, hi);
            apply_mask<MK_CMP>(S0, S1, tq, kt * 64, hi, false, lut, 0ull, ncv);
            softmax_step<64, false>(st, S0, S1, lds + AT_VBUF, wsf, lane);
        }
        __syncthreads();
        const float lt = sum32(st.l, lane); const float inv = lt > 0.f ? 1.f / lt : 0.f; const float mfin = st.m;
        f32x16 oc[2];
#pragma unroll
        for (int d = 0; d < 2; ++d)
#pragma unroll
            for (int r = 0; r < 16; ++r) oc[d][r] = 0.f;
        float carry = 0.f;
        stage_kv<64>(lds + AT_KBUF, lds + AT_VBUF, Kc, 64, Vc, 64, w, lane, true);
#pragma unroll 1
        for (int kt = 0; kt < NTc; ++kt) {
            VM_WAIT(); __syncthreads();
            const int cb = kt & 1;
            if (kt + 1 < NTc) stage_kv<64>(lds + AT_KBUF + (cb ^ 1) * 8192, lds + AT_VBUF + (cb ^ 1) * 16384, Kc + (size_t)(kt + 1) * 64 * 64, 64, Vc + (size_t)(kt + 1) * 64 * 64, 64, w, lane, true);
            f32x16 S0, S1; qk_tile(S0, S1, qr, lds + AT_KBUF + cb * 8192, r32, hi);
            apply_mask<MK_CMP>(S0, S1, tq, kt * 64, hi, false, lut, 0ull, ncv);
#pragma unroll
            for (int r = 0; r < 16; ++r) { S0[r] = fexp2(S0[r] - mfin) * inv; S1[r] = fexp2(S1[r] - mfin) * inv; }
            float own[2][4], pl[2][4];
#pragma unroll
            for (int g = 0; g < 4; ++g) { own[0][g] = (S0[4 * g] + S0[4 * g + 1]) + (S0[4 * g + 2] + S0[4 * g + 3]); own[1][g] = (S1[4 * g] + S1[4 * g + 1]) + (S1[4 * g + 2] + S1[4 * g + 3]);
                pl[0][g] = other32(S0[4 * g + 3], lane); pl[1][g] = other32(S1[4 * g + 3], lane); }
#pragma unroll
            for (int n = 0; n < 2; ++n)
#pragma unroll
                for (int g = 0; g < 4; ++g) { const int J = 16 * kt + 8 * n + 2 * g + hi;
                    const float prev0 = (g > 0) ? pl[n][g > 0 ? g - 1 : 0] : (n == 1 ? pl[0][3] : carry);
                    const float prev = hi ? pl[n][g] : prev0;
                    imp[(h * 64 + urow) * IMP_LD + J] = own[n][g] + prev; }
            carry = pl[1][3];
            { bf16x8 vf01[2][4]; v_load2(vf01, lds + AT_VBUF + cb * 16384, 0, lane); pv_tile<64>(oc, S0, S1, vf01, lds + AT_VBUF + cb * 16384, lane); }
        }
        finish_add<2>(ob, oc, 0.5f, g0, wsf, lane);
        __syncthreads();
    }
    {
        const int nf = cur >= 2 ? 3 : cur + 1, nfree = 16 - nf; u64 worl = 0ull;
#pragma unroll 1
        for (int rr = 0; rr < 8; ++rr) { const int row = 8 * w + rr; const int j = lane;
            const float v = (imp[(0 * 64 + row) * IMP_LD + j] + imp[(1 * 64 + row) * IMP_LD + j]) + (imp[(2 * 64 + row) * IMP_LD + j] + imp[(3 * 64 + row) * IMP_LD + j]);
            const bool cand = (j >= 1) && (j <= cur - 2);
            int rank = 0;
#pragma unroll 1
            for (int k = 1; k <= cur - 2; ++k) { const float vk = bperm_f(k, v); rank += (vk > v || (vk == v && k < j)) ? 1 : 0; }
            const bool forced = (j <= cur) && (j == 0 || j == cur || j == cur - 1);
            const bool sel = forced || (cand && rank < nfree);
            const u64 mk = __ballot(sel);
            if (lane == 0) rmask[row] = mk;
            worl |= mk; }
        if (lane == 0) wor[w] = worl;
        __syncthreads();
    }
    const u64 myrm = rmask[urow];
    u64 un = 0ull;
#pragma unroll
    for (int k = 0; k < 8; ++k) un |= wor[k];
    {
        const bf16_t* Kb = P + rowbase * DP + C_BKV + 2 * 64; const bf16_t* Vb = P + rowbase * DP + C_BKV + 3 * 64;
        AState<64> st; astate_init(st);
        const int nsel = __popcll(un);
        int j = __ffsll((long long)un) - 1; un &= un - 1;
        stage_kv<64>(lds + AT_KBUF, lds + AT_VBUF, Kb + (size_t)j * 64 * DP, DP, Vb + (size_t)j * 64 * DP, DP, w, lane, true);
#pragma unroll 1
        for (int i = 0; i < nsel; ++i) {
            VM_WAIT(); __syncthreads();
            const int cb = i & 1;
            int jn = -1;
            if (un) { jn = __ffsll((long long)un) - 1; un &= un - 1;
                stage_kv<64>(lds + AT_KBUF + (cb ^ 1) * 8192, lds + AT_VBUF + (cb ^ 1) * 16384, Kb + (size_t)jn * 64 * DP, DP, Vb + (size_t)jn * 64 * DP, DP, w, lane, true); }
            const int rowsel = (int)((myrm >> j) & 1ull);
            if (__any(rowsel)) {
                f32x16 S0, S1; qk_tile(S0, S1, qr, lds + AT_KBUF + cb * 8192, r32, hi);
                const int key0 = j * 64; const bool near = (tw0 - (key0 + 63)) < 113;
                if (near || j == cur || !__all(rowsel)) apply_mask<MK_SLC>(S0, S1, tq, key0, hi, near, lut, 0ull, rowsel);
                softmax_step<64, true>(st, S0, S1, lds + AT_VBUF + cb * 16384, wsf, lane);
            }
            j = jn;
        }
        __syncthreads();
        const float lt = sum32(st.l, lane);
        finish_add<2>(ob, st.o, 0.5f, lt > 0.f ? g1 / lt : 0.f, wsf, lane);
    }
    {
        const bf16_t* Kb = P + rowbase * DP + C_BKV + 4 * 64; const bf16_t* Vb = P + rowbase * DP + C_BKV + 5 * 64;
        AState<64> st; astate_init(st);
        const int kt0 = cur >= 8 ? cur - 8 : 0;
        stage_kv<64>(lds + AT_KBUF, lds + AT_VBUF, Kb + (size_t)kt0 * 64 * DP, DP, Vb + (size_t)kt0 * 64 * DP, DP, w, lane, true);
#pragma unroll 1
        for (int kt = kt0; kt <= cur; ++kt) {
            VM_WAIT(); __syncthreads();
            const int cb = (kt - kt0) & 1;
            if (kt + 1 <= cur) stage_kv<64>(lds + AT_KBUF + (cb ^ 1) * 8192, lds + AT_VBUF + (cb ^ 1) * 16384, Kb + (size_t)(kt + 1) * 64 * DP, DP, Vb + (size_t)(kt + 1) * 64 * DP, DP, w, lane, true);
            f32x16 S0, S1; qk_tile(S0, S1, qr, lds + AT_KBUF + cb * 8192, r32, hi);
            const int key0 = kt * 64; const bool near = (tw0 - (key0 + 63)) < 113;
            const bool allv = (key0 + 63 <= tw0) && (tw0 + 31 - key0 < 512);
            if (near || !allv) apply_mask<MK_WIN>(S0, S1, tq, key0, hi, near, lut, 0ull, 0);
            softmax_step<64, true>(st, S0, S1, lds + AT_VBUF + cb * 16384, wsf, lane);
        }
        __syncthreads();
        const float lt = sum32(st.l, lane);
        finish_add<2>(ob, st.o, 0.5f, lt > 0.f ? g2 / lt : 0.f, wsf, lane);
    }
    GAS bf16_t* orow = (GAS bf16_t*)OC + (rowbase + tw0) * 1024 + 256 + h * 64 + r32; asm volatile("" : "+v"(orow)); int hs = hi; asm volatile("" : "+v"(hs));
#pragma unroll
    for (int r = 0; r < 16; ++r)
#pragma unroll
        for (int d = 0; d < 2; ++d) orow[crow(r, hs) * 1024 + 32 * d] = (bf16_t)f2bf(ob[d][r]);
}

__device__ __forceinline__ void phase_cmp2(Frame& F, const bf16_t* HID, const bf16_t* W2T, bf16_t* KC) {
    const int lane = F.lane, fr = lane & 15, fq = lane >> 4;
    for (int task = F.gw; task < 512; task += F.NGW) { const int j = task >> 8, row0 = (task & 255) * 16;
        f32x4 acc[4];
#pragma unroll
        for (int n = 0; n < 4; ++n) acc[n] = (f32x4){0.f, 0.f, 0.f, 0.f};
#pragma unroll
        for (int ks = 0; ks < 8; ++ks) { const bf16x8 a = *(const bf16x8*)(HID + ((size_t)j * 4096 + row0 + fr) * 256 + ks * 32 + 8 * fq);
#pragma unroll
            for (int n = 0; n < 4; ++n) { const bf16x8 bb = *(const bf16x8*)(W2T + ((size_t)j * 64 + n * 16 + fr) * 256 + ks * 32 + 8 * fq);
                acc[n] = __builtin_amdgcn_mfma_f32_16x16x32_bf16(a, bb, acc[n], 0, 0, 0); } }
#pragma unroll
        for (int n = 0; n < 4; ++n)
#pragma unroll
            for (int jj = 0; jj < 4; ++jj) KC[((size_t)j * 4096 + row0 + 4 * fq + jj) * 64 + n * 16 + fr] = (bf16_t)f2bf(acc[n][jj]);
    }
}

constexpr int PH_PER_LAYER = 11, N_PHASES = 2 + DEPTH * PH_PER_LAYER;
struct Args { const float* in[27]; float* out; unsigned char* ws; int ph_lo, ph_hi, li, pad; };

#define IN(k) (lo <= (k) && (k) < hi)
#define SEAM(k) do { if (IN((k) + 1)) xcd_barrier(bar); } while (0)
#define WSB (F.ws)
#define PROJ ((bf16_t*)(WSB + WS_PROJ))
#define HB ((bf16_t*)(WSB + WS_HB))
#define OCAT ((bf16_t*)(WSB + WS_OCAT))
#define MERG ((bf16_t*)(WSB + WS_MERG))
#define X1 ((bf16_t*)(WSB + WS_X1))
#define MOD ((const float*)(WSB + WS_MOD))

template <int l>
__device__ __forceinline__ void run_layer(Frame& F, const Args& args, const XcdBarrier& bar, int lo, int hi) {
        const int pb = 2 + l * PH_PER_LAYER;
#define xres ((l == 0) ? args.in[0] : (const float*)args.out)
#define mod_a (MOD + (size_t)(2 * l) * 16 * 3072)
#define mod_f (MOD + (size_t)(2 * l + 1) * 16 * 3072)
        if (IN(pb + 0)) for (int rep = 0; rep < ((l == 0 && DUP == 0) ? 2 : 1); ++rep) { if (rep) xcd_barrier(bar); refresh(F);
            { pg8::Gemm g{HB, (const bf16_t*)(WSB + WS_WIN_T) + (size_t)l * DP * 1024, 1024, 1024, 1024, 128}; pg8::StaticOrder S; S.init(NTOK, N_BF, F.G, (int)blockIdx.x);
              pg8::EpiProj E{PROJ, 0, 1.f};
              pg8::gemm_phase<pg8::EpiProj, pg8::StaticOrder>(F.lds, g, S, E, F.wave); }
            { pg8::Gemm g{(const bf16_t*)(WSB + WS_HB8), (const bf16_t*)(WSB + WS_WMG8 + (size_t)l * N_F8 * 1024), 512, 512, 512, 128}; pg8::StaticOrder S; S.init(NTOK, N_F8, F.G, (int)blockIdx.x);
              pg8::EpiGate8 E{(unsigned char*)(WSB + WS_MG8), 1.f / (F8_H * F8_WIN)};
              pg8::gemm_phase<pg8::EpiGate8, pg8::StaticOrder, true>(F.lds, g, S, E, F.wave); }
            if (blockIdx.x == 255) { u32x4* z = (u32x4*)(PROJ + (size_t)NTOK * DP); for (int i = F.tid; i < 32 * DP * 2 / 16; i += 512) z[i] = (u32x4){0u, 0u, 0u, 0u}; }
            SEAM(pb + 0);
        }
        if (IN(pb + 1)) for (int rep = 0; rep < ((l == 0 && DUP == 1) ? 2 : 1); ++rep) { if (rep) xcd_barrier(bar); refresh(F);
            { pg8::Gemm g{PROJ + C_BKV, (const bf16_t*)(WSB + WS_W1_T) + (size_t)l * 2 * 256 * 2048, 16 * DP, 2048, 2048, DP * 2}; pg8::CmpOrder S{F.G, (int)blockIdx.x};
              pg8::EpiCmp1 E{(bf16_t*)(WSB + WS_HID), (const float*)(WSB + WS_BIAS1) + l * 512};
              pg8::gemm_phase<pg8::EpiCmp1, pg8::CmpOrder>(F.lds, g, S, E, F.wave); }
            __syncthreads();
            if (USE_A) {
#pragma unroll 1
                for (int i = 0; i < 16; ++i) { const int c = (int)blockIdx.x; const int qt = (i & 1) ? 255 - c : c;
                    dsa_select_tile(F, PROJ, (u64*)(WSB + WS_BM64), (unsigned*)(WSB + WS_OCAT) + (size_t)blockIdx.x * 65536, i, qt); }
            }
            SEAM(pb + 1);
        }
        if (IN(pb + 2)) for (int rep = 0; rep < ((l == 0 && DUP == 2) ? 2 : 1); ++rep) { if (rep) xcd_barrier(bar); refresh(F); phase_cmp2(F, (const bf16_t*)(WSB + WS_HID), (const bf16_t*)(WSB + WS_W2_T) + (size_t)l * 2 * 64 * 256, (bf16_t*)(WSB + WS_KCMP)); SEAM(pb + 2); }
        if (IN(pb + 3)) for (int rep = 0; rep < ((l == 0 && DUP == 3) ? 2 : 1); ++rep) { if (rep) xcd_barrier(bar); refresh(F);
            for (int i = F.tid; i < 12 * 128; i += 512) ((LAS float*)(F.lds + AT_LUT))[i] = ((const float*)(WSB + WS_LUT))[i];
            __syncthreads();
            const int c = (int)blockIdx.x;
            if (USE_C) {
                const float lam = ((const float*)(WSB + WS_LAM))[l]; const float lam_init = 0.8f - 0.6f * __expf(-0.3f * (float)l);
#pragma unroll 1
                for (int u = 0; u < 4; ++u) { const int bh = (c & 7) * 8 + (c >> 5), pp = ((c >> 3) & 3) * 2 + (u >> 1); const int qb = (u & 1) ? pp : 15 - pp;
                    refresh(F); unit_C(F, PROJ, OCAT, args.in[10] + l * 128, lam, lam_init, bh >> 2, bh & 3, qb); }
            }
            if (USE_A) {
#pragma unroll 1
                for (int u = 0; u < 4; ++u) { const int b = (c & 7) * 2 + (c >> 7), pp = ((c >> 3) & 15) * 2 + (u >> 1); const int qi = (u & 1) ? pp : 63 - pp;
                    refresh(F); unit_A(F, PROJ, (const u64*)(WSB + WS_BM64), OCAT, b, qi); }
            }
            if (USE_B) {
#pragma unroll 1
                for (int u = 0; u < 4; ++u) { const int b = (c & 7) * 2 + (c >> 7), pp = ((c >> 3) & 15) * 2 + (u >> 1); const int qi = (u & 1) ? pp : 63 - pp;
                    refresh(F); unit_B(F, PROJ, (const bf16_t*)(WSB + WS_KCMP), (const bf16_t*)(WSB + WS_KCMP) + 4096 * 64, OCAT, b, qi); }
            }
            if (!USE_A || !USE_B || !USE_C) {
                for (int row = F.gw; row < NTOK; row += F.NGW) { u32x4* o = (u32x4*)(OCAT + (size_t)row * 1024);
                    for (int q = F.lane; q < 128; q += 64) { const int col = q * 8; const bool z = (col < 256) ? !USE_A : (col < 512 ? !USE_B : !USE_C); if (z) o[q] = (u32x4){0u, 0u, 0u, 0u}; } }
            }
            SEAM(pb + 3);
        }
        if (IN(pb + 4)) for (int rep = 0; rep < ((l == 0 && DUP == 4) ? 2 : 1); ++rep) { if (rep) xcd_barrier(bar); refresh(F);
            const bf16_t* WB = (const bf16_t*)(WSB + WS_WBR_T + (size_t)l * 2 * MiB);
            pg8::StaticOrder S; S.init(NTOK, 1024, F.G, (int)blockIdx.x);
            { pg8::Gemm g{OCAT, WB, 1024, 1024, 1024, 128}; pg8::EpiBranchCat E{MERG, (const unsigned char*)(WSB + WS_MG8)}; pg8::gemm_phase<pg8::EpiBranchCat, pg8::StaticOrder>(F.lds, g, S, E, F.wave); }
            SEAM(pb + 4);
        }
        if (IN(pb + 5)) for (int rep = 0; rep < ((l == 0 && DUP == 5) ? 2 : 1); ++rep) { if (rep) xcd_barrier(bar); refresh(F);
            pg8::Gemm g{MERG, (const bf16_t*)(WSB + WS_WOUT_T) + (size_t)l * 1024 * 1024, 1024, 1024, 1024, 128}; pg8::StaticOrder S; S.init(NTOK, 1024, F.G, (int)blockIdx.x);
            pg8::EpiWout<(l > 0)> E{X1, (l == 0) ? (const void*)args.in[0] : (const void*)(WSB + WS_X2B), mod_a + 2048};
            pg8::gemm_phase<pg8::EpiWout<(l > 0)>, pg8::StaticOrder>(F.lds, g, S, E, F.wave);
            SEAM(pb + 5);
        }
#define cnt ((unsigned*)(WSB + WS_CTL) + CW_CNT + l * 64)
        if (IN(pb + 6)) for (int rep = 0; rep < ((l == 0 && DUP == 6) ? 2 : 1); ++rep) { if (rep) xcd_barrier(bar); refresh(F); phase_ln1_router(F, X1, args.in[15] + l * 1024, args.in[16] + l * 1024, mod_f, args.in[19] + (size_t)l * 1024 * 32, args.in[20] + l * 32, HB, cnt); SEAM(pb + 6); }
        if (IN(pb + 7)) for (int rep = 0; rep < ((l == 0 && DUP == 7) ? 2 : 1); ++rep) { if (rep) xcd_barrier(bar); refresh(F); phase_gather(F, cnt, HB, (unsigned char*)(WSB + WS_HS8)); SEAM(pb + 7); }
        if (IN(pb + 8)) for (int rep = 0; rep < ((l == 0 && DUP == 8) ? 2 : 1); ++rep) { if (rep) xcd_barrier(bar); refresh(F);
            build_pstart(F, cnt);
            pg8::Gemm g{(const bf16_t*)(WSB + WS_HS8), (const bf16_t*)(WSB + WS_WGU_T + (size_t)l * 32 * 2048 * 1024), 512, 512, 512, 128};
            pg8::MoeOrder S{F.G, (int)blockIdx.x, 8, (int)F.MISC[48], (const volatile LAS int*)(F.MISC + 16)};
            pg8::EpiMoe1 E{(unsigned char*)(WSB + WS_ACT), args.in[22] + (size_t)l * 32 * 2048};
            pg8::gemm_phase<pg8::EpiMoe1, pg8::MoeOrder, true>(F.lds, g, S, E, F.wave);
            SEAM(pb + 8);
        }
        if (IN(pb + 9)) for (int rep = 0; rep < ((l == 0 && DUP == 9) ? 2 : 1); ++rep) { if (rep) xcd_barrier(bar); refresh(F);
            build_pstart(F, cnt);
            pg8::Gemm g{(const bf16_t*)(WSB + WS_ACT), (const bf16_t*)(WSB + WS_WDN_T + (size_t)l * 32 * 1024 * 1024), 512, 512, 512, 128};
            pg8::MoeOrder S{F.G, (int)blockIdx.x, 4, (int)F.MISC[48], (const volatile LAS int*)(F.MISC + 16)};
            pg8::EpiMoe2 E{(bf16_t*)(WSB + WS_HS), args.in[24] + (size_t)l * 32 * 1024};
            pg8::gemm_phase<pg8::EpiMoe2, pg8::MoeOrder, true>(F.lds, g, S, E, F.wave);
            SEAM(pb + 9);
        }
        if (IN(pb + 10)) for (int rep = 0; rep < ((l == 0 && DUP == 10) ? 2 : 1); ++rep) { if (rep) xcd_barrier(bar); refresh(F);
            phase_combine(F, (const bf16_t*)(WSB + WS_HS), X1, mod_f, args.in[25] + l * 1024, args.in[26] + l * 1024, args.out, (l + 1 < DEPTH) ? MOD + (size_t)(2 * l + 2) * 16 * 3072 : nullptr, HB, (unsigned char*)(WSB + WS_HB8), (bf16_t*)(WSB + WS_X2B));
            SEAM(pb + 10);
        }
}

__global__ void __launch_bounds__(512, 2) mega_fwd(Args args) {
    extern __shared__ __attribute__((aligned(16))) unsigned char lds_raw[];
    Frame F;
    F.lds = (LAS unsigned char*)lds_raw; F.MISC = (volatile LAS unsigned*)(F.lds + LDS_MISC);
    F.tid = threadIdx.x; F.lane = F.tid & 63; F.wave = __builtin_amdgcn_readfirstlane(F.tid >> 6); F.wave0 = F.wave;
    F.G = gridDim.x; F.gw = blockIdx.x * 8 + F.wave; F.NGW = F.G * 8;
    F.ws = args.ws; F.ws0 = args.ws; F.ctl = (unsigned*)(args.ws + WS_CTL); F.in = args.in; F.out = args.out;
    for (int u = F.tid; u < (LDS_BYTES - LDS_MISC) / 4; u += 512) F.MISC[u] = 0u;
    __syncthreads();
    XcdBarrier bar = xcd_barrier_post(F.ctl + CW_BAR + args.li * XCD_BAR_WORDS, F.MISC);
    const int lo = args.ph_lo, hi = args.ph_hi;
    if (IN(0)) for (int rep = 0; rep < (DUP == 100 ? 2 : 1); ++rep) { refresh(F); phase_prologue(F); SEAM(0); }
    if (IN(1)) { refresh(F); phase_h0(F, args.in[0], MOD, HB, (unsigned char*)(WSB + WS_HB8)); SEAM(1); }

    run_layer<0>(F, args, bar, lo, hi);
    run_layer<1>(F, args, bar, lo, hi);
#undef IN
#undef SEAM
#undef WSB
#undef PROJ
#undef HB
#undef OCAT
#undef MERG
#undef X1
#undef MOD
#undef xres
#undef mod_a
#undef mod_f
#undef cnt
}

constexpr int N_LAUNCHES = 1;
extern "C" void kernel_launch(void* const* d_in, const int* in_sizes, int n_in, void* d_out, int out_size, void* d_ws, size_t ws_size, hipStream_t stream) {
    static int grid = 0;
    if (grid == 0) {
        if (n_in != 27 || out_size != NTOK * D || ws_size < WS_END) { fprintf(stderr, "kernel_launch: unexpected sizes n_in %d out %d ws %zu (need %zu)\n", n_in, out_size, ws_size, (size_t)WS_END); grid = -1; return; }
        int dev = 0, cus = 0, per_cu = 0;
        if (hipGetDevice(&dev) != hipSuccess || hipDeviceGetAttribute(&cus, hipDeviceAttributeMultiprocessorCount, dev) != hipSuccess) { grid = -1; return; }
        if (hipFuncSetAttribute((const void*)mega_fwd, hipFuncAttributeMaxDynamicSharedMemorySize, LDS_BYTES) != hipSuccess) { fprintf(stderr, "kernel_launch: hipFuncSetAttribute failed\n"); grid = -1; return; }
        if (hipOccupancyMaxActiveBlocksPerMultiprocessor(&per_cu, (const void*)mega_fwd, 512, LDS_BYTES) != hipSuccess || per_cu < 1) fprintf(stderr, "kernel_launch: occupancy query says %d\n", per_cu);
        (void)hipGetLastError();
        grid = cus;
        if (grid != 256) { fprintf(stderr, "kernel_launch: built for 256 CUs, got %d\n", cus); grid = -1; return; }
    }
    if (grid < 0) return;
    (void)hipMemsetAsync((char*)d_ws + WS_CTL, 0, CTL_BYTES, stream);
    Args a{};
    for (int i = 0; i < 27; ++i) a.in[i] = (const float*)d_in[i];
    a.out = (float*)d_out; a.ws = (unsigned char*)d_ws; a.pad = 0;
    for (int li = 0; li < N_LAUNCHES; ++li) {
        a.ph_lo = (N_LAUNCHES == 1) ? 0 : li; a.ph_hi = (N_LAUNCHES == 1) ? N_PHASES : li + 1; a.li = li;
        hipLaunchKernelGGL(mega_fwd, dim3(grid), dim3(512), LDS_BYTES, stream, a);
    }
}
```

```cpp
#include <hip/hip_runtime.h>
#include <cstdio>
#include <cstdint>

#define GAS __attribute__((address_space(1)))
#define LAS __attribute__((address_space(3)))
typedef unsigned short bf16_t;
typedef short bf16x8 __attribute__((ext_vector_type(8)));
typedef short s16x4 __attribute__((ext_vector_type(4)));
typedef float f32x2 __attribute__((ext_vector_type(2)));
typedef float f32x4 __attribute__((ext_vector_type(4)));
typedef float f32x16 __attribute__((ext_vector_type(16)));
typedef unsigned u32x4 __attribute__((ext_vector_type(4)));
typedef unsigned u32x2 __attribute__((ext_vector_type(2)));
typedef unsigned long long u64;

constexpr bool USE_A = true, USE_B = true, USE_C = true;
constexpr bool A_DENSE = false; constexpr bool DSA_FAKE = false; constexpr bool F8_RECOMPUTE = false; constexpr int STAGGER_TICKS = 0; constexpr int PROBE_EPI = 0; constexpr int PROBE_KL = 0; constexpr int PROBE_CLK = 0; constexpr int PROBE_CLKMODE = 2;
constexpr int PROBE_ATT = 0;
constexpr int DUP = -1;
constexpr int NB = 16, SEQ = 4096, NTOK = NB * SEQ, D = 1024, DEPTH = 2, NEXP = 32;
constexpr int DP = 2816;
constexpr int D_IN = 5808;
constexpr int C_AQ = 0, C_AK = 256, C_AV = 320, C_IQ = 384, C_IK = 512, C_IW = 544, C_BG = 548, C_BQ = 576, C_BKV = 832, C_CQ = 1216, C_CK = 1728, C_CV = 2240, C_MG = 2752;
constexpr float LOG2E = 1.4426950408889634f;
constexpr float QS = 0.125f * LOG2E;
constexpr float IQS = 0.17677669529663687f;
constexpr float DN_ALPHA = 1.4142135623730951f;
constexpr float LN_EPS = 1e-5f;
constexpr int MOE_ROWS = NTOK * 4 + NEXP * 256;
constexpr float F8_WGU = 256.f, F8_WDN = 512.f, F8_H = 4.f, F8_ACT = 4.f, F8_WIN = 256.f, F8_Y = 16.f, F8_MG2 = 16.f, F8_WO = 512.f;
constexpr int N_BF = 2816, N_F8 = 3072;

constexpr size_t MiB = 1u << 20;
constexpr size_t WS_CTL = 0, CTL_BYTES = 1 * MiB;
constexpr size_t WS_MOD = 1 * MiB;
constexpr size_t WS_BIAS1 = WS_MOD + 4 * 16 * 3072 * 4;
constexpr size_t WS_LUT = WS_BIAS1 + 4096;
constexpr size_t WS_LAM = WS_LUT + 8192;
constexpr size_t WS_TOKE = 2 * MiB;
constexpr size_t WS_TOKW = 3 * MiB;
constexpr size_t WS_TOKP = 4 * MiB;
constexpr size_t WS_TOKR = 5 * MiB;
constexpr size_t WS_KCMP = 6 * MiB;
constexpr size_t WS_WIN_T = 8 * MiB;
constexpr size_t WS_WBR_T = 31 * MiB;
constexpr size_t WS_WOUT_T = 35 * MiB;
constexpr size_t WS_W1_T = 39 * MiB;
constexpr size_t WS_W2_T = 43 * MiB;
constexpr size_t WS_WGU_T = 44 * MiB;
constexpr size_t WS_WDN_T = 300 * MiB;
constexpr size_t WS_WMG8 = 172 * MiB;
constexpr size_t WS_HB8 = 364 * MiB;
constexpr size_t WS_X1 = 428 * MiB;
constexpr size_t WS_X2B = 556 * MiB;
constexpr size_t WS_HB = 684 * MiB;
constexpr size_t WS_HID = 812 * MiB;
constexpr size_t WS_BIG = 820 * MiB;
constexpr size_t WS_PROJ = WS_BIG;
constexpr size_t WS_MG8 = WS_BIG + 353 * MiB;
constexpr size_t WS_OCAT = WS_BIG + 737 * MiB;
constexpr size_t WS_MERG = WS_OCAT + 128 * MiB;
constexpr size_t WS_BM64 = WS_MERG + 128 * MiB;
constexpr size_t WS_HS = WS_BIG;
constexpr size_t WS_HS8 = WS_BIG + 792 * MiB;
constexpr size_t WS_ACT = WS_BIG + 528 * MiB;
constexpr size_t WS_END = WS_BIG + 1056 * MiB;
static_assert((size_t)(NTOK + 32) * DP * 2 <= 353 * MiB, "proj");
static_assert((size_t)MOE_ROWS * 1024 * 2 <= 528 * MiB, "moe rows");
static_assert(WS_BM64 + 32 * MiB <= WS_END, "ws");
constexpr int CW_CNT = 1024;
constexpr int CW_BAR = 4096;

constexpr int LDS_MISC = 147456;
constexpr int LDS_BYTES = 151552;

#define LDS_WAIT() asm volatile("s_waitcnt lgkmcnt(0)" ::: "memory")
#define VM_WAIT() do { __builtin_amdgcn_s_waitcnt(0x0F70); asm volatile("" ::: "memory"); } while (0)

__device__ __forceinline__ unsigned f2bf(float f) { unsigned u = __builtin_bit_cast(unsigned, f); return (u + 0x7fffu + ((u >> 16) & 1u)) >> 16; }
__device__ __forceinline__ unsigned pk2(float lo, float hi) { return f2bf(lo) | (f2bf(hi) << 16); }
__device__ __forceinline__ float bf2f(unsigned short b) { return __builtin_bit_cast(float, (unsigned)b << 16); }
__device__ __forceinline__ float bflo(unsigned w) { return __builtin_bit_cast(float, w << 16); }
__device__ __forceinline__ float bfhi(unsigned w) { return __builtin_bit_cast(float, w & 0xffff0000u); }
typedef __bf16 bf16x2_t __attribute__((ext_vector_type(2)));
__device__ __forceinline__ unsigned cvt_pk_bf16(float lo, float hi) { return __builtin_bit_cast(unsigned, __builtin_convertvector((f32x2){lo, hi}, bf16x2_t)); }
__device__ __forceinline__ unsigned pk4_fp8(float a, float b, float c, float d) { int r = 0; r = __builtin_amdgcn_cvt_pk_fp8_f32(a, b, r, false); r = __builtin_amdgcn_cvt_pk_fp8_f32(c, d, r, true); return (unsigned)r; }
__device__ __forceinline__ void fp8x8_f32(u32x2 w, float (&f)[8]) { const f32x2 a = __builtin_amdgcn_cvt_pk_f32_fp8((int)w.x, false), b = __builtin_amdgcn_cvt_pk_f32_fp8((int)w.x, true), c = __builtin_amdgcn_cvt_pk_f32_fp8((int)w.y, false), d = __builtin_amdgcn_cvt_pk_f32_fp8((int)w.y, true);
    f[0] = a.x; f[1] = a.y; f[2] = b.x; f[3] = b.y; f[4] = c.x; f[5] = c.y; f[6] = d.x; f[7] = d.y; }
__device__ __forceinline__ float fexp2(float x) { return __builtin_amdgcn_exp2f(x); }
__device__ __forceinline__ float frcp(float x) { return __builtin_amdgcn_rcpf(x); }
__device__ __forceinline__ float fsigmoid(float x) { return frcp(1.f + fexp2(-LOG2E * x)); }
__device__ __forceinline__ float gelu_tanh(float x) { const float u = 0.7978845608028654f * (x + 0.044715f * x * x * x); return x * fsigmoid(2.f * u); }
__device__ __forceinline__ int bperm_i(int idx, int v) { return __builtin_amdgcn_ds_bpermute(idx << 2, v); }
__device__ __forceinline__ float bperm_f(int idx, float v) { return __builtin_bit_cast(float, __builtin_amdgcn_ds_bpermute(idx << 2, __builtin_bit_cast(int, v))); }
__device__ __forceinline__ float other32(float v, int lane) { return bperm_f(lane ^ 32, v); }
__device__ __forceinline__ float sum32(float v, int lane) { return v + bperm_f(lane ^ 32, v); }
__device__ __forceinline__ float max32(float v, int lane) { return fmaxf(v, bperm_f(lane ^ 32, v)); }
__device__ __forceinline__ float shx_f(float v, int mask, int lane) { return bperm_f(lane ^ mask, v); }
__device__ __forceinline__ int shx_i(int v, int mask, int lane) { return bperm_i(lane ^ mask, v); }
template <int CTRL> __device__ __forceinline__ float dpp_f(float v) { return __builtin_bit_cast(float, __builtin_amdgcn_update_dpp(0, __builtin_bit_cast(int, v), CTRL, 0xF, 0xF, true)); }
__device__ __forceinline__ float wave_sum(float v, int lane) {
    v += dpp_f<0xB1>(v); v += dpp_f<0x4E>(v); v += dpp_f<0x141>(v); v += dpp_f<0x140>(v);
    v += __builtin_bit_cast(float, __builtin_amdgcn_update_dpp(0, __builtin_bit_cast(int, v), 0x142, 0xA, 0xF, false));
    v += __builtin_bit_cast(float, __builtin_amdgcn_update_dpp(0, __builtin_bit_cast(int, v), 0x143, 0xC, 0xF, false));
    return __builtin_bit_cast(float, __builtin_amdgcn_readlane(__builtin_bit_cast(int, v), 63));
}
__device__ __forceinline__ float wave_max(float v) {
    v = fmaxf(v, dpp_f<0xB1>(v)); v = fmaxf(v, dpp_f<0x4E>(v)); v = fmaxf(v, dpp_f<0x141>(v)); v = fmaxf(v, dpp_f<0x140>(v));
    const int vi = __builtin_bit_cast(int, v);
    v = fmaxf(v, __builtin_bit_cast(float, __builtin_amdgcn_update_dpp(vi, vi, 0x142, 0xA, 0xF, false)));
    const int vj = __builtin_bit_cast(int, v);
    v = fmaxf(v, __builtin_bit_cast(float, __builtin_amdgcn_update_dpp(vj, vj, 0x143, 0xC, 0xF, false)));
    return __builtin_bit_cast(float, __builtin_amdgcn_readlane(__builtin_bit_cast(int, v), 63));
}

#define XB_TMO      128
#define XB_XCNT(j)  (256  + 64 * (j))
#define XB_XSUB(j)  (1280 + 64 * (j))
#define XB_XGEN(j)  (2304 + 64 * (j))
#define XB_TOP      3328
#define XB_TOPGEN   3392
#define XCD_BAR_WORDS 3456
#define XB_SPIN_CAP (1u << 18)

__device__ __forceinline__ unsigned xb_ld(unsigned* p)              { return __hip_atomic_load(p, __ATOMIC_RELAXED, __HIP_MEMORY_SCOPE_AGENT); }
__device__ __forceinline__ unsigned xb_add(unsigned* p, unsigned v) { return __hip_atomic_fetch_add(p, v, __ATOMIC_RELAXED, __HIP_MEMORY_SCOPE_AGENT); }
__device__ __forceinline__ unsigned xb_xcc_id() { return (unsigned)__builtin_amdgcn_s_getreg((3 << 11) | 20) & 0xFu; }
#define XB_SPIN(cond, bar) do { unsigned _sp = 0; while (cond) { __builtin_amdgcn_s_sleep(1); \
    if ((++_sp & 255u) == 0u) { if (xb_ld(&(bar)[XB_TMO])) break; if (_sp > XB_SPIN_CAP) { atomicAdd(&(bar)[XB_TMO], 1u); break; } } } } while (0)

struct XcdBarrier { unsigned* bar; unsigned x; volatile LAS unsigned* st; };

__device__ __forceinline__ XcdBarrier xcd_barrier_post(unsigned* bar, volatile LAS unsigned* st) {
    XcdBarrier b; b.bar = bar; b.x = xb_xcc_id(); b.st = st;
    if (threadIdx.x == 0) (void)xb_add(&bar[XB_XCNT(b.x)], 1u);
    return b;
}
__device__ __forceinline__ void xcd_barrier_complete(unsigned* bar, unsigned x, unsigned& nloc, unsigned& nx) {
    const unsigned G = gridDim.x * gridDim.y * gridDim.z;
    unsigned sum, cnt, mine, sp = 0u;
    for (;;) {
        sum = 0u; cnt = 0u; mine = 0u;
#pragma unroll
        for (unsigned j = 0; j < 16; ++j) { const unsigned c = xb_ld(&bar[XB_XCNT(j)]); sum += c; cnt += (c > 0u) ? 1u : 0u; mine = (j == x) ? c : mine; }
        if (sum == G) break;
        __builtin_amdgcn_s_sleep(1);
        if ((++sp & 255u) == 0u) { if (xb_ld(&bar[XB_TMO])) break; if (sp > XB_SPIN_CAP) { atomicAdd(&bar[XB_TMO], 1u); break; } }
    }
    nloc = mine > 0u ? mine : 1u; nx = cnt > 0u ? cnt : 1u;
}
__device__ __forceinline__ void xcd_barrier(const XcdBarrier& b) {
    asm volatile("s_waitcnt vmcnt(0)" ::: "memory");
    __syncthreads();
    if (threadIdx.x == 0) {
        unsigned* bar = b.bar;
        __builtin_amdgcn_s_waitcnt(0);
        unsigned nloc = b.st[0], nx = b.st[1];
        if (nloc == 0u) { xcd_barrier_complete(bar, b.x, nloc, nx); b.st[0] = nloc; b.st[1] = nx; }
        const unsigned old = xb_add(&bar[XB_XSUB(b.x)], 1u);
        const unsigned gen = old / nloc;
        if (old + 1u == (gen + 1u) * nloc) {
            __builtin_amdgcn_fence(__ATOMIC_RELEASE, "agent");
            asm volatile("s_waitcnt vmcnt(0)" ::: "memory");
            const unsigned og = xb_add(&bar[XB_TOP], 1u);
            const unsigned tg = og / nx;
            if (og + 1u == (tg + 1u) * nx) xb_add(&bar[XB_TOPGEN], 1u);
            else XB_SPIN(xb_ld(&bar[XB_TOPGEN]) == tg, bar);
            __builtin_amdgcn_fence(__ATOMIC_ACQUIRE, "agent");
            xb_add(&bar[XB_XGEN(b.x)], 1u);
            asm volatile("s_waitcnt vmcnt(0)" ::: "memory");
        } else {
            XB_SPIN(xb_ld(&bar[XB_XGEN(b.x)]) == gen, bar);
            __builtin_amdgcn_fence(__ATOMIC_ACQUIRE, "agent");
            asm volatile("s_waitcnt vmcnt(0)" ::: "memory");
        }
    }
    __syncthreads();
}

__device__ __forceinline__ int fresh_tid(int wave_s) {
    unsigned ones = ~0u; asm volatile("" : "+s"(ones));
    int ln = (int)__builtin_amdgcn_mbcnt_hi(ones, __builtin_amdgcn_mbcnt_lo(ones, 0u)); asm volatile("" : "+v"(ln));
    return wave_s * 64 + ln;
}

namespace pg8 {
typedef int v4i_t __attribute__((ext_vector_type(4)));
typedef int v8i_t __attribute__((ext_vector_type(8)));
constexpr int BM = 256, BK = 64, HALF = 128, HTB = HALF * BK * 2, STAGE_BYTES = 8 * HTB, NXCD = 8, WGM = 8;
__device__ __forceinline__ int lds_byte(int r, int c) { const int st = (r >> 4) * 2 + (c >> 5), rr = r & 15, cc = c & 31, ob = rr * 64 + cc * 2; return st * 1024 + (ob ^ (((ob >> 9) & 1) << 5)); }
__device__ __forceinline__ void stage_rc(int b, int& R, int& C) { const int st = b / 1024, sb = b % 1024, swz = sb ^ (((sb >> 9) & 1) << 5); R = (st >> 1) * 16 + swz / 64; C = (st & 1) * 32 + (swz % 64) / 2; }
__device__ __forceinline__ int perm32(int rho) { const int n = rho >> 4, i = rho & 15; return 8 * (i >> 2) + 4 * n + (i & 3); }

struct Unit { int pm, pn; };
struct Gemm { const bf16_t* A; const bf16_t* Bt; int lda, ldb, K, kstepA; };

struct StaticOrder {
    int nM, nN, nwg, G, c;
    __device__ void init(int M, int N, int G_, int c_) { nM = M / BM; nN = N / BM; nwg = nM * nN; G = G_; c = c_; }
    __device__ bool next(int i, Unit& u) const {
        const long L = (long)i * G + c; if (L >= nwg) return false;
        int wgid = (int)L; { const int q = nwg / NXCD, r = nwg % NXCD, xcd = wgid % NXCD, off = wgid / NXCD; wgid = (xcd < r ? xcd * (q + 1) : r * (q + 1) + (xcd - r) * q) + off; }
        const int nig = WGM * nN, gid = wgid / nig, fm = gid * WGM, gsz = (nM - fm) < WGM ? (nM - fm) : WGM;
        u.pm = fm + ((wgid % nig) % gsz); u.pn = (wgid % nig) / gsz; return true;
    }
    __device__ __forceinline__ const char* a_ptr(const Gemm& g, const Unit& u) const { return (const char*)g.A + (size_t)u.pm * (size_t)(BM * 2) * g.lda; }
    __device__ __forceinline__ const char* b_ptr(const Gemm& g, const Unit& u) const { return (const char*)g.Bt + (size_t)u.pn * (size_t)(BM * 2) * g.ldb; }
};
struct CmpOrder {
    int G, c;
    __device__ bool next(int i, Unit& u) const { const int L = i * G + c; if (L >= 32) return false; u.pn = L >> 4; u.pm = L & 15; return true; }
    __device__ __forceinline__ const char* a_ptr(const Gemm& g, const Unit& u) const { return (const char*)g.A + (size_t)u.pm * (size_t)(BM * 2) * g.lda + u.pn * 128; }
    __device__ __forceinline__ const char* b_ptr(const Gemm& g, const Unit& u) const { return (const char*)g.Bt + (size_t)u.pn * (size_t)(BM * 2) * g.ldb; }
};
struct MoeOrder {
    int G, c, NT, npan; const volatile LAS int* pstart;
    __device__ bool next(int i, Unit& u) const {
        const int ppx = (256 / NT) / 8, x = c & 7, r = c >> 3;
        const int p = i * (256 / NT) + x * ppx + (r % ppx), n = r / ppx; if (p >= npan) return false;
        const int ln = (int)__builtin_amdgcn_mbcnt_hi(~0u, __builtin_amdgcn_mbcnt_lo(~0u, 0u));
        const int ps = pstart[ln & 31];
        const int e = __popcll(__ballot(ln >= 1 && ln < 32 && ps <= p));
        u.pm = p; u.pn = e * NT + n; return true;
    }
    __device__ __forceinline__ const char* a_ptr(const Gemm& g, const Unit& u) const { return (const char*)g.A + (size_t)u.pm * (size_t)(BM * 2) * g.lda; }
    __device__ __forceinline__ const char* b_ptr(const Gemm& g, const Unit& u) const { return (const char*)g.Bt + (size_t)u.pn * (size_t)(BM * 2) * g.ldb; }
};

#define EPI_LOOP_AI_M  _Pragma("unroll") for (int ai = 0; ai < 2; ++ai) _Pragma("unroll") for (int m = 0; m < 4; ++m)

struct EpiProj {
    static constexpr bool PERM = true; static constexpr int CLKID = 0; static constexpr int NST = 16;
    bf16_t* O; int colbase; float scl;
    __device__ __forceinline__ void operator()(const f32x4 (&acc)[2][2][4][2], const Unit& u, int wr, int wc, int fr, int fq) const {
        const int row0 = u.pm * BM + wr * 64 + fr, col0 = colbase + u.pn * BM + wc * 32 + 8 * fq;
        EPI_LOOP_AI_M { bf16_t* rowp = O + (size_t)(row0 + ai * HALF + m * 16) * DP + col0;
#pragma unroll
            for (int bj = 0; bj < 2; ++bj) { const f32x4 v0 = acc[ai][bj][m][0] * scl, v1 = acc[ai][bj][m][1] * scl;
                u32x4 w; w.x = cvt_pk_bf16(v0[0], v0[1]); w.y = cvt_pk_bf16(v0[2], v0[3]); w.z = cvt_pk_bf16(v1[0], v1[1]); w.w = cvt_pk_bf16(v1[2], v1[3]);
                *(u32x4*)(rowp + bj * HALF) = w; } }
    }
};
struct EpiGate8 {
    static constexpr bool PERM = true; static constexpr int CLKID = 0; static constexpr int NST = 16;
    unsigned char* O; float scl;
    __device__ __forceinline__ void operator()(const f32x4 (&acc)[2][2][4][2], const Unit& u, int wr, int wc, int fr, int fq) const {
        const int row0 = u.pm * BM + wr * 64 + fr, col0 = u.pn * BM + wc * 32 + 8 * fq;
        EPI_LOOP_AI_M { unsigned char* rowp = O + (size_t)(row0 + ai * HALF + m * 16) * 3072 + col0;
#pragma unroll
            for (int bj = 0; bj < 2; ++bj) { const f32x4 v0 = acc[ai][bj][m][0] * scl, v1 = acc[ai][bj][m][1] * scl;
                *(u32x2*)(rowp + bj * HALF) = (u32x2){pk4_fp8(v0[0], v0[1], v0[2], v0[3]), pk4_fp8(v1[0], v1[1], v1[2], v1[3])}; } }
    }
};
struct EpiCmp1 {
    static constexpr bool PERM = true; static constexpr int CLKID = 0; static constexpr int NST = 16;
    bf16_t* O; const float* bias;
    __device__ __forceinline__ void operator()(const f32x4 (&acc)[2][2][4][2], const Unit& u, int wr, int wc, int fr, int fq) const {
        const int row0 = u.pm * BM + wr * 64 + fr, col0 = wc * 32 + 8 * fq; const int j = u.pn;
        f32x4 bv[2][2];
#pragma unroll
        for (int bj = 0; bj < 2; ++bj)
#pragma unroll
            for (int n = 0; n < 2; ++n) bv[bj][n] = *(const f32x4*)(bias + j * 256 + col0 + bj * HALF + 4 * n);
        EPI_LOOP_AI_M { bf16_t* rowp = O + ((size_t)j * 4096 + row0 + ai * HALF + m * 16) * 256 + col0;
#pragma unroll
            for (int bj = 0; bj < 2; ++bj) { f32x4 v0 = acc[ai][bj][m][0] + bv[bj][0], v1 = acc[ai][bj][m][1] + bv[bj][1];
#pragma unroll
                for (int q = 0; q < 4; ++q) { v0[q] = gelu_tanh(v0[q]); v1[q] = gelu_tanh(v1[q]); }
                u32x4 w; w.x = cvt_pk_bf16(v0[0], v0[1]); w.y = cvt_pk_bf16(v0[2], v0[3]); w.z = cvt_pk_bf16(v1[0], v1[1]); w.w = cvt_pk_bf16(v1[2], v1[3]);
                *(u32x4*)(rowp + bj * HALF) = w; } }
    }
};
__device__ __forceinline__ float sig_ratio(float a, float b) { return (1.f + fexp2(-LOG2E * b)) * frcp(1.f + fexp2(-LOG2E * a)); }
struct EpiBranchCat {
    static constexpr bool PERM = true, MID = true; static constexpr int CLKID = 0; static constexpr int NST = 8;
    unsigned char* MG; const unsigned char* G8;
    __device__ __forceinline__ void mid(f32x4 (&acc)[2][2][4][2], const Unit& u, int wr, int wc, int fr, int fq, int seg) const {
        const int row0 = u.pm * BM + wr * 64 + fr, col0 = u.pn * BM + wc * 32 + 8 * fq;
#pragma unroll
        for (int ai = 0; ai < 2; ++ai) {
            u32x2 ga[4][2], gb[4][2];
#pragma unroll
            for (int m = 0; m < 4; ++m) { const size_t row = (size_t)(row0 + ai * HALF + m * 16);
#pragma unroll
                for (int bj = 0; bj < 2; ++bj) { const unsigned char* gp = G8 + row * 3072 + seg * 1024 + col0 + bj * HALF; ga[m][bj] = *(const u32x2*)gp; gb[m][bj] = *(const u32x2*)(gp + 1024); } }
#pragma unroll
            for (int m = 0; m < 4; ++m)
#pragma unroll
                for (int bj = 0; bj < 2; ++bj) { float a[8], b[8]; fp8x8_f32(ga[m][bj], a); fp8x8_f32(gb[m][bj], b); f32x4& v0 = acc[ai][bj][m][0]; f32x4& v1 = acc[ai][bj][m][1];
#pragma unroll
                    for (int q = 0; q < 4; ++q) { v0[q] *= sig_ratio(a[q], b[q]); v1[q] *= sig_ratio(a[4 + q], b[4 + q]); } }
        }
    }
    __device__ __forceinline__ void operator()(const f32x4 (&acc)[2][2][4][2], const Unit& u, int wr, int wc, int fr, int fq) const {
        const int row0 = u.pm * BM + wr * 64 + fr, col0 = u.pn * BM + wc * 32 + 8 * fq;
#pragma unroll
        for (int ai = 0; ai < 2; ++ai) {
            u32x2 gq[4][2];
#pragma unroll
            for (int m = 0; m < 4; ++m) { const size_t row = (size_t)(row0 + ai * HALF + m * 16);
#pragma unroll
                for (int bj = 0; bj < 2; ++bj) gq[m][bj] = *(const u32x2*)(G8 + row * 3072 + 2 * 1024 + col0 + bj * HALF); }
#pragma unroll
            for (int m = 0; m < 4; ++m) { const size_t row = (size_t)(row0 + ai * HALF + m * 16);
#pragma unroll
                for (int bj = 0; bj < 2; ++bj) { float g[8]; fp8x8_f32(gq[m][bj], g); f32x4 v0 = acc[ai][bj][m][0], v1 = acc[ai][bj][m][1];
#pragma unroll
                    for (int q = 0; q < 4; ++q) { v0[q] *= F8_MG2 * fsigmoid(g[q]); v1[q] *= F8_MG2 * fsigmoid(g[4 + q]); }
                    *(u32x2*)(MG + row * 1024 + col0 + bj * HALF) = (u32x2){pk4_fp8(v0[0], v0[1], v0[2], v0[3]), pk4_fp8(v1[0], v1[1], v1[2], v1[3])}; } }
        }
    }
};
template <bool XBF> struct EpiWout {
    static constexpr bool PERM = true; static constexpr int CLKID = 2; static constexpr int NST = 8;
    bf16_t* Z; const void* XR; const float* gate; float asc;
    __device__ __forceinline__ void operator()(const f32x4 (&acc)[2][2][4][2], const Unit& u, int wr, int wc, int fr, int fq) const {
        const int row0 = u.pm * BM + wr * 64 + fr, col0 = u.pn * BM + wc * 32 + 8 * fq;
        const int b = (u.pm * BM) >> 12;
        f32x4 gv[2][2];
#pragma unroll
        for (int bj = 0; bj < 2; ++bj)
#pragma unroll
            for (int n = 0; n < 2; ++n) gv[bj][n] = (*(const f32x4*)(gate + (size_t)b * 3072 + col0 + bj * HALF + 4 * n) + 1.0f) * asc;
#pragma unroll
        for (int ai = 0; ai < 2; ++ai) {
            f32x4 xr[4][2][2];
#pragma unroll
            for (int m = 0; m < 4; ++m) { const size_t ro = (size_t)(row0 + ai * HALF + m * 16) * 1024 + col0;
#pragma unroll
                for (int bj = 0; bj < 2; ++bj) {
                    if (XBF) { const u32x4 q = *(const u32x4*)((const bf16_t*)XR + ro + bj * HALF);
                        xr[m][bj][0] = (f32x4){bflo(q.x), bfhi(q.x), bflo(q.y), bfhi(q.y)}; xr[m][bj][1] = (f32x4){bflo(q.z), bfhi(q.z), bflo(q.w), bfhi(q.w)}; }
                    else { xr[m][bj][0] = *(const f32x4*)((const float*)XR + ro + bj * HALF); xr[m][bj][1] = *(const f32x4*)((const float*)XR + ro + bj * HALF + 4); } } }
            asm volatile("" ::: "memory");
#pragma unroll
            for (int m = 0; m < 4; ++m) { const size_t ro = (size_t)(row0 + ai * HALF + m * 16) * 1024 + col0;
#pragma unroll
                for (int bj = 0; bj < 2; ++bj) { const f32x4 v0 = xr[m][bj][0] * DN_ALPHA + gv[bj][0] * acc[ai][bj][m][0], v1 = xr[m][bj][1] * DN_ALPHA + gv[bj][1] * acc[ai][bj][m][1];
                    u32x4 w; w.x = cvt_pk_bf16(v0[0], v0[1]); w.y = cvt_pk_bf16(v0[2], v0[3]); w.z = cvt_pk_bf16(v1[0], v1[1]); w.w = cvt_pk_bf16(v1[2], v1[3]);
                    *(u32x4*)(Z + ro + bj * HALF) = w; } }
            asm volatile("" ::: "memory");
        }
    }
};
__device__ __forceinline__ float swiglu(float g, float u) { const float gg = __builtin_amdgcn_fmed3f(g, -__builtin_inff(), 7.f), uu = __builtin_amdgcn_fmed3f(u, -7.f, 7.f); return (uu + 1.f) * gg * fsigmoid(1.702f * gg); }
struct EpiMoe1 {       static constexpr int CLKID = 1; static constexpr int NST = 16;
    static constexpr bool PERM = true;
    unsigned char* O; const float* bias;
    __device__ __forceinline__ void operator()(const f32x4 (&acc)[2][2][4][2], const Unit& u, int wr, int wc, int fr, int fq) const {
        const int row0 = u.pm * BM + wr * 64 + fr; const int e = u.pn >> 3, n8 = u.pn & 7; const int cg0 = n8 * BM + wc * 32 + 8 * fq;
        constexpr float isc = 1.f / (F8_H * F8_WGU);
        f32x4 bv[2][2];
#pragma unroll
        for (int bj = 0; bj < 2; ++bj)
#pragma unroll
            for (int n = 0; n < 2; ++n) bv[bj][n] = *(const f32x4*)(bias + (size_t)e * 2048 + cg0 + bj * HALF + 4 * n);
        EPI_LOOP_AI_M { unsigned char* rowp = O + (size_t)(row0 + ai * HALF + m * 16) * 1024 + (cg0 >> 1);
#pragma unroll
            for (int bj = 0; bj < 2; ++bj) { const f32x4 v0 = acc[ai][bj][m][0] * isc + bv[bj][0], v1 = acc[ai][bj][m][1] * isc + bv[bj][1];
                *(unsigned*)(rowp + bj * (HALF / 2)) = pk4_fp8(F8_ACT * swiglu(v0[0], v0[1]), F8_ACT * swiglu(v0[2], v0[3]), F8_ACT * swiglu(v1[0], v1[1]), F8_ACT * swiglu(v1[2], v1[3])); } }
    }
};
struct EpiMoe2 {
    static constexpr bool PERM = true; static constexpr int CLKID = 0; static constexpr int NST = 16;
    unsigned char* O; const float* bias;
    __device__ __forceinline__ void operator()(const f32x4 (&acc)[2][2][4][2], const Unit& u, int wr, int wc, int fr, int fq) const {
        const int row0 = u.pm * BM + wr * 64 + fr; const int e = u.pn >> 2, n4 = u.pn & 3; const int c0 = n4 * BM + wc * 32 + 8 * fq;
        constexpr float isc = F8_Y / (F8_ACT * F8_WDN);
        f32x4 bv[2][2];
#pragma unroll
        for (int bj = 0; bj < 2; ++bj)
#pragma unroll
            for (int n = 0; n < 2; ++n) bv[bj][n] = *(const f32x4*)(bias + (size_t)e * 1024 + c0 + bj * HALF + 4 * n) * F8_Y;
        EPI_LOOP_AI_M { unsigned char* rowp = O + (size_t)(row0 + ai * HALF + m * 16) * 1024 + c0;
#pragma unroll
            for (int bj = 0; bj < 2; ++bj) { const f32x4 v0 = acc[ai][bj][m][0] * isc + bv[bj][0], v1 = acc[ai][bj][m][1] * isc + bv[bj][1];
                *(u32x2*)(rowp + bj * HALF) = (u32x2){pk4_fp8(v0[0], v0[1], v0[2], v0[3]), pk4_fp8(v1[0], v1[1], v1[2], v1[3])}; } }
    }
};

__device__ __forceinline__ unsigned stage_voff(int tid, int i, int ld, bool perm) {
    int t = tid; asm volatile("" : "+v"(t));
    int R, C; stage_rc(t * 16 + i * 8192, R, C); const int Rb = perm ? ((R & ~31) + perm32(R & 31)) : R;
    return (unsigned)(Rb * ld + C) * 2u;
}
template <class T, class = void> struct has_mid { static constexpr bool value = false; };
template <class T> struct has_mid<T, decltype((void)T::MID)> { static constexpr bool value = T::MID; };
template <class Epi, class Sched, bool FP8 = false>
__device__ __forceinline__ void gemm_phase(LAS unsigned char* lds, const Gemm g, const Sched& S, const Epi& E, int wave_s) {
    const int tid = fresh_tid(wave_s), wid = wave_s, lane = tid & 63, wr = wid >> 2, wc = wid & 3, fr = lane & 15, fq = lane >> 4;
    const int K = g.K, nt = K / BK;
    unsigned voffA[2], voffB[2];
#pragma unroll
    for (int i = 0; i < 2; ++i) { int R, C; stage_rc(tid * 16 + i * 8192, R, C); const int Rb = Epi::PERM ? ((R & ~31) + perm32(R & 31)) : R;
        voffA[i] = (unsigned)(R * g.lda + C) * 2u; voffB[i] = (unsigned)(Rb * g.ldb + C) * 2u; }
    const size_t kstepA = (size_t)g.kstepA, kstepB = (size_t)(BK * 2);
    const size_t hstepA = (size_t)HALF * g.lda * 2, hstepB = (size_t)HALF * g.ldb * 2;
    const unsigned ldsw = (unsigned)wid * 1024u;
    const int aoff = lds_byte(wr * 64 + fr, fq * 8), boff = lds_byte(wc * 32 + fr, fq * 8);
#define PG8_SA(b, h) (((b) * 2 + (h)) * HTB)
#define PG8_SB(b, h) ((4 + (b) * 2 + (h)) * HTB)
#define PG8_VOFF(voff, _i) ((FP8 && F8_RECOMPUTE) ? stage_voff(tid, _i, (voff) == voffA ? g.lda : g.ldb, (voff) == voffB && Epi::PERM) : (voff)[_i])
#define PG8_STAGE(bufoff, gbase, voff) do { const char* _gb = (const char*)(gbase); asm volatile("" : "+s"(_gb));   \
        _Pragma("unroll") for (int _i = 0; _i < 2; ++_i) { unsigned _vo = PG8_VOFF(voff, _i); asm volatile("" : "+v"(_vo));   \
        __builtin_amdgcn_global_load_lds((const unsigned*)(_gb + _vo), (LAS unsigned*)(lds + (bufoff) + ldsw + _i * 8192), 16, 0, 0); } } while (0)
    const LAS unsigned char* aB = lds + aoff; asm volatile("" : "+v"(aB));
    const LAS unsigned char* bB = lds + 4 * HTB + boff; asm volatile("" : "+v"(bB));
#define PG8_RDA(off) (*(const LAS v4i_t*)(aB + (off)))
#define PG8_RDB(off) (*(const LAS v4i_t*)(bB + (off)))
#define PG8_LDA(dst, b, h) do { _Pragma("unroll") for (int m = 0; m < 4; ++m) dst[m] = __builtin_shufflevector(PG8_RDA(((b) * 2 + (h)) * HTB + m * 2048), PG8_RDA(((b) * 2 + (h)) * HTB + m * 2048 + 1024), 0, 1, 2, 3, 4, 5, 6, 7); } while (0)
#define PG8_LDB(dst, b, h) do { _Pragma("unroll") for (int n = 0; n < 2; ++n) dst[n] = __builtin_shufflevector(PG8_RDB(((b) * 2 + (h)) * HTB + n * 2048), PG8_RDB(((b) * 2 + (h)) * HTB + n * 2048 + 1024), 0, 1, 2, 3, 4, 5, 6, 7); } while (0)
#define PG8_LO(x) __builtin_bit_cast(bf16x8, __builtin_shufflevector(x, x, 0, 1, 2, 3))
#define PG8_HI(x) __builtin_bit_cast(bf16x8, __builtin_shufflevector(x, x, 4, 5, 6, 7))
#define PG8_MMA(ai, bj, At, Bt) do { __builtin_amdgcn_s_setprio(1); _Pragma("unroll") for (int m = 0; m < 4; ++m) _Pragma("unroll") for (int n = 0; n < 2; ++n) { \
        if (FP8) acc[ai][bj][m][n] = __builtin_amdgcn_mfma_scale_f32_16x16x128_f8f6f4(Bt[n], At[m], acc[ai][bj][m][n], 0, 0, 0, 0, 0, 0); \
        else { acc[ai][bj][m][n] = __builtin_amdgcn_mfma_f32_16x16x32_bf16(PG8_LO(Bt[n]), PG8_LO(At[m]), acc[ai][bj][m][n], 0, 0, 0); \
               acc[ai][bj][m][n] = __builtin_amdgcn_mfma_f32_16x16x32_bf16(PG8_HI(Bt[n]), PG8_HI(At[m]), acc[ai][bj][m][n], 0, 0, 0); } } \
        __builtin_amdgcn_s_setprio(0); } while (0)
#define PG8_WAIT_V(n) asm volatile("s_waitcnt vmcnt(" #n ")" ::: "memory")
#define PG8_WAIT_L(n) asm volatile("s_waitcnt lgkmcnt(" #n ")" ::: "memory")
#define PG8_WAIT_V6R do { if (relax) asm volatile("s_waitcnt vmcnt(%0)" :: "n"(6 + Epi::NST) : "memory"); else PG8_WAIT_V(6); } while (0)
#define PG8_BAR __builtin_amdgcn_s_barrier()
#define PG8_SCHED __builtin_amdgcn_sched_barrier(0)
    Unit cur, nxt; int ui = 0; unsigned long long clk_sum = 0; unsigned clk_n = 0;
    if (!S.next(0, cur)) return;
    if (STAGGER_TICKS > 0 && ((blockIdx.x >> 3) & 1)) {
        const unsigned long long r0 = __builtin_amdgcn_s_memrealtime(); while (__builtin_amdgcn_s_memrealtime() - r0 < (unsigned long long)STAGGER_TICKS) __builtin_amdgcn_s_sleep(4); }
    f32x4 acc[2][2][4][2];
#pragma unroll
    for (int a = 0; a < 2; ++a)
#pragma unroll
        for (int b = 0; b < 2; ++b)
#pragma unroll
            for (int m = 0; m < 4; ++m)
#pragma unroll
                for (int n = 0; n < 2; ++n) acc[a][b][m][n] = (f32x4){0.f, 0.f, 0.f, 0.f};
    v8i_t At[4], B0[2], B1[2];
    const char* cA = S.a_ptr(g, cur); const char* cB = S.b_ptr(g, cur);
    PG8_STAGE(PG8_SB(0, 0), cB, voffB); PG8_STAGE(PG8_SA(0, 0), cA, voffA); PG8_STAGE(PG8_SB(0, 1), cB + hstepB, voffB); PG8_STAGE(PG8_SA(0, 1), cA + hstepA, voffA);
    if (wr == 1) PG8_BAR;
    PG8_WAIT_V(4); PG8_BAR;
    PG8_STAGE(PG8_SB(1, 0), cB + kstepB, voffB); PG8_STAGE(PG8_SA(1, 0), cA + kstepA, voffA); PG8_STAGE(PG8_SB(1, 1), cB + hstepB + kstepB, voffB);
    PG8_WAIT_V(6); PG8_BAR;
    for (;;) {
        const bool has_next = S.next(ui + 1, nxt);
        const char* nA = has_next ? S.a_ptr(g, nxt) : cA; const char* nB = has_next ? S.b_ptr(g, nxt) : cB;
        unsigned long long clk0 = 0;
        if (PROBE_CLK != 0 && Epi::CLKID == PROBE_CLK && blockIdx.x == 0) clk0 = __builtin_readcyclecounter();
        constexpr bool KDUP = (PROBE_KL == (FP8 ? 1 : 2)) || (PROBE_KL == (FP8 ? 3 : 4) && Epi::CLKID == 1) || (PROBE_KL == 5 && Epi::CLKID == 1);
        constexpr bool KFIX = (PROBE_KL == (FP8 ? 3 : 4)) && Epi::CLKID == 1;
#pragma unroll 1
        for (int krep = 0; krep < (KDUP ? 2 : 1); ++krep) {
        const bool kfinal = (krep == (KDUP ? 1 : 0));
        const char* kA = (KFIX && !kfinal) ? (const char*)g.A : cA; const char* kB = (KFIX && !kfinal) ? (const char*)g.Bt : cB;
        if (krep) {
#pragma unroll
            for (int a = 0; a < 2; ++a)
#pragma unroll
                for (int b = 0; b < 2; ++b)
#pragma unroll
                    for (int m = 0; m < 4; ++m)
#pragma unroll
                        for (int n = 0; n < 2; ++n) acc[a][b][m][n] *= 0.f;
        }
#pragma unroll 1
        for (int t = 0; t < nt; t += 2) {
            if constexpr (has_mid<Epi>::value) { if (t == 4 || t == 8) { const int tz = fresh_tid(wave_s), ln = tz & 63; E.mid(acc, cur, wave_s >> 2, wave_s & 3, ln & 15, ln >> 4, (t >> 2) - 1); } }
            const bool last = (t == nt - 2);
            const bool relax = !KDUP && (t == 0) && (ui > 0);
            const char* a1 = kA + (size_t)(t + 1) * kstepA;
            const char* a2 = last ? (kfinal ? nA : cA) : kA + (size_t)(t + 2) * kstepA; const char* b2 = last ? (kfinal ? nB : cB) : kB + (size_t)(t + 2) * kstepB;
            const char* a3 = a2 + kstepA; const char* b3 = b2 + kstepB;
            PG8_LDB(B0, 0, 0); PG8_SCHED; PG8_LDA(At, 0, 0); if (!relax) PG8_STAGE(PG8_SA(1, 1), a1 + hstepA, voffA);
            PG8_WAIT_L(8); PG8_BAR; PG8_WAIT_L(0); PG8_MMA(0, 0, At, B0); PG8_BAR; PG8_SCHED;
            PG8_LDB(B1, 0, 1); PG8_STAGE(PG8_SB(0, 0), b2, voffB);
            PG8_BAR; PG8_WAIT_L(0); PG8_MMA(0, 1, At, B1); PG8_BAR;
            PG8_LDA(At, 0, 1); PG8_STAGE(PG8_SA(0, 0), a2, voffA);
            PG8_BAR; PG8_WAIT_L(0); PG8_MMA(1, 0, At, B0); PG8_BAR; PG8_SCHED;
            PG8_STAGE(PG8_SB(0, 1), b2 + hstepB, voffB);
            PG8_WAIT_V6R; PG8_BAR; PG8_MMA(1, 1, At, B1); PG8_BAR;
            PG8_LDB(B0, 1, 0); PG8_SCHED; PG8_LDA(At, 1, 0); PG8_STAGE(PG8_SA(0, 1), a2 + hstepA, voffA);
            PG8_WAIT_L(8); PG8_BAR; PG8_WAIT_L(0); PG8_MMA(0, 0, At, B0); PG8_BAR; PG8_SCHED;
            PG8_LDB(B1, 1, 1); PG8_STAGE(PG8_SB(1, 0), b3, voffB);
            PG8_BAR; PG8_WAIT_L(0); PG8_MMA(0, 1, At, B1); PG8_BAR;
            PG8_LDA(At, 1, 1); PG8_STAGE(PG8_SA(1, 0), a3, voffA);
            PG8_BAR; PG8_WAIT_L(0); PG8_MMA(1, 0, At, B0); PG8_BAR; PG8_SCHED;
            PG8_STAGE(PG8_SB(1, 1), b3 + hstepB, voffB);
            PG8_WAIT_V(6); PG8_BAR; PG8_MMA(1, 1, At, B1); PG8_BAR;
        }
        }
        if (PROBE_CLK != 0 && Epi::CLKID == PROBE_CLK && blockIdx.x == 0) { clk_sum += __builtin_readcyclecounter() - clk0; clk_n += (unsigned)nt; }
        if (!KDUP && has_next) { PG8_STAGE(PG8_SA(1, 1), nA + kstepA + hstepA, voffA); asm volatile("" ::: "memory"); PG8_SCHED; }
        { const int tz = fresh_tid(wave_s), ln = tz & 63; E(acc, cur, wave_s >> 2, wave_s & 3, ln & 15, ln >> 4); }
        if (PROBE_EPI == (FP8 ? 1 : 2)) { asm volatile("" ::: "memory"); const int tz = fresh_tid(wave_s), ln = tz & 63; E(acc, cur, wave_s >> 2, wave_s & 3, ln & 15, ln >> 4); }
        if (!has_next) break;
#pragma unroll
        for (int a = 0; a < 2; ++a)
#pragma unroll
            for (int b = 0; b < 2; ++b)
#pragma unroll
                for (int m = 0; m < 4; ++m)
#pragma unroll
                    for (int n = 0; n < 2; ++n) acc[a][b][m][n] = (f32x4){0.f, 0.f, 0.f, 0.f};
        cur = nxt; cA = nA; cB = nB; ++ui;
    }
    PG8_WAIT_V(0);
    if (wr == 0) PG8_BAR;
    PG8_BAR;
    if (PROBE_CLK != 0 && Epi::CLKID == PROBE_CLK && blockIdx.x == 0) {
        const unsigned long long ticks = (clk_sum / (unsigned long long)(clk_n ? clk_n : 1u)) * 10ull;
        const unsigned long long r0 = __builtin_amdgcn_s_memrealtime(); while (__builtin_amdgcn_s_memrealtime() - r0 < ticks) __builtin_amdgcn_s_sleep(8);
    }
#undef PG8_SA
#undef PG8_SB
#undef PG8_STAGE
#undef PG8_VOFF
#undef PG8_LDA
#undef PG8_LDB
#undef PG8_MMA
#undef PG8_LO
#undef PG8_HI
#undef PG8_RDA
#undef PG8_RDB
#undef PG8_WAIT_V
#undef PG8_WAIT_V6R
#undef PG8_WAIT_L
#undef PG8_BAR
#undef PG8_SCHED
}
}

struct Frame {
    LAS unsigned char* lds;
    volatile LAS unsigned* MISC;
    unsigned* ctl;
    unsigned char* ws; unsigned char* ws0;
    const float* const* in;
    float* out;
    int tid, lane, wave, G, gw, NGW, wave0;
};
__device__ __forceinline__ void refresh(Frame& F) {
    unsigned ones = ~0u; asm volatile("" : "+s"(ones));
    int ln = (int)__builtin_amdgcn_mbcnt_hi(ones, __builtin_amdgcn_mbcnt_lo(ones, 0u)); asm volatile("" : "+v"(ln));
    int wv = F.wave0; asm volatile("" : "+s"(wv));
    F.lane = ln; F.wave = wv; F.tid = wv * 64 + ln; F.gw = blockIdx.x * 8 + wv;
    GAS unsigned char* w = (GAS unsigned char*)F.ws0; asm volatile("" : "+s"(w)); F.ws = (unsigned char*)w;
}

__constant__ unsigned char kBucket[128] = {0, 1, 2, 3, 4, 5, 6, 7, 8, 9, 10, 11, 12, 13, 14, 15, 16, 16, 16, 17, 17, 18, 18, 18, 19, 19, 19, 20, 20, 20, 20, 21, 21, 21, 21, 22, 22, 22, 22, 22, 23, 23, 23, 23, 23, 23, 24, 24, 24, 24, 24, 24, 25, 25, 25, 25, 25, 25, 25, 26, 26, 26, 26, 26, 26, 26, 26, 27, 27, 27, 27, 27, 27, 27, 27, 27, 27, 28, 28, 28, 28, 28, 28, 28, 28, 28, 28, 29, 29, 29, 29, 29, 29, 29, 29, 29, 29, 29, 29, 30, 30, 30, 30, 30, 30, 30, 30, 30, 30, 30, 30, 30, 30, 31, 31, 31, 31, 31, 31, 31, 31, 31, 31, 31, 31, 31, 31, 31};

__device__ __forceinline__ int win_src(int n, float& sc) {
    sc = 1.f;
    if (n < 544) { if (n < 256) sc = QS; else if (n >= 384 && n < 512) sc = IQS; return n; }
    if (n < 548) { sc = 0.5f; return n; }
    if (n < 560) return 1188 + (n - 548);
    if (n < 576) return -1;
    if (n < 832) { sc = QS; return 548 + (n - 576); }
    if (n < 1216) return 804 + (n - 832);
    if (n < 1728) { sc = QS; return 1200 + (n - 1216); }
    if (n < 2240) return 1712 + (n - 1728);
    if (n < 2752) return 2224 + (n - 2240);
    if (n < 5824) return 2736 + (n - 2752);
    return -1;
}
template <bool WIN>
__device__ __forceinline__ void p0_transpose_item(const float* W, int K, int Nsrc, int Ndst, bf16_t* WT, LAS float* scr, int item, int lane, int ldt = 0) {
    if (ldt == 0) ldt = K;
    const int nblk = Ndst / 32, kb = item / nblk, nb = item % nblk, k0 = 64 * kb, n0 = 32 * nb;
    if (WIN) { float sc = 1.f; const int src = win_src(n0 + (lane & 31), sc);
#pragma unroll 8
        for (int i = 0; i < 32; ++i) { const int kk = 2 * i + (lane >> 5); scr[kk * 33 + (lane & 31)] = (src >= 0) ? W[(size_t)(k0 + kk) * Nsrc + src] * sc : 0.f; }
    } else {
        f32x4 v[8];
#pragma unroll
        for (int i = 0; i < 8; ++i) v[i] = *(const f32x4*)(W + (size_t)(k0 + 8 * i + (lane >> 3)) * Nsrc + n0 + (lane & 7) * 4);
#pragma unroll
        for (int i = 0; i < 8; ++i) { LAS float* q = scr + (8 * i + (lane >> 3)) * 33 + (lane & 7) * 4; q[0] = v[i].x; q[1] = v[i].y; q[2] = v[i].z; q[3] = v[i].w; }
    }
    LDS_WAIT(); asm volatile("" ::: "memory");
    const int c = lane & 7;
#pragma unroll
    for (int j = 0; j < 4; ++j) { const int n = (lane >> 3) + 8 * j; const LAS float* s = scr + (8 * c) * 33 + n;
        u32x4 o; o.x = pk2(s[0 * 33], s[1 * 33]); o.y = pk2(s[2 * 33], s[3 * 33]); o.z = pk2(s[4 * 33], s[5 * 33]); o.w = pk2(s[6 * 33], s[7 * 33]);
        *(u32x4*)(WT + (size_t)(n0 + n) * ldt + k0 + 8 * c) = o; }
    LDS_WAIT(); asm volatile("" ::: "memory");
}

template <bool WIN>
__device__ __forceinline__ void p0_transpose_item_f8(const float* W, int K, int N, unsigned char* WT, float sc, LAS float* scr, int item, int lane, int Nsrc = 0, int ncol0 = 0) {
    const int nblk = N / 32, kb = item / nblk, nb = item % nblk, k0 = 64 * kb, n0 = 32 * nb;
    if (WIN) { float s1 = 1.f; const int src = win_src(ncol0 + n0 + (lane & 31), s1);
#pragma unroll 8
        for (int i = 0; i < 32; ++i) { const int kk = 2 * i + (lane >> 5); scr[kk * 33 + (lane & 31)] = (src >= 0) ? W[(size_t)(k0 + kk) * Nsrc + src] * (s1 * sc) : 0.f; }
    } else
    { f32x4 v[8];
#pragma unroll
      for (int i = 0; i < 8; ++i) v[i] = *(const f32x4*)(W + (size_t)(k0 + 8 * i + (lane >> 3)) * N + n0 + (lane & 7) * 4);
#pragma unroll
      for (int i = 0; i < 8; ++i) { LAS float* q = scr + (8 * i + (lane >> 3)) * 33 + (lane & 7) * 4; q[0] = v[i].x * sc; q[1] = v[i].y * sc; q[2] = v[i].z * sc; q[3] = v[i].w * sc; } }
    LDS_WAIT(); asm volatile("" ::: "memory");
    const int c = lane & 3;
#pragma unroll
    for (int j = 0; j < 2; ++j) { const int n = (lane >> 2) + 16 * j; const LAS float* q = scr + (16 * c) * 33 + n;
        u32x4 o; o.x = pk4_fp8(q[0 * 33], q[1 * 33], q[2 * 33], q[3 * 33]); o.y = pk4_fp8(q[4 * 33], q[5 * 33], q[6 * 33], q[7 * 33]);
        o.z = pk4_fp8(q[8 * 33], q[9 * 33], q[10 * 33], q[11 * 33]); o.w = pk4_fp8(q[12 * 33], q[13 * 33], q[14 * 33], q[15 * 33]);
        *(u32x4*)(WT + (size_t)(n0 + n) * K + k0 + 16 * c) = o; }
    LDS_WAIT(); asm volatile("" ::: "memory");
}
__device__ __forceinline__ void phase_prologue(Frame& F) {
    const float* const* in = F.in;
    const int lane = F.lane;
    LAS float* sc = (LAS float*)F.lds;
    {
        float cv[32];
#pragma unroll
        for (int q = 0; q < 32; ++q) cv[q] = in[1][F.tid + 512 * q];
#pragma unroll
        for (int q = 0; q < 32; ++q) { const int i = F.tid + 512 * q, bq = i >> 10, k = i & 1023; sc[k * 16 + bq] = cv[q] * fsigmoid(cv[q]); }
    }
    if (F.tid == 0) F.MISC[8] = 0u;
    __syncthreads();
    if (F.wave < 3) {
        const int u = F.wave * 256 + (int)blockIdx.x; const int which = u / 192, cb = u % 192, layer = which >> 1, col = cb * 16 + (lane & 15), kq = lane >> 4;
        const float* W = (which & 1 ? in[17] : in[3]) + (size_t)layer * 1024 * 3072 + col;
        const float* Bv = (which & 1 ? in[18] : in[4]) + (size_t)layer * 3072;
        float acc[16];
#pragma unroll
        for (int q = 0; q < 16; ++q) acc[q] = 0.f;
#pragma unroll 1
        for (int k0 = kq * 256; k0 < kq * 256 + 256; k0 += 16) { float w[16];
#pragma unroll
            for (int i = 0; i < 16; ++i) w[i] = W[(size_t)(k0 + i) * 3072];
#pragma unroll
            for (int i = 0; i < 16; ++i) { const LAS f32x4* sp = (const LAS f32x4*)(sc + (k0 + i) * 16); const f32x4 s0 = sp[0], s1 = sp[1], s2 = sp[2], s3 = sp[3];
#pragma unroll
                for (int q = 0; q < 4; ++q) { acc[q] += s0[q] * w[i]; acc[4 + q] += s1[q] * w[i]; acc[8 + q] += s2[q] * w[i]; acc[12 + q] += s3[q] * w[i]; } } }
#pragma unroll
        for (int q = 0; q < 16; ++q) { acc[q] += shx_f(acc[q], 16, lane); acc[q] += shx_f(acc[q], 32, lane); }
        float* mod = (float*)(F.ws + WS_MOD) + (size_t)which * 16 * 3072;
        const float bb = Bv[col];
#pragma unroll
        for (int q = 0; q < 4; ++q) { const float v = kq == 0 ? acc[q] : kq == 1 ? acc[4 + q] : kq == 2 ? acc[8 + q] : acc[12 + q]; mod[(size_t)(4 * kq + q) * 3072 + col] = v + bb; }
    } else if (F.wave == 3) {
        if (blockIdx.x < 64) {
            const int u = (int)blockIdx.x, m = u >> 4, n = (u & 15) * 16 + (lane & 15), rq = lane >> 4;
            const float* P = in[6] + (size_t)m * 2048; const float* W = in[7] + (size_t)m * 2048 * 256 + n;
            float a = 0.f;
#pragma unroll 1
            for (int r0 = rq * 512; r0 < rq * 512 + 512; r0 += 16) { float w[16], pv[16];
#pragma unroll
                for (int i = 0; i < 16; ++i) { w[i] = W[(size_t)(r0 + i) * 256]; pv[i] = P[r0 + i]; }
#pragma unroll
                for (int i = 0; i < 16; ++i) a += pv[i] * w[i]; }
            a += shx_f(a, 16, lane); a += shx_f(a, 32, lane);
            if (rq == 0) ((float*)(F.ws + WS_BIAS1))[m * 256 + n] = a;
        } else if (blockIdx.x == 64) {
            float* lut = (float*)(F.ws + WS_LUT);
            for (int i = lane; i < 12 * 128; i += 64) { const int h = i >> 7, d = i & 127; lut[i] = (in[2][kBucket[d] * 12 + h] - in[2][31 * 12 + h]) * LOG2E; }
            for (int l = 0; l < 2; ++l) { const float* dl = in[9] + l * 256;
                const float s1 = wave_sum(dl[lane] * dl[64 + lane], lane), s2 = wave_sum(dl[128 + lane] * dl[192 + lane], lane);
                const float lam_init = 0.8f - 0.6f * __expf(-0.3f * (float)l);
                if (lane == 0) ((float*)(F.ws + WS_LAM))[l] = __expf(s1) - __expf(s2) + lam_init; }
        }
    }
    LAS float* scr = (LAS float*)(F.lds + 65536 + F.wave * 8448);
    constexpr int I_WIN = 16 * (N_BF / 32), I_WMG = 16 * (N_F8 / 32);
    constexpr int I_BA = 4 * 32, I_BC = 8 * 32, I_WO = 16 * 32, I_W1 = 32 * 8, I_W2 = 4 * 2;
    constexpr int I_GU = 16 * 64, I_DN = 16 * 32;
    constexpr int N_GU = 64 * I_GU, N_DN = 64 * I_DN, N_WIN = 2 * I_WIN, N_BA = 2 * I_BA, N_BC = 2 * I_BC, N_WO = 2 * I_WO, N_W1 = 4 * I_W1, N_W2 = 4 * I_W2, N_WMG = 2 * I_WMG;
    constexpr int NITEMS = N_GU + N_DN + N_WIN + N_WMG + 2 * N_BA + N_BC + N_WO + N_W1 + N_W2;
    for (;;) {
        unsigned jq = 0; if (lane == 0) jq = __hip_atomic_fetch_add((LAS unsigned*)(F.lds + LDS_MISC) + 8, 1u, __ATOMIC_RELAXED, __HIP_MEMORY_SCOPE_WORKGROUP);
        const int it = (int)blockIdx.x + 256 * (int)__builtin_amdgcn_readfirstlane(jq); if (it >= NITEMS) break;
        int r = it;
        if (r < N_GU) { const int m = r / I_GU; p0_transpose_item_f8<false>(in[21] + (size_t)m * 1024 * 2048, 1024, 2048, (unsigned char*)(F.ws + WS_WGU_T) + (size_t)m * 2048 * 1024, F8_WGU, scr, r % I_GU, F.lane); continue; } r -= N_GU;
        if (r < N_DN) { const int m = r / I_DN; p0_transpose_item_f8<false>(in[23] + (size_t)m * 1024 * 1024, 1024, 1024, (unsigned char*)(F.ws + WS_WDN_T) + (size_t)m * 1024 * 1024, F8_WDN, scr, r % I_DN, F.lane); continue; } r -= N_DN;
        if (r < N_WIN) { const int m = r / I_WIN; p0_transpose_item<true>(in[5] + (size_t)m * 1024 * D_IN, 1024, D_IN, N_BF, (bf16_t*)(F.ws + WS_WIN_T) + (size_t)m * DP * 1024, scr, r % I_WIN, F.lane); continue; } r -= N_WIN;
        if (r < N_WMG) { const int m = r / I_WMG; p0_transpose_item_f8<true>(in[5] + (size_t)m * 1024 * D_IN, 1024, N_F8, (unsigned char*)(F.ws + WS_WMG8) + (size_t)m * N_F8 * 1024, F8_WIN, scr, r % I_WMG, F.lane, D_IN, C_MG); continue; } r -= N_WMG;
        if (r < N_BA) { const int m = r / I_BA; p0_transpose_item<false>(in[11] + (size_t)m * 256 * 1024, 256, 1024, 1024, (bf16_t*)(F.ws + WS_WBR_T + m * 2 * MiB), scr, r % I_BA, F.lane, 1024); continue; } r -= N_BA;
        if (r < N_BA) { const int m = r / I_BA; p0_transpose_item<false>(in[12] + (size_t)m * 256 * 1024, 256, 1024, 1024, (bf16_t*)(F.ws + WS_WBR_T + m * 2 * MiB) + 256, scr, r % I_BA, F.lane, 1024); continue; } r -= N_BA;
        if (r < N_BC) { const int m = r / I_BC; p0_transpose_item<false>(in[13] + (size_t)m * 512 * 1024, 512, 1024, 1024, (bf16_t*)(F.ws + WS_WBR_T + m * 2 * MiB) + 512, scr, r % I_BC, F.lane, 1024); continue; } r -= N_BC;
        if (r < N_WO) { const int m = r / I_WO; p0_transpose_item_f8<false>(in[14] + (size_t)m * 1024 * 1024, 1024, 1024, (unsigned char*)(F.ws + WS_WOUT_T) + (size_t)m * 1024 * 1024, F8_WO, scr, r % I_WO, F.lane); continue; } r -= N_WO;
        if (r < N_W1) { const int m = r / I_W1; p0_transpose_item<false>(in[7] + (size_t)m * 2048 * 256, 2048, 256, 256, (bf16_t*)(F.ws + WS_W1_T) + (size_t)m * 256 * 2048, scr, r % I_W1, F.lane); continue; } r -= N_W1;
        { const int m = r / I_W2; p0_transpose_item<false>(in[8] + (size_t)m * 256 * 64, 256, 64, 64, (bf16_t*)(F.ws + WS_W2_T) + (size_t)m * 64 * 256, scr, r % I_W2, F.lane); }
    }
}

__device__ __forceinline__ void phase_h0(Frame& F, const float* X, const float* mod, bf16_t* HB, unsigned char* HB8) {
    constexpr int NIT = NTOK / 2048; const int lane = F.lane;
    f32x4 xc[4];
#pragma unroll
    for (int j = 0; j < 4; ++j) xc[j] = ((const f32x4*)(X + (size_t)F.gw * 1024))[lane + 64 * j];
#pragma unroll 1
    for (int it = 0; it < NIT; ++it) { const int row = F.gw + it * 2048, b = row >> 12; const int rown = (it + 1 < NIT) ? row + 2048 : row;
        const f32x4* sh = (const f32x4*)(mod + (size_t)b * 3072) + lane; const f32x4* sc = (const f32x4*)(mod + (size_t)b * 3072 + 1024) + lane;
        f32x4 scv[4], shv[4];
#pragma unroll
        for (int j = 0; j < 4; ++j) { scv[j] = sc[64 * j] + 1.0f; shv[j] = sh[64 * j]; }
        asm volatile("" ::: "memory");
        f32x4 xn[4];
#pragma unroll
        for (int j = 0; j < 4; ++j) xn[j] = ((const f32x4*)(X + (size_t)rown * 1024))[lane + 64 * j];
        u64* o8 = (u64*)(HB + (size_t)row * 1024) + lane; unsigned* q8 = (unsigned*)(HB8 + (size_t)row * 1024) + lane;
#pragma unroll
        for (int j = 0; j < 4; ++j) { const f32x4 v = xc[j] * scv[j] + shv[j]; o8[64 * j] = (u64)pk2(v.x, v.y) | ((u64)pk2(v.z, v.w) << 32);
            q8[64 * j] = pk4_fp8(F8_H * v.x, F8_H * v.y, F8_H * v.z, F8_H * v.w); }
#pragma unroll
        for (int j = 0; j < 4; ++j) xc[j] = xn[j];
    }
}
__device__ __forceinline__ void ln_stats(const f32x4 (&v)[4], float& mean, float& rstd, int lane) {
    float s = 0.f;
#pragma unroll
    for (int j = 0; j < 4; ++j) s += (v[j].x + v[j].y) + (v[j].z + v[j].w);
    mean = wave_sum(s, lane) * (1.f / 1024.f); float s2 = 0.f;
#pragma unroll
    for (int j = 0; j < 4; ++j) { const f32x4 d = v[j] - mean; s2 += (d.x * d.x + d.y * d.y) + (d.z * d.z + d.w * d.w); }
    rstd = 1.f / sqrtf(wave_sum(s2, lane) * (1.f / 1024.f) + LN_EPS);
}

__device__ __forceinline__ void phase_ln1_router(Frame& F, bf16_t* Z, const float* g1, const float* b1, const float* mod, const float* rw, const float* rb, bf16_t* HB, unsigned* cnt) {
    LAS float* rwT = (LAS float*)F.lds;
    for (int i = F.tid; i < 32 * 1024; i += 512) { const int k = i >> 5, e = i & 31; rwT[e * 1024 + k] = rw[i]; }
    __syncthreads();
    const int lane = F.lane, e_l = lane >> 1;
    const float rbias = rb[e_l];
    unsigned slot0 = 0, slot1 = 0; unsigned cnt_local = 0;
    f32x4 gg[4], bb[4];
#pragma unroll
    for (int j = 0; j < 4; ++j) { gg[j] = ((const f32x4*)g1)[lane + 64 * j]; bb[j] = ((const f32x4*)b1)[lane + 64 * j]; }
    constexpr int NIT = NTOK / (2 * 2048);
    u32x2 zq[2][4];
#pragma unroll
    for (int r = 0; r < 2; ++r)
#pragma unroll
        for (int j = 0; j < 4; ++j) zq[r][j] = ((const u32x2*)(Z + (size_t)(F.gw + r * 2048) * 1024))[lane + 64 * j];
#pragma unroll 1
    for (int it = 0; it < NIT; ++it) { const int b = it; const int row0 = F.gw + it * 4096;
        const f32x4* sh = (const f32x4*)(mod + (size_t)b * 3072) + lane; const f32x4* sc = (const f32x4*)(mod + (size_t)b * 3072 + 1024) + lane;
        f32x4 v[2][4];
#pragma unroll
        for (int r = 0; r < 2; ++r)
#pragma unroll
            for (int j = 0; j < 4; ++j) { const u32x2 q = zq[r][j]; v[r][j] = (f32x4){bflo(q.x), bfhi(q.x), bflo(q.y), bfhi(q.y)}; }
        f32x4 scj[4], shj[4];
#pragma unroll
        for (int j = 0; j < 4; ++j) { scj[j] = sc[64 * j] + 1.0f; shj[j] = sh[64 * j]; }
        asm volatile("" ::: "memory");
        if (it + 1 < NIT) {
#pragma unroll
            for (int r = 0; r < 2; ++r)
#pragma unroll
                for (int j = 0; j < 4; ++j) zq[r][j] = ((const u32x2*)(Z + (size_t)(row0 + 4096 + r * 2048) * 1024))[lane + 64 * j];
        }
        f32x4 h[2][4];
#pragma unroll
        for (int r = 0; r < 2; ++r) { const int row = row0 + r * 2048;
            float mean, rstd; ln_stats(v[r], mean, rstd, lane);
            u32x2* zr = (u32x2*)(Z + (size_t)row * 1024) + lane; unsigned* o8 = (unsigned*)((unsigned char*)HB + (size_t)row * 1024) + lane;
#pragma unroll
            for (int j = 0; j < 4; ++j) { const f32x4 xn = (v[r][j] - mean) * rstd * gg[j] + bb[j]; zr[64 * j] = (u32x2){cvt_pk_bf16(xn.x, xn.y), cvt_pk_bf16(xn.z, xn.w)}; h[r][j] = xn * scj[j] + shj[j];
                o8[64 * j] = pk4_fp8(F8_H * h[r][j].x, F8_H * h[r][j].y, F8_H * h[r][j].z, F8_H * h[r][j].w); } }
        f32x2 hp[4][4];
#pragma unroll
        for (int j = 0; j < 4; ++j) { hp[j][0] = (f32x2){h[0][j].x, h[1][j].x}; hp[j][1] = (f32x2){h[0][j].y, h[1][j].y}; hp[j][2] = (f32x2){h[0][j].z, h[1][j].z}; hp[j][3] = (f32x2){h[0][j].w, h[1][j].w}; }
        float a[2][32];
#pragma unroll
        for (int e = 0; e < 32; ++e) { f32x2 s0 = (f32x2){0.f, 0.f}, s1 = s0;
#pragma unroll
            for (int j = 0; j < 4; ++j) { const f32x4 w = *(const LAS f32x4*)(rwT + e * 1024 + 4 * lane + 256 * j);
                s0 += hp[j][0] * (f32x2){w.x, w.x}; s1 += hp[j][1] * (f32x2){w.y, w.y}; s0 += hp[j][2] * (f32x2){w.z, w.z}; s1 += hp[j][3] * (f32x2){w.w, w.w}; }
            s0 += s1; a[0][e] = s0.x; a[1][e] = s0.y; if ((e & 3) == 3) __builtin_amdgcn_sched_barrier(0); }
#pragma unroll
        for (int r = 0; r < 2; ++r) { const int row = row0 + r * 2048; const int i = 2 * it + r;
#pragma unroll
            for (int st = 0; st < 5; ++st) { const int half = 16 >> st, x = 32 >> st; const bool up = (lane & x) != 0;
#pragma unroll
                for (int q = 0; q < half; ++q) { const float send = up ? a[r][q] : a[r][q + half], keep = up ? a[r][q + half] : a[r][q];
                    a[r][q] = keep + (st == 0 ? other32(send, lane) : st == 1 ? shx_f(send, 16, lane) : st == 2 ? dpp_f<0x128>(send) : st == 3 ? dpp_f<0x141>(send) : dpp_f<0x4E>(send)); } }
            float lg = a[r][0] + dpp_f<0xB1>(a[r][0]) + rbias;
            float tv[4]; int te[4];
#pragma unroll
            for (int k = 0; k < 4; ++k) { const float mx = wave_max(lg); const u64 bal = __ballot(lg == mx); const int be = (__ffsll((long long)bal) - 1) >> 1;
                tv[k] = mx; te[k] = be; if (e_l == be) lg = -INFINITY; }
            const float e1 = __expf(tv[1] - tv[0]), e2 = __expf(tv[2] - tv[0]), e3 = __expf(tv[3] - tv[0]); const float inv = 1.f / (1.f + e1 + e2 + e3);
            { *(int4*)((int*)(F.ws + WS_TOKE) + (size_t)row * 4) = make_int4(te[0], te[1], te[2], te[3]);
                *(f32x4*)((float*)(F.ws + WS_TOKW) + (size_t)row * 4) = (f32x4){inv, e1 * inv, e2 * inv, e3 * inv}; }
#pragma unroll
            for (int k = 0; k < 4; ++k) { const int ek = __builtin_amdgcn_readfirstlane(te[k]); const unsigned rk = (unsigned)__builtin_amdgcn_readlane((int)cnt_local, ek);
                if (lane == ek) ++cnt_local;
                const int idx = i * 4 + k; const unsigned val = ((unsigned)ek << 16) | rk;
                if (lane == (idx & 63)) { if (idx < 64) slot0 = val; else slot1 = val; } }
        }
    }
    unsigned base = 0;
    if (lane < 32) base = __hip_atomic_fetch_add(cnt + lane, cnt_local, __ATOMIC_RELAXED, __HIP_MEMORY_SCOPE_AGENT);
#pragma unroll
    for (int s2 = 0; s2 < 2; ++s2) { const unsigned val = s2 ? slot1 : slot0; const int e = (int)(val >> 16); const unsigned pos = (unsigned)bperm_i(e, (int)base) + (val & 0xffffu);
        const int i = (64 * s2 + lane) >> 2, k = lane & 3; const int row = F.gw + (i >> 1) * 4096 + (i & 1) * 2048;
        ((int*)(F.ws + WS_TOKP))[(size_t)row * 4 + k] = (int)pos; }
    __syncthreads();
}

__device__ __forceinline__ void build_pstart(Frame& F, const unsigned* cnt) {
    if (F.wave == 0) { const int lane = F.lane;
        unsigned np = 0; if (lane < 32) np = (__hip_atomic_load(cnt + lane, __ATOMIC_RELAXED, __HIP_MEMORY_SCOPE_AGENT) + 255u) >> 8;
        int inc = (int)np;
#pragma unroll
        for (int o = 1; o < 32; o <<= 1) { const int t = bperm_i((lane - o) & 63, inc); if (lane >= o) inc += t; }
        if (lane < 32) F.MISC[17 + lane] = (unsigned)inc;
        if (lane == 0) F.MISC[16] = 0u; }
    __syncthreads();
}
__device__ __forceinline__ void phase_gather(Frame& F, const unsigned* cnt, const bf16_t* HB, unsigned char* HS) {
    build_pstart(F, cnt);
    const unsigned char* H8 = (const unsigned char*)HB;
    const int lane = F.lane; constexpr int NIT = NTOK / 2048;
    int4 te = *(const int4*)((const int*)(F.ws + WS_TOKE) + (size_t)F.gw * 4), tp = *(const int4*)((const int*)(F.ws + WS_TOKP) + (size_t)F.gw * 4);
    u32x4 v = ((const u32x4*)(H8 + (size_t)F.gw * 1024))[lane];
#pragma unroll 1
    for (int it = 0; it < NIT; ++it) { const int row = F.gw + it * 2048; const int rown = (it + 1 < NIT) ? row + 2048 : row;
        const int4 ten = *(const int4*)((const int*)(F.ws + WS_TOKE) + (size_t)rown * 4), tpn = *(const int4*)((const int*)(F.ws + WS_TOKP) + (size_t)rown * 4);
        const u32x4 vn = ((const u32x4*)(H8 + (size_t)rown * 1024))[lane];
        const int r0 = (int)F.MISC[16 + te.x] * 256 + tp.x, r1 = (int)F.MISC[16 + te.y] * 256 + tp.y, r2 = (int)F.MISC[16 + te.z] * 256 + tp.z, r3 = (int)F.MISC[16 + te.w] * 256 + tp.w;
        *(int4*)((int*)(F.ws + WS_TOKR) + (size_t)row * 4) = make_int4(r0, r1, r2, r3);
        ((u32x4*)(HS + (size_t)r0 * 1024))[lane] = v; ((u32x4*)(HS + (size_t)r1 * 1024))[lane] = v; ((u32x4*)(HS + (size_t)r2 * 1024))[lane] = v; ((u32x4*)(HS + (size_t)r3 * 1024))[lane] = v;
        te = ten; tp = tpn; v = vn;
    }
    if (blockIdx.x < 32) { const int e = blockIdx.x; const int c = (int)__hip_atomic_load(cnt + e, __ATOMIC_RELAXED, __HIP_MEMORY_SCOPE_AGENT);
        const int rbeg = (int)F.MISC[16 + e] * 256 + c, rend = (int)F.MISC[17 + e] * 256;
        for (int r = rbeg + F.wave; r < rend; r += 8) ((u32x4*)(HS + (size_t)r * 1024))[lane] = (u32x4){0u, 0u, 0u, 0u}; }
}
__device__ __forceinline__ void phase_combine(Frame& F, const unsigned char* YS, const bf16_t* X1, const float* modf, const float* g2, const float* b2, float* XO, const float* modn, bf16_t* HB, unsigned char* HB8, bf16_t* X2B) {
    const int lane = F.lane;
    f32x4 gg[4], bb[4];
#pragma unroll
    for (int q = 0; q < 4; ++q) { gg[q] = ((const f32x4*)g2)[128 * (q >> 1) + 2 * lane + (q & 1)]; bb[q] = ((const f32x4*)b2)[128 * (q >> 1) + 2 * lane + (q & 1)]; }
    constexpr int NIT = NTOK / 2048;
    const int* TR = (const int*)(F.ws + WS_TOKR); const float* TW = (const float*)(F.ws + WS_TOKW);
    int4 tr_n = *(const int4*)(TR + (size_t)F.gw * 4); f32x4 tw_n = *(const f32x4*)(TW + (size_t)F.gw * 4);
    u32x2 yq[4][2]; u32x4 xq[2]; f32x4 tw_c = tw_n;
    { const int rr[4] = {tr_n.x, tr_n.y, tr_n.z, tr_n.w};
#pragma unroll
        for (int k = 0; k < 4; ++k)
#pragma unroll
            for (int c = 0; c < 2; ++c) yq[k][c] = __builtin_nontemporal_load((const u32x2*)(YS + (size_t)rr[k] * 1024) + 64 * c + lane);
#pragma unroll
        for (int c = 0; c < 2; ++c) xq[c] = ((const u32x4*)(X1 + (size_t)F.gw * 1024))[64 * c + lane]; }
    tr_n = *(const int4*)(TR + (size_t)(F.gw + 2048) * 4); tw_n = *(const f32x4*)(TW + (size_t)(F.gw + 2048) * 4);
#pragma unroll 1
    for (int it = 0; it < NIT; ++it) { const int row = F.gw + it * 2048; const int b = row >> 12;
        const int rown = (it + 1 < NIT) ? row + 2048 : row, rownn = (it + 2 < NIT) ? row + 4096 : row;
        f32x4 gtv[4], scv[4], shv[4];
#pragma unroll
        for (int q = 0; q < 4; ++q) { gtv[q] = ((const f32x4*)(modf + (size_t)b * 3072 + 2048))[128 * (q >> 1) + 2 * lane + (q & 1)] + 1.0f;
            if (modn) { scv[q] = ((const f32x4*)(modn + (size_t)b * 3072 + 1024))[128 * (q >> 1) + 2 * lane + (q & 1)] + 1.0f; shv[q] = ((const f32x4*)(modn + (size_t)b * 3072))[128 * (q >> 1) + 2 * lane + (q & 1)]; } }
        asm volatile("" ::: "memory");
        u32x2 yn[4][2]; u32x4 xn[2];
        { const int rr[4] = {tr_n.x, tr_n.y, tr_n.z, tr_n.w};
#pragma unroll
            for (int k = 0; k < 4; ++k)
#pragma unroll
                for (int c = 0; c < 2; ++c) yn[k][c] = __builtin_nontemporal_load((const u32x2*)(YS + (size_t)rr[k] * 1024) + 64 * c + lane);
#pragma unroll
            for (int c = 0; c < 2; ++c) xn[c] = ((const u32x4*)(X1 + (size_t)rown * 1024))[64 * c + lane]; }
        const int4 tr_nn = *(const int4*)(TR + (size_t)rownn * 4); const f32x4 tw_nn = *(const f32x4*)(TW + (size_t)rownn * 4);
        const float ww[4] = {tw_c.x * (1.f / F8_Y), tw_c.y * (1.f / F8_Y), tw_c.z * (1.f / F8_Y), tw_c.w * (1.f / F8_Y)};
        f32x4 v[4];
#pragma unroll
        for (int c = 0; c < 2; ++c) { f32x4 y0 = (f32x4){0.f, 0.f, 0.f, 0.f}, y1 = y0;
#pragma unroll
            for (int k = 0; k < 4; ++k) { float f[8]; fp8x8_f32(yq[k][c], f); y0 += (f32x4){f[0], f[1], f[2], f[3]} * ww[k]; y1 += (f32x4){f[4], f[5], f[6], f[7]} * ww[k]; }
            const u32x4 q = xq[c];
            v[2 * c] = (f32x4){bflo(q.x), bfhi(q.x), bflo(q.y), bfhi(q.y)} * DN_ALPHA + gtv[2 * c] * y0;
            v[2 * c + 1] = (f32x4){bflo(q.z), bfhi(q.z), bflo(q.w), bfhi(q.w)} * DN_ALPHA + gtv[2 * c + 1] * y1; }
        float mean, rstd; ln_stats(v, mean, rstd, lane);
        if (modn) {
#pragma unroll
            for (int c = 0; c < 2; ++c) { const f32x4 x0 = (v[2 * c] - mean) * rstd * gg[2 * c] + bb[2 * c], x1 = (v[2 * c + 1] - mean) * rstd * gg[2 * c + 1] + bb[2 * c + 1];
                ((u32x4*)(X2B + (size_t)row * 1024))[64 * c + lane] = (u32x4){cvt_pk_bf16(x0.x, x0.y), cvt_pk_bf16(x0.z, x0.w), cvt_pk_bf16(x1.x, x1.y), cvt_pk_bf16(x1.z, x1.w)};
                const f32x4 h0 = x0 * scv[2 * c] + shv[2 * c], h1 = x1 * scv[2 * c + 1] + shv[2 * c + 1];
                ((u32x4*)(HB + (size_t)row * 1024))[64 * c + lane] = (u32x4){cvt_pk_bf16(h0.x, h0.y), cvt_pk_bf16(h0.z, h0.w), cvt_pk_bf16(h1.x, h1.y), cvt_pk_bf16(h1.z, h1.w)};
                ((u32x2*)(HB8 + (size_t)row * 1024))[64 * c + lane] = (u32x2){pk4_fp8(F8_H * h0.x, F8_H * h0.y, F8_H * h0.z, F8_H * h0.w), pk4_fp8(F8_H * h1.x, F8_H * h1.y, F8_H * h1.z, F8_H * h1.w)}; }
        } else {
#pragma unroll
            for (int q = 0; q < 4; ++q) __builtin_nontemporal_store((v[q] - mean) * rstd * gg[q] + bb[q], (f32x4*)(XO + (size_t)row * 1024) + 128 * (q >> 1) + 2 * lane + (q & 1));
        }
#pragma unroll
        for (int k = 0; k < 4; ++k)
#pragma unroll
            for (int c = 0; c < 2; ++c) yq[k][c] = yn[k][c];
        xq[0] = xn[0]; xq[1] = xn[1]; tw_c = tw_n; tr_n = tr_nn; tw_n = tw_nn;
    }
}

__device__ __forceinline__ unsigned okey16(float v) { unsigned u = __builtin_bit_cast(unsigned, v); u = (u & 0x80000000u) ? ~u : (u | 0x80000000u); return u >> 16; }
__device__ __forceinline__ f32x4 idx_score(const bf16x8 ka, const bf16x8 (&qb)[4], const float (&w4)[4]) {
    f32x4 s = (f32x4){0.f, 0.f, 0.f, 0.f};
#pragma unroll
    for (int h = 0; h < 4; ++h) { const f32x4 c = __builtin_amdgcn_mfma_f32_16x16x32_bf16(ka, qb[h], (f32x4){0.f, 0.f, 0.f, 0.f}, 0, 0, 0);
#pragma unroll
        for (int j = 0; j < 4; ++j) s[j] += w4[h] * __builtin_amdgcn_fmed3f(c[j], 0.f, __builtin_inff()); }
    return s;
}
constexpr int DS_HIST = 32768, HROW = 257;
__device__ __forceinline__ void scan_row(const volatile LAS unsigned* hw, unsigned need, int lane, int& bin, unsigned& above, unsigned& cntb) {
    const unsigned c0 = hw[4 * lane], c1 = hw[4 * lane + 1], c2 = hw[4 * lane + 2], c3 = hw[4 * lane + 3];
    unsigned S = (c0 + c1) + (c2 + c3);
#pragma unroll
    for (int o = 1; o < 64; o <<= 1) { const unsigned t = (unsigned)bperm_i((lane + o) & 63, (int)S); if (lane + o < 64) S += t; }
    const u64 bal = __ballot(S >= need);
    const int L = bal ? 63 - __clzll((long long)bal) : 0;
    const unsigned Snext = (unsigned)bperm_i((L + 1) & 63, (int)S);
    unsigned run = (L < 63) ? Snext : 0u;
    const unsigned d3 = (unsigned)bperm_i(L, (int)c3), d2 = (unsigned)bperm_i(L, (int)c2), d1 = (unsigned)bperm_i(L, (int)c1), d0 = (unsigned)bperm_i(L, (int)c0);
    if (run + d3 >= need) { bin = 4 * L + 3; above = run; cntb = d3; return; } run += d3;
    if (run + d2 >= need) { bin = 4 * L + 2; above = run; cntb = d2; return; } run += d2;
    if (run + d1 >= need) { bin = 4 * L + 1; above = run; cntb = d1; return; } run += d1;
    bin = 4 * L; above = run; cntb = d0;
}
template <int PASS, bool ALLSEL>
__device__ __forceinline__ void dsa_pass(Frame& F, const bf16_t* kbase, unsigned* KS, const bf16x8 (&qb)[4], const float (&w4)[4], int nkt, int tq, unsigned r_a) {
    const int lane = F.lane, fr = lane & 15, fq = lane >> 4;
    LAS unsigned* hist = (LAS unsigned*)(F.lds + DS_HIST); LAS unsigned* bm = (LAS unsigned*)F.lds;
    const int kt0 = F.wave; if (kt0 >= nkt) return;
    u32x2* ksl = (u32x2*)KS + lane;
    if (PASS == 3 && ALLSEL) {
        for (int kt = kt0; kt < nkt; kt += 8) { unsigned nd = 0;
#pragma unroll
            for (int j = 0; j < 4; ++j) nd |= ((kt * 16 + 4 * fq + j) <= tq ? 1u : 0u) << j;
            if (nd) __hip_atomic_fetch_or(bm + fr * 128 + (kt >> 1), nd << (16 * (kt & 1) + 4 * fq), __ATOMIC_RELAXED, __HIP_MEMORY_SCOPE_WORKGROUP); }
        return;
    }
    u32x4 kc[4], kn[4];
    if (PASS == 1) {
        const int klast = nkt - 1;
#pragma unroll
        for (int u = 0; u < 4; ++u) { const int ke = (kt0 + 8 * u < nkt) ? kt0 + 8 * u : klast; kc[u] = __builtin_bit_cast(u32x4, *(const bf16x8*)(kbase + (size_t)ke * 16 * DP)); }
        for (int kg = kt0; kg < nkt; kg += 32) {
#pragma unroll
            for (int u = 0; u < 4; ++u) { const int ke = (kg + 32 + 8 * u < nkt) ? kg + 32 + 8 * u : klast; kn[u] = __builtin_bit_cast(u32x4, *(const bf16x8*)(kbase + (size_t)ke * 16 * DP)); }
#pragma unroll
            for (int u = 0; u < 4; ++u) { const int kt = kg + 8 * u; const bool live = kt < nkt; const int ke = live ? kt : klast;
                unsigned kk[4];
                const f32x4 sc = idx_score(__builtin_bit_cast(bf16x8, kc[u]), qb, w4);
#pragma unroll
                for (int j = 0; j < 4; ++j) kk[j] = okey16(sc[j]);
                ksl[(size_t)ke * 64] = (u32x2){kk[0] | (kk[1] << 16), kk[2] | (kk[3] << 16)};
                const bool diag = (ke == klast);
                const bool same1 = !diag && ((kk[0] ^ kk[1]) | (kk[0] ^ kk[2]) | (kk[0] ^ kk[3])) < 256u;
                if (live && same1) __hip_atomic_fetch_add(hist + fr * HROW + (kk[0] >> 8), 4u, __ATOMIC_RELAXED, __HIP_MEMORY_SCOPE_WORKGROUP);
#pragma unroll
                for (int j = 0; j < 4; ++j) { const bool valid = live && (!diag || (ke * 16 + 4 * fq + j) <= tq);
                    if (!same1 && valid) __hip_atomic_fetch_add(hist + fr * HROW + (kk[j] >> 8), 1u, __ATOMIC_RELAXED, __HIP_MEMORY_SCOPE_WORKGROUP); } }
#pragma unroll
            for (int u = 0; u < 4; ++u) kc[u] = kn[u];
        }
        return;
    }
#pragma unroll
    for (int u = 0; u < 4; ++u) { kc[u] = (u32x4){0u, 0u, 0u, 0u}; if (kt0 + 8 * u < nkt) { const u32x2 q = ksl[(size_t)(kt0 + 8 * u) * 64]; kc[u].x = q.x; kc[u].y = q.y; } }
    for (int kg = kt0; kg < nkt; kg += 32) {
#pragma unroll
        for (int u = 0; u < 4; ++u) { kn[u] = kc[u]; if (kg + 32 + 8 * u < nkt) { const u32x2 q = ksl[(size_t)(kg + 32 + 8 * u) * 64]; kn[u].x = q.x; kn[u].y = q.y; } }
#pragma unroll
        for (int u = 0; u < 4; ++u) { const int kt = kg + 8 * u;
            if (kt < nkt) {
                unsigned kk[4];
                kk[0] = kc[u].x & 0xffffu; kk[1] = kc[u].x >> 16; kk[2] = kc[u].y & 0xffffu; kk[3] = kc[u].y >> 16;
                const bool diag = (kt == nkt - 1);
                unsigned nd = 0, nt_ = 0;
#pragma unroll
                for (int j = 0; j < 4; ++j) { const bool valid = !diag || (kt * 16 + 4 * fq + j) <= tq; const unsigned key = kk[j];
                    if (PASS == 2) { if (valid && (key >> 8) == r_a) __hip_atomic_fetch_add(hist + fr * HROW + (key & 255u), 1u, __ATOMIC_RELAXED, __HIP_MEMORY_SCOPE_WORKGROUP); }
                    if (PASS == 3) { if (valid) { nd |= (key > r_a ? 1u : 0u) << j; nt_ |= (key == r_a ? 1u : 0u) << j; } } }
                if (PASS == 3) { const int sh = 16 * (kt & 1) + 4 * fq; const int wd = fr * 128 + (kt >> 1);
                    if (nd) __hip_atomic_fetch_or(bm + wd, nd << sh, __ATOMIC_RELAXED, __HIP_MEMORY_SCOPE_WORKGROUP);
                    if (nt_) __hip_atomic_fetch_or(bm + 2048 + wd, nt_ << sh, __ATOMIC_RELAXED, __HIP_MEMORY_SCOPE_WORKGROUP); }
            } }
#pragma unroll
        for (int u = 0; u < 4; ++u) kc[u] = kn[u];
    }
}
__device__ __forceinline__ void lds_zero(Frame& F, int off, int bytes) {
    LAS u32x4* p = (LAS u32x4*)(F.lds + off); unsigned z = 0u; asm volatile("" : "+v"(z));
    for (int i = F.tid; i < bytes / 16; i += 512) p[i] = (u32x4){z, z, z, z};
}
__device__ __forceinline__ void dsa_select_tile(Frame& F, const bf16_t* P, u64* BM, unsigned* KS, int b, int qt) {
    volatile LAS unsigned* rinfo = F.MISC + 64;
    volatile LAS unsigned* bm = (volatile LAS unsigned*)F.lds; volatile LAS unsigned* hist = (volatile LAS unsigned*)(F.lds + DS_HIST);
    const int lane = F.lane, fr = lane & 15, fq = lane >> 4, w = F.wave;
    const int t0 = qt * 16, nkt = qt + 1; const size_t rowbase = (size_t)b * 4096;
    const bf16_t* qrow = P + (rowbase + t0 + fr) * DP;
    bf16x8 qb[4];
#pragma unroll
    for (int h = 0; h < 4; ++h) qb[h] = *(const bf16x8*)(qrow + C_IQ + h * 32 + 8 * fq);
    const u32x2 iwp = *(const u32x2*)(qrow + C_IW); const float w4[4] = {bflo(iwp.x), bfhi(iwp.x), bflo(iwp.y), bfhi(iwp.y)};
    const bf16_t* kbase = P + (rowbase + fr) * DP + C_IK + 8 * fq;
    const int tq = t0 + fr;
    lds_zero(F, 0, 16384);
    if (qt >= 16) {
        lds_zero(F, DS_HIST, 16 * HROW * 4 + 64); __syncthreads();
        dsa_pass<1, false>(F, kbase, KS, qb, w4, nkt, tq, 0u);
        __syncthreads();
#pragma unroll 1
        for (int rr = 0; rr < 2; ++rr) { const int r = 2 * w + rr; int bin; unsigned above, cb; scan_row(hist + r * HROW, 256u, lane, bin, above, cb);
            if (lane == 0) { rinfo[r * 4 + 0] = (unsigned)bin; rinfo[r * 4 + 1] = 256u - above; } }
        __syncthreads();
        lds_zero(F, DS_HIST, 16 * HROW * 4 + 64); __syncthreads();
        dsa_pass<2, false>(F, kbase, KS, qb, w4, nkt, tq, rinfo[fr * 4 + 0]);
        __syncthreads();
#pragma unroll 1
        for (int rr = 0; rr < 2; ++rr) { const int r = 2 * w + rr; const unsigned b1 = rinfo[r * 4 + 0], rem1 = rinfo[r * 4 + 1]; int bin; unsigned above, cb; scan_row(hist + r * HROW, rem1, lane, bin, above, cb);
            if (lane == 0) { const unsigned take = rem1 - above; rinfo[r * 4 + 0] = (b1 << 8) | (unsigned)bin; rinfo[r * 4 + 1] = take; rinfo[r * 4 + 2] = (cb > take) ? 1u : 0u; } }
        __syncthreads();
        dsa_pass<3, false>(F, kbase, KS, qb, w4, nkt, tq, rinfo[fr * 4 + 0]);
    } else {
        if (F.tid < 16) { rinfo[F.tid * 4 + 0] = 0u; rinfo[F.tid * 4 + 1] = 0xffffffffu; rinfo[F.tid * 4 + 2] = 0u; }
        __syncthreads();
        dsa_pass<3, true>(F, kbase, KS, qb, w4, nkt, tq, 0u);
    }
    __syncthreads();
    volatile LAS u64* FIN = (volatile LAS u64*)(F.lds + 16384);
#pragma unroll 1
    for (int rr = 0; rr < 2; ++rr) { const int r = 2 * w + rr;
        const u64 def = (u64)bm[r * 128 + 2 * lane] | ((u64)bm[r * 128 + 2 * lane + 1] << 32);
        u64 tie = (u64)bm[2048 + r * 128 + 2 * lane] | ((u64)bm[2048 + r * 128 + 2 * lane + 1] << 32);
        if (rinfo[r * 4 + 2]) { const int take = (int)rinfo[r * 4 + 1]; const int c = __popcll(tie); int inc = c;
#pragma unroll
            for (int o = 1; o < 64; o <<= 1) { const int t = bperm_i((lane - o) & 63, inc); if (lane >= o) inc += t; }
            int tk = take - (inc - c); tk = tk < 0 ? 0 : (tk > c ? c : tk);
            while (__popcll(tie) > tk) tie &= ~(1ull << (63 - __clzll((long long)tie))); }
        FIN[lane * 16 + r] = def | tie; }
    __syncthreads();
#pragma unroll
    for (int k = 0; k < 2; ++k) { const int idx = F.tid + 512 * k, l = idx >> 4, r = idx & 15;
        if (l <= (t0 >> 6)) BM[((size_t)(b * 64 + l) * 4096) + t0 + r] = FIN[l * 16 + r]; }
    __builtin_amdgcn_fence(__ATOMIC_ACQUIRE, "agent");
    __syncthreads();
}

#define MFMA32(a, b, c) __builtin_amdgcn_mfma_f32_32x32x16_bf16(a, b, c, 0, 0, 0)
typedef short v4i16_t __attribute__((ext_vector_type(4)));
__device__ __forceinline__ s16x4 vtr(const LAS unsigned char* p) { return __builtin_bit_cast(s16x4, __builtin_amdgcn_ds_read_tr16_b64_v4i16((LAS v4i16_t*)p)); }
constexpr int AT_KBUF = 0, AT_VBUF = 16384, AT_WSF = 49152, AT_LUT = 51200, AT_IMP = 57344, AT_RMASK = 124928, AT_WOR = 125440;
enum { MK_C = 0, MK_A = 1, MK_WIN = 2, MK_SLC = 3, MK_CMP = 4 };
constexpr float ATT_THR = 8.f;

template <int VD> struct AState { f32x16 o[VD / 32]; float m, l; };
template <int VD> __device__ __forceinline__ void astate_init(AState<VD>& s) {
#pragma unroll
    for (int d = 0; d < VD / 32; ++d)
#pragma unroll
        for (int r = 0; r < 16; ++r) s.o[d][r] = 0.f;
    s.m = -1e30f; s.l = 0.f;
}
__device__ __forceinline__ void dma16(const void* gsrc, LAS unsigned char* ldst) {
    unsigned keep; const unsigned la = (unsigned)(size_t)ldst;
    asm volatile("s_mov_b32 %0, m0\n\ts_mov_b32 m0, %2\n\ts_nop 0\n\tglobal_load_lds_dwordx4 %1, off\n\ts_mov_b32 m0, %0" : "=&s"(keep) : "v"(gsrc), "s"(la) : "memory");
}
template <int VD>
__device__ __forceinline__ void stage_kv(LAS unsigned char* kbuf, LAS unsigned char* vbuf, const bf16_t* Kt, int ldk, const bf16_t* Vt, int ldv, int wave, int lane, bool with_v) {
    dma16(Kt + (size_t)lane * ldk + wave * 8, kbuf + wave * 1024);
    if (with_v) {
#pragma unroll
        for (int pc0 = 0; pc0 < VD / 8; pc0 += 8) { const int pc = pc0 + wave;
            dma16(Vt + (size_t)(16 * (pc & 3) + (lane >> 2)) * ldv + (pc >> 2) * 32 + (lane & 3) * 8, vbuf + pc * 1024); }
    }
}
__device__ __forceinline__ void qk_tile(f32x16& S0, f32x16& S1, const bf16x8 (&qr)[4], const LAS unsigned char* kbuf, int r32, int hi) {
    const LAS unsigned char* kp = kbuf + hi * 1024 + r32 * 16; asm volatile("" : "+v"(kp));
#pragma unroll
    for (int r = 0; r < 16; ++r) { S0[r] = 0.f; S1[r] = 0.f; }
#pragma unroll
    for (int g = 0; g < 2; ++g) {
        bf16x8 kf[4];
#pragma unroll
        for (int d = 0; d < 2; ++d) { kf[2 * d] = *(const LAS bf16x8*)(kp + (2 * g + d) * 2048); kf[2 * d + 1] = *(const LAS bf16x8*)(kp + (2 * g + d) * 2048 + 512); }
#pragma unroll
        for (int d = 0; d < 2; ++d) { S0 = MFMA32(kf[2 * d], qr[2 * g + d], S0); S1 = MFMA32(kf[2 * d + 1], qr[2 * g + d], S1); }
        if (PROBE_ATT == 2) { f32x16 D0, D1;
#pragma unroll
            for (int r = 0; r < 16; ++r) { D0[r] = 0.f; D1[r] = 0.f; }
#pragma unroll
            for (int d = 0; d < 2; ++d) { D0 = MFMA32(kf[2 * d], qr[2 * g + d], D0); D1 = MFMA32(kf[2 * d + 1], qr[2 * g + d], D1); }
            asm volatile("" :: "v"(D0[0] + D1[0])); }
    }
}
template <int MODE>
__device__ __forceinline__ void apply_mask(f32x16& S0, f32x16& S1, int tq, int key0, int hi, bool near, const LAS float* lut, u64 bits, int aux) {
    const unsigned blo = (unsigned)bits >> (4 * hi), bhi = (unsigned)(bits >> 32) >> (4 * hi);
    if (MODE == MK_A) asm volatile("s_nop 15\n\ts_nop 3" ::: "memory");
#pragma unroll
    for (int n = 0; n < 2; ++n)
#pragma unroll
        for (int r = 0; r < 16; ++r) { const int kk0 = (r & 3) + 8 * (r >> 2); const int kk = kk0 + 4 * hi + 32 * n; const int dist = tq - (key0 + kk);
            bool valid;
            if (MODE == MK_C) valid = dist >= 0;
            else if (MODE == MK_A) valid = true;
            else if (MODE == MK_WIN) valid = dist >= 0 && dist < 512;
            else if (MODE == MK_SLC) valid = (aux != 0) && dist >= 0;
            else valid = (key0 + kk) < aux;
            float s = n ? S1[r] : S0[r];
            if (MODE != MK_CMP && near) { const int dc = dist < 0 ? 0 : (dist > 127 ? 127 : dist); s += lut[dc]; }
            if (MODE == MK_A) { const int mk = __builtin_amdgcn_sbfe((int)(n ? bhi : blo), kk0, 1);
                unsigned sb; asm("v_bfi_b32 %0, %1, %2, %3" : "=v"(sb) : "v"(mk), "v"(__builtin_bit_cast(unsigned, s)), "v"(0xff800000u)); s = __builtin_bit_cast(float, sb); }
            else s = valid ? s : -INFINITY;
            if (n) S1[r] = s; else S0[r] = s; }
}
__device__ __forceinline__ float vmax3(float a, float b, float c) { float r; asm("v_max3_f32 %0, %1, %2, %3" : "=v"(r) : "v"(a), "v"(b), "v"(c)); return r; }
__device__ __forceinline__ float vmax2(float a, float b) { float r; asm("v_max_f32 %0, %1, %2" : "=v"(r) : "v"(a), "v"(b)); return r; }
__device__ __forceinline__ float row_max32(const f32x16& S0, const f32x16& S1, int lane) {
    asm volatile("s_nop 15\n\ts_nop 3" ::: "memory");
    float a = vmax3(S0[0], S0[1], S1[0]), b = vmax3(S0[2], S0[3], S1[1]); a = vmax3(a, S1[2], S1[3]);
#pragma unroll
    for (int r = 4; r < 16; r += 4) { a = vmax3(a, S0[r], S0[r + 1]); b = vmax3(b, S0[r + 2], S0[r + 3]); a = vmax3(a, S1[r], S1[r + 1]); b = vmax3(b, S1[r + 2], S1[r + 3]); }
    return vmax2(a, b);
}
__device__ __forceinline__ void v_load2(bf16x8 (&vf)[2][4], const LAS unsigned char* vbuf, int db0, int lane) {
    const int hi = lane >> 5;
    const LAS unsigned char* vp = vbuf + ((lane >> 4) & 1) * 32 + (lane & 3) * 8 + (4 * hi + ((lane & 15) >> 2)) * 64 + db0 * 4096;
#pragma unroll
    for (int d = 0; d < 2; ++d)
#pragma unroll
        for (int ks = 0; ks < 4; ++ks) { const s16x4 lo = vtr(vp + d * 4096 + ks * 1024), hh = vtr(vp + d * 4096 + ks * 1024 + 512);
            vf[d][ks] = (bf16x8){lo[0], lo[1], lo[2], lo[3], hh[0], hh[1], hh[2], hh[3]}; }
}
__device__ __forceinline__ void p_pack(bf16x8 (&pa)[4], const f32x16& S0, const f32x16& S1) {
#pragma unroll
    for (int ks = 0; ks < 4; ++ks) { u32x4 w;
        if (ks == 0) { w.x = cvt_pk_bf16(S0[0], S0[1]); w.y = cvt_pk_bf16(S0[2], S0[3]); w.z = cvt_pk_bf16(S0[4], S0[5]); w.w = cvt_pk_bf16(S0[6], S0[7]); }
        else if (ks == 1) { w.x = cvt_pk_bf16(S0[8], S0[9]); w.y = cvt_pk_bf16(S0[10], S0[11]); w.z = cvt_pk_bf16(S0[12], S0[13]); w.w = cvt_pk_bf16(S0[14], S0[15]); }
        else if (ks == 2) { w.x = cvt_pk_bf16(S1[0], S1[1]); w.y = cvt_pk_bf16(S1[2], S1[3]); w.z = cvt_pk_bf16(S1[4], S1[5]); w.w = cvt_pk_bf16(S1[6], S1[7]); }
        else { w.x = cvt_pk_bf16(S1[8], S1[9]); w.y = cvt_pk_bf16(S1[10], S1[11]); w.z = cvt_pk_bf16(S1[12], S1[13]); w.w = cvt_pk_bf16(S1[14], S1[15]); }
        pa[ks] = __builtin_bit_cast(bf16x8, w); }
}
template <int VD>
__device__ __forceinline__ void pv_tile(f32x16 (&o)[VD / 32], const f32x16& S0, const f32x16& S1, const bf16x8 (&vf01)[2][4], const LAS unsigned char* vbuf, int lane) {
    bf16x8 pa[4]; p_pack(pa, S0, S1);
    if (VD == 128) {
        bf16x8 va[4], vb[4];
        const int hi = lane >> 5;
        const LAS unsigned char* vp = vbuf + ((lane >> 4) & 1) * 32 + (lane & 3) * 8 + (4 * hi + ((lane & 15) >> 2)) * 64;
#pragma unroll
        for (int ks = 0; ks < 4; ++ks) { const s16x4 lo = vtr(vp + 2 * 4096 + ks * 1024), hh = vtr(vp + 2 * 4096 + ks * 1024 + 512); va[ks] = (bf16x8){lo[0], lo[1], lo[2], lo[3], hh[0], hh[1], hh[2], hh[3]}; }
#pragma unroll
        for (int ks = 0; ks < 4; ++ks) { const s16x4 lo = vtr(vp + 3 * 4096 + ks * 1024), hh = vtr(vp + 3 * 4096 + ks * 1024 + 512); vb[ks] = (bf16x8){lo[0], lo[1], lo[2], lo[3], hh[0], hh[1], hh[2], hh[3]}; }
#pragma unroll
        for (int ks = 0; ks < 4; ++ks) { o[0] = MFMA32(pa[ks], vf01[0][ks], o[0]); o[1] = MFMA32(pa[ks], vf01[1][ks], o[1]); }
        __builtin_amdgcn_sched_barrier(0);
#pragma unroll
        for (int ks = 0; ks < 4; ++ks) { o[(VD == 128) ? 2 : 0] = MFMA32(pa[ks], va[ks], o[(VD == 128) ? 2 : 0]); o[(VD == 128) ? 3 : 0] = MFMA32(pa[ks], vb[ks], o[(VD == 128) ? 3 : 0]); }
    } else {
#pragma unroll
        for (int ks = 0; ks < 4; ++ks)
#pragma unroll
            for (int d = 0; d < 2; ++d) o[d] = MFMA32(pa[ks], vf01[d][ks], o[d]);
    }
}
template <int ND>
__device__ __forceinline__ void scale_rows(f32x16 (&o)[ND], float f, LAS float* wsf, int lane) {
    const int hi = lane >> 5;
    wsf[lane & 31] = f;
#pragma unroll
    for (int g = 0; g < 4; ++g) { const f32x4 a = *(const LAS f32x4*)(wsf + 8 * g + 4 * hi);
#pragma unroll
        for (int d = 0; d < ND; ++d)
#pragma unroll
            for (int i = 0; i < 4; ++i) o[d][4 * g + i] *= a[i]; }
}
template <int VD, bool PV>
__device__ __forceinline__ void softmax_step(AState<VD>& st, f32x16& S0, f32x16& S1, const LAS unsigned char* vbuf, LAS float* wsf, int lane) {
    bf16x8 vf01[2][4];
    if (PV) { v_load2(vf01, vbuf, 0, lane); __builtin_amdgcn_sched_barrier(0); }
    const float mx = row_max32(S0, S1, lane);
    if (__any(mx - st.m > ATT_THR)) { const float mnew = vmax2(st.m, vmax2(mx, bperm_f(lane ^ 32, mx))); const float alpha = fexp2(st.m - mnew); st.l *= alpha; st.m = mnew;
        if (PV) scale_rows<VD / 32>(st.o, alpha, wsf, lane); }
    float sum = 0.f;
#pragma unroll
    for (int r = 0; r < 16; ++r) { S0[r] = fexp2(S0[r] - st.m); S1[r] = fexp2(S1[r] - st.m); }
#pragma unroll
    for (int r = 0; r < 16; ++r) sum += S0[r];
#pragma unroll
    for (int r = 0; r < 16; ++r) sum += S1[r];
    st.l += sum;
    if (PROBE_ATT == 1) { float dm = 0.f;
#pragma unroll
        for (int r = 0; r < 16; ++r) { float t0 = S0[r], t1 = S1[r]; asm volatile("" : "+v"(t0), "+v"(t1)); dm += fexp2(t0 - st.m) + fexp2(t1 - st.m); }
        asm volatile("" :: "v"(dm)); }
    if (PV) pv_tile<VD>(st.o, S0, S1, vf01, vbuf, lane);
}
template <int ND>
__device__ __forceinline__ void finish_add(f32x16 (&acc)[ND], const f32x16 (&o)[ND], float l, float gate, LAS float* wsf, int lane) {
    const int hi = lane >> 5;
    const float lt = sum32(l, lane); const float f = lt > 0.f ? gate / lt : 0.f;
    wsf[lane & 31] = f;
#pragma unroll
    for (int g = 0; g < 4; ++g) { const f32x4 a = *(const LAS f32x4*)(wsf + 8 * g + 4 * hi);
#pragma unroll
        for (int d = 0; d < ND; ++d)
#pragma unroll
            for (int i = 0; i < 4; ++i) acc[d][4 * g + i] += o[d][4 * g + i] * a[i]; }
}

__device__ __forceinline__ int crow(int r, int hi) { return (r & 3) + 8 * (r >> 2) + 4 * hi; }

#define C_KS(s_) ((s_) == 2 ? 122880 : (s_) * 8192)
#define C_VS(s_) ((s_) == 2 ? 131072 : 16384 + (s_) * 16384)
__device__ __forceinline__ void unit_C(Frame& F, const bf16_t* P, bf16_t* OC, const float* gnorm, float lam, float lam_init, int b, int h, int qb) {
    const int lane = F.lane, r32 = lane & 31, hi = lane >> 5, w = F.wave;
    LAS unsigned char* lds = F.lds; LAS float* wsf = (LAS float*)(lds + AT_WSF) + w * 64; const LAS float* lut = (const LAS float*)(lds + AT_LUT) + (8 + h) * 128;
    const int q0 = qb * 256, tw0 = q0 + 32 * w, tq = tw0 + r32; const size_t rowbase = (size_t)b * 4096;
    const int NT = 4 * qb + 4, my_last = (tw0 + 31) >> 6;
    LAS unsigned* kpl = (LAS unsigned*)(lds + AT_IMP) + w * 2048 + lane;
    AState<128> st;
#pragma unroll 1
    for (int j = 0; j < 2; ++j) {
        const bf16_t* Qp = P + (rowbase + tq) * DP + C_CQ + h * 128 + j * 64;
        bf16x8 qr[4];
#pragma unroll
        for (int d0 = 0; d0 < 4; ++d0) qr[d0] = *(const bf16x8*)(Qp + d0 * 16 + hi * 8);
        const bf16_t* Kb = P + rowbase * DP + C_CK + h * 128 + j * 64; const bf16_t* Vb = P + rowbase * DP + C_CV + h * 128;
        astate_init(st);
        stage_kv<128>(lds + AT_KBUF, lds + AT_VBUF, Kb, DP, Vb, DP, w, lane, true);
#pragma unroll 1
        for (int kt = 0; kt < NT; ++kt) {
            VM_WAIT(); __syncthreads();
            const int cb = kt & 1;
            if (kt + 1 < NT) stage_kv<128>(lds + AT_KBUF + (cb ^ 1) * 8192, lds + AT_VBUF + (cb ^ 1) * 16384, Kb + (size_t)(kt + 1) * 64 * DP, DP, Vb + (size_t)(kt + 1) * 64 * DP, DP, w, lane, true);
            if (kt <= my_last) {
                f32x16 S0, S1; qk_tile(S0, S1, qr, lds + AT_KBUF + cb * 8192, r32, hi);
                const int key0 = kt * 64; const bool near = (tw0 - (key0 + 63)) < 113;
                if (near) apply_mask<MK_C>(S0, S1, tq, key0, hi, true, lut, 0ull, 0);
                softmax_step<128, true>(st, S0, S1, lds + AT_VBUF + cb * 16384, wsf, lane);
            }
        }
        __syncthreads();
        const float lt = sum32(st.l, lane);
        if (j == 0) { scale_rows<4>(st.o, 1.f / lt, wsf, lane);
#pragma unroll
            for (int d = 0; d < 4; ++d)
#pragma unroll
                for (int r = 0; r < 8; ++r) kpl[(d * 8 + r) * 64] = cvt_pk_bf16(st.o[d][2 * r], st.o[d][2 * r + 1]);
        } else { scale_rows<4>(st.o, -lam / lt, wsf, lane);
#pragma unroll
            for (int d = 0; d < 4; ++d)
#pragma unroll
                for (int r = 0; r < 8; ++r) { const unsigned kw = kpl[(d * 8 + r) * 64]; st.o[d][2 * r] += bflo(kw); st.o[d][2 * r + 1] += bfhi(kw); } }
    }
    f32x16 (&keep)[4] = st.o;
    float gch[4];
#pragma unroll
    for (int d = 0; d < 4; ++d) gch[d] = gnorm[32 * d + r32] * (1.f - lam_init);
    GAS bf16_t* orow = (GAS bf16_t*)OC + (rowbase + tw0) * 1024 + 512 + h * 128 + r32; asm volatile("" : "+v"(orow)); int hs = hi; asm volatile("" : "+v"(hs));
#pragma unroll
    for (int r = 0; r < 16; ++r) { float ss = keep[0][r] * keep[0][r] + keep[1][r] * keep[1][r] + keep[2][r] * keep[2][r] + keep[3][r] * keep[3][r];
        ss += shx_f(ss, 1, lane); ss += shx_f(ss, 2, lane); ss += shx_f(ss, 4, lane); ss += shx_f(ss, 8, lane); ss += shx_f(ss, 16, lane);
        const float sc = 1.f / sqrtf(ss * (1.f / 128.f) + LN_EPS);
#pragma unroll
        for (int d = 0; d < 4; ++d) orow[crow(r, hs) * 1024 + 32 * d] = (bf16_t)f2bf(keep[d][r] * sc * gch[d]); }
}

__device__ __forceinline__ void unit_A(Frame& F, const bf16_t* P, const u64* BM, bf16_t* OC, int b, int qi) {
    const int lane = F.lane, r32 = lane & 31, hi = lane >> 5, w = F.wave, h = w & 3, rg = w >> 2;
    LAS unsigned char* lds = F.lds; LAS float* wsf = (LAS float*)(lds + AT_WSF) + w * 64; const LAS float* lut = (const LAS float*)(lds + AT_LUT) + h * 128;
    const int q0 = qi * 64, tw0 = q0 + 32 * rg, tq = tw0 + r32; const size_t rowbase = (size_t)b * 4096;
    const int NT = qi + 1;
    const bf16_t* Qp = P + (rowbase + tq) * DP + C_AQ + h * 64;
    bf16x8 qr[4];
#pragma unroll
    for (int d0 = 0; d0 < 4; ++d0) qr[d0] = *(const bf16x8*)(Qp + d0 * 16 + hi * 8);
    const bf16_t* Kb = P + rowbase * DP + C_AK; const bf16_t* Vb = P + rowbase * DP + C_AV;
    const u64* bmp = BM + (size_t)b * 64 * 4096 + tq;
    u64 bits = bmp[0];
    AState<64> st; astate_init(st);
    stage_kv<64>(lds + AT_KBUF, lds + AT_VBUF, Kb, DP, Vb, DP, w, lane, true);
#pragma unroll 1
    for (int kt = 0; kt < NT; ++kt) {
        VM_WAIT(); __syncthreads();
        const int cb = kt & 1;
        u64 nbits = 0ull;
        if (kt + 1 < NT) { stage_kv<64>(lds + AT_KBUF + (cb ^ 1) * 8192, lds + AT_VBUF + (cb ^ 1) * 16384, Kb + (size_t)(kt + 1) * 64 * DP, DP, Vb + (size_t)(kt + 1) * 64 * DP, DP, w, lane, true);
            nbits = bmp[(size_t)(kt + 1) * 4096]; }
        f32x16 S0, S1; qk_tile(S0, S1, qr, lds + AT_KBUF + cb * 8192, r32, hi);
        const int key0 = kt * 64; const bool near = (tw0 - (key0 + 63)) < 113;
        if (A_DENSE) { if (near) apply_mask<MK_C>(S0, S1, tq, key0, hi, true, lut, 0ull, 0); } else apply_mask<MK_A>(S0, S1, tq, key0, hi, near, lut, bits, 0);
        softmax_step<64, true>(st, S0, S1, lds + AT_VBUF + cb * 16384, wsf, lane);
        bits = nbits;
    }
    __syncthreads();
    f32x16 acc[2];
#pragma unroll
    for (int d = 0; d < 2; ++d)
#pragma unroll
        for (int r = 0; r < 16; ++r) acc[d][r] = 0.f;
    const float lt = sum32(st.l, lane);
    finish_add<2>(acc, st.o, 0.5f, lt > 0.f ? 1.f / lt : 0.f, wsf, lane);
    GAS bf16_t* orow = (GAS bf16_t*)OC + (rowbase + tw0) * 1024 + h * 64 + r32; asm volatile("" : "+v"(orow)); int hs = hi; asm volatile("" : "+v"(hs));
#pragma unroll
    for (int r = 0; r < 16; ++r)
#pragma unroll
        for (int d = 0; d < 2; ++d) orow[crow(r, hs) * 1024 + 32 * d] = (bf16_t)f2bf(acc[d][r]);
}

constexpr int IMP_LD = 65;
__device__ __forceinline__ void unit_B(Frame& F, const bf16_t* P, const bf16_t* KC, const bf16_t* VC, bf16_t* OC, int b, int qi) {
    const int lane = F.lane, r32 = lane & 31, hi = lane >> 5, w = F.wave, h = w & 3, rg = w >> 2;
    LAS unsigned char* lds = F.lds; LAS float* wsf = (LAS float*)(lds + AT_WSF) + w * 64; const LAS float* lut = (const LAS float*)(lds + AT_LUT) + (4 + h) * 128;
    LAS float* imp = (LAS float*)(lds + AT_IMP); volatile LAS u64* rmask = (volatile LAS u64*)(lds + AT_RMASK); volatile LAS u64* wor = (volatile LAS u64*)(lds + AT_WOR);
    const int q0 = qi * 64, cur = qi, tw0 = q0 + 32 * rg, tq = tw0 + r32, urow = 32 * rg + r32; const size_t rowbase = (size_t)b * 4096;
    const bf16_t* prow = P + (rowbase + tq) * DP;
    bf16x8 qr[4];
#pragma unroll
    for (int d0 = 0; d0 < 4; ++d0) qr[d0] = *(const bf16x8*)(prow + C_BQ + h * 64 + d0 * 16 + hi * 8);
    const float g0 = fsigmoid(bf2f(prow[C_BG + h * 3 + 0])), g1 = fsigmoid(bf2f(prow[C_BG + h * 3 + 1])), g2 = fsigmoid(bf2f(prow[C_BG + h * 3 + 2]));
    f32x16 ob[2];
#pragma unroll
    for (int d = 0; d < 2; ++d)
#pragma unroll
        for (int r = 0; r < 16; ++r) ob[d][r] = 0.f;
    {
        const int ncv = tq >= 31 ? ((tq - 31) >> 4) + 1 : 0;
        const int ncv_max = ((q0 + 63 - 31) >> 4) + 1, NTc = (ncv_max + 63) >> 6;
        const bf16_t* Kc = KC + (size_t)b * 256 * 64; const bf16_t* Vc = VC + (size_t)b * 256 * 64;
        AState<64> st; astate_init(st);
        stage_kv<64>(lds + AT_KBUF, lds + AT_VBUF, Kc, 64, Vc, 64, w, lane, false);
#pragma unroll 1
        for (int kt = 0; kt < NTc; ++kt) {
            VM_WAIT(); __syncthreads();
            const int cb = kt & 1;
            if (kt + 1 < NTc) stage_kv<64>(lds + AT_KBUF + (cb ^ 1) * 8192, lds + AT_VBUF + (cb ^ 1) * 16384, Kc + (size_t)(kt + 1) * 64 * 64, 64, Vc, 64, w, lane, false);
            f32x16 S0, S1; qk_tile(S0, S1, qr, lds + AT_KBUF + cb * 8192, r32, hi);
            apply_mask<MK_CMP>(S0, S1, tq, kt * 64, hi, false, lut, 0ull, ncv);
            softmax_step<64, false>(st, S0, S1, lds + AT_VBUF, wsf, lane);
        }
        __syncthreads();
        const float lt = sum32(st.l, lane); const float inv = lt > 0.f ? 1.f / lt : 0.f; const float mfin = st.m;
        f32x16 oc[2];
#pragma unroll
        for (int d = 0; d < 2; ++d)
#pragma unroll
            for (int r = 0; r < 16; ++r) oc[d][r] = 0.f;
        float carry = 0.f;
        stage_kv<64>(lds + AT_KBUF, lds + AT_VBUF, Kc, 64, Vc, 64, w, lane, true);
#pragma unroll 1
        for (int kt = 0; kt < NTc; ++kt) {
            VM_WAIT(); __syncthreads();
            const int cb = kt & 1;
            if (kt + 1 < NTc) stage_kv<64>(lds + AT_KBUF + (cb ^ 1) * 8192, lds + AT_VBUF + (cb ^ 1) * 16384, Kc + (size_t)(kt + 1) * 64 * 64, 64, Vc + (size_t)(kt + 1) * 64 * 64, 64, w, lane, true);
            f32x16 S0, S1; qk_tile(S0, S1, qr, lds + AT_KBUF + cb * 8192, r32, hi);
            apply_mask<MK_CMP>(S0, S1, tq, kt * 64, hi, false, lut, 0ull, ncv);
#pragma unroll
            for (int r = 0; r < 16; ++r) { S0[r] = fexp2(S0[r] - mfin) * inv; S1[r] = fexp2(S1[r] - mfin) * inv; }
            float own[2][4], pl[2][4];
#pragma unroll
            for (int g = 0; g < 4; ++g) { own[0][g] = (S0[4 * g] + S0[4 * g + 1]) + (S0[4 * g + 2] + S0[4 * g + 3]); own[1][g] = (S1[4 * g] + S1[4 * g + 1]) + (S1[4 * g + 2] + S1[4 * g + 3]);
                pl[0][g] = other32(S0[4 * g + 3], lane); pl[1][g] = other32(S1[4 * g + 3], lane); }
#pragma unroll
            for (int n = 0; n < 2; ++n)
#pragma unroll
                for (int g = 0; g < 4; ++g) { const int J = 16 * kt + 8 * n + 2 * g + hi;
                    const float prev0 = (g > 0) ? pl[n][g > 0 ? g - 1 : 0] : (n == 1 ? pl[0][3] : carry);
                    const float prev = hi ? pl[n][g] : prev0;
                    imp[(h * 64 + urow) * IMP_LD + J] = own[n][g] + prev; }
            carry = pl[1][3];
            { bf16x8 vf01[2][4]; v_load2(vf01, lds + AT_VBUF + cb * 16384, 0, lane); pv_tile<64>(oc, S0, S1, vf01, lds + AT_VBUF + cb * 16384, lane); }
        }
        finish_add<2>(ob, oc, 0.5f, g0, wsf, lane);
        __syncthreads();
    }
    {
        const int nf = cur >= 2 ? 3 : cur + 1, nfree = 16 - nf; u64 worl = 0ull;
#pragma unroll 1
        for (int rr = 0; rr < 8; ++rr) { const int row = 8 * w + rr; const int j = lane;
            const float v = (imp[(0 * 64 + row) * IMP_LD + j] + imp[(1 * 64 + row) * IMP_LD + j]) + (imp[(2 * 64 + row) * IMP_LD + j] + imp[(3 * 64 + row) * IMP_LD + j]);
            const bool cand = (j >= 1) && (j <= cur - 2);
            int rank = 0;
#pragma unroll 4
            for (int k = 1; k <= cur - 2; ++k) { const float vk = __builtin_bit_cast(float, __builtin_amdgcn_readlane(__builtin_bit_cast(int, v), k)); rank += (vk > v || (vk == v && k < j)) ? 1 : 0; }
            const bool forced = (j <= cur) && (j == 0 || j == cur || j == cur - 1);
            const bool sel = forced || (cand && rank < nfree);
            const u64 mk = __ballot(sel);
            if (lane == 0) rmask[row] = mk;
            worl |= mk; }
        if (lane == 0) wor[w] = worl;
        __syncthreads();
    }
    const u64 myrm = rmask[urow];
    u64 un = 0ull;
#pragma unroll
    for (int k = 0; k < 8; ++k) un |= wor[k];
    {
        const bf16_t* Kb = P + rowbase * DP + C_BKV + 2 * 64; const bf16_t* Vb = P + rowbase * DP + C_BKV + 3 * 64;
        AState<64> st; astate_init(st);
        const int nsel = __popcll(un);
        int j = __ffsll((long long)un) - 1; un &= un - 1;
        stage_kv<64>(lds + AT_KBUF, lds + AT_VBUF, Kb + (size_t)j * 64 * DP, DP, Vb + (size_t)j * 64 * DP, DP, w, lane, true);
#pragma unroll 1
        for (int i = 0; i < nsel; ++i) {
            VM_WAIT(); __syncthreads();
            const int cb = i & 1;
            int jn = -1;
            if (un) { jn = __ffsll((long long)un) - 1; un &= un - 1;
                stage_kv<64>(lds + AT_KBUF + (cb ^ 1) * 8192, lds + AT_VBUF + (cb ^ 1) * 16384, Kb + (size_t)jn * 64 * DP, DP, Vb + (size_t)jn * 64 * DP, DP, w, lane, true); }
            const int rowsel = (int)((myrm >> j) & 1ull);
            if (__any(rowsel)) {
                f32x16 S0, S1; qk_tile(S0, S1, qr, lds + AT_KBUF + cb * 8192, r32, hi);
                const int key0 = j * 64; const bool near = (tw0 - (key0 + 63)) < 113;
                if (near || j == cur || !__all(rowsel)) apply_mask<MK_SLC>(S0, S1, tq, key0, hi, near, lut, 0ull, rowsel);
                softmax_step<64, true>(st, S0, S1, lds + AT_VBUF + cb * 16384, wsf, lane);
            }
            j = jn;
        }
        __syncthreads();
        const float lt = sum32(st.l, lane);
        finish_add<2>(ob, st.o, 0.5f, lt > 0.f ? g1 / lt : 0.f, wsf, lane);
    }
    {
        const bf16_t* Kb = P + rowbase * DP + C_BKV + 4 * 64; const bf16_t* Vb = P + rowbase * DP + C_BKV + 5 * 64;
        AState<64> st; astate_init(st);
        const int kt0 = cur >= 8 ? cur - 8 : 0;
        stage_kv<64>(lds + AT_KBUF, lds + AT_VBUF, Kb + (size_t)kt0 * 64 * DP, DP, Vb + (size_t)kt0 * 64 * DP, DP, w, lane, true);
#pragma unroll 1
        for (int kt = kt0; kt <= cur; ++kt) {
            VM_WAIT(); __syncthreads();
            const int cb = (kt - kt0) & 1;
            if (kt + 1 <= cur) stage_kv<64>(lds + AT_KBUF + (cb ^ 1) * 8192, lds + AT_VBUF + (cb ^ 1) * 16384, Kb + (size_t)(kt + 1) * 64 * DP, DP, Vb + (size_t)(kt + 1) * 64 * DP, DP, w, lane, true);
            f32x16 S0, S1; qk_tile(S0, S1, qr, lds + AT_KBUF + cb * 8192, r32, hi);
            const int key0 = kt * 64; const bool near = (tw0 - (key0 + 63)) < 113;
            const bool allv = (key0 + 63 <= tw0) && (tw0 + 31 - key0 < 512);
            if (near || !allv) apply_mask<MK_WIN>(S0, S1, tq, key0, hi, near, lut, 0ull, 0);
            softmax_step<64, true>(st, S0, S1, lds + AT_VBUF + cb * 16384, wsf, lane);
        }
        __syncthreads();
        const float lt = sum32(st.l, lane);
        finish_add<2>(ob, st.o, 0.5f, lt > 0.f ? g2 / lt : 0.f, wsf, lane);
    }
    GAS bf16_t* orow = (GAS bf16_t*)OC + (rowbase + tw0) * 1024 + 256 + h * 64 + r32; asm volatile("" : "+v"(orow)); int hs = hi; asm volatile("" : "+v"(hs));
#pragma unroll
    for (int r = 0; r < 16; ++r)
#pragma unroll
        for (int d = 0; d < 2; ++d) orow[crow(r, hs) * 1024 + 32 * d] = (bf16_t)f2bf(ob[d][r]);
}

__device__ __forceinline__ void phase_cmp2(Frame& F, const bf16_t* HID, const bf16_t* W2T, bf16_t* KC) {
    const int lane = F.lane, fr = lane & 15, fq = lane >> 4;
    for (int task = F.gw; task < 512; task += F.NGW) { const int j = task >> 8, row0 = (task & 255) * 16;
        f32x4 acc[4];
#pragma unroll
        for (int n = 0; n < 4; ++n) acc[n] = (f32x4){0.f, 0.f, 0.f, 0.f};
#pragma unroll
        for (int ks = 0; ks < 8; ++ks) { const bf16x8 a = *(const bf16x8*)(HID + ((size_t)j * 4096 + row0 + fr) * 256 + ks * 32 + 8 * fq);
#pragma unroll
            for (int n = 0; n < 4; ++n) { const bf16x8 bb = *(const bf16x8*)(W2T + ((size_t)j * 64 + n * 16 + fr) * 256 + ks * 32 + 8 * fq);
                acc[n] = __builtin_amdgcn_mfma_f32_16x16x32_bf16(a, bb, acc[n], 0, 0, 0); } }
#pragma unroll
        for (int n = 0; n < 4; ++n)
#pragma unroll
            for (int jj = 0; jj < 4; ++jj) KC[((size_t)j * 4096 + row0 + 4 * fq + jj) * 64 + n * 16 + fr] = (bf16_t)f2bf(acc[n][jj]);
    }
}

constexpr int PH_PER_LAYER = 11, N_PHASES = 2 + DEPTH * PH_PER_LAYER;
struct Args { const float* in[27]; float* out; unsigned char* ws; int ph_lo, ph_hi, li, pad; };

#define IN(k) (lo <= (k) && (k) < hi)
#define SEAM(k) do { if (IN((k) + 1)) xcd_barrier(bar); } while (0)
#define WSB (F.ws)
#define PROJ ((bf16_t*)(WSB + WS_PROJ))
#define HB ((bf16_t*)(WSB + WS_HB))
#define OCAT ((bf16_t*)(WSB + WS_OCAT))
#define MERG ((bf16_t*)(WSB + WS_MERG))
#define X1 ((bf16_t*)(WSB + WS_X1))
#define MOD ((const float*)(WSB + WS_MOD))

template <int l>
__device__ __forceinline__ void run_layer(Frame& F, const Args& args, const XcdBarrier& bar, int lo, int hi) {
        const int pb = 2 + l * PH_PER_LAYER;
#define xres ((l == 0) ? args.in[0] : (const float*)args.out)
#define mod_a (MOD + (size_t)(2 * l) * 16 * 3072)
#define mod_f (MOD + (size_t)(2 * l + 1) * 16 * 3072)
        if (IN(pb + 0)) for (int rep = 0; rep < ((l == 0 && DUP == 0) ? 2 : 1); ++rep) { if (rep) xcd_barrier(bar); refresh(F);
            { pg8::Gemm g{HB, (const bf16_t*)(WSB + WS_WIN_T) + (size_t)l * DP * 1024, 1024, 1024, 1024, 128}; pg8::StaticOrder S; S.init(NTOK, N_BF, F.G, (int)blockIdx.x);
              pg8::EpiProj E{PROJ, 0, 1.f};
              pg8::gemm_phase<pg8::EpiProj, pg8::StaticOrder>(F.lds, g, S, E, F.wave); }
            { pg8::Gemm g{(const bf16_t*)(WSB + WS_HB8), (const bf16_t*)(WSB + WS_WMG8 + (size_t)l * N_F8 * 1024), 512, 512, 512, 128}; pg8::StaticOrder S; S.init(NTOK, N_F8, F.G, (int)blockIdx.x);
              pg8::EpiGate8 E{(unsigned char*)(WSB + WS_MG8), 1.f / (F8_H * F8_WIN)};
              pg8::gemm_phase<pg8::EpiGate8, pg8::StaticOrder, true>(F.lds, g, S, E, F.wave); }
            if (blockIdx.x == 255) { u32x4* z = (u32x4*)(PROJ + (size_t)NTOK * DP); for (int i = F.tid; i < 32 * DP * 2 / 16; i += 512) z[i] = (u32x4){0u, 0u, 0u, 0u}; }
            SEAM(pb + 0);
        }
        if (IN(pb + 1)) for (int rep = 0; rep < ((l == 0 && DUP == 1) ? 2 : 1); ++rep) { if (rep) xcd_barrier(bar); refresh(F);
            { pg8::Gemm g{PROJ + C_BKV, (const bf16_t*)(WSB + WS_W1_T) + (size_t)l * 2 * 256 * 2048, 16 * DP, 2048, 2048, DP * 2}; pg8::CmpOrder S{F.G, (int)blockIdx.x};
              pg8::EpiCmp1 E{(bf16_t*)(WSB + WS_HID), (const float*)(WSB + WS_BIAS1) + l * 512};
              pg8::gemm_phase<pg8::EpiCmp1, pg8::CmpOrder>(F.lds, g, S, E, F.wave); }
            __syncthreads();
            if (USE_A) {
                unsigned* tq = (unsigned*)(WSB + WS_CTL) + CW_CNT + l * 64 + 48;
                if (F.tid == 0) F.MISC[9] = __hip_atomic_fetch_add(tq, 1u, __ATOMIC_RELAXED, __HIP_MEMORY_SCOPE_AGENT);
                __syncthreads();
                unsigned n = F.MISC[9];
#pragma unroll 1
                while (n < 4096u) {
                    unsigned nn = 0u; if (F.tid == 0) nn = __hip_atomic_fetch_add(tq, 1u, __ATOMIC_RELAXED, __HIP_MEMORY_SCOPE_AGENT);
                    dsa_select_tile(F, PROJ, (u64*)(WSB + WS_BM64), (unsigned*)(WSB + WS_OCAT) + (size_t)blockIdx.x * 65536, (int)(n >> 8), 255 - (int)(n & 255u));
                    if (F.tid == 0) F.MISC[9] = nn;
                    __syncthreads();
                    n = F.MISC[9];
                    __syncthreads();
                }
            }
            SEAM(pb + 1);
        }
        if (IN(pb + 2)) for (int rep = 0; rep < ((l == 0 && DUP == 2) ? 2 : 1); ++rep) { if (rep) xcd_barrier(bar); refresh(F); phase_cmp2(F, (const bf16_t*)(WSB + WS_HID), (const bf16_t*)(WSB + WS_W2_T) + (size_t)l * 2 * 64 * 256, (bf16_t*)(WSB + WS_KCMP)); SEAM(pb + 2); }
        if (IN(pb + 3)) for (int rep = 0; rep < ((l == 0 && DUP == 3) ? 2 : 1); ++rep) { if (rep) xcd_barrier(bar); refresh(F);
            for (int i = F.tid; i < 12 * 128; i += 512) ((LAS float*)(F.lds + AT_LUT))[i] = ((const float*)(WSB + WS_LUT))[i];
            __syncthreads();
            const int c = (int)blockIdx.x;
            if (USE_C) {
                const float lam = ((const float*)(WSB + WS_LAM))[l]; const float lam_init = 0.8f - 0.6f * __expf(-0.3f * (float)l);
#pragma unroll 1
                for (int u = 0; u < 4; ++u) { const int bh = (c & 7) * 8 + (c >> 5), pp = ((c >> 3) & 3) * 2 + (u >> 1); const int qb = (u & 1) ? pp : 15 - pp;
                    refresh(F); unit_C(F, PROJ, OCAT, args.in[10] + l * 128, lam, lam_init, bh >> 2, bh & 3, qb); }
            }
            if (USE_A) {
#pragma unroll 1
                for (int u = 0; u < 4; ++u) { const int b = (c & 7) * 2 + (c >> 7), pp = ((c >> 3) & 15) * 2 + (u >> 1); const int qi = (u & 1) ? pp : 63 - pp;
                    refresh(F); unit_A(F, PROJ, (const u64*)(WSB + WS_BM64), OCAT, b, qi); }
            }
            if (USE_B) {
#pragma unroll 1
                for (int u = 0; u < 4; ++u) { const int b = (c & 7) * 2 + (c >> 7), pp = ((c >> 3) & 15) * 2 + (u >> 1); const int qi = (u & 1) ? pp : 63 - pp;
                    refresh(F); unit_B(F, PROJ, (const bf16_t*)(WSB + WS_KCMP), (const bf16_t*)(WSB + WS_KCMP) + 4096 * 64, OCAT, b, qi); }
            }
            if (!USE_A || !USE_B || !USE_C) {
                for (int row = F.gw; row < NTOK; row += F.NGW) { u32x4* o = (u32x4*)(OCAT + (size_t)row * 1024);
                    for (int q = F.lane; q < 128; q += 64) { const int col = q * 8; const bool z = (col < 256) ? !USE_A : (col < 512 ? !USE_B : !USE_C); if (z) o[q] = (u32x4){0u, 0u, 0u, 0u}; } }
            }
            SEAM(pb + 3);
        }
        if (IN(pb + 4)) for (int rep = 0; rep < ((l == 0 && DUP == 4) ? 2 : 1); ++rep) { if (rep) xcd_barrier(bar); refresh(F);
            const bf16_t* WB = (const bf16_t*)(WSB + WS_WBR_T + (size_t)l * 2 * MiB);
            pg8::StaticOrder S; S.init(NTOK, 1024, F.G, (int)blockIdx.x);
            { pg8::Gemm g{OCAT, WB, 1024, 1024, 1024, 128}; pg8::EpiBranchCat E{(unsigned char*)MERG, (const unsigned char*)(WSB + WS_MG8)}; pg8::gemm_phase<pg8::EpiBranchCat, pg8::StaticOrder>(F.lds, g, S, E, F.wave); }
            SEAM(pb + 4);
        }
        if (IN(pb + 5)) for (int rep = 0; rep < ((l == 0 && DUP == 5) ? 2 : 1); ++rep) { if (rep) xcd_barrier(bar); refresh(F);
            pg8::Gemm g{MERG, (const bf16_t*)(WSB + WS_WOUT_T + (size_t)l * 1024 * 1024), 512, 512, 512, 128}; pg8::StaticOrder S; S.init(NTOK, 1024, F.G, (int)blockIdx.x);
            pg8::EpiWout<(l > 0)> E{X1, (l == 0) ? (const void*)args.in[0] : (const void*)(WSB + WS_X2B), mod_a + 2048, 1.f / (F8_MG2 * F8_WO)};
            pg8::gemm_phase<pg8::EpiWout<(l > 0)>, pg8::StaticOrder, true>(F.lds, g, S, E, F.wave);
            SEAM(pb + 5);
        }
#define cnt ((unsigned*)(WSB + WS_CTL) + CW_CNT + l * 64)
        if (IN(pb + 6)) for (int rep = 0; rep < ((l == 0 && DUP == 6) ? 2 : 1); ++rep) { if (rep) xcd_barrier(bar); refresh(F); phase_ln1_router(F, X1, args.in[15] + l * 1024, args.in[16] + l * 1024, mod_f, args.in[19] + (size_t)l * 1024 * 32, args.in[20] + l * 32, HB, cnt); SEAM(pb + 6); }
        if (IN(pb + 7)) for (int rep = 0; rep < ((l == 0 && DUP == 7) ? 2 : 1); ++rep) { if (rep) xcd_barrier(bar); refresh(F); phase_gather(F, cnt, HB, (unsigned char*)(WSB + WS_HS8)); SEAM(pb + 7); }
        if (IN(pb + 8)) for (int rep = 0; rep < ((l == 0 && DUP == 8) ? 2 : 1); ++rep) { if (rep) xcd_barrier(bar); refresh(F);
            build_pstart(F, cnt);
            pg8::Gemm g{(const bf16_t*)(WSB + WS_HS8), (const bf16_t*)(WSB + WS_WGU_T + (size_t)l * 32 * 2048 * 1024), 512, 512, 512, 128};
            pg8::MoeOrder S{F.G, (int)blockIdx.x, 8, (int)F.MISC[48], (const volatile LAS int*)(F.MISC + 16)};
            pg8::EpiMoe1 E{(unsigned char*)(WSB + WS_ACT), args.in[22] + (size_t)l * 32 * 2048};
            pg8::gemm_phase<pg8::EpiMoe1, pg8::MoeOrder, true>(F.lds, g, S, E, F.wave);
            SEAM(pb + 8);
        }
        if (IN(pb + 9)) for (int rep = 0; rep < ((l == 0 && DUP == 9) ? 2 : 1); ++rep) { if (rep) xcd_barrier(bar); refresh(F);
            build_pstart(F, cnt);
            pg8::Gemm g{(const bf16_t*)(WSB + WS_ACT), (const bf16_t*)(WSB + WS_WDN_T + (size_t)l * 32 * 1024 * 1024), 512, 512, 512, 128};
            pg8::MoeOrder S{F.G, (int)blockIdx.x, 4, (int)F.MISC[48], (const volatile LAS int*)(F.MISC + 16)};
            pg8::EpiMoe2 E{(unsigned char*)(WSB + WS_HS), args.in[24] + (size_t)l * 32 * 1024};
            pg8::gemm_phase<pg8::EpiMoe2, pg8::MoeOrder, true>(F.lds, g, S, E, F.wave);
            SEAM(pb + 9);
        }
        if (IN(pb + 10)) for (int rep = 0; rep < ((l == 0 && DUP == 10) ? 2 : 1); ++rep) { if (rep) xcd_barrier(bar); refresh(F);
            phase_combine(F, (const unsigned char*)(WSB + WS_HS), X1, mod_f, args.in[25] + l * 1024, args.in[26] + l * 1024, args.out, (l + 1 < DEPTH) ? MOD + (size_t)(2 * l + 2) * 16 * 3072 : nullptr, HB, (unsigned char*)(WSB + WS_HB8), (bf16_t*)(WSB + WS_X2B));
            SEAM(pb + 10);
        }
}

__global__ void __launch_bounds__(512, 2) mega_fwd(Args args) {
    extern __shared__ __attribute__((aligned(16))) unsigned char lds_raw[];
    Frame F;
    F.lds = (LAS unsigned char*)lds_raw; F.MISC = (volatile LAS unsigned*)(F.lds + LDS_MISC);
    F.tid = threadIdx.x; F.lane = F.tid & 63; F.wave = __builtin_amdgcn_readfirstlane(F.tid >> 6); F.wave0 = F.wave;
    F.G = gridDim.x; F.gw = blockIdx.x * 8 + F.wave; F.NGW = F.G * 8;
    F.ws = args.ws; F.ws0 = args.ws; F.ctl = (unsigned*)(args.ws + WS_CTL); F.in = args.in; F.out = args.out;
    for (int u = F.tid; u < (LDS_BYTES - LDS_MISC) / 4; u += 512) F.MISC[u] = 0u;
    __syncthreads();
    XcdBarrier bar = xcd_barrier_post(F.ctl + CW_BAR + args.li * XCD_BAR_WORDS, F.MISC);
    const int lo = args.ph_lo, hi = args.ph_hi;
    if (IN(0)) for (int rep = 0; rep < (DUP == 100 ? 2 : 1); ++rep) { refresh(F); phase_prologue(F); SEAM(0); }
    if (IN(1)) { refresh(F); phase_h0(F, args.in[0], MOD, HB, (unsigned char*)(WSB + WS_HB8)); SEAM(1); }

    run_layer<0>(F, args, bar, lo, hi);
    run_layer<1>(F, args, bar, lo, hi);
#undef IN
#undef SEAM
#undef WSB
#undef PROJ
#undef HB
#undef OCAT
#undef MERG
#undef X1
#undef MOD
#undef xres
#undef mod_a
#undef mod_f
#undef cnt
}

constexpr int N_LAUNCHES = 1;
extern "C" void kernel_launch(void* const* d_in, const int* in_sizes, int n_in, void* d_out, int out_size, void* d_ws, size_t ws_size, hipStream_t stream) {
    static int grid = 0;
    if (grid == 0) {
        if (n_in != 27 || out_size != NTOK * D || ws_size < WS_END) { fprintf(stderr, "kernel_launch: unexpected sizes n_in %d out %d ws %zu (need %zu)\n", n_in, out_size, ws_size, (size_t)WS_END); grid = -1; return; }
        int dev = 0, cus = 0, per_cu = 0;
        if (hipGetDevice(&dev) != hipSuccess || hipDeviceGetAttribute(&cus, hipDeviceAttributeMultiprocessorCount, dev) != hipSuccess) { grid = -1; return; }
        if (hipFuncSetAttribute((const void*)mega_fwd, hipFuncAttributeMaxDynamicSharedMemorySize, LDS_BYTES) != hipSuccess) { fprintf(stderr, "kernel_launch: hipFuncSetAttribute failed\n"); grid = -1; return; }
        if (hipOccupancyMaxActiveBlocksPerMultiprocessor(&per_cu, (const void*)mega_fwd, 512, LDS_BYTES) != hipSuccess || per_cu < 1) fprintf(stderr, "kernel_launch: occupancy query says %d\n", per_cu);
        (void)hipGetLastError();
        grid = cus;
        if (grid != 256) { fprintf(stderr, "kernel_launch: built for 256 CUs, got %d\n", cus); grid = -1; return; }
    }
    if (grid < 0) return;
    (void)hipMemsetAsync((char*)d_ws + WS_CTL, 0, CTL_BYTES, stream);
    Args a{};
    for (int i = 0; i < 27; ++i) a.in[i] = (const float*)d_in[i];
    a.out = (float*)d_out; a.ws = (unsigned char*)d_ws; a.pad = 0;
    for (int li = 0; li < N_LAUNCHES; ++li) {
        a.ph_lo = (N_LAUNCHES == 1) ? 0 : li; a.ph_hi = (N_LAUNCHES == 1) ? N_PHASES : li + 1; a.li = li;
        hipLaunchKernelGGL(mega_fwd, dim3(grid), dim3(512), LDS_BYTES, stream, a);
    }
}
```

```cpp
#include <hip/hip_runtime.h>
#include <cstdio>
#include <cstdint>

#define GAS __attribute__((address_space(1)))
#define LAS __attribute__((address_space(3)))
typedef unsigned short bf16_t;
typedef short bf16x8 __attribute__((ext_vector_type(8)));
typedef short s16x4 __attribute__((ext_vector_type(4)));
typedef float f32x2 __attribute__((ext_vector_type(2)));
typedef float f32x4 __attribute__((ext_vector_type(4)));
typedef float f32x16 __attribute__((ext_vector_type(16)));
typedef unsigned u32x4 __attribute__((ext_vector_type(4)));
typedef unsigned u32x2 __attribute__((ext_vector_type(2)));
typedef unsigned long long u64;

constexpr bool USE_A = true, USE_B = true, USE_C = true;
constexpr bool A_DENSE = false; constexpr bool DSA_FAKE = false; constexpr bool F8_RECOMPUTE = false; constexpr int STAGGER_TICKS = 0; constexpr int PROBE_EPI = 0; constexpr int PROBE_KL = 0; constexpr int PROBE_CLK = 0; constexpr int PROBE_CLKMODE = 2;
constexpr int PROBE_ATT = 0;
constexpr int DUP = -1;
constexpr int NB = 16, SEQ = 4096, NTOK = NB * SEQ, D = 1024, DEPTH = 2, NEXP = 32;
constexpr int DP = 2816;
constexpr int D_IN = 5808;
constexpr int C_AQ = 0, C_AK = 256, C_AV = 320, C_IQ = 384, C_IK = 512, C_IW = 544, C_BG = 548, C_BQ = 576, C_BKV = 832, C_CQ = 1216, C_CK = 1728, C_CV = 2240, C_MG = 2752;
constexpr float LOG2E = 1.4426950408889634f;
constexpr float QS = 0.125f * LOG2E;
constexpr float IQS = 0.17677669529663687f;
constexpr float DN_ALPHA = 1.4142135623730951f;
constexpr float LN_EPS = 1e-5f;
constexpr int MOE_ROWS = NTOK * 4 + NEXP * 256;
constexpr float F8_WGU = 256.f, F8_WDN = 512.f, F8_H = 4.f, F8_ACT = 4.f, F8_WIN = 256.f, F8_Y = 16.f, F8_MG2 = 16.f, F8_WO = 512.f, F8_OC = 16.f, F8_WB = 128.f;
constexpr int N_BF = 2816, N_F8 = 3072;

constexpr size_t MiB = 1u << 20;
constexpr size_t WS_CTL = 0, CTL_BYTES = 1 * MiB;
constexpr size_t WS_MOD = 1 * MiB;
constexpr size_t WS_BIAS1 = WS_MOD + 4 * 16 * 3072 * 4;
constexpr size_t WS_LUT = WS_BIAS1 + 4096;
constexpr size_t WS_LAM = WS_LUT + 8192;
constexpr size_t WS_TOKE = 2 * MiB;
constexpr size_t WS_TOKW = 3 * MiB;
constexpr size_t WS_TOKP = 4 * MiB;
constexpr size_t WS_TOKR = 5 * MiB;
constexpr size_t WS_KCMP = 6 * MiB;
constexpr size_t WS_WIN_T = 8 * MiB;
constexpr size_t WS_WBR_T = 31 * MiB;
constexpr size_t WS_WOUT_T = 35 * MiB;
constexpr size_t WS_W1_T = 39 * MiB;
constexpr size_t WS_W2_T = 43 * MiB;
constexpr size_t WS_WGU_T = 44 * MiB;
constexpr size_t WS_WDN_T = 300 * MiB;
constexpr size_t WS_WMG8 = 172 * MiB;
constexpr size_t WS_HB8 = 364 * MiB;
constexpr size_t WS_X1 = 428 * MiB;
constexpr size_t WS_X2B = 556 * MiB;
constexpr size_t WS_HB = 684 * MiB;
constexpr size_t WS_HID = 812 * MiB;
constexpr size_t WS_BIG = 820 * MiB;
constexpr size_t WS_PROJ = WS_BIG;
constexpr size_t WS_MG8 = WS_BIG + 353 * MiB;
constexpr size_t WS_OCAT = WS_BIG + 737 * MiB;
constexpr size_t WS_MERG = WS_OCAT + 128 * MiB;
constexpr size_t WS_BM64 = WS_MERG + 128 * MiB;
constexpr size_t WS_HS = WS_BIG;
constexpr size_t WS_HS8 = WS_BIG + 792 * MiB;
constexpr size_t WS_ACT = WS_BIG + 528 * MiB;
constexpr size_t WS_END = WS_BIG + 1056 * MiB;
static_assert((size_t)(NTOK + 32) * DP * 2 <= 353 * MiB, "proj");
static_assert((size_t)MOE_ROWS * 1024 * 2 <= 528 * MiB, "moe rows");
static_assert(WS_BM64 + 32 * MiB <= WS_END, "ws");
constexpr int CW_CNT = 1024;
constexpr int CW_BAR = 4096;

constexpr int LDS_MISC = 147456;
constexpr int LDS_BYTES = 151552;

#define LDS_WAIT() asm volatile("s_waitcnt lgkmcnt(0)" ::: "memory")
#define VM_WAIT() do { __builtin_amdgcn_s_waitcnt(0x0F70); asm volatile("" ::: "memory"); } while (0)

__device__ __forceinline__ unsigned f2bf(float f) { unsigned u = __builtin_bit_cast(unsigned, f); return (u + 0x7fffu + ((u >> 16) & 1u)) >> 16; }
__device__ __forceinline__ unsigned pk2(float lo, float hi) { return f2bf(lo) | (f2bf(hi) << 16); }
__device__ __forceinline__ float bf2f(unsigned short b) { return __builtin_bit_cast(float, (unsigned)b << 16); }
__device__ __forceinline__ float bflo(unsigned w) { return __builtin_bit_cast(float, w << 16); }
__device__ __forceinline__ float bfhi(unsigned w) { return __builtin_bit_cast(float, w & 0xffff0000u); }
typedef __bf16 bf16x2_t __attribute__((ext_vector_type(2)));
__device__ __forceinline__ unsigned cvt_pk_bf16(float lo, float hi) { return __builtin_bit_cast(unsigned, __builtin_convertvector((f32x2){lo, hi}, bf16x2_t)); }
__device__ __forceinline__ unsigned pk4_fp8(float a, float b, float c, float d) { int r = 0; r = __builtin_amdgcn_cvt_pk_fp8_f32(a, b, r, false); r = __builtin_amdgcn_cvt_pk_fp8_f32(c, d, r, true); return (unsigned)r; }
__device__ __forceinline__ void fp8x8_f32(u32x2 w, float (&f)[8]) { const f32x2 a = __builtin_amdgcn_cvt_pk_f32_fp8((int)w.x, false), b = __builtin_amdgcn_cvt_pk_f32_fp8((int)w.x, true), c = __builtin_amdgcn_cvt_pk_f32_fp8((int)w.y, false), d = __builtin_amdgcn_cvt_pk_f32_fp8((int)w.y, true);
    f[0] = a.x; f[1] = a.y; f[2] = b.x; f[3] = b.y; f[4] = c.x; f[5] = c.y; f[6] = d.x; f[7] = d.y; }
__device__ __forceinline__ float fexp2(float x) { return __builtin_amdgcn_exp2f(x); }
__device__ __forceinline__ float frcp(float x) { return __builtin_amdgcn_rcpf(x); }
__device__ __forceinline__ float fsigmoid(float x) { return frcp(1.f + fexp2(-LOG2E * x)); }
__device__ __forceinline__ float gelu_tanh(float x) { const float u = 0.7978845608028654f * (x + 0.044715f * x * x * x); return x * fsigmoid(2.f * u); }
__device__ __forceinline__ int bperm_i(int idx, int v) { return __builtin_amdgcn_ds_bpermute(idx << 2, v); }
__device__ __forceinline__ float bperm_f(int idx, float v) { return __builtin_bit_cast(float, __builtin_amdgcn_ds_bpermute(idx << 2, __builtin_bit_cast(int, v))); }
__device__ __forceinline__ float other32(float v, int lane) { return bperm_f(lane ^ 32, v); }
__device__ __forceinline__ float sum32(float v, int lane) { return v + bperm_f(lane ^ 32, v); }
__device__ __forceinline__ float max32(float v, int lane) { return fmaxf(v, bperm_f(lane ^ 32, v)); }
__device__ __forceinline__ float shx_f(float v, int mask, int lane) { return bperm_f(lane ^ mask, v); }
__device__ __forceinline__ int shx_i(int v, int mask, int lane) { return bperm_i(lane ^ mask, v); }
template <int CTRL> __device__ __forceinline__ float dpp_f(float v) { return __builtin_bit_cast(float, __builtin_amdgcn_update_dpp(0, __builtin_bit_cast(int, v), CTRL, 0xF, 0xF, true)); }
__device__ __forceinline__ float wave_sum(float v, int lane) {
    v += dpp_f<0xB1>(v); v += dpp_f<0x4E>(v); v += dpp_f<0x141>(v); v += dpp_f<0x140>(v);
    v += __builtin_bit_cast(float, __builtin_amdgcn_update_dpp(0, __builtin_bit_cast(int, v), 0x142, 0xA, 0xF, false));
    v += __builtin_bit_cast(float, __builtin_amdgcn_update_dpp(0, __builtin_bit_cast(int, v), 0x143, 0xC, 0xF, false));
    return __builtin_bit_cast(float, __builtin_amdgcn_readlane(__builtin_bit_cast(int, v), 63));
}
__device__ __forceinline__ float wave_max(float v) {
    v = fmaxf(v, dpp_f<0xB1>(v)); v = fmaxf(v, dpp_f<0x4E>(v)); v = fmaxf(v, dpp_f<0x141>(v)); v = fmaxf(v, dpp_f<0x140>(v));
    const int vi = __builtin_bit_cast(int, v);
    v = fmaxf(v, __builtin_bit_cast(float, __builtin_amdgcn_update_dpp(vi, vi, 0x142, 0xA, 0xF, false)));
    const int vj = __builtin_bit_cast(int, v);
    v = fmaxf(v, __builtin_bit_cast(float, __builtin_amdgcn_update_dpp(vj, vj, 0x143, 0xC, 0xF, false)));
    return __builtin_bit_cast(float, __builtin_amdgcn_readlane(__builtin_bit_cast(int, v), 63));
}

#define XB_TMO      128
#define XB_XCNT(j)  (256  + 64 * (j))
#define XB_XSUB(j)  (1280 + 64 * (j))
#define XB_XGEN(j)  (2304 + 64 * (j))
#define XB_TOP      3328
#define XB_TOPGEN   3392
#define XCD_BAR_WORDS 3456
#define XB_SPIN_CAP (1u << 18)

__device__ __forceinline__ unsigned xb_ld(unsigned* p)              { return __hip_atomic_load(p, __ATOMIC_RELAXED, __HIP_MEMORY_SCOPE_AGENT); }
__device__ __forceinline__ unsigned xb_add(unsigned* p, unsigned v) { return __hip_atomic_fetch_add(p, v, __ATOMIC_RELAXED, __HIP_MEMORY_SCOPE_AGENT); }
__device__ __forceinline__ unsigned xb_xcc_id() { return (unsigned)__builtin_amdgcn_s_getreg((3 << 11) | 20) & 0xFu; }
#define XB_SPIN(cond, bar) do { unsigned _sp = 0; while (cond) { __builtin_amdgcn_s_sleep(1); \
    if ((++_sp & 255u) == 0u) { if (xb_ld(&(bar)[XB_TMO])) break; if (_sp > XB_SPIN_CAP) { atomicAdd(&(bar)[XB_TMO], 1u); break; } } } } while (0)

struct XcdBarrier { unsigned* bar; unsigned x; volatile LAS unsigned* st; };

__device__ __forceinline__ XcdBarrier xcd_barrier_post(unsigned* bar, volatile LAS unsigned* st) {
    XcdBarrier b; b.bar = bar; b.x = xb_xcc_id(); b.st = st;
    if (threadIdx.x == 0) (void)xb_add(&bar[XB_XCNT(b.x)], 1u);
    return b;
}
__device__ __forceinline__ void xcd_barrier_complete(unsigned* bar, unsigned x, unsigned& nloc, unsigned& nx) {
    const unsigned G = gridDim.x * gridDim.y * gridDim.z;
    unsigned sum, cnt, mine, sp = 0u;
    for (;;) {
        sum = 0u; cnt = 0u; mine = 0u;
#pragma unroll
        for (unsigned j = 0; j < 16; ++j) { const unsigned c = xb_ld(&bar[XB_XCNT(j)]); sum += c; cnt += (c > 0u) ? 1u : 0u; mine = (j == x) ? c : mine; }
        if (sum == G) break;
        __builtin_amdgcn_s_sleep(1);
        if ((++sp & 255u) == 0u) { if (xb_ld(&bar[XB_TMO])) break; if (sp > XB_SPIN_CAP) { atomicAdd(&bar[XB_TMO], 1u); break; } }
    }
    nloc = mine > 0u ? mine : 1u; nx = cnt > 0u ? cnt : 1u;
}
__device__ __forceinline__ void xcd_barrier(const XcdBarrier& b) {
    asm volatile("s_waitcnt vmcnt(0)" ::: "memory");
    __syncthreads();
    if (threadIdx.x == 0) {
        unsigned* bar = b.bar;
        __builtin_amdgcn_s_waitcnt(0);
        unsigned nloc = b.st[0], nx = b.st[1];
        if (nloc == 0u) { xcd_barrier_complete(bar, b.x, nloc, nx); b.st[0] = nloc; b.st[1] = nx; }
        const unsigned old = xb_add(&bar[XB_XSUB(b.x)], 1u);
        const unsigned gen = old / nloc;
        if (old + 1u == (gen + 1u) * nloc) {
            __builtin_amdgcn_fence(__ATOMIC_RELEASE, "agent");
            asm volatile("s_waitcnt vmcnt(0)" ::: "memory");
            const unsigned og = xb_add(&bar[XB_TOP], 1u);
            const unsigned tg = og / nx;
            if (og + 1u == (tg + 1u) * nx) xb_add(&bar[XB_TOPGEN], 1u);
            else XB_SPIN(xb_ld(&bar[XB_TOPGEN]) == tg, bar);
            __builtin_amdgcn_fence(__ATOMIC_ACQUIRE, "agent");
            xb_add(&bar[XB_XGEN(b.x)], 1u);
            asm volatile("s_waitcnt vmcnt(0)" ::: "memory");
        } else {
            XB_SPIN(xb_ld(&bar[XB_XGEN(b.x)]) == gen, bar);
            __builtin_amdgcn_fence(__ATOMIC_ACQUIRE, "agent");
            asm volatile("s_waitcnt vmcnt(0)" ::: "memory");
        }
    }
    __syncthreads();
}

__device__ __forceinline__ int fresh_tid(int wave_s) {
    unsigned ones = ~0u; asm volatile("" : "+s"(ones));
    int ln = (int)__builtin_amdgcn_mbcnt_hi(ones, __builtin_amdgcn_mbcnt_lo(ones, 0u)); asm volatile("" : "+v"(ln));
    return wave_s * 64 + ln;
}

namespace pg8 {
typedef int v4i_t __attribute__((ext_vector_type(4)));
typedef int v8i_t __attribute__((ext_vector_type(8)));
constexpr int BM = 256, BK = 64, HALF = 128, HTB = HALF * BK * 2, STAGE_BYTES = 8 * HTB, NXCD = 8, WGM = 8;
__device__ __forceinline__ int lds_byte(int r, int c) { const int st = (r >> 4) * 2 + (c >> 5), rr = r & 15, cc = c & 31, ob = rr * 64 + cc * 2; return st * 1024 + (ob ^ (((ob >> 9) & 1) << 5)); }
__device__ __forceinline__ void stage_rc(int b, int& R, int& C) { const int st = b / 1024, sb = b % 1024, swz = sb ^ (((sb >> 9) & 1) << 5); R = (st >> 1) * 16 + swz / 64; C = (st & 1) * 32 + (swz % 64) / 2; }
__device__ __forceinline__ int perm32(int rho) { const int n = rho >> 4, i = rho & 15; return 8 * (i >> 2) + 4 * n + (i & 3); }

struct Unit { int pm, pn; };
struct Gemm { const bf16_t* A; const bf16_t* Bt; int lda, ldb, K, kstepA; };

struct StaticOrder {
    int nM, nN, nwg, G, c;
    __device__ void init(int M, int N, int G_, int c_) { nM = M / BM; nN = N / BM; nwg = nM * nN; G = G_; c = c_; }
    __device__ bool next(int i, Unit& u) const {
        const long L = (long)i * G + c; if (L >= nwg) return false;
        int wgid = (int)L; { const int q = nwg / NXCD, r = nwg % NXCD, xcd = wgid % NXCD, off = wgid / NXCD; wgid = (xcd < r ? xcd * (q + 1) : r * (q + 1) + (xcd - r) * q) + off; }
        const int nig = WGM * nN, gid = wgid / nig, fm = gid * WGM, gsz = (nM - fm) < WGM ? (nM - fm) : WGM;
        u.pm = fm + ((wgid % nig) % gsz); u.pn = (wgid % nig) / gsz; return true;
    }
    __device__ __forceinline__ const char* a_ptr(const Gemm& g, const Unit& u) const { return (const char*)g.A + (size_t)u.pm * (size_t)(BM * 2) * g.lda; }
    __device__ __forceinline__ const char* b_ptr(const Gemm& g, const Unit& u) const { return (const char*)g.Bt + (size_t)u.pn * (size_t)(BM * 2) * g.ldb; }
};
struct CmpOrder {
    int G, c;
    __device__ bool next(int i, Unit& u) const { const int L = i * G + c; if (L >= 32) return false; u.pn = L >> 4; u.pm = L & 15; return true; }
    __device__ __forceinline__ const char* a_ptr(const Gemm& g, const Unit& u) const { return (const char*)g.A + (size_t)u.pm * (size_t)(BM * 2) * g.lda + u.pn * 128; }
    __device__ __forceinline__ const char* b_ptr(const Gemm& g, const Unit& u) const { return (const char*)g.Bt + (size_t)u.pn * (size_t)(BM * 2) * g.ldb; }
};
struct MoeOrder {
    int G, c, NT, npan; const volatile LAS int* pstart;
    __device__ bool next(int i, Unit& u) const {
        const int ppx = (256 / NT) / 8, x = c & 7, r = c >> 3;
        const int p = i * (256 / NT) + x * ppx + (r % ppx), n = r / ppx; if (p >= npan) return false;
        const int ln = (int)__builtin_amdgcn_mbcnt_hi(~0u, __builtin_amdgcn_mbcnt_lo(~0u, 0u));
        const int ps = pstart[ln & 31];
        const int e = __popcll(__ballot(ln >= 1 && ln < 32 && ps <= p));
        u.pm = p; u.pn = e * NT + n; return true;
    }
    __device__ __forceinline__ const char* a_ptr(const Gemm& g, const Unit& u) const { return (const char*)g.A + (size_t)u.pm * (size_t)(BM * 2) * g.lda; }
    __device__ __forceinline__ const char* b_ptr(const Gemm& g, const Unit& u) const { return (const char*)g.Bt + (size_t)u.pn * (size_t)(BM * 2) * g.ldb; }
};

#define EPI_LOOP_AI_M  _Pragma("unroll") for (int ai = 0; ai < 2; ++ai) _Pragma("unroll") for (int m = 0; m < 4; ++m)

struct EpiProj {
    static constexpr bool PERM = true; static constexpr int CLKID = 0; static constexpr int NST = 16;
    bf16_t* O; int colbase; float scl;
    __device__ __forceinline__ void operator()(const f32x4 (&acc)[2][2][4][2], const Unit& u, int wr, int wc, int fr, int fq) const {
        const int row0 = u.pm * BM + wr * 64 + fr, col0 = colbase + u.pn * BM + wc * 32 + 8 * fq;
        EPI_LOOP_AI_M { bf16_t* rowp = O + (size_t)(row0 + ai * HALF + m * 16) * DP + col0;
#pragma unroll
            for (int bj = 0; bj < 2; ++bj) { const f32x4 v0 = acc[ai][bj][m][0] * scl, v1 = acc[ai][bj][m][1] * scl;
                u32x4 w; w.x = cvt_pk_bf16(v0[0], v0[1]); w.y = cvt_pk_bf16(v0[2], v0[3]); w.z = cvt_pk_bf16(v1[0], v1[1]); w.w = cvt_pk_bf16(v1[2], v1[3]);
                *(u32x4*)(rowp + bj * HALF) = w; } }
    }
};
struct EpiGate8 {
    static constexpr bool PERM = true; static constexpr int CLKID = 0; static constexpr int NST = 16;
    unsigned char* O; float scl;
    __device__ __forceinline__ void operator()(const f32x4 (&acc)[2][2][4][2], const Unit& u, int wr, int wc, int fr, int fq) const {
        const int row0 = u.pm * BM + wr * 64 + fr, col0 = u.pn * BM + wc * 32 + 8 * fq;
        EPI_LOOP_AI_M { unsigned char* rowp = O + (size_t)(row0 + ai * HALF + m * 16) * 3072 + col0;
#pragma unroll
            for (int bj = 0; bj < 2; ++bj) { const f32x4 v0 = acc[ai][bj][m][0] * scl, v1 = acc[ai][bj][m][1] * scl;
                *(u32x2*)(rowp + bj * HALF) = (u32x2){pk4_fp8(v0[0], v0[1], v0[2], v0[3]), pk4_fp8(v1[0], v1[1], v1[2], v1[3])}; } }
    }
};
struct EpiCmp1 {
    static constexpr bool PERM = true; static constexpr int CLKID = 0; static constexpr int NST = 16;
    bf16_t* O; const float* bias;
    __device__ __forceinline__ void operator()(const f32x4 (&acc)[2][2][4][2], const Unit& u, int wr, int wc, int fr, int fq) const {
        const int row0 = u.pm * BM + wr * 64 + fr, col0 = wc * 32 + 8 * fq; const int j = u.pn;
        f32x4 bv[2][2];
#pragma unroll
        for (int bj = 0; bj < 2; ++bj)
#pragma unroll
            for (int n = 0; n < 2; ++n) bv[bj][n] = *(const f32x4*)(bias + j * 256 + col0 + bj * HALF + 4 * n);
        EPI_LOOP_AI_M { bf16_t* rowp = O + ((size_t)j * 4096 + row0 + ai * HALF + m * 16) * 256 + col0;
#pragma unroll
            for (int bj = 0; bj < 2; ++bj) { f32x4 v0 = acc[ai][bj][m][0] + bv[bj][0], v1 = acc[ai][bj][m][1] + bv[bj][1];
#pragma unroll
                for (int q = 0; q < 4; ++q) { v0[q] = gelu_tanh(v0[q]); v1[q] = gelu_tanh(v1[q]); }
                u32x4 w; w.x = cvt_pk_bf16(v0[0], v0[1]); w.y = cvt_pk_bf16(v0[2], v0[3]); w.z = cvt_pk_bf16(v1[0], v1[1]); w.w = cvt_pk_bf16(v1[2], v1[3]);
                *(u32x4*)(rowp + bj * HALF) = w; } }
    }
};
__device__ __forceinline__ float sig_ratio(float a, float b) { return (1.f + fexp2(-LOG2E * b)) * frcp(1.f + fexp2(-LOG2E * a)); }
struct EpiBranchCat {
    static constexpr bool PERM = true, MID = true; static constexpr int CLKID = 0; static constexpr int NST = 8;
    unsigned char* MG; const unsigned char* G8;
    __device__ __forceinline__ void mid(f32x4 (&acc)[2][2][4][2], const Unit& u, int wr, int wc, int fr, int fq, int seg) const {
        const int row0 = u.pm * BM + wr * 64 + fr, col0 = u.pn * BM + wc * 32 + 8 * fq;
#pragma unroll
        for (int ai = 0; ai < 2; ++ai) {
            u32x2 ga[4][2], gb[4][2];
#pragma unroll
            for (int m = 0; m < 4; ++m) { const size_t row = (size_t)(row0 + ai * HALF + m * 16);
#pragma unroll
                for (int bj = 0; bj < 2; ++bj) { const unsigned char* gp = G8 + row * 3072 + seg * 1024 + col0 + bj * HALF; ga[m][bj] = *(const u32x2*)gp; gb[m][bj] = *(const u32x2*)(gp + 1024); } }
#pragma unroll
            for (int m = 0; m < 4; ++m)
#pragma unroll
                for (int bj = 0; bj < 2; ++bj) { float a[8], b[8]; fp8x8_f32(ga[m][bj], a); fp8x8_f32(gb[m][bj], b); f32x4& v0 = acc[ai][bj][m][0]; f32x4& v1 = acc[ai][bj][m][1];
#pragma unroll
                    for (int q = 0; q < 4; ++q) { v0[q] *= sig_ratio(a[q], b[q]); v1[q] *= sig_ratio(a[4 + q], b[4 + q]); } }
        }
    }
    __device__ __forceinline__ void operator()(const f32x4 (&acc)[2][2][4][2], const Unit& u, int wr, int wc, int fr, int fq) const {
        const int row0 = u.pm * BM + wr * 64 + fr, col0 = u.pn * BM + wc * 32 + 8 * fq;
#pragma unroll
        for (int ai = 0; ai < 2; ++ai) {
            u32x2 gq[4][2];
#pragma unroll
            for (int m = 0; m < 4; ++m) { const size_t row = (size_t)(row0 + ai * HALF + m * 16);
#pragma unroll
                for (int bj = 0; bj < 2; ++bj) gq[m][bj] = *(const u32x2*)(G8 + row * 3072 + 2 * 1024 + col0 + bj * HALF); }
#pragma unroll
            for (int m = 0; m < 4; ++m) { const size_t row = (size_t)(row0 + ai * HALF + m * 16);
#pragma unroll
                for (int bj = 0; bj < 2; ++bj) { float g[8]; fp8x8_f32(gq[m][bj], g); f32x4 v0 = acc[ai][bj][m][0], v1 = acc[ai][bj][m][1];
#pragma unroll
                    for (int q = 0; q < 4; ++q) { v0[q] *= (F8_MG2 / (F8_OC * F8_WB)) * fsigmoid(g[q]); v1[q] *= (F8_MG2 / (F8_OC * F8_WB)) * fsigmoid(g[4 + q]); }
                    *(u32x2*)(MG + row * 1024 + col0 + bj * HALF) = (u32x2){pk4_fp8(v0[0], v0[1], v0[2], v0[3]), pk4_fp8(v1[0], v1[1], v1[2], v1[3])}; } }
        }
    }
};
template <bool XBF> struct EpiWout {
    static constexpr bool PERM = true; static constexpr int CLKID = 2; static constexpr int NST = 8;
    bf16_t* Z; const void* XR; const float* gate; float asc;
    __device__ __forceinline__ void operator()(const f32x4 (&acc)[2][2][4][2], const Unit& u, int wr, int wc, int fr, int fq) const {
        const int row0 = u.pm * BM + wr * 64 + fr, col0 = u.pn * BM + wc * 32 + 8 * fq;
        const int b = (u.pm * BM) >> 12;
        f32x4 gv[2][2];
#pragma unroll
        for (int bj = 0; bj < 2; ++bj)
#pragma unroll
            for (int n = 0; n < 2; ++n) gv[bj][n] = (*(const f32x4*)(gate + (size_t)b * 3072 + col0 + bj * HALF + 4 * n) + 1.0f) * asc;
#pragma unroll
        for (int ai = 0; ai < 2; ++ai) {
            f32x4 xr[4][2][2];
#pragma unroll
            for (int m = 0; m < 4; ++m) { const size_t ro = (size_t)(row0 + ai * HALF + m * 16) * 1024 + col0;
#pragma unroll
                for (int bj = 0; bj < 2; ++bj) {
                    if (XBF) { const u32x4 q = *(const u32x4*)((const bf16_t*)XR + ro + bj * HALF);
                        xr[m][bj][0] = (f32x4){bflo(q.x), bfhi(q.x), bflo(q.y), bfhi(q.y)}; xr[m][bj][1] = (f32x4){bflo(q.z), bfhi(q.z), bflo(q.w), bfhi(q.w)}; }
                    else { xr[m][bj][0] = *(const f32x4*)((const float*)XR + ro + bj * HALF); xr[m][bj][1] = *(const f32x4*)((const float*)XR + ro + bj * HALF + 4); } } }
            asm volatile("" ::: "memory");
#pragma unroll
            for (int m = 0; m < 4; ++m) { const size_t ro = (size_t)(row0 + ai * HALF + m * 16) * 1024 + col0;
#pragma unroll
                for (int bj = 0; bj < 2; ++bj) { const f32x4 v0 = xr[m][bj][0] * DN_ALPHA + gv[bj][0] * acc[ai][bj][m][0], v1 = xr[m][bj][1] * DN_ALPHA + gv[bj][1] * acc[ai][bj][m][1];
                    u32x4 w; w.x = cvt_pk_bf16(v0[0], v0[1]); w.y = cvt_pk_bf16(v0[2], v0[3]); w.z = cvt_pk_bf16(v1[0], v1[1]); w.w = cvt_pk_bf16(v1[2], v1[3]);
                    *(u32x4*)(Z + ro + bj * HALF) = w; } }
            asm volatile("" ::: "memory");
        }
    }
};
__device__ __forceinline__ float swiglu(float g, float u) { const float gg = __builtin_amdgcn_fmed3f(g, -__builtin_inff(), 7.f), uu = __builtin_amdgcn_fmed3f(u, -7.f, 7.f); return (uu + 1.f) * gg * fsigmoid(1.702f * gg); }
struct EpiMoe1 {       static constexpr int CLKID = 1; static constexpr int NST = 16;
    static constexpr bool PERM = true;
    unsigned char* O; const float* bias;
    __device__ __forceinline__ void operator()(const f32x4 (&acc)[2][2][4][2], const Unit& u, int wr, int wc, int fr, int fq) const {
        const int row0 = u.pm * BM + wr * 64 + fr; const int e = u.pn >> 3, n8 = u.pn & 7; const int cg0 = n8 * BM + wc * 32 + 8 * fq;
        constexpr float isc = 1.f / (F8_H * F8_WGU);
        f32x4 bv[2][2];
#pragma unroll
        for (int bj = 0; bj < 2; ++bj)
#pragma unroll
            for (int n = 0; n < 2; ++n) bv[bj][n] = *(const f32x4*)(bias + (size_t)e * 2048 + cg0 + bj * HALF + 4 * n);
        EPI_LOOP_AI_M { unsigned char* rowp = O + (size_t)(row0 + ai * HALF + m * 16) * 1024 + (cg0 >> 1);
#pragma unroll
            for (int bj = 0; bj < 2; ++bj) { const f32x4 v0 = acc[ai][bj][m][0] * isc + bv[bj][0], v1 = acc[ai][bj][m][1] * isc + bv[bj][1];
                *(unsigned*)(rowp + bj * (HALF / 2)) = pk4_fp8(F8_ACT * swiglu(v0[0], v0[1]), F8_ACT * swiglu(v0[2], v0[3]), F8_ACT * swiglu(v1[0], v1[1]), F8_ACT * swiglu(v1[2], v1[3])); } }
    }
};
struct EpiMoe2 {
    static constexpr bool PERM = true; static constexpr int CLKID = 0; static constexpr int NST = 16;
    unsigned char* O; const float* bias;
    __device__ __forceinline__ void operator()(const f32x4 (&acc)[2][2][4][2], const Unit& u, int wr, int wc, int fr, int fq) const {
        const int row0 = u.pm * BM + wr * 64 + fr; const int e = u.pn >> 2, n4 = u.pn & 3; const int c0 = n4 * BM + wc * 32 + 8 * fq;
        constexpr float isc = F8_Y / (F8_ACT * F8_WDN);
        f32x4 bv[2][2];
#pragma unroll
        for (int bj = 0; bj < 2; ++bj)
#pragma unroll
            for (int n = 0; n < 2; ++n) bv[bj][n] = *(const f32x4*)(bias + (size_t)e * 1024 + c0 + bj * HALF + 4 * n) * F8_Y;
        EPI_LOOP_AI_M { unsigned char* rowp = O + (size_t)(row0 + ai * HALF + m * 16) * 1024 + c0;
#pragma unroll
            for (int bj = 0; bj < 2; ++bj) { const f32x4 v0 = acc[ai][bj][m][0] * isc + bv[bj][0], v1 = acc[ai][bj][m][1] * isc + bv[bj][1];
                *(u32x2*)(rowp + bj * HALF) = (u32x2){pk4_fp8(v0[0], v0[1], v0[2], v0[3]), pk4_fp8(v1[0], v1[1], v1[2], v1[3])}; } }
    }
};

__device__ __forceinline__ unsigned stage_voff(int tid, int i, int ld, bool perm) {
    int t = tid; asm volatile("" : "+v"(t));
    int R, C; stage_rc(t * 16 + i * 8192, R, C); const int Rb = perm ? ((R & ~31) + perm32(R & 31)) : R;
    return (unsigned)(Rb * ld + C) * 2u;
}
template <class T, class = void> struct has_mid { static constexpr bool value = false; };
template <class T> struct has_mid<T, decltype((void)T::MID)> { static constexpr bool value = T::MID; };
template <class Epi, class Sched, bool FP8 = false>
__device__ __forceinline__ void gemm_phase(LAS unsigned char* lds, const Gemm g, const Sched& S, const Epi& E, int wave_s) {
    const int tid = fresh_tid(wave_s), wid = wave_s, lane = tid & 63, wr = wid >> 2, wc = wid & 3, fr = lane & 15, fq = lane >> 4;
    const int K = g.K, nt = K / BK;
    unsigned voffA[2], voffB[2];
#pragma unroll
    for (int i = 0; i < 2; ++i) { int R, C; stage_rc(tid * 16 + i * 8192, R, C); const int Rb = Epi::PERM ? ((R & ~31) + perm32(R & 31)) : R;
        voffA[i] = (unsigned)(R * g.lda + C) * 2u; voffB[i] = (unsigned)(Rb * g.ldb + C) * 2u; }
    const size_t kstepA = (size_t)g.kstepA, kstepB = (size_t)(BK * 2);
    const size_t hstepA = (size_t)HALF * g.lda * 2, hstepB = (size_t)HALF * g.ldb * 2;
    const unsigned ldsw = (unsigned)wid * 1024u;
    const int aoff = lds_byte(wr * 64 + fr, fq * 8), boff = lds_byte(wc * 32 + fr, fq * 8);
#define PG8_SA(b, h) (((b) * 2 + (h)) * HTB)
#define PG8_SB(b, h) ((4 + (b) * 2 + (h)) * HTB)
#define PG8_VOFF(voff, _i) ((FP8 && F8_RECOMPUTE) ? stage_voff(tid, _i, (voff) == voffA ? g.lda : g.ldb, (voff) == voffB && Epi::PERM) : (voff)[_i])
#define PG8_STAGE(bufoff, gbase, voff) do { const char* _gb = (const char*)(gbase); asm volatile("" : "+s"(_gb));   \
        _Pragma("unroll") for (int _i = 0; _i < 2; ++_i) { unsigned _vo = PG8_VOFF(voff, _i); asm volatile("" : "+v"(_vo));   \
        __builtin_amdgcn_global_load_lds((const unsigned*)(_gb + _vo), (LAS unsigned*)(lds + (bufoff) + ldsw + _i * 8192), 16, 0, 0); } } while (0)
    const LAS unsigned char* aB = lds + aoff; asm volatile("" : "+v"(aB));
    const LAS unsigned char* bB = lds + 4 * HTB + boff; asm volatile("" : "+v"(bB));
#define PG8_RDA(off) (*(const LAS v4i_t*)(aB + (off)))
#define PG8_RDB(off) (*(const LAS v4i_t*)(bB + (off)))
#define PG8_LDA(dst, b, h) do { _Pragma("unroll") for (int m = 0; m < 4; ++m) dst[m] = __builtin_shufflevector(PG8_RDA(((b) * 2 + (h)) * HTB + m * 2048), PG8_RDA(((b) * 2 + (h)) * HTB + m * 2048 + 1024), 0, 1, 2, 3, 4, 5, 6, 7); } while (0)
#define PG8_LDB(dst, b, h) do { _Pragma("unroll") for (int n = 0; n < 2; ++n) dst[n] = __builtin_shufflevector(PG8_RDB(((b) * 2 + (h)) * HTB + n * 2048), PG8_RDB(((b) * 2 + (h)) * HTB + n * 2048 + 1024), 0, 1, 2, 3, 4, 5, 6, 7); } while (0)
#define PG8_LO(x) __builtin_bit_cast(bf16x8, __builtin_shufflevector(x, x, 0, 1, 2, 3))
#define PG8_HI(x) __builtin_bit_cast(bf16x8, __builtin_shufflevector(x, x, 4, 5, 6, 7))
#define PG8_MMA(ai, bj, At, Bt) do { __builtin_amdgcn_s_setprio(1); _Pragma("unroll") for (int m = 0; m < 4; ++m) _Pragma("unroll") for (int n = 0; n < 2; ++n) { \
        if (FP8) acc[ai][bj][m][n] = __builtin_amdgcn_mfma_scale_f32_16x16x128_f8f6f4(Bt[n], At[m], acc[ai][bj][m][n], 0, 0, 0, 0, 0, 0); \
        else { acc[ai][bj][m][n] = __builtin_amdgcn_mfma_f32_16x16x32_bf16(PG8_LO(Bt[n]), PG8_LO(At[m]), acc[ai][bj][m][n], 0, 0, 0); \
               acc[ai][bj][m][n] = __builtin_amdgcn_mfma_f32_16x16x32_bf16(PG8_HI(Bt[n]), PG8_HI(At[m]), acc[ai][bj][m][n], 0, 0, 0); } } \
        __builtin_amdgcn_s_setprio(0); } while (0)
#define PG8_WAIT_V(n) asm volatile("s_waitcnt vmcnt(" #n ")" ::: "memory")
#define PG8_WAIT_L(n) asm volatile("s_waitcnt lgkmcnt(" #n ")" ::: "memory")
#define PG8_WAIT_V6R do { if (relax) asm volatile("s_waitcnt vmcnt(%0)" :: "n"(6 + Epi::NST) : "memory"); else PG8_WAIT_V(6); } while (0)
#define PG8_BAR __builtin_amdgcn_s_barrier()
#define PG8_SCHED __builtin_amdgcn_sched_barrier(0)
    Unit cur, nxt; int ui = 0; unsigned long long clk_sum = 0; unsigned clk_n = 0;
    if (!S.next(0, cur)) return;
    if (STAGGER_TICKS > 0 && ((blockIdx.x >> 3) & 1)) {
        const unsigned long long r0 = __builtin_amdgcn_s_memrealtime(); while (__builtin_amdgcn_s_memrealtime() - r0 < (unsigned long long)STAGGER_TICKS) __builtin_amdgcn_s_sleep(4); }
    f32x4 acc[2][2][4][2];
#pragma unroll
    for (int a = 0; a < 2; ++a)
#pragma unroll
        for (int b = 0; b < 2; ++b)
#pragma unroll
            for (int m = 0; m < 4; ++m)
#pragma unroll
                for (int n = 0; n < 2; ++n) acc[a][b][m][n] = (f32x4){0.f, 0.f, 0.f, 0.f};
    v8i_t At[4], B0[2], B1[2];
    const char* cA = S.a_ptr(g, cur); const char* cB = S.b_ptr(g, cur);
    PG8_STAGE(PG8_SB(0, 0), cB, voffB); PG8_STAGE(PG8_SA(0, 0), cA, voffA); PG8_STAGE(PG8_SB(0, 1), cB + hstepB, voffB); PG8_STAGE(PG8_SA(0, 1), cA + hstepA, voffA);
    if (wr == 1) PG8_BAR;
    PG8_WAIT_V(4); PG8_BAR;
    PG8_STAGE(PG8_SB(1, 0), cB + kstepB, voffB); PG8_STAGE(PG8_SA(1, 0), cA + kstepA, voffA); PG8_STAGE(PG8_SB(1, 1), cB + hstepB + kstepB, voffB);
    PG8_WAIT_V(6); PG8_BAR;
    for (;;) {
        const bool has_next = S.next(ui + 1, nxt);
        const char* nA = has_next ? S.a_ptr(g, nxt) : cA; const char* nB = has_next ? S.b_ptr(g, nxt) : cB;
        unsigned long long clk0 = 0;
        if (PROBE_CLK != 0 && Epi::CLKID == PROBE_CLK && blockIdx.x == 0) clk0 = __builtin_readcyclecounter();
        constexpr bool KDUP = (PROBE_KL == (FP8 ? 1 : 2)) || (PROBE_KL == (FP8 ? 3 : 4) && Epi::CLKID == 1) || (PROBE_KL == 5 && Epi::CLKID == 1);
        constexpr bool KFIX = (PROBE_KL == (FP8 ? 3 : 4)) && Epi::CLKID == 1;
#pragma unroll 1
        for (int krep = 0; krep < (KDUP ? 2 : 1); ++krep) {
        const bool kfinal = (krep == (KDUP ? 1 : 0));
        const char* kA = (KFIX && !kfinal) ? (const char*)g.A : cA; const char* kB = (KFIX && !kfinal) ? (const char*)g.Bt : cB;
        if (krep) {
#pragma unroll
            for (int a = 0; a < 2; ++a)
#pragma unroll
                for (int b = 0; b < 2; ++b)
#pragma unroll
                    for (int m = 0; m < 4; ++m)
#pragma unroll
                        for (int n = 0; n < 2; ++n) acc[a][b][m][n] *= 0.f;
        }
#pragma unroll 1
        for (int t = 0; t < nt; t += 2) {
            if constexpr (has_mid<Epi>::value) { constexpr int MT = FP8 ? 2 : 4;
                if (t == MT || t == 2 * MT) { const int tz = fresh_tid(wave_s), ln = tz & 63; E.mid(acc, cur, wave_s >> 2, wave_s & 3, ln & 15, ln >> 4, t / MT - 1); } }
            const bool last = (t == nt - 2);
            const bool relax = !KDUP && (t == 0) && (ui > 0);
            const char* a1 = kA + (size_t)(t + 1) * kstepA;
            const char* a2 = last ? (kfinal ? nA : cA) : kA + (size_t)(t + 2) * kstepA; const char* b2 = last ? (kfinal ? nB : cB) : kB + (size_t)(t + 2) * kstepB;
            const char* a3 = a2 + kstepA; const char* b3 = b2 + kstepB;
            PG8_LDB(B0, 0, 0); PG8_SCHED; PG8_LDA(At, 0, 0); if (!relax) PG8_STAGE(PG8_SA(1, 1), a1 + hstepA, voffA);
            PG8_WAIT_L(8); PG8_BAR; PG8_WAIT_L(0); PG8_MMA(0, 0, At, B0); PG8_BAR; PG8_SCHED;
            PG8_LDB(B1, 0, 1); PG8_STAGE(PG8_SB(0, 0), b2, voffB);
            PG8_BAR; PG8_WAIT_L(0); PG8_MMA(0, 1, At, B1); PG8_BAR;
            PG8_LDA(At, 0, 1); PG8_STAGE(PG8_SA(0, 0), a2, voffA);
            PG8_BAR; PG8_WAIT_L(0); PG8_MMA(1, 0, At, B0); PG8_BAR; PG8_SCHED;
            PG8_STAGE(PG8_SB(0, 1), b2 + hstepB, voffB);
            PG8_WAIT_V6R; PG8_BAR; PG8_MMA(1, 1, At, B1); PG8_BAR;
            PG8_LDB(B0, 1, 0); PG8_SCHED; PG8_LDA(At, 1, 0); PG8_STAGE(PG8_SA(0, 1), a2 + hstepA, voffA);
            PG8_WAIT_L(8); PG8_BAR; PG8_WAIT_L(0); PG8_MMA(0, 0, At, B0); PG8_BAR; PG8_SCHED;
            PG8_LDB(B1, 1, 1); PG8_STAGE(PG8_SB(1, 0), b3, voffB);
            PG8_BAR; PG8_WAIT_L(0); PG8_MMA(0, 1, At, B1); PG8_BAR;
            PG8_LDA(At, 1, 1); PG8_STAGE(PG8_SA(1, 0), a3, voffA);
            PG8_BAR; PG8_WAIT_L(0); PG8_MMA(1, 0, At, B0); PG8_BAR; PG8_SCHED;
            PG8_STAGE(PG8_SB(1, 1), b3 + hstepB, voffB);
            PG8_WAIT_V(6); PG8_BAR; PG8_MMA(1, 1, At, B1); PG8_BAR;
        }
        }
        if (PROBE_CLK != 0 && Epi::CLKID == PROBE_CLK && blockIdx.x == 0) { clk_sum += __builtin_readcyclecounter() - clk0; clk_n += (unsigned)nt; }
        if (!KDUP && has_next) { PG8_STAGE(PG8_SA(1, 1), nA + kstepA + hstepA, voffA); asm volatile("" ::: "memory"); PG8_SCHED; }
        { const int tz = fresh_tid(wave_s), ln = tz & 63; E(acc, cur, wave_s >> 2, wave_s & 3, ln & 15, ln >> 4); }
        if (PROBE_EPI == (FP8 ? 1 : 2)) { asm volatile("" ::: "memory"); const int tz = fresh_tid(wave_s), ln = tz & 63; E(acc, cur, wave_s >> 2, wave_s & 3, ln & 15, ln >> 4); }
        if (!has_next) break;
#pragma unroll
        for (int a = 0; a < 2; ++a)
#pragma unroll
            for (int b = 0; b < 2; ++b)
#pragma unroll
                for (int m = 0; m < 4; ++m)
#pragma unroll
                    for (int n = 0; n < 2; ++n) acc[a][b][m][n] = (f32x4){0.f, 0.f, 0.f, 0.f};
        cur = nxt; cA = nA; cB = nB; ++ui;
    }
    PG8_WAIT_V(0);
    if (wr == 0) PG8_BAR;
    PG8_BAR;
    if (PROBE_CLK != 0 && Epi::CLKID == PROBE_CLK && blockIdx.x == 0) {
        const unsigned long long ticks = (clk_sum / (unsigned long long)(clk_n ? clk_n : 1u)) * 10ull;
        const unsigned long long r0 = __builtin_amdgcn_s_memrealtime(); while (__builtin_amdgcn_s_memrealtime() - r0 < ticks) __builtin_amdgcn_s_sleep(8);
    }
#undef PG8_SA
#undef PG8_SB
#undef PG8_STAGE
#undef PG8_VOFF
#undef PG8_LDA
#undef PG8_LDB
#undef PG8_MMA
#undef PG8_LO
#undef PG8_HI
#undef PG8_RDA
#undef PG8_RDB
#undef PG8_WAIT_V
#undef PG8_WAIT_V6R
#undef PG8_WAIT_L
#undef PG8_BAR
#undef PG8_SCHED
}
}

struct Frame {
    LAS unsigned char* lds;
    volatile LAS unsigned* MISC;
    unsigned* ctl;
    unsigned char* ws; unsigned char* ws0;
    const float* const* in;
    float* out;
    int tid, lane, wave, G, gw, NGW, wave0;
};
__device__ __forceinline__ void refresh(Frame& F) {
    unsigned ones = ~0u; asm volatile("" : "+s"(ones));
    int ln = (int)__builtin_amdgcn_mbcnt_hi(ones, __builtin_amdgcn_mbcnt_lo(ones, 0u)); asm volatile("" : "+v"(ln));
    int wv = F.wave0; asm volatile("" : "+s"(wv));
    F.lane = ln; F.wave = wv; F.tid = wv * 64 + ln; F.gw = blockIdx.x * 8 + wv;
    GAS unsigned char* w = (GAS unsigned char*)F.ws0; asm volatile("" : "+s"(w)); F.ws = (unsigned char*)w;
}

__constant__ unsigned char kBucket[128] = {0, 1, 2, 3, 4, 5, 6, 7, 8, 9, 10, 11, 12, 13, 14, 15, 16, 16, 16, 17, 17, 18, 18, 18, 19, 19, 19, 20, 20, 20, 20, 21, 21, 21, 21, 22, 22, 22, 22, 22, 23, 23, 23, 23, 23, 23, 24, 24, 24, 24, 24, 24, 25, 25, 25, 25, 25, 25, 25, 26, 26, 26, 26, 26, 26, 26, 26, 27, 27, 27, 27, 27, 27, 27, 27, 27, 27, 28, 28, 28, 28, 28, 28, 28, 28, 28, 28, 29, 29, 29, 29, 29, 29, 29, 29, 29, 29, 29, 29, 30, 30, 30, 30, 30, 30, 30, 30, 30, 30, 30, 30, 30, 30, 31, 31, 31, 31, 31, 31, 31, 31, 31, 31, 31, 31, 31, 31, 31};

__device__ __forceinline__ int win_src(int n, float& sc) {
    sc = 1.f;
    if (n < 544) { if (n < 256) sc = QS; else if (n >= 384 && n < 512) sc = IQS; return n; }
    if (n < 548) { sc = 0.5f; return n; }
    if (n < 560) return 1188 + (n - 548);
    if (n < 576) return -1;
    if (n < 832) { sc = QS; return 548 + (n - 576); }
    if (n < 1216) return 804 + (n - 832);
    if (n < 1728) { sc = QS; return 1200 + (n - 1216); }
    if (n < 2240) return 1712 + (n - 1728);
    if (n < 2752) return 2224 + (n - 2240);
    if (n < 5824) return 2736 + (n - 2752);
    return -1;
}
template <bool WIN>
__device__ __forceinline__ void p0_transpose_item(const float* W, int K, int Nsrc, int Ndst, bf16_t* WT, LAS float* scr, int item, int lane, int ldt = 0) {
    if (ldt == 0) ldt = K;
    const int nblk = Ndst / 32, kb = item / nblk, nb = item % nblk, k0 = 64 * kb, n0 = 32 * nb;
    if (WIN) { float sc = 1.f; const int src = win_src(n0 + (lane & 31), sc);
#pragma unroll 8
        for (int i = 0; i < 32; ++i) { const int kk = 2 * i + (lane >> 5); scr[kk * 33 + (lane & 31)] = (src >= 0) ? W[(size_t)(k0 + kk) * Nsrc + src] * sc : 0.f; }
    } else {
        f32x4 v[8];
#pragma unroll
        for (int i = 0; i < 8; ++i) v[i] = *(const f32x4*)(W + (size_t)(k0 + 8 * i + (lane >> 3)) * Nsrc + n0 + (lane & 7) * 4);
#pragma unroll
        for (int i = 0; i < 8; ++i) { LAS float* q = scr + (8 * i + (lane >> 3)) * 33 + (lane & 7) * 4; q[0] = v[i].x; q[1] = v[i].y; q[2] = v[i].z; q[3] = v[i].w; }
    }
    LDS_WAIT(); asm volatile("" ::: "memory");
    const int c = lane & 7;
#pragma unroll
    for (int j = 0; j < 4; ++j) { const int n = (lane >> 3) + 8 * j; const LAS float* s = scr + (8 * c) * 33 + n;
        u32x4 o; o.x = pk2(s[0 * 33], s[1 * 33]); o.y = pk2(s[2 * 33], s[3 * 33]); o.z = pk2(s[4 * 33], s[5 * 33]); o.w = pk2(s[6 * 33], s[7 * 33]);
        *(u32x4*)(WT + (size_t)(n0 + n) * ldt + k0 + 8 * c) = o; }
    LDS_WAIT(); asm volatile("" ::: "memory");
}

template <bool WIN>
__device__ __forceinline__ void p0_transpose_item_f8(const float* W, int K, int N, unsigned char* WT, float sc, LAS float* scr, int item, int lane, int Nsrc = 0, int ncol0 = 0, int ldt = 0) {
    if (ldt == 0) ldt = K;
    const int nblk = N / 32, kb = item / nblk, nb = item % nblk, k0 = 64 * kb, n0 = 32 * nb;
    if (WIN) { float s1 = 1.f; const int src = win_src(ncol0 + n0 + (lane & 31), s1);
#pragma unroll 8
        for (int i = 0; i < 32; ++i) { const int kk = 2 * i + (lane >> 5); scr[kk * 33 + (lane & 31)] = (src >= 0) ? W[(size_t)(k0 + kk) * Nsrc + src] * (s1 * sc) : 0.f; }
    } else
    { f32x4 v[8];
#pragma unroll
      for (int i = 0; i < 8; ++i) v[i] = *(const f32x4*)(W + (size_t)(k0 + 8 * i + (lane >> 3)) * N + n0 + (lane & 7) * 4);
#pragma unroll
      for (int i = 0; i < 8; ++i) { LAS float* q = scr + (8 * i + (lane >> 3)) * 33 + (lane & 7) * 4; q[0] = v[i].x * sc; q[1] = v[i].y * sc; q[2] = v[i].z * sc; q[3] = v[i].w * sc; } }
    LDS_WAIT(); asm volatile("" ::: "memory");
    const int c = lane & 3;
#pragma unroll
    for (int j = 0; j < 2; ++j) { const int n = (lane >> 2) + 16 * j; const LAS float* q = scr + (16 * c) * 33 + n;
        u32x4 o; o.x = pk4_fp8(q[0 * 33], q[1 * 33], q[2 * 33], q[3 * 33]); o.y = pk4_fp8(q[4 * 33], q[5 * 33], q[6 * 33], q[7 * 33]);
        o.z = pk4_fp8(q[8 * 33], q[9 * 33], q[10 * 33], q[11 * 33]); o.w = pk4_fp8(q[12 * 33], q[13 * 33], q[14 * 33], q[15 * 33]);
        *(u32x4*)(WT + (size_t)(n0 + n) * ldt + k0 + 16 * c) = o; }
    LDS_WAIT(); asm volatile("" ::: "memory");
}
__device__ __forceinline__ void phase_prologue(Frame& F) {
    const float* const* in = F.in;
    const int lane = F.lane;
    LAS float* sc = (LAS float*)F.lds;
    {
        float cv[32];
#pragma unroll
        for (int q = 0; q < 32; ++q) cv[q] = in[1][F.tid + 512 * q];
#pragma unroll
        for (int q = 0; q < 32; ++q) { const int i = F.tid + 512 * q, bq = i >> 10, k = i & 1023; sc[k * 16 + bq] = cv[q] * fsigmoid(cv[q]); }
    }
    if (F.tid == 0) F.MISC[8] = 0u;
    __syncthreads();
    if (F.wave < 3) {
        const int u = F.wave * 256 + (int)blockIdx.x; const int which = u / 192, cb = u % 192, layer = which >> 1, col = cb * 16 + (lane & 15), kq = lane >> 4;
        const float* W = (which & 1 ? in[17] : in[3]) + (size_t)layer * 1024 * 3072 + col;
        const float* Bv = (which & 1 ? in[18] : in[4]) + (size_t)layer * 3072;
        float acc[16];
#pragma unroll
        for (int q = 0; q < 16; ++q) acc[q] = 0.f;
#pragma unroll 1
        for (int k0 = kq * 256; k0 < kq * 256 + 256; k0 += 16) { float w[16];
#pragma unroll
            for (int i = 0; i < 16; ++i) w[i] = W[(size_t)(k0 + i) * 3072];
#pragma unroll
            for (int i = 0; i < 16; ++i) { const LAS f32x4* sp = (const LAS f32x4*)(sc + (k0 + i) * 16); const f32x4 s0 = sp[0], s1 = sp[1], s2 = sp[2], s3 = sp[3];
#pragma unroll
                for (int q = 0; q < 4; ++q) { acc[q] += s0[q] * w[i]; acc[4 + q] += s1[q] * w[i]; acc[8 + q] += s2[q] * w[i]; acc[12 + q] += s3[q] * w[i]; } } }
#pragma unroll
        for (int q = 0; q < 16; ++q) { acc[q] += shx_f(acc[q], 16, lane); acc[q] += shx_f(acc[q], 32, lane); }
        float* mod = (float*)(F.ws + WS_MOD) + (size_t)which * 16 * 3072;
        const float bb = Bv[col];
#pragma unroll
        for (int q = 0; q < 4; ++q) { const float v = kq == 0 ? acc[q] : kq == 1 ? acc[4 + q] : kq == 2 ? acc[8 + q] : acc[12 + q]; mod[(size_t)(4 * kq + q) * 3072 + col] = v + bb; }
    } else if (F.wave == 3) {
        if (blockIdx.x < 64) {
            const int u = (int)blockIdx.x, m = u >> 4, n = (u & 15) * 16 + (lane & 15), rq = lane >> 4;
            const float* P = in[6] + (size_t)m * 2048; const float* W = in[7] + (size_t)m * 2048 * 256 + n;
            float a = 0.f;
#pragma unroll 1
            for (int r0 = rq * 512; r0 < rq * 512 + 512; r0 += 16) { float w[16], pv[16];
#pragma unroll
                for (int i = 0; i < 16; ++i) { w[i] = W[(size_t)(r0 + i) * 256]; pv[i] = P[r0 + i]; }
#pragma unroll
                for (int i = 0; i < 16; ++i) a += pv[i] * w[i]; }
            a += shx_f(a, 16, lane); a += shx_f(a, 32, lane);
            if (rq == 0) ((float*)(F.ws + WS_BIAS1))[m * 256 + n] = a;
        } else if (blockIdx.x == 64) {
            float* lut = (float*)(F.ws + WS_LUT);
            for (int i = lane; i < 12 * 128; i += 64) { const int h = i >> 7, d = i & 127; lut[i] = (in[2][kBucket[d] * 12 + h] - in[2][31 * 12 + h]) * LOG2E; }
            for (int l = 0; l < 2; ++l) { const float* dl = in[9] + l * 256;
                const float s1 = wave_sum(dl[lane] * dl[64 + lane], lane), s2 = wave_sum(dl[128 + lane] * dl[192 + lane], lane);
                const float lam_init = 0.8f - 0.6f * __expf(-0.3f * (float)l);
                if (lane == 0) ((float*)(F.ws + WS_LAM))[l] = __expf(s1) - __expf(s2) + lam_init; }
        }
    }
    LAS float* scr = (LAS float*)(F.lds + 65536 + F.wave * 8448);
    constexpr int I_WIN = 16 * (N_BF / 32), I_WMG = 16 * (N_F8 / 32);
    constexpr int I_BA = 4 * 32, I_BC = 8 * 32, I_WO = 16 * 32, I_W1 = 32 * 8, I_W2 = 4 * 2;
    constexpr int I_GU = 16 * 64, I_DN = 16 * 32;
    constexpr int N_GU = 64 * I_GU, N_DN = 64 * I_DN, N_WIN = 2 * I_WIN, N_BA = 2 * I_BA, N_BC = 2 * I_BC, N_WO = 2 * I_WO, N_W1 = 4 * I_W1, N_W2 = 4 * I_W2, N_WMG = 2 * I_WMG;
    constexpr int NITEMS = N_GU + N_DN + N_WIN + N_WMG + 2 * N_BA + N_BC + N_WO + N_W1 + N_W2;
    for (;;) {
        unsigned jq = 0; if (lane == 0) jq = __hip_atomic_fetch_add((LAS unsigned*)(F.lds + LDS_MISC) + 8, 1u, __ATOMIC_RELAXED, __HIP_MEMORY_SCOPE_WORKGROUP);
        const int it = (int)blockIdx.x + 256 * (int)__builtin_amdgcn_readfirstlane(jq); if (it >= NITEMS) break;
        int r = it;
        if (r < N_GU) { const int m = r / I_GU; p0_transpose_item_f8<false>(in[21] + (size_t)m * 1024 * 2048, 1024, 2048, (unsigned char*)(F.ws + WS_WGU_T) + (size_t)m * 2048 * 1024, F8_WGU, scr, r % I_GU, F.lane); continue; } r -= N_GU;
        if (r < N_DN) { const int m = r / I_DN; p0_transpose_item_f8<false>(in[23] + (size_t)m * 1024 * 1024, 1024, 1024, (unsigned char*)(F.ws + WS_WDN_T) + (size_t)m * 1024 * 1024, F8_WDN, scr, r % I_DN, F.lane); continue; } r -= N_DN;
        if (r < N_WIN) { const int m = r / I_WIN; p0_transpose_item<true>(in[5] + (size_t)m * 1024 * D_IN, 1024, D_IN, N_BF, (bf16_t*)(F.ws + WS_WIN_T) + (size_t)m * DP * 1024, scr, r % I_WIN, F.lane); continue; } r -= N_WIN;
        if (r < N_WMG) { const int m = r / I_WMG; p0_transpose_item_f8<true>(in[5] + (size_t)m * 1024 * D_IN, 1024, N_F8, (unsigned char*)(F.ws + WS_WMG8) + (size_t)m * N_F8 * 1024, F8_WIN, scr, r % I_WMG, F.lane, D_IN, C_MG); continue; } r -= N_WMG;
        if (r < N_BA) { const int m = r / I_BA; p0_transpose_item_f8<false>(in[11] + (size_t)m * 256 * 1024, 256, 1024, (unsigned char*)(F.ws + WS_WBR_T + m * 2 * MiB), F8_WB, scr, r % I_BA, F.lane, 0, 0, 1024); continue; } r -= N_BA;
        if (r < N_BA) { const int m = r / I_BA; p0_transpose_item_f8<false>(in[12] + (size_t)m * 256 * 1024, 256, 1024, (unsigned char*)(F.ws + WS_WBR_T + m * 2 * MiB) + 256, F8_WB, scr, r % I_BA, F.lane, 0, 0, 1024); continue; } r -= N_BA;
        if (r < N_BC) { const int m = r / I_BC; p0_transpose_item_f8<false>(in[13] + (size_t)m * 512 * 1024, 512, 1024, (unsigned char*)(F.ws + WS_WBR_T + m * 2 * MiB) + 512, F8_WB, scr, r % I_BC, F.lane, 0, 0, 1024); continue; } r -= N_BC;
        if (r < N_WO) { const int m = r / I_WO; p0_transpose_item_f8<false>(in[14] + (size_t)m * 1024 * 1024, 1024, 1024, (unsigned char*)(F.ws + WS_WOUT_T) + (size_t)m * 1024 * 1024, F8_WO, scr, r % I_WO, F.lane); continue; } r -= N_WO;
        if (r < N_W1) { const int m = r / I_W1; p0_transpose_item<false>(in[7] + (size_t)m * 2048 * 256, 2048, 256, 256, (bf16_t*)(F.ws + WS_W1_T) + (size_t)m * 256 * 2048, scr, r % I_W1, F.lane); continue; } r -= N_W1;
        { const int m = r / I_W2; p0_transpose_item<false>(in[8] + (size_t)m * 256 * 64, 256, 64, 64, (bf16_t*)(F.ws + WS_W2_T) + (size_t)m * 64 * 256, scr, r % I_W2, F.lane); }
    }
}

__device__ __forceinline__ void phase_h0(Frame& F, const float* X, const float* mod, bf16_t* HB, unsigned char* HB8) {
    constexpr int NIT = NTOK / 2048; const int lane = F.lane;
    f32x4 xc[4];
#pragma unroll
    for (int j = 0; j < 4; ++j) xc[j] = ((const f32x4*)(X + (size_t)F.gw * 1024))[lane + 64 * j];
#pragma unroll 1
    for (int it = 0; it < NIT; ++it) { const int row = F.gw + it * 2048, b = row >> 12; const int rown = (it + 1 < NIT) ? row + 2048 : row;
        const f32x4* sh = (const f32x4*)(mod + (size_t)b * 3072) + lane; const f32x4* sc = (const f32x4*)(mod + (size_t)b * 3072 + 1024) + lane;
        f32x4 scv[4], shv[4];
#pragma unroll
        for (int j = 0; j < 4; ++j) { scv[j] = sc[64 * j] + 1.0f; shv[j] = sh[64 * j]; }
        asm volatile("" ::: "memory");
        f32x4 xn[4];
#pragma unroll
        for (int j = 0; j < 4; ++j) xn[j] = ((const f32x4*)(X + (size_t)rown * 1024))[lane + 64 * j];
        u64* o8 = (u64*)(HB + (size_t)row * 1024) + lane; unsigned* q8 = (unsigned*)(HB8 + (size_t)row * 1024) + lane;
#pragma unroll
        for (int j = 0; j < 4; ++j) { const f32x4 v = xc[j] * scv[j] + shv[j]; o8[64 * j] = (u64)pk2(v.x, v.y) | ((u64)pk2(v.z, v.w) << 32);
            q8[64 * j] = pk4_fp8(F8_H * v.x, F8_H * v.y, F8_H * v.z, F8_H * v.w); }
#pragma unroll
        for (int j = 0; j < 4; ++j) xc[j] = xn[j];
    }
}
__device__ __forceinline__ void ln_stats(const f32x4 (&v)[4], float& mean, float& rstd, int lane) {
    float s = 0.f;
#pragma unroll
    for (int j = 0; j < 4; ++j) s += (v[j].x + v[j].y) + (v[j].z + v[j].w);
    mean = wave_sum(s, lane) * (1.f / 1024.f); float s2 = 0.f;
#pragma unroll
    for (int j = 0; j < 4; ++j) { const f32x4 d = v[j] - mean; s2 += (d.x * d.x + d.y * d.y) + (d.z * d.z + d.w * d.w); }
    rstd = 1.f / sqrtf(wave_sum(s2, lane) * (1.f / 1024.f) + LN_EPS);
}

__device__ __forceinline__ void phase_ln1_router(Frame& F, bf16_t* Z, const float* g1, const float* b1, const float* mod, const float* rw, const float* rb, bf16_t* HB, unsigned* cnt) {
    LAS float* rwT = (LAS float*)F.lds;
    for (int i = F.tid; i < 32 * 1024; i += 512) { const int k = i >> 5, e = i & 31; rwT[e * 1024 + k] = rw[i]; }
    __syncthreads();
    const int lane = F.lane, e_l = lane >> 1;
    const float rbias = rb[e_l];
    unsigned slot0 = 0, slot1 = 0; unsigned cnt_local = 0;
    f32x4 gg[4], bb[4];
#pragma unroll
    for (int j = 0; j < 4; ++j) { gg[j] = ((const f32x4*)g1)[lane + 64 * j]; bb[j] = ((const f32x4*)b1)[lane + 64 * j]; }
    constexpr int NIT = NTOK / (2 * 2048);
    u32x2 zq[2][4];
#pragma unroll
    for (int r = 0; r < 2; ++r)
#pragma unroll
        for (int j = 0; j < 4; ++j) zq[r][j] = ((const u32x2*)(Z + (size_t)(F.gw + r * 2048) * 1024))[lane + 64 * j];
#pragma unroll 1
    for (int it = 0; it < NIT; ++it) { const int b = it; const int row0 = F.gw + it * 4096;
        const f32x4* sh = (const f32x4*)(mod + (size_t)b * 3072) + lane; const f32x4* sc = (const f32x4*)(mod + (size_t)b * 3072 + 1024) + lane;
        f32x4 v[2][4];
#pragma unroll
        for (int r = 0; r < 2; ++r)
#pragma unroll
            for (int j = 0; j < 4; ++j) { const u32x2 q = zq[r][j]; v[r][j] = (f32x4){bflo(q.x), bfhi(q.x), bflo(q.y), bfhi(q.y)}; }
        f32x4 scj[4], shj[4];
#pragma unroll
        for (int j = 0; j < 4; ++j) { scj[j] = sc[64 * j] + 1.0f; shj[j] = sh[64 * j]; }
        asm volatile("" ::: "memory");
        if (it + 1 < NIT) {
#pragma unroll
            for (int r = 0; r < 2; ++r)
#pragma unroll
                for (int j = 0; j < 4; ++j) zq[r][j] = ((const u32x2*)(Z + (size_t)(row0 + 4096 + r * 2048) * 1024))[lane + 64 * j];
        }
        f32x4 h[2][4];
#pragma unroll
        for (int r = 0; r < 2; ++r) { const int row = row0 + r * 2048;
            float mean, rstd; ln_stats(v[r], mean, rstd, lane);
            u32x2* zr = (u32x2*)(Z + (size_t)row * 1024) + lane; unsigned* o8 = (unsigned*)((unsigned char*)HB + (size_t)row * 1024) + lane;
#pragma unroll
            for (int j = 0; j < 4; ++j) { const f32x4 xn = (v[r][j] - mean) * rstd * gg[j] + bb[j]; zr[64 * j] = (u32x2){cvt_pk_bf16(xn.x, xn.y), cvt_pk_bf16(xn.z, xn.w)}; h[r][j] = xn * scj[j] + shj[j];
                o8[64 * j] = pk4_fp8(F8_H * h[r][j].x, F8_H * h[r][j].y, F8_H * h[r][j].z, F8_H * h[r][j].w); } }
        f32x2 hp[4][4];
#pragma unroll
        for (int j = 0; j < 4; ++j) { hp[j][0] = (f32x2){h[0][j].x, h[1][j].x}; hp[j][1] = (f32x2){h[0][j].y, h[1][j].y}; hp[j][2] = (f32x2){h[0][j].z, h[1][j].z}; hp[j][3] = (f32x2){h[0][j].w, h[1][j].w}; }
        float a[2][32];
#pragma unroll
        for (int e = 0; e < 32; ++e) { f32x2 s0 = (f32x2){0.f, 0.f}, s1 = s0;
#pragma unroll
            for (int j = 0; j < 4; ++j) { const f32x4 w = *(const LAS f32x4*)(rwT + e * 1024 + 4 * lane + 256 * j);
                s0 += hp[j][0] * (f32x2){w.x, w.x}; s1 += hp[j][1] * (f32x2){w.y, w.y}; s0 += hp[j][2] * (f32x2){w.z, w.z}; s1 += hp[j][3] * (f32x2){w.w, w.w}; }
            s0 += s1; a[0][e] = s0.x; a[1][e] = s0.y; if ((e & 3) == 3) __builtin_amdgcn_sched_barrier(0); }
#pragma unroll
        for (int r = 0; r < 2; ++r) { const int row = row0 + r * 2048; const int i = 2 * it + r;
#pragma unroll
            for (int st = 0; st < 5; ++st) { const int half = 16 >> st, x = 32 >> st; const bool up = (lane & x) != 0;
#pragma unroll
                for (int q = 0; q < half; ++q) { const float send = up ? a[r][q] : a[r][q + half], keep = up ? a[r][q + half] : a[r][q];
                    a[r][q] = keep + (st == 0 ? other32(send, lane) : st == 1 ? shx_f(send, 16, lane) : st == 2 ? dpp_f<0x128>(send) : st == 3 ? dpp_f<0x141>(send) : dpp_f<0x4E>(send)); } }
            float lg = a[r][0] + dpp_f<0xB1>(a[r][0]) + rbias;
            float tv[4]; int te[4];
#pragma unroll
            for (int k = 0; k < 4; ++k) { const float mx = wave_max(lg); const u64 bal = __ballot(lg == mx); const int be = (__ffsll((long long)bal) - 1) >> 1;
                tv[k] = mx; te[k] = be; if (e_l == be) lg = -INFINITY; }
            const float e1 = __expf(tv[1] - tv[0]), e2 = __expf(tv[2] - tv[0]), e3 = __expf(tv[3] - tv[0]); const float inv = 1.f / (1.f + e1 + e2 + e3);
            { *(int4*)((int*)(F.ws + WS_TOKE) + (size_t)row * 4) = make_int4(te[0], te[1], te[2], te[3]);
                *(f32x4*)((float*)(F.ws + WS_TOKW) + (size_t)row * 4) = (f32x4){inv, e1 * inv, e2 * inv, e3 * inv}; }
#pragma unroll
            for (int k = 0; k < 4; ++k) { const int ek = __builtin_amdgcn_readfirstlane(te[k]); const unsigned rk = (unsigned)__builtin_amdgcn_readlane((int)cnt_local, ek);
                if (lane == ek) ++cnt_local;
                const int idx = i * 4 + k; const unsigned val = ((unsigned)ek << 16) | rk;
                if (lane == (idx & 63)) { if (idx < 64) slot0 = val; else slot1 = val; } }
        }
    }
    unsigned base = 0;
    if (lane < 32) base = __hip_atomic_fetch_add(cnt + lane, cnt_local, __ATOMIC_RELAXED, __HIP_MEMORY_SCOPE_AGENT);
#pragma unroll
    for (int s2 = 0; s2 < 2; ++s2) { const unsigned val = s2 ? slot1 : slot0; const int e = (int)(val >> 16); const unsigned pos = (unsigned)bperm_i(e, (int)base) + (val & 0xffffu);
        const int i = (64 * s2 + lane) >> 2, k = lane & 3; const int row = F.gw + (i >> 1) * 4096 + (i & 1) * 2048;
        ((int*)(F.ws + WS_TOKP))[(size_t)row * 4 + k] = (int)pos; }
    __syncthreads();
}

__device__ __forceinline__ void build_pstart(Frame& F, const unsigned* cnt) {
    if (F.wave == 0) { const int lane = F.lane;
        unsigned np = 0; if (lane < 32) np = (__hip_atomic_load(cnt + lane, __ATOMIC_RELAXED, __HIP_MEMORY_SCOPE_AGENT) + 255u) >> 8;
        int inc = (int)np;
#pragma unroll
        for (int o = 1; o < 32; o <<= 1) { const int t = bperm_i((lane - o) & 63, inc); if (lane >= o) inc += t; }
        if (lane < 32) F.MISC[17 + lane] = (unsigned)inc;
        if (lane == 0) F.MISC[16] = 0u; }
    __syncthreads();
}
__device__ __forceinline__ void phase_gather(Frame& F, const unsigned* cnt, const bf16_t* HB, unsigned char* HS) {
    build_pstart(F, cnt);
    const unsigned char* H8 = (const unsigned char*)HB;
    const int lane = F.lane; constexpr int NIT = NTOK / 2048;
    int4 te = *(const int4*)((const int*)(F.ws + WS_TOKE) + (size_t)F.gw * 4), tp = *(const int4*)((const int*)(F.ws + WS_TOKP) + (size_t)F.gw * 4);
    u32x4 v = ((const u32x4*)(H8 + (size_t)F.gw * 1024))[lane];
#pragma unroll 1
    for (int it = 0; it < NIT; ++it) { const int row = F.gw + it * 2048; const int rown = (it + 1 < NIT) ? row + 2048 : row;
        const int4 ten = *(const int4*)((const int*)(F.ws + WS_TOKE) + (size_t)rown * 4), tpn = *(const int4*)((const int*)(F.ws + WS_TOKP) + (size_t)rown * 4);
        const u32x4 vn = ((const u32x4*)(H8 + (size_t)rown * 1024))[lane];
        const int r0 = (int)F.MISC[16 + te.x] * 256 + tp.x, r1 = (int)F.MISC[16 + te.y] * 256 + tp.y, r2 = (int)F.MISC[16 + te.z] * 256 + tp.z, r3 = (int)F.MISC[16 + te.w] * 256 + tp.w;
        *(int4*)((int*)(F.ws + WS_TOKR) + (size_t)row * 4) = make_int4(r0, r1, r2, r3);
        ((u32x4*)(HS + (size_t)r0 * 1024))[lane] = v; ((u32x4*)(HS + (size_t)r1 * 1024))[lane] = v; ((u32x4*)(HS + (size_t)r2 * 1024))[lane] = v; ((u32x4*)(HS + (size_t)r3 * 1024))[lane] = v;
        te = ten; tp = tpn; v = vn;
    }
    if (blockIdx.x < 32) { const int e = blockIdx.x; const int c = (int)__hip_atomic_load(cnt + e, __ATOMIC_RELAXED, __HIP_MEMORY_SCOPE_AGENT);
        const int rbeg = (int)F.MISC[16 + e] * 256 + c, rend = (int)F.MISC[17 + e] * 256;
        for (int r = rbeg + F.wave; r < rend; r += 8) ((u32x4*)(HS + (size_t)r * 1024))[lane] = (u32x4){0u, 0u, 0u, 0u}; }
}
__device__ __forceinline__ void phase_combine(Frame& F, const unsigned char* YS, const bf16_t* X1, const float* modf, const float* g2, const float* b2, float* XO, const float* modn, bf16_t* HB, unsigned char* HB8, bf16_t* X2B) {
    const int lane = F.lane;
    f32x4 gg[4], bb[4];
#pragma unroll
    for (int q = 0; q < 4; ++q) { gg[q] = ((const f32x4*)g2)[128 * (q >> 1) + 2 * lane + (q & 1)]; bb[q] = ((const f32x4*)b2)[128 * (q >> 1) + 2 * lane + (q & 1)]; }
    constexpr int NIT = NTOK / 2048;
    const int* TR = (const int*)(F.ws + WS_TOKR); const float* TW = (const float*)(F.ws + WS_TOKW);
    int4 tr_n = *(const int4*)(TR + (size_t)F.gw * 4); f32x4 tw_n = *(const f32x4*)(TW + (size_t)F.gw * 4);
    u32x2 yq[4][2]; u32x4 xq[2]; f32x4 tw_c = tw_n;
    { const int rr[4] = {tr_n.x, tr_n.y, tr_n.z, tr_n.w};
#pragma unroll
        for (int k = 0; k < 4; ++k)
#pragma unroll
            for (int c = 0; c < 2; ++c) yq[k][c] = ((const u32x2*)(YS + (size_t)rr[k] * 1024))[64 * c + lane];
#pragma unroll
        for (int c = 0; c < 2; ++c) xq[c] = ((const u32x4*)(X1 + (size_t)F.gw * 1024))[64 * c + lane]; }
    tr_n = *(const int4*)(TR + (size_t)(F.gw + 2048) * 4); tw_n = *(const f32x4*)(TW + (size_t)(F.gw + 2048) * 4);
#pragma unroll 1
    for (int it = 0; it < NIT; ++it) { const int row = F.gw + it * 2048; const int b = row >> 12;
        const int rown = (it + 1 < NIT) ? row + 2048 : row, rownn = (it + 2 < NIT) ? row + 4096 : row;
        f32x4 gtv[4], scv[4], shv[4];
#pragma unroll
        for (int q = 0; q < 4; ++q) { gtv[q] = ((const f32x4*)(modf + (size_t)b * 3072 + 2048))[128 * (q >> 1) + 2 * lane + (q & 1)] + 1.0f;
            if (modn) { scv[q] = ((const f32x4*)(modn + (size_t)b * 3072 + 1024))[128 * (q >> 1) + 2 * lane + (q & 1)] + 1.0f; shv[q] = ((const f32x4*)(modn + (size_t)b * 3072))[128 * (q >> 1) + 2 * lane + (q & 1)]; } }
        asm volatile("" ::: "memory");
        u32x2 yn[4][2]; u32x4 xn[2];
        { const int rr[4] = {tr_n.x, tr_n.y, tr_n.z, tr_n.w};
#pragma unroll
            for (int k = 0; k < 4; ++k)
#pragma unroll
                for (int c = 0; c < 2; ++c) yn[k][c] = ((const u32x2*)(YS + (size_t)rr[k] * 1024))[64 * c + lane];
#pragma unroll
            for (int c = 0; c < 2; ++c) xn[c] = ((const u32x4*)(X1 + (size_t)rown * 1024))[64 * c + lane]; }
        const int4 tr_nn = *(const int4*)(TR + (size_t)rownn * 4); const f32x4 tw_nn = *(const f32x4*)(TW + (size_t)rownn * 4);
        const float ww[4] = {tw_c.x * (1.f / F8_Y), tw_c.y * (1.f / F8_Y), tw_c.z * (1.f / F8_Y), tw_c.w * (1.f / F8_Y)};
        f32x4 v[4];
#pragma unroll
        for (int c = 0; c < 2; ++c) { f32x4 y0 = (f32x4){0.f, 0.f, 0.f, 0.f}, y1 = y0;
#pragma unroll
            for (int k = 0; k < 4; ++k) { float f[8]; fp8x8_f32(yq[k][c], f); y0 += (f32x4){f[0], f[1], f[2], f[3]} * ww[k]; y1 += (f32x4){f[4], f[5], f[6], f[7]} * ww[k]; }
            const u32x4 q = xq[c];
            v[2 * c] = (f32x4){bflo(q.x), bfhi(q.x), bflo(q.y), bfhi(q.y)} * DN_ALPHA + gtv[2 * c] * y0;
            v[2 * c + 1] = (f32x4){bflo(q.z), bfhi(q.z), bflo(q.w), bfhi(q.w)} * DN_ALPHA + gtv[2 * c + 1] * y1; }
        float mean, rstd; ln_stats(v, mean, rstd, lane);
        if (modn) {
#pragma unroll
            for (int c = 0; c < 2; ++c) { const f32x4 x0 = (v[2 * c] - mean) * rstd * gg[2 * c] + bb[2 * c], x1 = (v[2 * c + 1] - mean) * rstd * gg[2 * c + 1] + bb[2 * c + 1];
                ((u32x4*)(X2B + (size_t)row * 1024))[64 * c + lane] = (u32x4){cvt_pk_bf16(x0.x, x0.y), cvt_pk_bf16(x0.z, x0.w), cvt_pk_bf16(x1.x, x1.y), cvt_pk_bf16(x1.z, x1.w)};
                const f32x4 h0 = x0 * scv[2 * c] + shv[2 * c], h1 = x1 * scv[2 * c + 1] + shv[2 * c + 1];
                ((u32x4*)(HB + (size_t)row * 1024))[64 * c + lane] = (u32x4){cvt_pk_bf16(h0.x, h0.y), cvt_pk_bf16(h0.z, h0.w), cvt_pk_bf16(h1.x, h1.y), cvt_pk_bf16(h1.z, h1.w)};
                ((u32x2*)(HB8 + (size_t)row * 1024))[64 * c + lane] = (u32x2){pk4_fp8(F8_H * h0.x, F8_H * h0.y, F8_H * h0.z, F8_H * h0.w), pk4_fp8(F8_H * h1.x, F8_H * h1.y, F8_H * h1.z, F8_H * h1.w)}; }
        } else {
#pragma unroll
            for (int q = 0; q < 4; ++q) ((f32x4*)(XO + (size_t)row * 1024))[128 * (q >> 1) + 2 * lane + (q & 1)] = (v[q] - mean) * rstd * gg[q] + bb[q];
        }
#pragma unroll
        for (int k = 0; k < 4; ++k)
#pragma unroll
            for (int c = 0; c < 2; ++c) yq[k][c] = yn[k][c];
        xq[0] = xn[0]; xq[1] = xn[1]; tw_c = tw_n; tr_n = tr_nn; tw_n = tw_nn;
    }
}

__device__ __forceinline__ unsigned okey16(float v) { unsigned u = __builtin_bit_cast(unsigned, v); u = (u & 0x80000000u) ? ~u : (u | 0x80000000u); return u >> 16; }
__device__ __forceinline__ f32x4 idx_score(const bf16x8 ka, const bf16x8 (&qb)[4], const float (&w4)[4]) {
    f32x4 s = (f32x4){0.f, 0.f, 0.f, 0.f};
#pragma unroll
    for (int h = 0; h < 4; ++h) { const f32x4 c = __builtin_amdgcn_mfma_f32_16x16x32_bf16(ka, qb[h], (f32x4){0.f, 0.f, 0.f, 0.f}, 0, 0, 0);
#pragma unroll
        for (int j = 0; j < 4; ++j) s[j] += w4[h] * __builtin_amdgcn_fmed3f(c[j], 0.f, __builtin_inff()); }
    return s;
}
constexpr int DS_HIST = 32768, HROW = 257;
__device__ __forceinline__ void scan_row(const volatile LAS unsigned* hw, unsigned need, int lane, int& bin, unsigned& above, unsigned& cntb) {
    const unsigned c0 = hw[4 * lane], c1 = hw[4 * lane + 1], c2 = hw[4 * lane + 2], c3 = hw[4 * lane + 3];
    unsigned S = (c0 + c1) + (c2 + c3);
#pragma unroll
    for (int o = 1; o < 64; o <<= 1) { const unsigned t = (unsigned)bperm_i((lane + o) & 63, (int)S); if (lane + o < 64) S += t; }
    const u64 bal = __ballot(S >= need);
    const int L = bal ? 63 - __clzll((long long)bal) : 0;
    const unsigned Snext = (unsigned)bperm_i((L + 1) & 63, (int)S);
    unsigned run = (L < 63) ? Snext : 0u;
    const unsigned d3 = (unsigned)bperm_i(L, (int)c3), d2 = (unsigned)bperm_i(L, (int)c2), d1 = (unsigned)bperm_i(L, (int)c1), d0 = (unsigned)bperm_i(L, (int)c0);
    if (run + d3 >= need) { bin = 4 * L + 3; above = run; cntb = d3; return; } run += d3;
    if (run + d2 >= need) { bin = 4 * L + 2; above = run; cntb = d2; return; } run += d2;
    if (run + d1 >= need) { bin = 4 * L + 1; above = run; cntb = d1; return; } run += d1;
    bin = 4 * L; above = run; cntb = d0;
}
template <int PASS, bool ALLSEL>
__device__ __forceinline__ void dsa_pass(Frame& F, const bf16_t* kbase, unsigned* KS, const bf16x8 (&qb)[4], const float (&w4)[4], int nkt, int tq, unsigned r_a) {
    const int lane = F.lane, fr = lane & 15, fq = lane >> 4;
    LAS unsigned* hist = (LAS unsigned*)(F.lds + DS_HIST); LAS unsigned* bm = (LAS unsigned*)F.lds;
    const int kt0 = F.wave; if (kt0 >= nkt) return;
    u32x2* ksl = (u32x2*)KS + lane;
    if (PASS == 3 && ALLSEL) {
        for (int kt = kt0; kt < nkt; kt += 8) { unsigned nd = 0;
#pragma unroll
            for (int j = 0; j < 4; ++j) nd |= ((kt * 16 + 4 * fq + j) <= tq ? 1u : 0u) << j;
            if (nd) __hip_atomic_fetch_or(bm + fr * 128 + (kt >> 1), nd << (16 * (kt & 1) + 4 * fq), __ATOMIC_RELAXED, __HIP_MEMORY_SCOPE_WORKGROUP); }
        return;
    }
    u32x4 kc[4], kn[4];
    if (PASS == 1) {
        const int klast = nkt - 1;
#pragma unroll
        for (int u = 0; u < 4; ++u) { const int ke = (kt0 + 8 * u < nkt) ? kt0 + 8 * u : klast; kc[u] = __builtin_bit_cast(u32x4, *(const bf16x8*)(kbase + (size_t)ke * 16 * DP)); }
        for (int kg = kt0; kg < nkt; kg += 32) {
#pragma unroll
            for (int u = 0; u < 4; ++u) { const int ke = (kg + 32 + 8 * u < nkt) ? kg + 32 + 8 * u : klast; kn[u] = __builtin_bit_cast(u32x4, *(const bf16x8*)(kbase + (size_t)ke * 16 * DP)); }
#pragma unroll
            for (int u = 0; u < 4; ++u) { const int kt = kg + 8 * u; const bool live = kt < nkt; const int ke = live ? kt : klast;
                unsigned kk[4];
                const f32x4 sc = idx_score(__builtin_bit_cast(bf16x8, kc[u]), qb, w4);
#pragma unroll
                for (int j = 0; j < 4; ++j) kk[j] = okey16(sc[j]);
                ksl[(size_t)ke * 64] = (u32x2){kk[0] | (kk[1] << 16), kk[2] | (kk[3] << 16)};
                const bool diag = (ke == klast);
                const bool same1 = !diag && ((kk[0] ^ kk[1]) | (kk[0] ^ kk[2]) | (kk[0] ^ kk[3])) < 256u;
                if (live && same1) __hip_atomic_fetch_add(hist + fr * HROW + (kk[0] >> 8), 4u, __ATOMIC_RELAXED, __HIP_MEMORY_SCOPE_WORKGROUP);
#pragma unroll
                for (int j = 0; j < 4; ++j) { const bool valid = live && (!diag || (ke * 16 + 4 * fq + j) <= tq);
                    if (!same1 && valid) __hip_atomic_fetch_add(hist + fr * HROW + (kk[j] >> 8), 1u, __ATOMIC_RELAXED, __HIP_MEMORY_SCOPE_WORKGROUP); } }
#pragma unroll
            for (int u = 0; u < 4; ++u) kc[u] = kn[u];
        }
        return;
    }
#pragma unroll
    for (int u = 0; u < 4; ++u) { kc[u] = (u32x4){0u, 0u, 0u, 0u}; if (kt0 + 8 * u < nkt) { const u32x2 q = ksl[(size_t)(kt0 + 8 * u) * 64]; kc[u].x = q.x; kc[u].y = q.y; } }
    for (int kg = kt0; kg < nkt; kg += 32) {
#pragma unroll
        for (int u = 0; u < 4; ++u) { kn[u] = kc[u]; if (kg + 32 + 8 * u < nkt) { const u32x2 q = ksl[(size_t)(kg + 32 + 8 * u) * 64]; kn[u].x = q.x; kn[u].y = q.y; } }
#pragma unroll
        for (int u = 0; u < 4; ++u) { const int kt = kg + 8 * u;
            if (kt < nkt) {
                unsigned kk[4];
                kk[0] = kc[u].x & 0xffffu; kk[1] = kc[u].x >> 16; kk[2] = kc[u].y & 0xffffu; kk[3] = kc[u].y >> 16;
                const bool diag = (kt == nkt - 1);
                unsigned nd = 0, nt_ = 0;
#pragma unroll
                for (int j = 0; j < 4; ++j) { const bool valid = !diag || (kt * 16 + 4 * fq + j) <= tq; const unsigned key = kk[j];
                    if (PASS == 2) { if (valid && (key >> 8) == r_a) __hip_atomic_fetch_add(hist + fr * HROW + (key & 255u), 1u, __ATOMIC_RELAXED, __HIP_MEMORY_SCOPE_WORKGROUP); }
                    if (PASS == 3) { if (valid) { nd |= (key > r_a ? 1u : 0u) << j; nt_ |= (key == r_a ? 1u : 0u) << j; } } }
                if (PASS == 3) { const int sh = 16 * (kt & 1) + 4 * fq; const int wd = fr * 128 + (kt >> 1);
                    if (nd) __hip_atomic_fetch_or(bm + wd, nd << sh, __ATOMIC_RELAXED, __HIP_MEMORY_SCOPE_WORKGROUP);
                    if (nt_) __hip_atomic_fetch_or(bm + 2048 + wd, nt_ << sh, __ATOMIC_RELAXED, __HIP_MEMORY_SCOPE_WORKGROUP); }
            } }
#pragma unroll
        for (int u = 0; u < 4; ++u) kc[u] = kn[u];
    }
}
__device__ __forceinline__ void lds_zero(Frame& F, int off, int bytes) {
    LAS u32x4* p = (LAS u32x4*)(F.lds + off); unsigned z = 0u; asm volatile("" : "+v"(z));
    for (int i = F.tid; i < bytes / 16; i += 512) p[i] = (u32x4){z, z, z, z};
}
__device__ __forceinline__ void dsa_select_tile(Frame& F, const bf16_t* P, u64* BM, unsigned* KS, int b, int qt) {
    volatile LAS unsigned* rinfo = F.MISC + 64;
    volatile LAS unsigned* bm = (volatile LAS unsigned*)F.lds; volatile LAS unsigned* hist = (volatile LAS unsigned*)(F.lds + DS_HIST);
    const int lane = F.lane, fr = lane & 15, fq = lane >> 4, w = F.wave;
    const int t0 = qt * 16, nkt = qt + 1; const size_t rowbase = (size_t)b * 4096;
    const bf16_t* qrow = P + (rowbase + t0 + fr) * DP;
    bf16x8 qb[4];
#pragma unroll
    for (int h = 0; h < 4; ++h) qb[h] = *(const bf16x8*)(qrow + C_IQ + h * 32 + 8 * fq);
    const u32x2 iwp = *(const u32x2*)(qrow + C_IW); const float w4[4] = {bflo(iwp.x), bfhi(iwp.x), bflo(iwp.y), bfhi(iwp.y)};
    const bf16_t* kbase = P + (rowbase + fr) * DP + C_IK + 8 * fq;
    const int tq = t0 + fr;
    lds_zero(F, 0, 16384);
    if (qt >= 16) {
        lds_zero(F, DS_HIST, 16 * HROW * 4 + 64); __syncthreads();
        dsa_pass<1, false>(F, kbase, KS, qb, w4, nkt, tq, 0u);
        __syncthreads();
#pragma unroll 1
        for (int rr = 0; rr < 2; ++rr) { const int r = 2 * w + rr; int bin; unsigned above, cb; scan_row(hist + r * HROW, 256u, lane, bin, above, cb);
            if (lane == 0) { rinfo[r * 4 + 0] = (unsigned)bin; rinfo[r * 4 + 1] = 256u - above; } }
        __syncthreads();
        lds_zero(F, DS_HIST, 16 * HROW * 4 + 64); __syncthreads();
        dsa_pass<2, false>(F, kbase, KS, qb, w4, nkt, tq, rinfo[fr * 4 + 0]);
        __syncthreads();
#pragma unroll 1
        for (int rr = 0; rr < 2; ++rr) { const int r = 2 * w + rr; const unsigned b1 = rinfo[r * 4 + 0], rem1 = rinfo[r * 4 + 1]; int bin; unsigned above, cb; scan_row(hist + r * HROW, rem1, lane, bin, above, cb);
            if (lane == 0) { const unsigned take = rem1 - above; rinfo[r * 4 + 0] = (b1 << 8) | (unsigned)bin; rinfo[r * 4 + 1] = take; rinfo[r * 4 + 2] = (cb > take) ? 1u : 0u; } }
        __syncthreads();
        dsa_pass<3, false>(F, kbase, KS, qb, w4, nkt, tq, rinfo[fr * 4 + 0]);
    } else {
        if (F.tid < 16) { rinfo[F.tid * 4 + 0] = 0u; rinfo[F.tid * 4 + 1] = 0xffffffffu; rinfo[F.tid * 4 + 2] = 0u; }
        __syncthreads();
        dsa_pass<3, true>(F, kbase, KS, qb, w4, nkt, tq, 0u);
    }
    __syncthreads();
    volatile LAS u64* FIN = (volatile LAS u64*)(F.lds + 16384);
#pragma unroll 1
    for (int rr = 0; rr < 2; ++rr) { const int r = 2 * w + rr;
        const u64 def = (u64)bm[r * 128 + 2 * lane] | ((u64)bm[r * 128 + 2 * lane + 1] << 32);
        u64 tie = (u64)bm[2048 + r * 128 + 2 * lane] | ((u64)bm[2048 + r * 128 + 2 * lane + 1] << 32);
        if (rinfo[r * 4 + 2]) { const int take = (int)rinfo[r * 4 + 1]; const int c = __popcll(tie); int inc = c;
#pragma unroll
            for (int o = 1; o < 64; o <<= 1) { const int t = bperm_i((lane - o) & 63, inc); if (lane >= o) inc += t; }
            int tk = take - (inc - c); tk = tk < 0 ? 0 : (tk > c ? c : tk);
            while (__popcll(tie) > tk) tie &= ~(1ull << (63 - __clzll((long long)tie))); }
        FIN[lane * 16 + r] = def | tie; }
    __syncthreads();
#pragma unroll
    for (int k = 0; k < 2; ++k) { const int idx = F.tid + 512 * k, l = idx >> 4, r = idx & 15;
        if (l <= (t0 >> 6)) BM[((size_t)(b * 64 + l) * 4096) + t0 + r] = FIN[l * 16 + r]; }
    __builtin_amdgcn_fence(__ATOMIC_ACQUIRE, "agent");
    __syncthreads();
}

#define MFMA32(a, b, c) __builtin_amdgcn_mfma_f32_32x32x16_bf16(a, b, c, 0, 0, 0)
typedef short v4i16_t __attribute__((ext_vector_type(4)));
__device__ __forceinline__ s16x4 vtr(const LAS unsigned char* p) { return __builtin_bit_cast(s16x4, __builtin_amdgcn_ds_read_tr16_b64_v4i16((LAS v4i16_t*)p)); }
constexpr int AT_KBUF = 0, AT_VBUF = 16384, AT_WSF = 49152, AT_LUT = 51200, AT_IMP = 57344, AT_RMASK = 124928, AT_WOR = 125440;
enum { MK_C = 0, MK_A = 1, MK_WIN = 2, MK_SLC = 3, MK_CMP = 4 };
constexpr float ATT_THR = 8.f;

template <int VD> struct AState { f32x16 o[VD / 32]; float m, l; };
template <int VD> __device__ __forceinline__ void astate_init(AState<VD>& s) {
#pragma unroll
    for (int d = 0; d < VD / 32; ++d)
#pragma unroll
        for (int r = 0; r < 16; ++r) s.o[d][r] = 0.f;
    s.m = -1e30f; s.l = 0.f;
}
__device__ __forceinline__ void dma16(const void* gsrc, LAS unsigned char* ldst) {
    unsigned keep; const unsigned la = (unsigned)(size_t)ldst;
    asm volatile("s_mov_b32 %0, m0\n\ts_mov_b32 m0, %2\n\ts_nop 0\n\tglobal_load_lds_dwordx4 %1, off\n\ts_mov_b32 m0, %0" : "=&s"(keep) : "v"(gsrc), "s"(la) : "memory");
}
template <int VD>
__device__ __forceinline__ void stage_kv(LAS unsigned char* kbuf, LAS unsigned char* vbuf, const bf16_t* Kt, int ldk, const bf16_t* Vt, int ldv, int wave, int lane, bool with_v) {
    dma16(Kt + (size_t)lane * ldk + wave * 8, kbuf + wave * 1024);
    if (with_v) {
#pragma unroll
        for (int pc0 = 0; pc0 < VD / 8; pc0 += 8) { const int pc = pc0 + wave;
            dma16(Vt + (size_t)(16 * (pc & 3) + (lane >> 2)) * ldv + (pc >> 2) * 32 + (lane & 3) * 8, vbuf + pc * 1024); }
    }
}
__device__ __forceinline__ void qk_tile(f32x16& S0, f32x16& S1, const bf16x8 (&qr)[4], const LAS unsigned char* kbuf, int r32, int hi) {
    const LAS unsigned char* kp = kbuf + hi * 1024 + r32 * 16; asm volatile("" : "+v"(kp));
#pragma unroll
    for (int r = 0; r < 16; ++r) { S0[r] = 0.f; S1[r] = 0.f; }
#pragma unroll
    for (int g = 0; g < 2; ++g) {
        bf16x8 kf[4];
#pragma unroll
        for (int d = 0; d < 2; ++d) { kf[2 * d] = *(const LAS bf16x8*)(kp + (2 * g + d) * 2048); kf[2 * d + 1] = *(const LAS bf16x8*)(kp + (2 * g + d) * 2048 + 512); }
#pragma unroll
        for (int d = 0; d < 2; ++d) { S0 = MFMA32(kf[2 * d], qr[2 * g + d], S0); S1 = MFMA32(kf[2 * d + 1], qr[2 * g + d], S1); }
        if (PROBE_ATT == 2) { f32x16 D0, D1;
#pragma unroll
            for (int r = 0; r < 16; ++r) { D0[r] = 0.f; D1[r] = 0.f; }
#pragma unroll
            for (int d = 0; d < 2; ++d) { D0 = MFMA32(kf[2 * d], qr[2 * g + d], D0); D1 = MFMA32(kf[2 * d + 1], qr[2 * g + d], D1); }
            asm volatile("" :: "v"(D0[0] + D1[0])); }
    }
}
template <int MODE>
__device__ __forceinline__ void apply_mask(f32x16& S0, f32x16& S1, int tq, int key0, int hi, bool near, const LAS float* lut, u64 bits, int aux) {
    const unsigned blo = (unsigned)bits >> (4 * hi), bhi = (unsigned)(bits >> 32) >> (4 * hi);
    if (MODE == MK_A) asm volatile("s_nop 15\n\ts_nop 3" ::: "memory");
#pragma unroll
    for (int n = 0; n < 2; ++n)
#pragma unroll
        for (int r = 0; r < 16; ++r) { const int kk0 = (r & 3) + 8 * (r >> 2); const int kk = kk0 + 4 * hi + 32 * n; const int dist = tq - (key0 + kk);
            bool valid;
            if (MODE == MK_C) valid = dist >= 0;
            else if (MODE == MK_A) valid = true;
            else if (MODE == MK_WIN) valid = dist >= 0 && dist < 512;
            else if (MODE == MK_SLC) valid = (aux != 0) && dist >= 0;
            else valid = (key0 + kk) < aux;
            float s = n ? S1[r] : S0[r];
            if (MODE != MK_CMP && near) { const int dc = dist < 0 ? 0 : (dist > 127 ? 127 : dist); s += lut[dc]; }
            if (MODE == MK_A) { const int mk = __builtin_amdgcn_sbfe((int)(n ? bhi : blo), kk0, 1);
                unsigned sb; asm("v_bfi_b32 %0, %1, %2, %3" : "=v"(sb) : "v"(mk), "v"(__builtin_bit_cast(unsigned, s)), "v"(0xff800000u)); s = __builtin_bit_cast(float, sb); }
            else s = valid ? s : -INFINITY;
            if (n) S1[r] = s; else S0[r] = s; }
}
__device__ __forceinline__ float vmax3(float a, float b, float c) { float r; asm("v_max3_f32 %0, %1, %2, %3" : "=v"(r) : "v"(a), "v"(b), "v"(c)); return r; }
__device__ __forceinline__ float vmax2(float a, float b) { float r; asm("v_max_f32 %0, %1, %2" : "=v"(r) : "v"(a), "v"(b)); return r; }
__device__ __forceinline__ float row_max32(const f32x16& S0, const f32x16& S1, int lane) {
    asm volatile("s_nop 15\n\ts_nop 3" ::: "memory");
    float a = vmax3(S0[0], S0[1], S1[0]), b = vmax3(S0[2], S0[3], S1[1]); a = vmax3(a, S1[2], S1[3]);
#pragma unroll
    for (int r = 4; r < 16; r += 4) { a = vmax3(a, S0[r], S0[r + 1]); b = vmax3(b, S0[r + 2], S0[r + 3]); a = vmax3(a, S1[r], S1[r + 1]); b = vmax3(b, S1[r + 2], S1[r + 3]); }
    return vmax2(a, b);
}
__device__ __forceinline__ void v_load2(bf16x8 (&vf)[2][4], const LAS unsigned char* vbuf, int db0, int lane) {
    const int hi = lane >> 5;
    const LAS unsigned char* vp = vbuf + ((lane >> 4) & 1) * 32 + (lane & 3) * 8 + (4 * hi + ((lane & 15) >> 2)) * 64 + db0 * 4096;
#pragma unroll
    for (int d = 0; d < 2; ++d)
#pragma unroll
        for (int ks = 0; ks < 4; ++ks) { const s16x4 lo = vtr(vp + d * 4096 + ks * 1024), hh = vtr(vp + d * 4096 + ks * 1024 + 512);
            vf[d][ks] = (bf16x8){lo[0], lo[1], lo[2], lo[3], hh[0], hh[1], hh[2], hh[3]}; }
}
__device__ __forceinline__ void p_pack(bf16x8 (&pa)[4], const f32x16& S0, const f32x16& S1) {
#pragma unroll
    for (int ks = 0; ks < 4; ++ks) { u32x4 w;
        if (ks == 0) { w.x = cvt_pk_bf16(S0[0], S0[1]); w.y = cvt_pk_bf16(S0[2], S0[3]); w.z = cvt_pk_bf16(S0[4], S0[5]); w.w = cvt_pk_bf16(S0[6], S0[7]); }
        else if (ks == 1) { w.x = cvt_pk_bf16(S0[8], S0[9]); w.y = cvt_pk_bf16(S0[10], S0[11]); w.z = cvt_pk_bf16(S0[12], S0[13]); w.w = cvt_pk_bf16(S0[14], S0[15]); }
        else if (ks == 2) { w.x = cvt_pk_bf16(S1[0], S1[1]); w.y = cvt_pk_bf16(S1[2], S1[3]); w.z = cvt_pk_bf16(S1[4], S1[5]); w.w = cvt_pk_bf16(S1[6], S1[7]); }
        else { w.x = cvt_pk_bf16(S1[8], S1[9]); w.y = cvt_pk_bf16(S1[10], S1[11]); w.z = cvt_pk_bf16(S1[12], S1[13]); w.w = cvt_pk_bf16(S1[14], S1[15]); }
        pa[ks] = __builtin_bit_cast(bf16x8, w); }
}
template <int VD>
__device__ __forceinline__ void pv_tile(f32x16 (&o)[VD / 32], const f32x16& S0, const f32x16& S1, const bf16x8 (&vf01)[2][4], const LAS unsigned char* vbuf, int lane) {
    bf16x8 pa[4]; p_pack(pa, S0, S1);
    if (VD == 128) {
        bf16x8 va[4], vb[4];
        const int hi = lane >> 5;
        const LAS unsigned char* vp = vbuf + ((lane >> 4) & 1) * 32 + (lane & 3) * 8 + (4 * hi + ((lane & 15) >> 2)) * 64;
#pragma unroll
        for (int ks = 0; ks < 4; ++ks) { const s16x4 lo = vtr(vp + 2 * 4096 + ks * 1024), hh = vtr(vp + 2 * 4096 + ks * 1024 + 512); va[ks] = (bf16x8){lo[0], lo[1], lo[2], lo[3], hh[0], hh[1], hh[2], hh[3]}; }
#pragma unroll
        for (int ks = 0; ks < 4; ++ks) { const s16x4 lo = vtr(vp + 3 * 4096 + ks * 1024), hh = vtr(vp + 3 * 4096 + ks * 1024 + 512); vb[ks] = (bf16x8){lo[0], lo[1], lo[2], lo[3], hh[0], hh[1], hh[2], hh[3]}; }
#pragma unroll
        for (int ks = 0; ks < 4; ++ks) { o[0] = MFMA32(pa[ks], vf01[0][ks], o[0]); o[1] = MFMA32(pa[ks], vf01[1][ks], o[1]); }
        __builtin_amdgcn_sched_barrier(0);
#pragma unroll
        for (int ks = 0; ks < 4; ++ks) { o[(VD == 128) ? 2 : 0] = MFMA32(pa[ks], va[ks], o[(VD == 128) ? 2 : 0]); o[(VD == 128) ? 3 : 0] = MFMA32(pa[ks], vb[ks], o[(VD == 128) ? 3 : 0]); }
    } else {
#pragma unroll
        for (int ks = 0; ks < 4; ++ks)
#pragma unroll
            for (int d = 0; d < 2; ++d) o[d] = MFMA32(pa[ks], vf01[d][ks], o[d]);
    }
}
template <int ND>
__device__ __forceinline__ void scale_rows(f32x16 (&o)[ND], float f, LAS float* wsf, int lane) {
    const int hi = lane >> 5;
    wsf[lane & 31] = f;
#pragma unroll
    for (int g = 0; g < 4; ++g) { const f32x4 a = *(const LAS f32x4*)(wsf + 8 * g + 4 * hi);
#pragma unroll
        for (int d = 0; d < ND; ++d)
#pragma unroll
            for (int i = 0; i < 4; ++i) o[d][4 * g + i] *= a[i]; }
}
template <int VD, bool PV>
__device__ __forceinline__ void softmax_step(AState<VD>& st, f32x16& S0, f32x16& S1, const LAS unsigned char* vbuf, LAS float* wsf, int lane) {
    bf16x8 vf01[2][4];
    if (PV) { v_load2(vf01, vbuf, 0, lane); __builtin_amdgcn_sched_barrier(0); }
    const float mx = row_max32(S0, S1, lane);
    if (__any(mx - st.m > ATT_THR)) { const float mnew = vmax2(st.m, vmax2(mx, bperm_f(lane ^ 32, mx))); const float alpha = fexp2(st.m - mnew); st.l *= alpha; st.m = mnew;
        if (PV) scale_rows<VD / 32>(st.o, alpha, wsf, lane); }
    float sum = 0.f;
#pragma unroll
    for (int r = 0; r < 16; ++r) { S0[r] = fexp2(S0[r] - st.m); S1[r] = fexp2(S1[r] - st.m); }
#pragma unroll
    for (int r = 0; r < 16; ++r) sum += S0[r];
#pragma unroll
    for (int r = 0; r < 16; ++r) sum += S1[r];
    st.l += sum;
    if (PROBE_ATT == 1) { float dm = 0.f;
#pragma unroll
        for (int r = 0; r < 16; ++r) { float t0 = S0[r], t1 = S1[r]; asm volatile("" : "+v"(t0), "+v"(t1)); dm += fexp2(t0 - st.m) + fexp2(t1 - st.m); }
        asm volatile("" :: "v"(dm)); }
    if (PV) pv_tile<VD>(st.o, S0, S1, vf01, vbuf, lane);
}
template <int ND>
__device__ __forceinline__ void finish_add(f32x16 (&acc)[ND], const f32x16 (&o)[ND], float l, float gate, LAS float* wsf, int lane) {
    const int hi = lane >> 5;
    const float lt = sum32(l, lane); const float f = lt > 0.f ? gate / lt : 0.f;
    wsf[lane & 31] = f;
#pragma unroll
    for (int g = 0; g < 4; ++g) { const f32x4 a = *(const LAS f32x4*)(wsf + 8 * g + 4 * hi);
#pragma unroll
        for (int d = 0; d < ND; ++d)
#pragma unroll
            for (int i = 0; i < 4; ++i) acc[d][4 * g + i] += o[d][4 * g + i] * a[i]; }
}

__device__ __forceinline__ int crow(int r, int hi) { return (r & 3) + 8 * (r >> 2) + 4 * hi; }

#define C_KS(s_) ((s_) == 2 ? 122880 : (s_) * 8192)
#define C_VS(s_) ((s_) == 2 ? 131072 : 16384 + (s_) * 16384)
__device__ __forceinline__ void unit_C(Frame& F, const bf16_t* P, bf16_t* OC, const float* gnorm, float lam, float lam_init, int b, int h, int qb) {
    const int lane = F.lane, r32 = lane & 31, hi = lane >> 5, w = F.wave;
    LAS unsigned char* lds = F.lds; LAS float* wsf = (LAS float*)(lds + AT_WSF) + w * 64; const LAS float* lut = (const LAS float*)(lds + AT_LUT) + (8 + h) * 128;
    const int q0 = qb * 256, tw0 = q0 + 32 * w, tq = tw0 + r32; const size_t rowbase = (size_t)b * 4096;
    const int NT = 4 * qb + 4, my_last = (tw0 + 31) >> 6;
    LAS unsigned* kpl = (LAS unsigned*)(lds + AT_IMP) + w * 2048 + lane;
    AState<128> st;
#pragma unroll 1
    for (int j = 0; j < 2; ++j) {
        const bf16_t* Qp = P + (rowbase + tq) * DP + C_CQ + h * 128 + j * 64;
        bf16x8 qr[4];
#pragma unroll
        for (int d0 = 0; d0 < 4; ++d0) qr[d0] = *(const bf16x8*)(Qp + d0 * 16 + hi * 8);
        const bf16_t* Kb = P + rowbase * DP + C_CK + h * 128 + j * 64; const bf16_t* Vb = P + rowbase * DP + C_CV + h * 128;
        astate_init(st);
        stage_kv<128>(lds + AT_KBUF, lds + AT_VBUF, Kb, DP, Vb, DP, w, lane, true);
#pragma unroll 1
        for (int kt = 0; kt < NT; ++kt) {
            VM_WAIT(); __syncthreads();
            const int cb = kt & 1;
            if (kt + 1 < NT) stage_kv<128>(lds + AT_KBUF + (cb ^ 1) * 8192, lds + AT_VBUF + (cb ^ 1) * 16384, Kb + (size_t)(kt + 1) * 64 * DP, DP, Vb + (size_t)(kt + 1) * 64 * DP, DP, w, lane, true);
            if (kt <= my_last) {
                f32x16 S0, S1; qk_tile(S0, S1, qr, lds + AT_KBUF + cb * 8192, r32, hi);
                const int key0 = kt * 64; const bool near = (tw0 - (key0 + 63)) < 113;
                if (near) apply_mask<MK_C>(S0, S1, tq, key0, hi, true, lut, 0ull, 0);
                softmax_step<128, true>(st, S0, S1, lds + AT_VBUF + cb * 16384, wsf, lane);
            }
        }
        __syncthreads();
        const float lt = sum32(st.l, lane);
        if (j == 0) { scale_rows<4>(st.o, 1.f / lt, wsf, lane);
#pragma unroll
            for (int d = 0; d < 4; ++d)
#pragma unroll
                for (int r = 0; r < 8; ++r) kpl[(d * 8 + r) * 64] = cvt_pk_bf16(st.o[d][2 * r], st.o[d][2 * r + 1]);
        } else { scale_rows<4>(st.o, -lam / lt, wsf, lane);
#pragma unroll
            for (int d = 0; d < 4; ++d)
#pragma unroll
                for (int r = 0; r < 8; ++r) { const unsigned kw = kpl[(d * 8 + r) * 64]; st.o[d][2 * r] += bflo(kw); st.o[d][2 * r + 1] += bfhi(kw); } }
    }
    f32x16 (&keep)[4] = st.o;
    float gch[4];
#pragma unroll
    for (int d = 0; d < 4; ++d) gch[d] = gnorm[32 * d + r32] * (1.f - lam_init);
    GAS unsigned char* orow = (GAS unsigned char*)OC + (rowbase + tw0) * 1024 + 512 + h * 128 + r32; asm volatile("" : "+v"(orow)); int hs = hi; asm volatile("" : "+v"(hs));
#pragma unroll
    for (int r = 0; r < 16; ++r) { float ss = keep[0][r] * keep[0][r] + keep[1][r] * keep[1][r] + keep[2][r] * keep[2][r] + keep[3][r] * keep[3][r];
        ss += shx_f(ss, 1, lane); ss += shx_f(ss, 2, lane); ss += shx_f(ss, 4, lane); ss += shx_f(ss, 8, lane); ss += shx_f(ss, 16, lane);
        const float sc = 1.f / sqrtf(ss * (1.f / 128.f) + LN_EPS);
#pragma unroll
        for (int d = 0; d < 4; ++d) orow[crow(r, hs) * 1024 + 32 * d] = (unsigned char)__builtin_amdgcn_cvt_pk_fp8_f32(F8_OC * keep[d][r] * sc * gch[d], 0.f, 0, false); }
}

__device__ __forceinline__ void unit_A(Frame& F, const bf16_t* P, const u64* BM, bf16_t* OC, int b, int qi) {
    const int lane = F.lane, r32 = lane & 31, hi = lane >> 5, w = F.wave, h = w & 3, rg = w >> 2;
    LAS unsigned char* lds = F.lds; LAS float* wsf = (LAS float*)(lds + AT_WSF) + w * 64; const LAS float* lut = (const LAS float*)(lds + AT_LUT) + h * 128;
    const int q0 = qi * 64, tw0 = q0 + 32 * rg, tq = tw0 + r32; const size_t rowbase = (size_t)b * 4096;
    const int NT = qi + 1;
    const bf16_t* Qp = P + (rowbase + tq) * DP + C_AQ + h * 64;
    bf16x8 qr[4];
#pragma unroll
    for (int d0 = 0; d0 < 4; ++d0) qr[d0] = *(const bf16x8*)(Qp + d0 * 16 + hi * 8);
    const bf16_t* Kb = P + rowbase * DP + C_AK; const bf16_t* Vb = P + rowbase * DP + C_AV;
    const u64* bmp = BM + (size_t)b * 64 * 4096 + tq;
    u64 bits = bmp[0];
    AState<64> st; astate_init(st);
    stage_kv<64>(lds + AT_KBUF, lds + AT_VBUF, Kb, DP, Vb, DP, w, lane, true);
#pragma unroll 1
    for (int kt = 0; kt < NT; ++kt) {
        VM_WAIT(); __syncthreads();
        const int cb = kt & 1;
        u64 nbits = 0ull;
        if (kt + 1 < NT) { stage_kv<64>(lds + AT_KBUF + (cb ^ 1) * 8192, lds + AT_VBUF + (cb ^ 1) * 16384, Kb + (size_t)(kt + 1) * 64 * DP, DP, Vb + (size_t)(kt + 1) * 64 * DP, DP, w, lane, true);
            nbits = bmp[(size_t)(kt + 1) * 4096]; }
        f32x16 S0, S1; qk_tile(S0, S1, qr, lds + AT_KBUF + cb * 8192, r32, hi);
        const int key0 = kt * 64; const bool near = (tw0 - (key0 + 63)) < 113;
        if (A_DENSE) { if (near) apply_mask<MK_C>(S0, S1, tq, key0, hi, true, lut, 0ull, 0); } else apply_mask<MK_A>(S0, S1, tq, key0, hi, near, lut, bits, 0);
        softmax_step<64, true>(st, S0, S1, lds + AT_VBUF + cb * 16384, wsf, lane);
        bits = nbits;
    }
    __syncthreads();
    f32x16 acc[2];
#pragma unroll
    for (int d = 0; d < 2; ++d)
#pragma unroll
        for (int r = 0; r < 16; ++r) acc[d][r] = 0.f;
    const float lt = sum32(st.l, lane);
    finish_add<2>(acc, st.o, 0.5f, lt > 0.f ? 1.f / lt : 0.f, wsf, lane);
    GAS unsigned char* orow = (GAS unsigned char*)OC + (rowbase + tw0) * 1024 + h * 64 + r32; asm volatile("" : "+v"(orow)); int hs = hi; asm volatile("" : "+v"(hs));
#pragma unroll
    for (int r = 0; r < 16; ++r)
#pragma unroll
        for (int d = 0; d < 2; ++d) orow[crow(r, hs) * 1024 + 32 * d] = (unsigned char)__builtin_amdgcn_cvt_pk_fp8_f32(F8_OC * acc[d][r], 0.f, 0, false);
}

constexpr int IMP_LD = 65;
__device__ __forceinline__ void unit_B(Frame& F, const bf16_t* P, const bf16_t* KC, const bf16_t* VC, bf16_t* OC, int b, int qi) {
    const int lane = F.lane, r32 = lane & 31, hi = lane >> 5, w = F.wave, h = w & 3, rg = w >> 2;
    LAS unsigned char* lds = F.lds; LAS float* wsf = (LAS float*)(lds + AT_WSF) + w * 64; const LAS float* lut = (const LAS float*)(lds + AT_LUT) + (4 + h) * 128;
    LAS float* imp = (LAS float*)(lds + AT_IMP); volatile LAS u64* rmask = (volatile LAS u64*)(lds + AT_RMASK); volatile LAS u64* wor = (volatile LAS u64*)(lds + AT_WOR);
    const int q0 = qi * 64, cur = qi, tw0 = q0 + 32 * rg, tq = tw0 + r32, urow = 32 * rg + r32; const size_t rowbase = (size_t)b * 4096;
    const bf16_t* prow = P + (rowbase + tq) * DP;
    bf16x8 qr[4];
#pragma unroll
    for (int d0 = 0; d0 < 4; ++d0) qr[d0] = *(const bf16x8*)(prow + C_BQ + h * 64 + d0 * 16 + hi * 8);
    const float g0 = fsigmoid(bf2f(prow[C_BG + h * 3 + 0])), g1 = fsigmoid(bf2f(prow[C_BG + h * 3 + 1])), g2 = fsigmoid(bf2f(prow[C_BG + h * 3 + 2]));
    f32x16 ob[2];
#pragma unroll
    for (int d = 0; d < 2; ++d)
#pragma unroll
        for (int r = 0; r < 16; ++r) ob[d][r] = 0.f;
    {
        const int ncv = tq >= 31 ? ((tq - 31) >> 4) + 1 : 0;
        const int ncv_max = ((q0 + 63 - 31) >> 4) + 1, NTc = (ncv_max + 63) >> 6;
        const bf16_t* Kc = KC + (size_t)b * 256 * 64; const bf16_t* Vc = VC + (size_t)b * 256 * 64;
        AState<64> st; astate_init(st);
        stage_kv<64>(lds + AT_KBUF, lds + AT_VBUF, Kc, 64, Vc, 64, w, lane, false);
#pragma unroll 1
        for (int kt = 0; kt < NTc; ++kt) {
            VM_WAIT(); __syncthreads();
            const int cb = kt & 1;
            if (kt + 1 < NTc) stage_kv<64>(lds + AT_KBUF + (cb ^ 1) * 8192, lds + AT_VBUF + (cb ^ 1) * 16384, Kc + (size_t)(kt + 1) * 64 * 64, 64, Vc, 64, w, lane, false);
            f32x16 S0, S1; qk_tile(S0, S1, qr, lds + AT_KBUF + cb * 8192, r32, hi);
            apply_mask<MK_CMP>(S0, S1, tq, kt * 64, hi, false, lut, 0ull, ncv);
            softmax_step<64, false>(st, S0, S1, lds + AT_VBUF, wsf, lane);
        }
        __syncthreads();
        const float lt = sum32(st.l, lane); const float inv = lt > 0.f ? 1.f / lt : 0.f; const float mfin = st.m;
        f32x16 oc[2];
#pragma unroll
        for (int d = 0; d < 2; ++d)
#pragma unroll
            for (int r = 0; r < 16; ++r) oc[d][r] = 0.f;
        float carry = 0.f;
        stage_kv<64>(lds + AT_KBUF, lds + AT_VBUF, Kc, 64, Vc, 64, w, lane, true);
#pragma unroll 1
        for (int kt = 0; kt < NTc; ++kt) {
            VM_WAIT(); __syncthreads();
            const int cb = kt & 1;
            if (kt + 1 < NTc) stage_kv<64>(lds + AT_KBUF + (cb ^ 1) * 8192, lds + AT_VBUF + (cb ^ 1) * 16384, Kc + (size_t)(kt + 1) * 64 * 64, 64, Vc + (size_t)(kt + 1) * 64 * 64, 64, w, lane, true);
            f32x16 S0, S1; qk_tile(S0, S1, qr, lds + AT_KBUF + cb * 8192, r32, hi);
            apply_mask<MK_CMP>(S0, S1, tq, kt * 64, hi, false, lut, 0ull, ncv);
#pragma unroll
            for (int r = 0; r < 16; ++r) { S0[r] = fexp2(S0[r] - mfin) * inv; S1[r] = fexp2(S1[r] - mfin) * inv; }
            float own[2][4], pl[2][4];
#pragma unroll
            for (int g = 0; g < 4; ++g) { own[0][g] = (S0[4 * g] + S0[4 * g + 1]) + (S0[4 * g + 2] + S0[4 * g + 3]); own[1][g] = (S1[4 * g] + S1[4 * g + 1]) + (S1[4 * g + 2] + S1[4 * g + 3]);
                pl[0][g] = other32(S0[4 * g + 3], lane); pl[1][g] = other32(S1[4 * g + 3], lane); }
#pragma unroll
            for (int n = 0; n < 2; ++n)
#pragma unroll
                for (int g = 0; g < 4; ++g) { const int J = 16 * kt + 8 * n + 2 * g + hi;
                    const float prev0 = (g > 0) ? pl[n][g > 0 ? g - 1 : 0] : (n == 1 ? pl[0][3] : carry);
                    const float prev = hi ? pl[n][g] : prev0;
                    imp[(h * 64 + urow) * IMP_LD + J] = own[n][g] + prev; }
            carry = pl[1][3];
            { bf16x8 vf01[2][4]; v_load2(vf01, lds + AT_VBUF + cb * 16384, 0, lane); pv_tile<64>(oc, S0, S1, vf01, lds + AT_VBUF + cb * 16384, lane); }
        }
        finish_add<2>(ob, oc, 0.5f, g0, wsf, lane);
        __syncthreads();
    }
    {
        const int nf = cur >= 2 ? 3 : cur + 1, nfree = 16 - nf; u64 worl = 0ull;
#pragma unroll 1
        for (int rr = 0; rr < 8; ++rr) { const int row = 8 * w + rr; const int j = lane;
            const float v = (imp[(0 * 64 + row) * IMP_LD + j] + imp[(1 * 64 + row) * IMP_LD + j]) + (imp[(2 * 64 + row) * IMP_LD + j] + imp[(3 * 64 + row) * IMP_LD + j]);
            const bool cand = (j >= 1) && (j <= cur - 2);
            int rank = 0;
#pragma unroll 4
            for (int k = 1; k <= cur - 2; ++k) { const float vk = __builtin_bit_cast(float, __builtin_amdgcn_readlane(__builtin_bit_cast(int, v), k)); rank += (vk > v || (vk == v && k < j)) ? 1 : 0; }
            const bool forced = (j <= cur) && (j == 0 || j == cur || j == cur - 1);
            const bool sel = forced || (cand && rank < nfree);
            const u64 mk = __ballot(sel);
            if (lane == 0) rmask[row] = mk;
            worl |= mk; }
        if (lane == 0) wor[w] = worl;
        __syncthreads();
    }
    const u64 myrm = rmask[urow];
    u64 un = 0ull;
#pragma unroll
    for (int k = 0; k < 8; ++k) un |= wor[k];
    {
        const bf16_t* Kb = P + rowbase * DP + C_BKV + 2 * 64; const bf16_t* Vb = P + rowbase * DP + C_BKV + 3 * 64;
        AState<64> st; astate_init(st);
        const int nsel = __popcll(un);
        int j = __ffsll((long long)un) - 1; un &= un - 1;
        stage_kv<64>(lds + AT_KBUF, lds + AT_VBUF, Kb + (size_t)j * 64 * DP, DP, Vb + (size_t)j * 64 * DP, DP, w, lane, true);
#pragma unroll 1
        for (int i = 0; i < nsel; ++i) {
            VM_WAIT(); __syncthreads();
            const int cb = i & 1;
            int jn = -1;
            if (un) { jn = __ffsll((long long)un) - 1; un &= un - 1;
                stage_kv<64>(lds + AT_KBUF + (cb ^ 1) * 8192, lds + AT_VBUF + (cb ^ 1) * 16384, Kb + (size_t)jn * 64 * DP, DP, Vb + (size_t)jn * 64 * DP, DP, w, lane, true); }
            const int rowsel = (int)((myrm >> j) & 1ull);
            if (__any(rowsel)) {
                f32x16 S0, S1; qk_tile(S0, S1, qr, lds + AT_KBUF + cb * 8192, r32, hi);
                const int key0 = j * 64; const bool near = (tw0 - (key0 + 63)) < 113;
                if (near || j == cur || !__all(rowsel)) apply_mask<MK_SLC>(S0, S1, tq, key0, hi, near, lut, 0ull, rowsel);
                softmax_step<64, true>(st, S0, S1, lds + AT_VBUF + cb * 16384, wsf, lane);
            }
            j = jn;
        }
        __syncthreads();
        const float lt = sum32(st.l, lane);
        finish_add<2>(ob, st.o, 0.5f, lt > 0.f ? g1 / lt : 0.f, wsf, lane);
    }
    {
        const bf16_t* Kb = P + rowbase * DP + C_BKV + 4 * 64; const bf16_t* Vb = P + rowbase * DP + C_BKV + 5 * 64;
        AState<64> st; astate_init(st);
        const int kt0 = cur >= 8 ? cur - 8 : 0;
        stage_kv<64>(lds + AT_KBUF, lds + AT_VBUF, Kb + (size_t)kt0 * 64 * DP, DP, Vb + (size_t)kt0 * 64 * DP, DP, w, lane, true);
#pragma unroll 1
        for (int kt = kt0; kt <= cur; ++kt) {
            VM_WAIT(); __syncthreads();
            const int cb = (kt - kt0) & 1;
            if (kt + 1 <= cur) stage_kv<64>(lds + AT_KBUF + (cb ^ 1) * 8192, lds + AT_VBUF + (cb ^ 1) * 16384, Kb + (size_t)(kt + 1) * 64 * DP, DP, Vb + (size_t)(kt + 1) * 64 * DP, DP, w, lane, true);
            f32x16 S0, S1; qk_tile(S0, S1, qr, lds + AT_KBUF + cb * 8192, r32, hi);
            const int key0 = kt * 64; const bool near = (tw0 - (key0 + 63)) < 113;
            const bool allv = (key0 + 63 <= tw0) && (tw0 + 31 - key0 < 512);
            if (near || !allv) apply_mask<MK_WIN>(S0, S1, tq, key0, hi, near, lut, 0ull, 0);
            softmax_step<64, true>(st, S0, S1, lds + AT_VBUF + cb * 16384, wsf, lane);
        }
        __syncthreads();
        const float lt = sum32(st.l, lane);
        finish_add<2>(ob, st.o, 0.5f, lt > 0.f ? g2 / lt : 0.f, wsf, lane);
    }
    GAS unsigned char* orow = (GAS unsigned char*)OC + (rowbase + tw0) * 1024 + 256 + h * 64 + r32; asm volatile("" : "+v"(orow)); int hs = hi; asm volatile("" : "+v"(hs));
#pragma unroll
    for (int r = 0; r < 16; ++r)
#pragma unroll
        for (int d = 0; d < 2; ++d) orow[crow(r, hs) * 1024 + 32 * d] = (unsigned char)__builtin_amdgcn_cvt_pk_fp8_f32(F8_OC * ob[d][r], 0.f, 0, false);
}

__device__ __forceinline__ void phase_cmp2(Frame& F, const bf16_t* HID, const bf16_t* W2T, bf16_t* KC) {
    const int lane = F.lane, fr = lane & 15, fq = lane >> 4;
    for (int task = F.gw; task < 512; task += F.NGW) { const int j = task >> 8, row0 = (task & 255) * 16;
        f32x4 acc[4];
#pragma unroll
        for (int n = 0; n < 4; ++n) acc[n] = (f32x4){0.f, 0.f, 0.f, 0.f};
#pragma unroll
        for (int ks = 0; ks < 8; ++ks) { const bf16x8 a = *(const bf16x8*)(HID + ((size_t)j * 4096 + row0 + fr) * 256 + ks * 32 + 8 * fq);
#pragma unroll
            for (int n = 0; n < 4; ++n) { const bf16x8 bb = *(const bf16x8*)(W2T + ((size_t)j * 64 + n * 16 + fr) * 256 + ks * 32 + 8 * fq);
                acc[n] = __builtin_amdgcn_mfma_f32_16x16x32_bf16(a, bb, acc[n], 0, 0, 0); } }
#pragma unroll
        for (int n = 0; n < 4; ++n)
#pragma unroll
            for (int jj = 0; jj < 4; ++jj) KC[((size_t)j * 4096 + row0 + 4 * fq + jj) * 64 + n * 16 + fr] = (bf16_t)f2bf(acc[n][jj]);
    }
}

constexpr int PH_PER_LAYER = 11, N_PHASES = 2 + DEPTH * PH_PER_LAYER;
struct Args { const float* in[27]; float* out; unsigned char* ws; int ph_lo, ph_hi, li, pad; };

#define IN(k) (lo <= (k) && (k) < hi)
#define SEAM(k) do { if (IN((k) + 1)) xcd_barrier(bar); } while (0)
#define WSB (F.ws)
#define PROJ ((bf16_t*)(WSB + WS_PROJ))
#define HB ((bf16_t*)(WSB + WS_HB))
#define OCAT ((bf16_t*)(WSB + WS_OCAT))
#define MERG ((bf16_t*)(WSB + WS_MERG))
#define X1 ((bf16_t*)(WSB + WS_X1))
#define MOD ((const float*)(WSB + WS_MOD))

template <int l>
__device__ __forceinline__ void run_layer(Frame& F, const Args& args, const XcdBarrier& bar, int lo, int hi) {
        const int pb = 2 + l * PH_PER_LAYER;
#define xres ((l == 0) ? args.in[0] : (const float*)args.out)
#define mod_a (MOD + (size_t)(2 * l) * 16 * 3072)
#define mod_f (MOD + (size_t)(2 * l + 1) * 16 * 3072)
        if (IN(pb + 0)) for (int rep = 0; rep < ((l == 0 && DUP == 0) ? 2 : 1); ++rep) { if (rep) xcd_barrier(bar); refresh(F);
            { pg8::Gemm g{HB, (const bf16_t*)(WSB + WS_WIN_T) + (size_t)l * DP * 1024, 1024, 1024, 1024, 128}; pg8::StaticOrder S; S.init(NTOK, N_BF, F.G, (int)blockIdx.x);
              pg8::EpiProj E{PROJ, 0, 1.f};
              pg8::gemm_phase<pg8::EpiProj, pg8::StaticOrder>(F.lds, g, S, E, F.wave); }
            { pg8::Gemm g{(const bf16_t*)(WSB + WS_HB8), (const bf16_t*)(WSB + WS_WMG8 + (size_t)l * N_F8 * 1024), 512, 512, 512, 128}; pg8::StaticOrder S; S.init(NTOK, N_F8, F.G, (int)blockIdx.x);
              pg8::EpiGate8 E{(unsigned char*)(WSB + WS_MG8), 1.f / (F8_H * F8_WIN)};
              pg8::gemm_phase<pg8::EpiGate8, pg8::StaticOrder, true>(F.lds, g, S, E, F.wave); }
            if (blockIdx.x == 255) { u32x4* z = (u32x4*)(PROJ + (size_t)NTOK * DP); for (int i = F.tid; i < 32 * DP * 2 / 16; i += 512) z[i] = (u32x4){0u, 0u, 0u, 0u}; }
            SEAM(pb + 0);
        }
        if (IN(pb + 1)) for (int rep = 0; rep < ((l == 0 && DUP == 1) ? 2 : 1); ++rep) { if (rep) xcd_barrier(bar); refresh(F);
            { pg8::Gemm g{PROJ + C_BKV, (const bf16_t*)(WSB + WS_W1_T) + (size_t)l * 2 * 256 * 2048, 16 * DP, 2048, 2048, DP * 2}; pg8::CmpOrder S{F.G, (int)blockIdx.x};
              pg8::EpiCmp1 E{(bf16_t*)(WSB + WS_HID), (const float*)(WSB + WS_BIAS1) + l * 512};
              pg8::gemm_phase<pg8::EpiCmp1, pg8::CmpOrder>(F.lds, g, S, E, F.wave); }
            __syncthreads();
            if (USE_A) {
                unsigned* tq = (unsigned*)(WSB + WS_CTL) + CW_CNT + l * 64 + 48;
                if (F.tid == 0) F.MISC[9] = __hip_atomic_fetch_add(tq, 1u, __ATOMIC_RELAXED, __HIP_MEMORY_SCOPE_AGENT);
                __syncthreads();
                unsigned n = F.MISC[9];
#pragma unroll 1
                while (n < 4096u) {
                    unsigned nn = 0u; if (F.tid == 0) nn = __hip_atomic_fetch_add(tq, 1u, __ATOMIC_RELAXED, __HIP_MEMORY_SCOPE_AGENT);
                    dsa_select_tile(F, PROJ, (u64*)(WSB + WS_BM64), (unsigned*)(WSB + WS_OCAT) + (size_t)blockIdx.x * 65536, (int)(n >> 8), 255 - (int)(n & 255u));
                    if (F.tid == 0) F.MISC[9] = nn;
                    __syncthreads();
                    n = F.MISC[9];
                    __syncthreads();
                }
            }
            SEAM(pb + 1);
        }
        if (IN(pb + 2)) for (int rep = 0; rep < ((l == 0 && DUP == 2) ? 2 : 1); ++rep) { if (rep) xcd_barrier(bar); refresh(F); phase_cmp2(F, (const bf16_t*)(WSB + WS_HID), (const bf16_t*)(WSB + WS_W2_T) + (size_t)l * 2 * 64 * 256, (bf16_t*)(WSB + WS_KCMP)); SEAM(pb + 2); }
        if (IN(pb + 3)) for (int rep = 0; rep < ((l == 0 && DUP == 3) ? 2 : 1); ++rep) { if (rep) xcd_barrier(bar); refresh(F);
            for (int i = F.tid; i < 12 * 128; i += 512) ((LAS float*)(F.lds + AT_LUT))[i] = ((const float*)(WSB + WS_LUT))[i];
            __syncthreads();
            const int c = (int)blockIdx.x;
            if (USE_C) {
                const float lam = ((const float*)(WSB + WS_LAM))[l]; const float lam_init = 0.8f - 0.6f * __expf(-0.3f * (float)l);
#pragma unroll 1
                for (int u = 0; u < 4; ++u) { const int bh = (c & 7) * 8 + (c >> 5), pp = ((c >> 3) & 3) * 2 + (u >> 1); const int qb = (u & 1) ? pp : 15 - pp;
                    refresh(F); unit_C(F, PROJ, OCAT, args.in[10] + l * 128, lam, lam_init, bh >> 2, bh & 3, qb); }
            }
            if (USE_A) {
#pragma unroll 1
                for (int u = 0; u < 4; ++u) { const int b = (c & 7) * 2 + (c >> 7), pp = ((c >> 3) & 15) * 2 + (u >> 1); const int qi = (u & 1) ? pp : 63 - pp;
                    refresh(F); unit_A(F, PROJ, (const u64*)(WSB + WS_BM64), OCAT, b, qi); }
            }
            if (USE_B) {
#pragma unroll 1
                for (int u = 0; u < 4; ++u) { const int b = (c & 7) * 2 + (c >> 7), pp = ((c >> 3) & 15) * 2 + (u >> 1); const int qi = (u & 1) ? pp : 63 - pp;
                    refresh(F); unit_B(F, PROJ, (const bf16_t*)(WSB + WS_KCMP), (const bf16_t*)(WSB + WS_KCMP) + 4096 * 64, OCAT, b, qi); }
            }
            if (!USE_A || !USE_B || !USE_C) {
                for (int row = F.gw; row < NTOK; row += F.NGW) { u32x4* o = (u32x4*)(OCAT + (size_t)row * 1024);
                    for (int q = F.lane; q < 128; q += 64) { const int col = q * 8; const bool z = (col < 256) ? !USE_A : (col < 512 ? !USE_B : !USE_C); if (z) o[q] = (u32x4){0u, 0u, 0u, 0u}; } }
            }
            SEAM(pb + 3);
        }
        if (IN(pb + 4)) for (int rep = 0; rep < ((l == 0 && DUP == 4) ? 2 : 1); ++rep) { if (rep) xcd_barrier(bar); refresh(F);
            const bf16_t* WB = (const bf16_t*)(WSB + WS_WBR_T + (size_t)l * 2 * MiB);
            pg8::StaticOrder S; S.init(NTOK, 1024, F.G, (int)blockIdx.x);
            { pg8::Gemm g{OCAT, WB, 512, 512, 512, 128}; pg8::EpiBranchCat E{(unsigned char*)MERG, (const unsigned char*)(WSB + WS_MG8)}; pg8::gemm_phase<pg8::EpiBranchCat, pg8::StaticOrder, true>(F.lds, g, S, E, F.wave); }
            SEAM(pb + 4);
        }
        if (IN(pb + 5)) for (int rep = 0; rep < ((l == 0 && DUP == 5) ? 2 : 1); ++rep) { if (rep) xcd_barrier(bar); refresh(F);
            pg8::Gemm g{MERG, (const bf16_t*)(WSB + WS_WOUT_T + (size_t)l * 1024 * 1024), 512, 512, 512, 128}; pg8::StaticOrder S; S.init(NTOK, 1024, F.G, (int)blockIdx.x);
            pg8::EpiWout<(l > 0)> E{X1, (l == 0) ? (const void*)args.in[0] : (const void*)(WSB + WS_X2B), mod_a + 2048, 1.f / (F8_MG2 * F8_WO)};
            pg8::gemm_phase<pg8::EpiWout<(l > 0)>, pg8::StaticOrder, true>(F.lds, g, S, E, F.wave);
            SEAM(pb + 5);
        }
#define cnt ((unsigned*)(WSB + WS_CTL) + CW_CNT + l * 64)
        if (IN(pb + 6)) for (int rep = 0; rep < ((l == 0 && DUP == 6) ? 2 : 1); ++rep) { if (rep) xcd_barrier(bar); refresh(F); phase_ln1_router(F, X1, args.in[15] + l * 1024, args.in[16] + l * 1024, mod_f, args.in[19] + (size_t)l * 1024 * 32, args.in[20] + l * 32, HB, cnt); SEAM(pb + 6); }
        if (IN(pb + 7)) for (int rep = 0; rep < ((l == 0 && DUP == 7) ? 2 : 1); ++rep) { if (rep) xcd_barrier(bar); refresh(F); phase_gather(F, cnt, HB, (unsigned char*)(WSB + WS_HS8)); SEAM(pb + 7); }
        if (IN(pb + 8)) for (int rep = 0; rep < ((l == 0 && DUP == 8) ? 2 : 1); ++rep) { if (rep) xcd_barrier(bar); refresh(F);
            build_pstart(F, cnt);
            pg8::Gemm g{(const bf16_t*)(WSB + WS_HS8), (const bf16_t*)(WSB + WS_WGU_T + (size_t)l * 32 * 2048 * 1024), 512, 512, 512, 128};
            pg8::MoeOrder S{F.G, (int)blockIdx.x, 8, (int)F.MISC[48], (const volatile LAS int*)(F.MISC + 16)};
            pg8::EpiMoe1 E{(unsigned char*)(WSB + WS_ACT), args.in[22] + (size_t)l * 32 * 2048};
            pg8::gemm_phase<pg8::EpiMoe1, pg8::MoeOrder, true>(F.lds, g, S, E, F.wave);
            SEAM(pb + 8);
        }
        if (IN(pb + 9)) for (int rep = 0; rep < ((l == 0 && DUP == 9) ? 2 : 1); ++rep) { if (rep) xcd_barrier(bar); refresh(F);
            build_pstart(F, cnt);
            pg8::Gemm g{(const bf16_t*)(WSB + WS_ACT), (const bf16_t*)(WSB + WS_WDN_T + (size_t)l * 32 * 1024 * 1024), 512, 512, 512, 128};
            pg8::MoeOrder S{F.G, (int)blockIdx.x, 4, (int)F.MISC[48], (const volatile LAS int*)(F.MISC + 16)};
            pg8::EpiMoe2 E{(unsigned char*)(WSB + WS_HS), args.in[24] + (size_t)l * 32 * 1024};
            pg8::gemm_phase<pg8::EpiMoe2, pg8::MoeOrder, true>(F.lds, g, S, E, F.wave);
            SEAM(pb + 9);
        }
        if (IN(pb + 10)) for (int rep = 0; rep < ((l == 0 && DUP == 10) ? 2 : 1); ++rep) { if (rep) xcd_barrier(bar); refresh(F);
            phase_combine(F, (const unsigned char*)(WSB + WS_HS), X1, mod_f, args.in[25] + l * 1024, args.in[26] + l * 1024, args.out, (l + 1 < DEPTH) ? MOD + (size_t)(2 * l + 2) * 16 * 3072 : nullptr, HB, (unsigned char*)(WSB + WS_HB8), (bf16_t*)(WSB + WS_X2B));
            SEAM(pb + 10);
        }
}

__global__ void __launch_bounds__(512, 2) mega_fwd(Args args) {
    extern __shared__ __attribute__((aligned(16))) unsigned char lds_raw[];
    Frame F;
    F.lds = (LAS unsigned char*)lds_raw; F.MISC = (volatile LAS unsigned*)(F.lds + LDS_MISC);
    F.tid = threadIdx.x; F.lane = F.tid & 63; F.wave = __builtin_amdgcn_readfirstlane(F.tid >> 6); F.wave0 = F.wave;
    F.G = gridDim.x; F.gw = blockIdx.x * 8 + F.wave; F.NGW = F.G * 8;
    F.ws = args.ws; F.ws0 = args.ws; F.ctl = (unsigned*)(args.ws + WS_CTL); F.in = args.in; F.out = args.out;
    for (int u = F.tid; u < (LDS_BYTES - LDS_MISC) / 4; u += 512) F.MISC[u] = 0u;
    __syncthreads();
    XcdBarrier bar = xcd_barrier_post(F.ctl + CW_BAR + args.li * XCD_BAR_WORDS, F.MISC);
    const int lo = args.ph_lo, hi = args.ph_hi;
    if (IN(0)) for (int rep = 0; rep < (DUP == 100 ? 2 : 1); ++rep) { refresh(F); phase_prologue(F); SEAM(0); }
    if (IN(1)) { refresh(F); phase_h0(F, args.in[0], MOD, HB, (unsigned char*)(WSB + WS_HB8)); SEAM(1); }

    run_layer<0>(F, args, bar, lo, hi);
    run_layer<1>(F, args, bar, lo, hi);
#undef IN
#undef SEAM
#undef WSB
#undef PROJ
#undef HB
#undef OCAT
#undef MERG
#undef X1
#undef MOD
#undef xres
#undef mod_a
#undef mod_f
#undef cnt
}

constexpr int N_LAUNCHES = 1;
extern "C" void kernel_launch(void* const* d_in, const int* in_sizes, int n_in, void* d_out, int out_size, void* d_ws, size_t ws_size, hipStream_t stream) {
    static int grid = 0;
    if (grid == 0) {
        if (n_in != 27 || out_size != NTOK * D || ws_size < WS_END) { fprintf(stderr, "kernel_launch: unexpected sizes n_in %d out %d ws %zu (need %zu)\n", n_in, out_size, ws_size, (size_t)WS_END); grid = -1; return; }
        int dev = 0, cus = 0, per_cu = 0;
        if (hipGetDevice(&dev) != hipSuccess || hipDeviceGetAttribute(&cus, hipDeviceAttributeMultiprocessorCount, dev) != hipSuccess) { grid = -1; return; }
        if (hipFuncSetAttribute((const void*)mega_fwd, hipFuncAttributeMaxDynamicSharedMemorySize, LDS_BYTES) != hipSuccess) { fprintf(stderr, "kernel_launch: hipFuncSetAttribute failed\n"); grid = -1; return; }
        if (hipOccupancyMaxActiveBlocksPerMultiprocessor(&per_cu, (const void*)mega_fwd, 512, LDS_BYTES) != hipSuccess || per_cu < 1) fprintf(stderr, "kernel_launch: occupancy query says %d\n", per_cu);
        (void)hipGetLastError();
        grid = cus;
        if (grid != 256) { fprintf(stderr, "kernel_launch: built for 256 CUs, got %d\n", cus); grid = -1; return; }
    }
    if (grid < 0) return;
    (void)hipMemsetAsync((char*)d_ws + WS_CTL, 0, CTL_BYTES, stream);
    Args a{};
    for (int i = 0; i < 27; ++i) a.in[i] = (const float*)d_in[i];
    a.out = (float*)d_out; a.ws = (unsigned char*)d_ws; a.pad = 0;
    for (int li = 0; li < N_LAUNCHES; ++li) {
        a.ph_lo = (N_LAUNCHES == 1) ? 0 : li; a.ph_hi = (N_LAUNCHES == 1) ? N_PHASES : li + 1; a.li = li;
        hipLaunchKernelGGL(mega_fwd, dim3(grid), dim3(512), LDS_BYTES, stream, a);
    }
}
```
